# Optimizing an MI355X kernel written in HIP

```python
import jax, jax.numpy as jnp
from jax import lax
import numpy as np

D_MODEL = 1024
BATCH = 1
SEQ = 16384
DEPTH = 1
DEC_BATCH = 16
DEC_SEQ = 32
PAST_LEN = 1024

CHUNK = 64
Q_BLOCK = 128

A_HEADS = 8
A_HEAD_DIM = 64
D_A = A_HEADS * A_HEAD_DIM
DECAY_LORA = 64
AAA_LORA = 64
GATE_LORA = 128
A_COLS = 3 * D_A + DECAY_LORA + AAA_LORA + GATE_LORA
A_SPLITS = (D_A, 2 * D_A, 3 * D_A, 3 * D_A + DECAY_LORA, 3 * D_A + DECAY_LORA + AAA_LORA)
LNX_EPS = A_HEAD_DIM * 1e-5

B_HEADS = 8
Q_LORA = 256
KV_LORA = 128
NOPE_DIM = 64
ROPE_DIM = 32
V_DIM = 64
D_B = B_HEADS * V_DIM
B_COLS = Q_LORA + KV_LORA + ROPE_DIM
ROPE_BASE = 10000.0
ATTN_SCALE = (NOPE_DIM + ROPE_DIM) ** -0.5
RMS_EPS = 1e-6

GATE_COLS = 2 * D_MODEL
N_IN = A_COLS + B_COLS + GATE_COLS

D_FF = -(-8 * D_MODEL // (3 * 256)) * 256
LN_EPS = 1e-5
DN_ALPHA = (2 * DEPTH) ** 0.25
DN_BETA = (8 * DEPTH) ** -0.25

kernel_name = "rwkv7_mla_gated_hybrid_stream_step"


def layer_norm(x, g, b):
    xf = x.astype(jnp.float32)
    mu = jnp.mean(xf, -1, keepdims=True)
    var = jnp.mean(jnp.square(xf - mu), -1, keepdims=True)
    return ((xf - mu) * lax.rsqrt(var + LN_EPS)).astype(x.dtype) * g + b


def rms_norm(x, g):
    xf = x.astype(jnp.float32)
    return (xf * lax.rsqrt(jnp.mean(xf * xf, -1, keepdims=True) + RMS_EPS)).astype(x.dtype) * g


def apply_rope(x, pos):
    half = ROPE_DIM // 2
    inv = ROPE_BASE ** (-jnp.arange(half, dtype=jnp.float32) / half)
    ang = pos.astype(jnp.float32)[:, None] * inv
    shape = (ang.shape[0],) + (1,) * (x.ndim - 3) + (half,)
    cos, sin = jnp.cos(ang).reshape(shape), jnp.sin(ang).reshape(shape)
    x1 = x[..., :half].astype(jnp.float32)
    x2 = x[..., half:].astype(jnp.float32)
    return jnp.concatenate([x1 * cos - x2 * sin, x1 * sin + x2 * cos], -1).astype(x.dtype)


def in_projection(x, w_in):
    p = x @ w_in
    return p[..., :A_COLS], p[..., A_COLS:A_COLS + B_COLS], p[..., A_COLS + B_COLS:]


def wkv_scan(r, w, k, v, aa, bb, s0):
    def step(S, inp):
        r_t, w_t, k_t, v_t, a_t, b_t = inp
        sa = jnp.einsum('bhvk,bhk->bhv', S, a_t)
        S = S * w_t[:, :, None, :] + sa[..., None] * b_t[:, :, None, :] + v_t[..., None] * k_t[:, :, None, :]
        return S, jnp.einsum('bhvk,bhk->bhv', S, r_t)
    xs = tuple(jnp.moveaxis(t, 1, 0) for t in (r, w, k, v, aa, bb))
    s_last, y = lax.scan(step, s0, xs)
    return s_last, jnp.moveaxis(y, 0, 1)


def rwkv_branch(p_a, shift_prev, wkv_prev, mu_shift, w0, w_w2, a0, w_a2, w_g2, k_k, k_a, r_k, lnx_g, lnx_b):
    B, T, _ = p_a.shape
    f32 = jnp.float32
    prev = jnp.concatenate([shift_prev.astype(p_a.dtype), p_a[:, :-1]], axis=1)
    xs = p_a + (prev - p_a) * mu_shift
    r, k, v, wd, ad, gd = jnp.split(xs, A_SPLITS, axis=-1)
    logw = -jax.nn.softplus(-(w0 + jnp.tanh(wd) @ w_w2).astype(f32)) - 0.5
    decay = jnp.exp(-jnp.exp(logw))
    a = jax.nn.sigmoid((a0 + ad @ w_a2).astype(f32))
    g = jax.nn.sigmoid(gd) @ w_g2
    heads = lambda t: t.astype(f32).reshape(B, T, A_HEADS, A_HEAD_DIM)
    kk = heads(k * k_k)
    kk = kk / jnp.maximum(jnp.linalg.norm(kk, axis=-1, keepdims=True), 1e-12)
    a_h = heads(a)
    k_h = heads(k.astype(f32) * (1.0 + (a - 1.0) * k_a.astype(f32)))
    r_h, v_h = heads(r), heads(v)
    s_last, y = wkv_scan(r_h, heads(decay), k_h, v_h, -kk, kk * a_h, wkv_prev.astype(f32))
    mu = jnp.mean(y, -1, keepdims=True)
    var = jnp.mean(jnp.square(y - mu), -1, keepdims=True)
    yn = ((y - mu) * lax.rsqrt(var + LNX_EPS)).reshape(B, T, D_A).astype(p_a.dtype) * lnx_g + lnx_b
    bonus = (jnp.sum(r_h * k_h * r_k.astype(f32), -1, keepdims=True) * v_h).reshape(B, T, D_A)
    out = (yn + bonus.astype(p_a.dtype)) * g
    return out, p_a[:, -1:], s_last.astype(wkv_prev.dtype)


def mla_project(p_b, pos, q_norm_g, w_uq, kv_norm_g):
    B, T, _ = p_b.shape
    cq = rms_norm(p_b[..., :Q_LORA], q_norm_g)
    ckv = rms_norm(p_b[..., Q_LORA:Q_LORA + KV_LORA], kv_norm_g)
    kpe = apply_rope(p_b[..., Q_LORA + KV_LORA:], pos)
    q = (cq @ w_uq).reshape(B, T, B_HEADS, NOPE_DIM + ROPE_DIM)
    return q[..., :NOPE_DIM], apply_rope(q[..., NOPE_DIM:], pos), ckv, kpe


def mla_expand(ckv, w_ukv):
    B, S, _ = ckv.shape
    kv = (ckv @ w_ukv).reshape(B, S, B_HEADS, NOPE_DIM + V_DIM)
    return kv[..., :NOPE_DIM], kv[..., NOPE_DIM:]


def attend(q_nope, q_pe, k_nope, k_pe, v, allowed):
    s = jnp.einsum('bqhd,bkhd->bhqk', q_nope, k_nope) + jnp.einsum('bqhr,bkr->bhqk', q_pe, k_pe)
    s = s.astype(jnp.float32) * ATTN_SCALE
    if allowed is not None:
        s = jnp.where(allowed, s, -jnp.inf)
    p = jax.nn.softmax(s, axis=-1).astype(v.dtype)
    return jnp.einsum('bhqk,bkhd->bqhd', p, v)


def mla_prompt_attention(q_nope, q_pe, k_nope, k_pe, v):
    B, S = q_nope.shape[:2]
    nb = S // Q_BLOCK
    blocks = lambda t: jnp.moveaxis(t.reshape((B, nb, Q_BLOCK) + t.shape[2:]), 1, 0)
    key_chunk = jnp.arange(S) // CHUNK

    def one_block(args):
        i, qn, qp = args
        q_chunk = (i * Q_BLOCK + jnp.arange(Q_BLOCK)) // CHUNK
        allowed = key_chunk[None, :] <= q_chunk[:, None]
        return attend(qn, qp, k_nope, k_pe, v, allowed)

    out = lax.map(one_block, (jnp.arange(nb), blocks(q_nope), blocks(q_pe)))
    return jnp.moveaxis(out, 0, 1).reshape(B, S, D_B)


def merge_and_channel_mix(x, y_a, y_b, g_cols, b_gate, w_o, ln1_g, ln1_b, w_gu, w_down, ln2_g, ln2_b):
    gates = jax.nn.sigmoid(g_cols + b_gate)
    m = gates[..., :D_MODEL] * y_a + gates[..., D_MODEL:] * y_b
    h = layer_norm(DN_ALPHA * x + m @ w_o, ln1_g, ln1_b)
    gu = h @ w_gu
    f = (jax.nn.silu(gu[..., :D_FF]) * gu[..., D_FF:]) @ w_down
    return layer_norm(DN_ALPHA * h + f, ln2_g, ln2_b)


def setup_inputs(seed: int = 0) -> dict:
    key = jax.random.key(seed)
    ks = iter(jax.random.split(key, 48))
    nrm = lambda shape, scale: jax.random.normal(next(ks), shape, jnp.float32) * scale
    return {
        "x_prompt": nrm((BATCH, SEQ, D_MODEL), 1.0),
        "x_sample": nrm((DEC_BATCH, DEC_SEQ, D_MODEL), 1.0),
        "cache_ckv": nrm((DEC_BATCH, PAST_LEN, KV_LORA), 1.0),
        "cache_kpe": nrm((DEC_BATCH, PAST_LEN, ROPE_DIM), 1.0),
        "state_wkv": nrm((DEC_BATCH, A_HEADS, A_HEAD_DIM, A_HEAD_DIM), 0.5),
        "state_shift": nrm((DEC_BATCH, 1, A_COLS), 1.0),
        "w_in": nrm((D_MODEL, N_IN), D_MODEL ** -0.5),
        "mu_shift": jax.random.uniform(next(ks), (A_COLS,), jnp.float32),
        "w0": nrm((D_A,), 0.5) - 0.5,
        "w_w2": nrm((DECAY_LORA, D_A), 0.1 * DECAY_LORA ** -0.5),
        "a0": nrm((D_A,), 0.5),
        "w_a2": nrm((AAA_LORA, D_A), 0.1 * AAA_LORA ** -0.5),
        "w_g2": nrm((GATE_LORA, D_A), GATE_LORA ** -0.5),
        "k_k": 0.85 + nrm((D_A,), 0.05),
        "k_a": 1.0 + nrm((D_A,), 0.05),
        "r_k": nrm((A_HEADS, A_HEAD_DIM), 0.1),
        "lnx_g": 1.0 + nrm((D_A,), 0.05),
        "lnx_b": nrm((D_A,), 0.02),
        "w_pa": nrm((D_A, D_MODEL), D_A ** -0.5),
        "q_norm_g": 1.0 + nrm((Q_LORA,), 0.05),
        "w_uq": nrm((Q_LORA, B_HEADS * (NOPE_DIM + ROPE_DIM)), Q_LORA ** -0.5),
        "kv_norm_g": 1.0 + nrm((KV_LORA,), 0.05),
        "w_ukv": nrm((KV_LORA, B_HEADS * (NOPE_DIM + V_DIM)), KV_LORA ** -0.5),
        "w_pb": nrm((D_B, D_MODEL), D_B ** -0.5),
        "b_gate": nrm((GATE_COLS,), 0.01),
        "w_o": nrm((D_MODEL, D_MODEL), DN_BETA * D_MODEL ** -0.5),
        "ln1_g": 1.0 + nrm((D_MODEL,), 0.05),
        "ln1_b": nrm((D_MODEL,), 0.02),
        "w_gu": nrm((D_MODEL, 2 * D_FF), D_MODEL ** -0.5),
        "w_down": nrm((D_FF, D_MODEL), DN_BETA * D_FF ** -0.5),
        "ln2_g": 1.0 + nrm((D_MODEL,), 0.05),
        "ln2_b": nrm((D_MODEL,), 0.02),
    }


def reference(x_prompt, x_sample, cache_ckv, cache_kpe, state_wkv, state_shift,
              w_in, mu_shift, w0, w_w2, a0, w_a2, w_g2, k_k, k_a, r_k, lnx_g, lnx_b, w_pa,
              q_norm_g, w_uq, kv_norm_g, w_ukv, w_pb,
              b_gate, w_o, ln1_g, ln1_b, w_gu, w_down, ln2_g, ln2_b):
    rwkv_w = (mu_shift, w0, w_w2, a0, w_a2, w_g2, k_k, k_a, r_k, lnx_g, lnx_b)
    tail_w = (b_gate, w_o, ln1_g, ln1_b, w_gu, w_down, ln2_g, ln2_b)

    y_prompt = x_prompt
    ckv_p = kpe_p = wkv_p = shift_p = None
    for _ in range(DEPTH):
        Bp, Tp, _ = y_prompt.shape
        pa, pb, pg = in_projection(y_prompt, w_in)
        shift0 = jnp.zeros((Bp, 1, A_COLS), y_prompt.dtype)
        wkv0 = jnp.zeros((Bp, A_HEADS, A_HEAD_DIM, A_HEAD_DIM), y_prompt.dtype)
        ya_p, shift_p, wkv_p = rwkv_branch(pa, shift0, wkv0, *rwkv_w)
        pos_p = jnp.arange(Tp)
        qn, qp, ckv_p, kpe_p = mla_project(pb, pos_p, q_norm_g, w_uq, kv_norm_g)
        kn, vv = mla_expand(ckv_p, w_ukv)
        yb_p = mla_prompt_attention(qn, qp, kn, kpe_p, vv)
        y_prompt = merge_and_channel_mix(y_prompt, ya_p @ w_pa, yb_p @ w_pb, pg, *tail_w)

    y_sample = x_sample
    ckv_s = kpe_s = wkv_s = shift_s = None
    for _ in range(DEPTH):
        Bs, Ts, _ = y_sample.shape
        pa, pb, pg = in_projection(y_sample, w_in)
        ya_s, shift_s, wkv_s = rwkv_branch(pa, state_shift, state_wkv, *rwkv_w)
        pos_s = PAST_LEN + jnp.arange(Ts)
        qn, qp, ckv_s, kpe_s = mla_project(pb, pos_s, q_norm_g, w_uq, kv_norm_g)
        ckv_all = jnp.concatenate([cache_ckv.astype(ckv_s.dtype), ckv_s], axis=1)
        kpe_all = jnp.concatenate([cache_kpe.astype(kpe_s.dtype), kpe_s], axis=1)
        kn, vv = mla_expand(ckv_all, w_ukv)
        yb_s = attend(qn, qp, kn, kpe_all, vv, None).reshape(Bs, Ts, D_B)
        y_sample = merge_and_channel_mix(y_sample, ya_s @ w_pa, yb_s @ w_pb, pg, *tail_w)

    return (y_prompt, y_sample, ckv_p, kpe_p, wkv_p, shift_p, ckv_s, kpe_s, wkv_s, shift_s)
```

```cpp
#include <hip/hip_runtime.h>
#include <hip/hip_cooperative_groups.h>
#include <cstdio>
#include <cstdint>
namespace cg = cooperative_groups;


#ifndef PROBE_DUP
#define PROBE_DUP -1
#endif
#ifndef MULTI_LAUNCH
#define MULTI_LAUNCH 0
#endif

#define DI __device__ __forceinline__
typedef unsigned short bf16_t;
typedef short bf16x8 __attribute__((ext_vector_type(8)));
typedef short s16x4 __attribute__((ext_vector_type(4)));
typedef float f32x16 __attribute__((ext_vector_type(16)));
typedef float f32x4 __attribute__((ext_vector_type(4)));
typedef float f32x2 __attribute__((ext_vector_type(2)));
typedef unsigned u32x4 __attribute__((ext_vector_type(4)));
typedef unsigned u32x2 __attribute__((ext_vector_type(2)));
typedef __bf16 bf2_t __attribute__((ext_vector_type(2)));

constexpr int NP = 16384, NS = 512, NT = NP + NS;
constexpr int DM = 1024, ACOLS = 1792, BCOLS = 416, PABC = ACOLS + BCOLS  , NIN = 4256;
constexpr int DFF = 2816;
constexpr int PAST = 1024, DSEQ = 32, DB = 16, SKV = PAST + DSEQ  ;
constexpr int NKV = NP + DB * SKV  , NKVP = NKV + 64;
constexpr float DN_ALPHA = 1.189207115002721f;
constexpr float QSCALE = 0.10206207261596575f * 1.4426950408889634f;

constexpr size_t al256(size_t x) { return (x + 255) & ~(size_t)255; }
constexpr size_t O_WIN = 0;
constexpr size_t O_WUQ = O_WIN + al256((size_t)NIN * 1024 * 2);
constexpr size_t O_WUKV = O_WUQ + al256(768 * 256 * 2);
constexpr size_t O_WPA = O_WUKV + al256(1024 * 128 * 2);
constexpr size_t O_WPB = O_WPA + al256(1024 * 512 * 2);
constexpr size_t O_WO = O_WPB + al256(1024 * 512 * 2);
constexpr size_t O_WGU = O_WO + al256(1024 * 1024 * 2);
constexpr size_t O_WDN = O_WGU + al256((size_t)5632 * 1024 * 2);
constexpr size_t O_WW2 = O_WDN + al256((size_t)1024 * 2816 * 2);
constexpr size_t O_WA2 = O_WW2 + al256(512 * 64 * 2);
constexpr size_t O_WG2 = O_WA2 + al256(512 * 64 * 2);
constexpr size_t O_ROPE = O_WG2 + al256(512 * 128 * 2);
constexpr size_t O_CTR = O_ROPE + al256((size_t)NT * 32 * 4);
constexpr size_t O_PAB = O_CTR + 16384;
constexpr size_t SZ_T512 = (size_t)NT * 512 * 2;
constexpr size_t O_SIN = O_PAB + al256((size_t)NT * PABC * 2);
constexpr size_t O_G = O_SIN + 6 * SZ_T512;
constexpr size_t O_RK = O_G + SZ_T512;
constexpr size_t O_KNB = O_RK + al256((size_t)NT * 8 * 4);
constexpr size_t O_KPEB = O_KNB + al256((size_t)8 * NKVP * 64 * 2);
constexpr int SCC = 4, SCL = NP / SCC;
constexpr size_t O_GH = O_KPEB + al256((size_t)NKVP * 32 * 2);
constexpr size_t O_SST = O_GH + 2 * (size_t)8 * SCC * 4096 * 4;
constexpr size_t WS_END = O_SST + (size_t)SCC * 8 * 4096 * 2;
constexpr size_t O_Y = O_PAB;
constexpr size_t O_E = O_Y + SZ_T512;
constexpr size_t O_YB = O_Y + (size_t)NT * 512 * 4;
constexpr size_t O_YA = O_YB + SZ_T512;
constexpr size_t O_H = O_PAB;
constexpr size_t O_M = O_SIN;
constexpr size_t O_Z = O_SIN + (size_t)NT * 1024 * 2;
constexpr size_t O_Z2 = O_PAB + (size_t)NT * 1024 * 2;
constexpr size_t O_ACT = O_SIN;
constexpr size_t OO_XB = 0;
constexpr size_t OO_Q = 0;
constexpr size_t OO_VT = (size_t)NT * 768 * 2;
constexpr size_t F_Y = 0, F_CKVP = (size_t)NT * 1024, F_KPEP = F_CKVP + (size_t)NP * 128, F_WKVP = F_KPEP + (size_t)NP * 32,
                 F_SHP = F_WKVP + 32768, F_CKVS = F_SHP + 1792, F_KPES = F_CKVS + (size_t)NS * 128, F_WKVS = F_KPES + (size_t)NS * 32,
                 F_SHS = F_WKVS + (size_t)DB * 32768;

constexpr int LDS_BYTES = 120 * 1024;
constexpr int NTHREADS = 512;

struct Params {
  const float* in[32];
  float* out;
  unsigned char* ws;
};

DI int tidx() { int t = threadIdx.x; asm volatile("" : "+v"(t)); return t; }
DI unsigned pk2(float a, float b) { f32x2 v = {a, b}; bf2_t r = __builtin_convertvector(v, bf2_t); return __builtin_bit_cast(unsigned, r); }
DI bf16_t f2bf(float a) { return (bf16_t)(pk2(a, 0.f) & 0xffffu); }
DI float bf2f(bf16_t x) { return __uint_as_float(((unsigned)x) << 16); }
DI void unpack8(u32x4 v, float* f) {
#pragma unroll
  for (int j = 0; j < 4; ++j) { f[2 * j] = __uint_as_float(v[j] << 16); f[2 * j + 1] = __uint_as_float(v[j] & 0xffff0000u); }
}
DI u32x4 pack8(const float* f) { u32x4 o; o[0] = pk2(f[0], f[1]); o[1] = pk2(f[2], f[3]); o[2] = pk2(f[4], f[5]); o[3] = pk2(f[6], f[7]); return o; }
DI float sigmoidf_(float x) { return 1.f / (1.f + __expf(-x)); }
DI float dpp_sum16(float x) {
  x += __builtin_bit_cast(float, __builtin_amdgcn_update_dpp(0, __builtin_bit_cast(int, x), 0xB1, 0xF, 0xF, true));
  x += __builtin_bit_cast(float, __builtin_amdgcn_update_dpp(0, __builtin_bit_cast(int, x), 0x4E, 0xF, 0xF, true));
  x += __builtin_bit_cast(float, __builtin_amdgcn_update_dpp(0, __builtin_bit_cast(int, x), 0x141, 0xF, 0xF, true));
  x += __builtin_bit_cast(float, __builtin_amdgcn_update_dpp(0, __builtin_bit_cast(int, x), 0x140, 0xF, 0xF, true));
  return x;
}
DI float sum32(float x) { x = dpp_sum16(x); x += __shfl_xor(x, 16); return x; }
DI float wave_sum(float v) {
#pragma unroll
  for (int o = 1; o < 64; o <<= 1) v += __shfl_xor(v, o);
  return v;
}
DI int crow(int i, int h) { return (i & 3) + 8 * (i >> 2) + 4 * h; }
#define MFMA32(a, b, c) __builtin_amdgcn_mfma_f32_32x32x16_bf16((a), (b), (c), 0, 0, 0)
DI int slot_of_token(int t) { return t < NP ? t : NP + ((t - NP) >> 5) * SKV + PAST + ((t - NP) & 31); }
DI const float* xrow(const Params& p, int t) { return t < NP ? p.in[0] + (size_t)t * DM : p.in[1] + (size_t)(t - NP) * DM; }

DI void conv_T(const float* W, int K, int N, bf16_t* WT, bool perm, int gtid, int gsz) {
  const int ntask = (K / 8) * N;
  for (int id = gtid; id < ntask; id += gsz) {
    const int kc = id / N, n = id - kc * N, k0 = kc * 8;
    float f[8];
#pragma unroll
    for (int j = 0; j < 8; ++j) f[j] = W[(size_t)(k0 + j) * N + n];
    int row = n;
    if (perm) { const int nt = n >= DFF ? 1 : 0, j = n - nt * DFF; row = 128 * (j >> 6) + 64 * ((j & 63) >> 5) + 32 * nt + (j & 31); }
    *(u32x4*)(WT + (size_t)row * K + k0) = pack8(f);
  }
}
DI void conv_x(const Params& p, bf16_t* XB, int gtid, int gsz) {
  for (int id = gtid; id < NT * 128; id += gsz) {
    const int t = id >> 7, c = (id & 127) * 8;
    const float* src = xrow(p, t) + c;
    f32x4 a = *(const f32x4*)src, b = *(const f32x4*)(src + 4);
    float f[8] = {a[0], a[1], a[2], a[3], b[0], b[1], b[2], b[3]};
    *(u32x4*)(XB + (size_t)t * DM + c) = pack8(f);
  }
}
DI void phase0(const Params& p) {
  const int gtid = blockIdx.x * NTHREADS + tidx(), gsz = gridDim.x * NTHREADS;
  unsigned char* ws = p.ws;
  if (gtid < 64) ((unsigned*)(ws + O_CTR))[gtid] = 0u;
  conv_T(p.in[6], 1024, NIN, (bf16_t*)(ws + O_WIN), false, gtid, gsz);
  conv_T(p.in[20], 256, 768, (bf16_t*)(ws + O_WUQ), false, gtid, gsz);
  conv_T(p.in[22], 128, 1024, (bf16_t*)(ws + O_WUKV), false, gtid, gsz);
  conv_T(p.in[18], 512, 1024, (bf16_t*)(ws + O_WPA), false, gtid, gsz);
  conv_T(p.in[23], 512, 1024, (bf16_t*)(ws + O_WPB), false, gtid, gsz);
  conv_T(p.in[25], 1024, 1024, (bf16_t*)(ws + O_WO), false, gtid, gsz);
  conv_T(p.in[28], 1024, 5632, (bf16_t*)(ws + O_WGU), true, gtid, gsz);
  conv_T(p.in[29], 2816, 1024, (bf16_t*)(ws + O_WDN), false, gtid, gsz);
  conv_T(p.in[9], 64, 512, (bf16_t*)(ws + O_WW2), false, gtid, gsz);
  conv_T(p.in[11], 64, 512, (bf16_t*)(ws + O_WA2), false, gtid, gsz);
  conv_T(p.in[12], 128, 512, (bf16_t*)(ws + O_WG2), false, gtid, gsz);
  conv_x(p, (bf16_t*)((unsigned char*)p.out + OO_XB), gtid, gsz);
  float* rope = (float*)(ws + O_ROPE);
  for (int id = gtid; id < NT * 16; id += gsz) {
    const int t = id >> 4, j = id & 15;
    const int pos = t < NP ? t : PAST + ((t - NP) & 31);
    const float inv = (float)exp2(-(double)j * (13.287712379549449 / 16.0));
    const float ang = (float)pos * inv;
    const double x = (double)ang;
    const double n = rint(x * 0.15915494309189535);
    const float red = (float)(x - n * 6.283185307179586);
    rope[t * 32 + j] = __cosf(red);
    rope[t * 32 + 16 + j] = __sinf(red);
  }
  bf16_t* kpeb = (bf16_t*)(ws + O_KPEB);
  for (int id = gtid; id < DB * PAST * 4; id += gsz) {
    const int row = id >> 2, ch = id & 3, b = row >> 10, j = row & 1023;
    const float* src = p.in[3] + (size_t)row * 32 + ch * 8;
    f32x4 a = *(const f32x4*)src, c = *(const f32x4*)(src + 4);
    float f[8] = {a[0], a[1], a[2], a[3], c[0], c[1], c[2], c[3]};
    *(u32x4*)(kpeb + (size_t)(NP + b * SKV + j) * 32 + ch * 8) = pack8(f);
  }
  bf16_t* knb = (bf16_t*)(ws + O_KNB);
  for (int id = gtid; id < 64 * 32; id += gsz) kpeb[(size_t)NKV * 32 + id] = 0;
  for (int id = gtid; id < 8 * 64 * 64; id += gsz) {
    const int h = id >> 12, rem = id & 4095;
    knb[((size_t)h * NKVP + NKV) * 64 + rem] = 0;
  }
}

template <int TM, int TN, bool ZERO = true>
DI void gemm_mainloop(const bf16_t* __restrict__ A, int lda, const bf16_t* __restrict__ Bt, int ldb, int K, int m0, int n0, int nmax,
                      f32x16 (&acc)[TM][TN], unsigned char* lds) {
  constexpr int BM = 128 * TM, BN = 64 * TN, ACH = BM * 8 / NTHREADS, BCH = BN * 8 / NTHREADS;
  constexpr int ABYTES = BM * 144, STAGE = (BM + BN) * 144;
  static_assert(2 * STAGE <= LDS_BYTES, "lds");
  const int tid = tidx(), wave = __builtin_amdgcn_readfirstlane(tid >> 6), lane = tid & 63, r = lane & 31, h = lane >> 5, wm = wave & 3, wn = wave >> 2;
  const bf16_t* ap[ACH]; const bf16_t* bp[BCH];
  int aoff[ACH], boff[BCH];
#pragma unroll
  for (int i = 0; i < ACH; ++i) { const int id = tid + NTHREADS * i, row = id >> 3, c = id & 7; ap[i] = A + (size_t)(m0 + row) * lda + c * 8; aoff[i] = row * 144 + c * 16; }
#pragma unroll
  for (int i = 0; i < BCH; ++i) { const int id = tid + NTHREADS * i, row = id >> 3, c = id & 7; int br = n0 + row; br = br < nmax ? br : nmax - 1; bp[i] = Bt + (size_t)br * ldb + c * 8; boff[i] = ABYTES + row * 144 + c * 16; }
  if (ZERO) {
#pragma unroll
  for (int tm = 0; tm < TM; ++tm)
#pragma unroll
    for (int tn = 0; tn < TN; ++tn)
#pragma unroll
      for (int i = 0; i < 16; ++i) acc[tm][tn][i] = 0.f;
  }
  u32x4 ra0[ACH], rb0[BCH], ra1[ACH], rb1[BCH];
#pragma unroll
  for (int i = 0; i < ACH; ++i) ra0[i] = *(const u32x4*)(ap[i]);
#pragma unroll
  for (int i = 0; i < BCH; ++i) rb0[i] = *(const u32x4*)(bp[i]);
#pragma unroll
  for (int i = 0; i < ACH; ++i) ra1[i] = *(const u32x4*)(ap[i] + 64);
#pragma unroll
  for (int i = 0; i < BCH; ++i) rb1[i] = *(const u32x4*)(bp[i] + 64);
#pragma unroll
  for (int i = 0; i < ACH; ++i) *(u32x4*)(lds + aoff[i]) = ra0[i];
#pragma unroll
  for (int i = 0; i < BCH; ++i) *(u32x4*)(lds + boff[i]) = rb0[i];
  __syncthreads();
  const int nk = K >> 6;
  const int a_rd = (wm * 32 * TM + r) * 144 + h * 16, b_rd = ABYTES + (wn * 32 * TN + r) * 144 + h * 16;
  auto compute = [&](const unsigned char* cur) {
#pragma unroll
    for (int ks = 0; ks < 4; ++ks) {
      bf16x8 af[TM], bfr[TN];
#pragma unroll
      for (int tm = 0; tm < TM; ++tm) af[tm] = *(const bf16x8*)(cur + a_rd + tm * 32 * 144 + ks * 32);
#pragma unroll
      for (int tn = 0; tn < TN; ++tn) bfr[tn] = *(const bf16x8*)(cur + b_rd + tn * 32 * 144 + ks * 32);
#pragma unroll
      for (int tm = 0; tm < TM; ++tm)
#pragma unroll
        for (int tn = 0; tn < TN; ++tn) acc[tm][tn] = MFMA32(bfr[tn], af[tm], acc[tm][tn]);
    }
  };
  for (int kt = 0; kt < nk; kt += 2) {
    if (kt + 2 < nk) {
      const int ko = (kt + 2) * 64;
#pragma unroll
      for (int i = 0; i < ACH; ++i) ra0[i] = *(const u32x4*)(ap[i] + ko);
#pragma unroll
      for (int i = 0; i < BCH; ++i) rb0[i] = *(const u32x4*)(bp[i] + ko);
    }
    __builtin_amdgcn_sched_barrier(0);
    compute(lds);
    __builtin_amdgcn_sched_barrier(0);
#pragma unroll
    for (int i = 0; i < ACH; ++i) *(u32x4*)(lds + STAGE + aoff[i]) = ra1[i];
#pragma unroll
    for (int i = 0; i < BCH; ++i) *(u32x4*)(lds + STAGE + boff[i]) = rb1[i];
    __syncthreads();
    if (kt + 3 < nk) {
      const int ko = (kt + 3) * 64;
#pragma unroll
      for (int i = 0; i < ACH; ++i) ra1[i] = *(const u32x4*)(ap[i] + ko);
#pragma unroll
      for (int i = 0; i < BCH; ++i) rb1[i] = *(const u32x4*)(bp[i] + ko);
    }
    __builtin_amdgcn_sched_barrier(0);
    compute(lds + STAGE);
    __builtin_amdgcn_sched_barrier(0);
    if (kt + 2 < nk) {
#pragma unroll
      for (int i = 0; i < ACH; ++i) *(u32x4*)(lds + aoff[i]) = ra0[i];
#pragma unroll
      for (int i = 0; i < BCH; ++i) *(u32x4*)(lds + boff[i]) = rb0[i];
    }
    __syncthreads();
  }
}

template <int TM, int TN, int OUTC, class F>
DI void epilogue_bf16(const f32x16 (&acc)[TM][TN], unsigned char* lds, bf16_t* out, int ldo, int m0, int c0, int cmax, F f) {
  constexpr int BM = 128 * TM, STRIDE = OUTC * 2 + 16, TNO = OUTC / (32 * 2);
  const int tid = tidx(), wave = __builtin_amdgcn_readfirstlane(tid >> 6), lane = tid & 63, r = lane & 31, h = lane >> 5, wm = wave & 3, wn = wave >> 2;
#pragma unroll
  for (int tm = 0; tm < TM; ++tm)
#pragma unroll
    for (int tn = 0; tn < TNO; ++tn)
#pragma unroll
      for (int g = 0; g < 4; ++g) {
        const int rowl = wm * 32 * TM + tm * 32 + r, coll = wn * 32 * TNO + tn * 32 + 8 * g + 4 * h;
        const f32x4 o = f(tm, tn, g, rowl, coll);
        u32x2 w; w[0] = pk2(o[0], o[1]); w[1] = pk2(o[2], o[3]);
        *(u32x2*)(lds + rowl * STRIDE + coll * 2) = w;
      }
  __syncthreads();
  constexpr int CPR = OUTC / 8;
#pragma unroll
  for (int j = 0; j < BM * CPR / NTHREADS; ++j) {
    const int id = tid + NTHREADS * j, row = id / CPR, c = id % CPR;
    if (c0 + c * 8 < cmax) *(u32x4*)(out + (size_t)(m0 + row) * ldo + c0 + c * 8) = *(const u32x4*)(lds + row * STRIDE + c * 16);
  }
  __syncthreads();
}
DI f32x4 acc4(const f32x16& a, int g) { return (f32x4){a[4 * g], a[4 * g + 1], a[4 * g + 2], a[4 * g + 3]}; }

struct TileIter {
  int nM, nN, total, L, Lend, step;
  DI void init(int nM_, int nN_) {
    nM = nM_; nN = nN_; total = nM * nN;
    const int nx = (gridDim.x & 7) == 0 ? 8 : 1, x = blockIdx.x % nx, local = blockIdx.x / nx;
    step = gridDim.x / nx;
    const int per = (total + nx - 1) / nx;
    L = x * per + local; Lend = (x + 1) * per < total ? (x + 1) * per : total;
  }
  DI bool next(int& tmi, int& tni) {
    if (L >= Lend) return false;
    const int fb = nM >> 2, fullcnt = fb * 4 * nN;
    if (L < fullcnt) { const int band = L / (4 * nN), jj = L - band * 4 * nN; tni = jj >> 2; tmi = band * 4 + (jj & 3); }
    else { const int l2 = L - fullcnt, bm = nM & 3; tni = l2 / bm; tmi = fb * 4 + l2 % bm; }
    L += step; return true;
  }
};

DI void phase1(const Params& p, unsigned char* lds) {
  const bf16_t* XB = (const bf16_t*)((unsigned char*)p.out + OO_XB);
  const bf16_t* WT = (const bf16_t*)(p.ws + O_WIN);
  bf16_t* PAB = (bf16_t*)(p.ws + O_PAB);
  constexpr int NMT = NT / 256, NNT = (PABC + 127) / 128;
  const int lane = tidx() & 63, wave = __builtin_amdgcn_readfirstlane(tidx() >> 6), r = lane & 31, h = lane >> 5, wm = wave & 3, wn = wave >> 2;
  TileIter ti; ti.init(NMT, NNT);
  int tmi, tni;
  while (ti.next(tmi, tni)) {
    const int m0 = tmi * 256, n0 = tni * 128;
    f32x16 acc[2][2];
    gemm_mainloop<2, 2>(XB, DM, WT, DM, DM, m0, n0, PABC, acc, lds);
    if (m0 + 256 > NP - 1 && n0 < ACOLS) {
#pragma unroll
      for (int tm = 0; tm < 2; ++tm) {
        const int row = m0 + wm * 64 + tm * 32 + r;
        const bool lastp = row == NP - 1, lasts = row >= NP && ((row - NP) & 31) == 31;
        if (lastp || lasts) {
          float* dst = lastp ? p.out + F_SHP : p.out + F_SHS + (size_t)((row - NP) >> 5) * ACOLS;
#pragma unroll
          for (int tn = 0; tn < 2; ++tn)
#pragma unroll
            for (int g = 0; g < 4; ++g) {
              const int col = n0 + wn * 64 + tn * 32 + 8 * g + 4 * h;
              if (col < ACOLS) *(f32x4*)(dst + col) = acc4(acc[tm][tn], g);
            }
        }
      }
    }
    epilogue_bf16<2, 2, 128>(acc, lds, PAB, PABC, m0, n0, PABC, [&](int tm, int tn, int g, int, int) { return acc4(acc[tm][tn], g); });
  }
}

constexpr int L2_LORA = 0, L2_K = L2_LORA + 32 * 528, L2_R = L2_K + 32 * 1040, L2A_STG = L2_R + 32 * 1040, L2A_END = L2A_STG + 8 * 32 * 144;
constexpr int L2_CQ = 0, L2_CKV = L2_CQ + 32 * 528, L2B_STG = L2_CKV + 32 * 272, L2B_END = L2B_STG + 8 * 32 * 208;
static_assert(L2A_END <= LDS_BYTES && L2B_END <= LDS_BYTES, "lds p2");
template <int NTL, class F>
DI void stage_store16(unsigned char* stg, int lane, bf16_t* dst  , unsigned row_stride  , F f) {
  constexpr int RS = NTL * 64 + 16, CPR = NTL * 4;
  const int r = lane & 31, h = lane >> 5;
#pragma unroll
  for (int nt = 0; nt < NTL; ++nt)
#pragma unroll
    for (int i = 0; i < 16; ++i) *(unsigned short*)(stg + crow(i, h) * RS + (nt * 32 + r) * 2) = f(nt, i);
  __syncthreads();
#pragma unroll
  for (int j = 0; j < 32 * CPR / 64; ++j) {
    const int id = lane + 64 * j, row = id / CPR, ch = id % CPR;
    *(u32x4*)(dst + (size_t)row * row_stride + ch * 8) = *(const u32x4*)(stg + row * RS + ch * 16);
  }
  __syncthreads();
}

template <int NTL, int KS>
DI void mm32(const unsigned char* ldsA, int strideB, const bf16_t* Bt, int ldb, int lane, f32x16 (&acc)[NTL]) {
  constexpr int KG = (NTL * KS <= 16) ? KS : (NTL <= 2 ? 4 : (NTL == 3 ? 4 : 2)), NG = KS / KG;
  const int r = lane & 31, h = lane >> 5;
#pragma unroll
  for (int nt = 0; nt < NTL; ++nt)
#pragma unroll
    for (int i = 0; i < 16; ++i) acc[nt][i] = 0.f;
  bf16x8 bq[2][KG][NTL];
  const bf16_t* bp = Bt + (size_t)r * ldb + h * 8;
#pragma unroll
  for (int k = 0; k < KG; ++k)
#pragma unroll
    for (int nt = 0; nt < NTL; ++nt) bq[0][k][nt] = *(const bf16x8*)(bp + (size_t)(nt * 32) * ldb + k * 16);
#pragma unroll
  for (int g = 0; g < NG; ++g) {
    if (g + 1 < NG) {
#pragma unroll
      for (int k = 0; k < KG; ++k)
#pragma unroll
        for (int nt = 0; nt < NTL; ++nt) bq[(g + 1) & 1][k][nt] = *(const bf16x8*)(bp + (size_t)(nt * 32) * ldb + ((g + 1) * KG + k) * 16);
    }
    __builtin_amdgcn_sched_barrier(0);
#pragma unroll
    for (int k = 0; k < KG; ++k) {
      const bf16x8 a = *(const bf16x8*)(ldsA + r * strideB + (g * KG + k) * 32 + h * 16);
#pragma unroll
      for (int nt = 0; nt < NTL; ++nt) acc[nt] = MFMA32(a, bq[g & 1][k][nt], acc[nt]);
    }
    __builtin_amdgcn_sched_barrier(0);
  }
}

DI void kv_expand(const Params& p, unsigned char* lds, int w, int lane, int slot0) {
  const int r = lane & 31, h = lane >> 5;
  bf16_t* knb = (bf16_t*)(p.ws + O_KNB);
  bf16_t* vT = (bf16_t*)((unsigned char*)p.out + OO_VT);
  f32x16 acc[4];
  mm32<4, 8>(lds + L2_CKV, 272, (const bf16_t*)(p.ws + O_WUKV) + (size_t)(128 * w) * 128, 128, lane, acc);
  stage_store16<2>((unsigned char*)lds + L2B_STG + w * (32 * 208), lane, knb + ((size_t)w * NKVP + slot0) * 64, 64, [&](int nt, int i) { return f2bf(acc[nt][i]); });
#pragma unroll
  for (int nt = 2; nt < 4; ++nt)
#pragma unroll
    for (int g = 0; g < 4; ++g) {
      u32x2 o; o[0] = pk2(acc[nt][4 * g], acc[nt][4 * g + 1]); o[1] = pk2(acc[nt][4 * g + 2], acc[nt][4 * g + 3]);
      *(u32x2*)(vT + ((unsigned)w * 64 + (nt - 2) * 32 + r) * (unsigned)NKVP + slot0 + 8 * g + 4 * h) = o;
    }
}

DI void p2_token_tile_a(const Params& p, unsigned char* lds, int tile) {
  const int tid = tidx(), wave = __builtin_amdgcn_readfirstlane(tid >> 6), lane = tid & 63, r = lane & 31, h = lane >> 5;
  const int t0 = tile * 32;
  unsigned char* ws = p.ws;
  const bf16_t* PAB = (const bf16_t*)(ws + O_PAB);
  bf16_t* SR = (bf16_t*)(ws + O_SIN);
  bf16_t* SK = SR + (size_t)NT * 512; bf16_t* SV = SK + (size_t)NT * 512; bf16_t* SA = SV + (size_t)NT * 512; bf16_t* SB = SA + (size_t)NT * 512;
  _Float16* SW = (_Float16*)(SB + (size_t)NT * 512);
  bf16_t* G = (bf16_t*)(ws + O_G);
  float* RK = (float*)(ws + O_RK);
  const float* rope = (const float*)(ws + O_ROPE);
#pragma unroll 1
  for (int bt = 0; bt < 2; ++bt) {
    u32x4 rawp[7], rawq[7]; f32x4 mu0[7], mu1[7];
#pragma unroll
    for (int it = 0; it < 7; ++it) {
      const int task = tid + NTHREADS * (bt * 7 + it);
      const int tl = task / 224, ch = task - tl * 224, c0 = ch * 8, t = t0 + tl;
      rawp[it] = *(const u32x4*)(PAB + (size_t)t * PABC + c0);
      rawq[it] = *(const u32x4*)(PAB + (size_t)(t > 0 ? t - 1 : 0) * PABC + c0);
      mu0[it] = *(const f32x4*)(p.in[7] + c0); mu1[it] = *(const f32x4*)(p.in[7] + c0 + 4);
    }
#pragma unroll
    for (int it = 0; it < 7; ++it) {
      const int task = tid + NTHREADS * (bt * 7 + it);
      const int tl = task / 224, ch = task - tl * 224, c0 = ch * 8, t = t0 + tl;
      float pv[8], pr[8];
      unpack8(rawp[it], pv);
      unpack8(rawq[it], pr);
      if (t == 0) {
#pragma unroll
        for (int j = 0; j < 8; ++j) pr[j] = 0.f;
      } else if (t >= NP && ((t - NP) & 31) == 0) {
        const float* sp = p.in[5] + (size_t)((t - NP) >> 5) * ACOLS + c0;
        const f32x4 a = *(const f32x4*)sp, b = *(const f32x4*)(sp + 4);
        pr[0] = a[0]; pr[1] = a[1]; pr[2] = a[2]; pr[3] = a[3]; pr[4] = b[0]; pr[5] = b[1]; pr[6] = b[2]; pr[7] = b[3];
      }
      const float mm[8] = {mu0[it][0], mu0[it][1], mu0[it][2], mu0[it][3], mu1[it][0], mu1[it][1], mu1[it][2], mu1[it][3]};
      float xs[8];
#pragma unroll
      for (int j = 0; j < 8; ++j) xs[j] = pv[j] + (pr[j] - pv[j]) * mm[j];
      if (c0 < 512) {
        const u32x4 o = pack8(xs);
        *(u32x4*)(SR + (size_t)t * 512 + c0) = o;
        *(u32x4*)(lds + L2_R + tl * 1040 + c0 * 2) = o;
      } else if (c0 < 1024) {
        *(u32x4*)(lds + L2_K + tl * 1040 + (c0 - 512) * 2) = pack8(xs);
      } else if (c0 < 1536) {
        *(u32x4*)(SV + (size_t)t * 512 + (c0 - 1024)) = pack8(xs);
      } else {
        if (c0 < 1600) {
#pragma unroll
          for (int j = 0; j < 8; ++j) { const float e = __expf(2.f * xs[j]); xs[j] = 1.f - 2.f / (e + 1.f); }
        } else if (c0 >= 1664) {
#pragma unroll
          for (int j = 0; j < 8; ++j) xs[j] = sigmoidf_(xs[j]);
        }
        *(u32x4*)(lds + L2_LORA + tl * 528 + (c0 - 1536) * 2) = pack8(xs);
      }
    }
  }
  __syncthreads();
  const int w = wave, cb = 64 * w;
  {
    int r = (tidx() & 31);
    f32x16 acc[2];
    mm32<2, 4>(lds + L2_LORA, 528, (const bf16_t*)(ws + O_WW2) + (size_t)cb * 64, 64, lane, acc);
    const float w00 = p.in[8][cb + r], w01 = p.in[8][cb + 32 + r];
    stage_store16<2>(lds + L2A_STG + w * (32 * 144), lane, (bf16_t*)SW + (size_t)t0 * 512 + cb, 512, [&](int nt, int i) {
      const float z = (nt ? w01 : w00) + acc[nt][i];
      const float sp = fmaxf(-z, 0.f) + __logf(1.f + __expf(-fabsf(z)));
      const float dec = __expf(-__expf(-sp - 0.5f));
      return __builtin_bit_cast(unsigned short, (_Float16)dec);
    });
  }
  __syncthreads();
  {
    int r = (tidx() & 31);
    f32x16 acc[2];
    mm32<2, 4>(lds + L2_LORA + 128, 528, (const bf16_t*)(ws + O_WA2) + (size_t)cb * 64, 64, lane, acc);
    float kkv[2][16];
#pragma unroll
    for (int nt = 0; nt < 2; ++nt) {
      const int c = cb + nt * 32 + r;
      const float a0 = p.in[10][c], kkc = p.in[13][c];
#pragma unroll
      for (int i = 0; i < 16; ++i) {
        acc[nt][i] = sigmoidf_(a0 + acc[nt][i]);
        kkv[nt][i] = bf2f(*(const bf16_t*)(lds + L2_K + crow(i, h) * 1040 + c * 2)) * kkc;
      }
    }
#pragma unroll
    for (int i = 0; i < 16; ++i) {
      const float nsq = sum32(kkv[0][i] * kkv[0][i] + kkv[1][i] * kkv[1][i]);
      const float inv = 1.f / fmaxf(sqrtf(nsq), 1e-12f);
      kkv[0][i] *= inv; kkv[1][i] *= inv;
      __builtin_amdgcn_sched_barrier(0);
    }
    const int c0 = cb + r, c1 = cb + 32 + r;
    const float ka0 = p.in[14][c0], ka1 = p.in[14][c1], rk0 = p.in[15][c0], rk1 = p.in[15][c1];
    unsigned char* stg = lds + L2A_STG + w * (32 * 144);
    stage_store16<2>(stg, lane, SA + (size_t)t0 * 512 + cb, 512, [&](int nt, int i) { return f2bf(-kkv[nt][i]); });
    stage_store16<2>(stg, lane, SB + (size_t)t0 * 512 + cb, 512, [&](int nt, int i) { return f2bf(kkv[nt][i] * acc[nt][i]); });
#pragma unroll
    for (int i = 0; i < 16; ++i) {
      const int tl = crow(i, h);
      const float kr0 = bf2f(*(const bf16_t*)(lds + L2_K + tl * 1040 + c0 * 2)), kr1 = bf2f(*(const bf16_t*)(lds + L2_K + tl * 1040 + c1 * 2));
      const float kh0 = kr0 * (1.f + (acc[0][i] - 1.f) * ka0), kh1 = kr1 * (1.f + (acc[1][i] - 1.f) * ka1);
      kkv[0][i] = kh0; kkv[1][i] = kh1;
      const float rr0 = bf2f(*(const bf16_t*)(lds + L2_R + tl * 1040 + c0 * 2)), rr1 = bf2f(*(const bf16_t*)(lds + L2_R + tl * 1040 + c1 * 2));
      const float sb = sum32(rr0 * kh0 * rk0 + rr1 * kh1 * rk1);
      if (r == 0) RK[(unsigned)(t0 + tl) * 8u + w] = sb;
    }
    stage_store16<2>(stg, lane, SK + (size_t)t0 * 512 + cb, 512, [&](int nt, int i) { return f2bf(kkv[nt][i]); });
  }
  __syncthreads();
  {
    int r = (tidx() & 31);
    f32x16 acc[2];
    mm32<2, 8>(lds + L2_LORA + 256, 528, (const bf16_t*)(ws + O_WG2) + (size_t)cb * 128, 128, lane, acc);
    stage_store16<2>(lds + L2A_STG + w * (32 * 144), lane, G + (size_t)t0 * 512 + cb, 512, [&](int nt, int i) { return f2bf(acc[nt][i]); });
  }
  __syncthreads();
}

DI void p2_token_tile_b(const Params& p, unsigned char* lds, int tile) {
  const int tid = tidx(), wave = __builtin_amdgcn_readfirstlane(tid >> 6), lane = tid & 63, r = lane & 31, h = lane >> 5;
  const int t0 = tile * 32;
  unsigned char* ws = p.ws;
  const bf16_t* PAB = (const bf16_t*)(ws + O_PAB);
  bf16_t* SR = (bf16_t*)(ws + O_SIN);
  bf16_t* SK = SR + (size_t)NT * 512; bf16_t* SV = SK + (size_t)NT * 512; bf16_t* SA = SV + (size_t)NT * 512; bf16_t* SB = SA + (size_t)NT * 512;
  _Float16* SW = (_Float16*)(SB + (size_t)NT * 512);
  bf16_t* G = (bf16_t*)(ws + O_G);
  float* RK = (float*)(ws + O_RK);
  const float* rope = (const float*)(ws + O_ROPE);
  {
    u32x2 vq[4]; unsigned vc[4]; float k1[4], k2[4], rc[4], rs_[4];
#pragma unroll
    for (int q = 0; q < 4; ++q) {
      const int t = t0 + wave * 4 + q;
      const bf16_t* pb = PAB + (size_t)t * PABC + ACOLS;
      vq[q] = *(const u32x2*)(pb + 4 * lane);
      vc[q] = *(const unsigned*)(pb + 256 + 2 * lane);
      k1[q] = bf2f(pb[384 + (lane & 15)]); k2[q] = bf2f(pb[400 + (lane & 15)]);
      rc[q] = rope[t * 32 + (lane & 15)]; rs_[q] = rope[t * 32 + 16 + (lane & 15)];
    }
    const f32x4 gq = *(const f32x4*)(p.in[19] + 4 * lane);
    const f32x2 gkv = *(const f32x2*)(p.in[21] + 2 * lane);
#pragma unroll
    for (int q = 0; q < 4; ++q) {
      const int tl = wave * 4 + q, t = t0 + tl;
      {
        const u32x2 v = vq[q];
        float x[4] = {__uint_as_float(v[0] << 16), __uint_as_float(v[0] & 0xffff0000u), __uint_as_float(v[1] << 16), __uint_as_float(v[1] & 0xffff0000u)};
        const float ss = wave_sum(x[0] * x[0] + x[1] * x[1] + x[2] * x[2] + x[3] * x[3]);
        const float rs = rsqrtf(ss * (1.f / 256.f) + 1e-6f);
        u32x2 o; o[0] = pk2(x[0] * rs * gq[0], x[1] * rs * gq[1]); o[1] = pk2(x[2] * rs * gq[2], x[3] * rs * gq[3]);
        *(u32x2*)(lds + L2_CQ + tl * 528 + lane * 8) = o;
      }
      {
        const unsigned v = vc[q];
        const float x0 = __uint_as_float(v << 16), x1 = __uint_as_float(v & 0xffff0000u);
        const float ss = wave_sum(x0 * x0 + x1 * x1);
        const float rs = rsqrtf(ss * (1.f / 128.f) + 1e-6f);
        const float o0 = x0 * rs * gkv[0], o1 = x1 * rs * gkv[1];
        float* dst = (t < NP) ? p.out + F_CKVP + (size_t)t * 128 : p.out + F_CKVS + (size_t)(t - NP) * 128;
        f32x2 of = {o0, o1};
        *(f32x2*)(dst + 2 * lane) = of;
        *(unsigned*)(lds + L2_CKV + tl * 272 + lane * 4) = pk2(o0, o1);
      }
      if (lane < 16) {
        const float o1 = k1[q] * rc[q] - k2[q] * rs_[q], o2 = k1[q] * rs_[q] + k2[q] * rc[q];
        float* dst = (t < NP) ? p.out + F_KPEP + (size_t)t * 32 : p.out + F_KPES + (size_t)(t - NP) * 32;
        dst[lane] = o1; dst[16 + lane] = o2;
        bf16_t* kp = (bf16_t*)(ws + O_KPEB) + (size_t)slot_of_token(t) * 32;
        kp[lane] = f2bf(o1); kp[16 + lane] = f2bf(o2);
      }
    }
  }
  __syncthreads();
  const int w = wave, cb = 64 * w;
  {
    int r = (tidx() & 31);
    f32x16 acc[3];
    mm32<3, 16>(lds + L2_CQ, 528, (const bf16_t*)(ws + O_WUQ) + (size_t)(96 * w) * 256, 256, lane, acc);
    bf16_t* Q = (bf16_t*)((unsigned char*)p.out + OO_Q);
    const int j = r & 15;
#pragma unroll
    for (int i = 0; i < 16; ++i) {
      const int t = t0 + crow(i, h);
      const float own = acc[2][i], oth = __shfl_xor(own, 16);
      const float c = rope[t * 32 + j], sn = rope[t * 32 + 16 + j];
      acc[2][i] = (r < 16) ? own * c - oth * sn : oth * sn + own * c;
    }
    stage_store16<3>(lds + L2B_STG + w * (32 * 208), lane, Q + (size_t)t0 * 768 + 96 * w, 768, [&](int nt, int i) { return f2bf(acc[nt][i] * QSCALE); });
  }
  __syncthreads();
  kv_expand(p, lds, w, lane, slot_of_token(t0));
  __syncthreads();
}

DI void p2_cache_tile(const Params& p, unsigned char* lds, int ctile) {
  const int tid = tidx(), wave = __builtin_amdgcn_readfirstlane(tid >> 6), lane = tid & 63;
  const int b = ctile >> 5, j0 = (ctile & 31) * 32;
  {
    const int row = tid >> 4, c = (tid & 15) * 8;
    const float* src = p.in[2] + ((size_t)(b * PAST + j0 + row)) * 128 + c;
    f32x4 a = *(const f32x4*)src, d = *(const f32x4*)(src + 4);
    float f[8] = {a[0], a[1], a[2], a[3], d[0], d[1], d[2], d[3]};
    *(u32x4*)(lds + L2_CKV + row * 272 + c * 2) = pack8(f);
  }
  __syncthreads();
  kv_expand(p, lds, wave, lane, NP + b * SKV + j0);
  __syncthreads();
}

DI void phase2(const Params& p, unsigned char* lds) {
  constexpr int NTT = NT / 32, NCT = DB * PAST / 32;
  {
    bf16_t* vT = (bf16_t*)((unsigned char*)p.out + OO_VT);
    for (int id = blockIdx.x * NTHREADS + tidx(); id < 8 * 64 * 64; id += gridDim.x * NTHREADS) vT[(size_t)(id >> 6) * NKVP + NKV + (id & 63)] = 0;
  }
  for (int it = blockIdx.x; it < NTT; it += gridDim.x) p2_token_tile_a(p, lds, it);
  for (int it = blockIdx.x; it < NTT + NCT; it += gridDim.x) {
    if (it < NTT) p2_token_tile_b(p, lds, it); else p2_cache_tile(p, lds, it - NTT);
  }
}

constexpr int AT_KSTRIDE = 208, AT_VSTRIDE = 136, AT_KBYTES = 64 * AT_KSTRIDE, AT_STAGE = AT_KBYTES + 64 * AT_VSTRIDE;

DI void attn_item(const Params& p, unsigned char* lds, int hd, int qtok0, int nact, int slot0, int ntiles, int nvalid, bool causal) {
  const int tid = tidx(), wave = __builtin_amdgcn_readfirstlane(tid >> 6), lane = tid & 63, r = lane & 31, h = lane >> 5;
  const bf16_t* Q = (const bf16_t*)((const unsigned char*)p.out + OO_Q);
  const bf16_t* knb = (const bf16_t*)(p.ws + O_KNB) + (size_t)hd * NKVP * 64;
  const bf16_t* kpeb = (const bf16_t*)(p.ws + O_KPEB);
  const bf16_t* vT = (const bf16_t*)((const unsigned char*)p.out + OO_VT) + (size_t)hd * 64 * NKVP;
  bf16_t* YB = (bf16_t*)(p.ws + O_YB);
  const bool active = wave < nact;
  const int qtok = qtok0 + 32 * wave;
  const int wlim = !active ? 0 : (causal ? (qtok >> 6) + 1 : ntiles);
  bf16x8 qf[6];
  if (active) {
#pragma unroll
    for (int ks = 0; ks < 6; ++ks) qf[ks] = *(const bf16x8*)(Q + (size_t)(qtok + r) * 768 + 96 * hd + ks * 16 + h * 8);
  } else {
#pragma unroll
    for (int ks = 0; ks < 6; ++ks) qf[ks] = (bf16x8){0, 0, 0, 0, 0, 0, 0, 0};
  }
  f32x16 o0, o1;
#pragma unroll
  for (int i = 0; i < 16; ++i) { o0[i] = 0.f; o1[i] = 0.f; }
  float mrun = -1e30f, lsum = 0.f;
  const int k_key = tid >> 3, k_ch = tid & 7;
  const int pe_key = (tid & 255) >> 2, pe_ch = tid & 3;
  const int v_dim = tid >> 3, v_ch = tid & 7;
  u32x4 rk, rpe, rv;
  auto gload = [&](int kt) {
    const int s = slot0 + kt * 64;
    rk = *(const u32x4*)(knb + (size_t)(s + k_key) * 64 + k_ch * 8);
    if (tid < 256) rpe = *(const u32x4*)(kpeb + (size_t)(s + pe_key) * 32 + pe_ch * 8);
    rv = *(const u32x4*)(vT + (size_t)v_dim * NKVP + s + v_ch * 8);
  };
  auto lstore = [&](int buf) {
    unsigned char* b = lds + buf * AT_STAGE;
    *(u32x4*)(b + k_key * AT_KSTRIDE + k_ch * 16) = rk;
    if (tid < 256) *(u32x4*)(b + pe_key * AT_KSTRIDE + 128 + pe_ch * 16) = rpe;
    u32x2 lo = {rv[0], rv[1]}, hi = {rv[2], rv[3]};
    *(u32x2*)(b + AT_KBYTES + v_dim * AT_VSTRIDE + v_ch * 16) = lo;
    *(u32x2*)(b + AT_KBYTES + v_dim * AT_VSTRIDE + v_ch * 16 + 8) = hi;
  };
  gload(0); lstore(0);
  __syncthreads();
  for (int kt = 0; kt < ntiles; ++kt) {
    const bool more = kt + 1 < ntiles;
    if (more) gload(kt + 1);
    if (kt < wlim) {
      const unsigned char* kb = lds + (kt & 1) * AT_STAGE;
      const unsigned char* vb = kb + AT_KBYTES;
      f32x16 s0, s1;
#pragma unroll
      for (int i = 0; i < 16; ++i) { s0[i] = 0.f; s1[i] = 0.f; }
#pragma unroll
      for (int ks = 0; ks < 6; ++ks) {
        const bf16x8 a0 = *(const bf16x8*)(kb + r * AT_KSTRIDE + ks * 32 + h * 16);
        const bf16x8 a1 = *(const bf16x8*)(kb + (32 + r) * AT_KSTRIDE + ks * 32 + h * 16);
        s0 = MFMA32(a0, qf[ks], s0);
        s1 = MFMA32(a1, qf[ks], s1);
      }
      if (kt * 64 + 64 > nvalid) {
#pragma unroll
        for (int i = 0; i < 16; ++i) {
          const int key = kt * 64 + crow(i, h);
          if (key >= nvalid) s0[i] = -1e30f;
          if (key + 32 >= nvalid) s1[i] = -1e30f;
        }
      }
      float mx = s0[0];
#pragma unroll
      for (int i = 1; i < 16; ++i) mx = fmaxf(mx, s0[i]);
#pragma unroll
      for (int i = 0; i < 16; ++i) mx = fmaxf(mx, s1[i]);
      mx = fmaxf(mx, __shfl_xor(mx, 32));
      const float mnew = fmaxf(mrun, mx);
      const float alpha = __builtin_amdgcn_exp2f(mrun - mnew);
      mrun = mnew;
      float rs = 0.f;
#pragma unroll
      for (int i = 0; i < 16; ++i) { s0[i] = __builtin_amdgcn_exp2f(s0[i] - mnew); rs += s0[i]; }
#pragma unroll
      for (int i = 0; i < 16; ++i) { s1[i] = __builtin_amdgcn_exp2f(s1[i] - mnew); rs += s1[i]; }
      lsum = lsum * alpha + rs;
#pragma unroll
      for (int i = 0; i < 16; ++i) { o0[i] *= alpha; o1[i] *= alpha; }
#pragma unroll
      for (int mt = 0; mt < 2; ++mt)
#pragma unroll
        for (int s = 0; s < 2; ++s) {
          const f32x16& sv = mt ? s1 : s0;
          u32x4 pw;
          pw[0] = pk2(sv[8 * s], sv[8 * s + 1]); pw[1] = pk2(sv[8 * s + 2], sv[8 * s + 3]);
          pw[2] = pk2(sv[8 * s + 4], sv[8 * s + 5]); pw[3] = pk2(sv[8 * s + 6], sv[8 * s + 7]);
          const bf16x8 pb = __builtin_bit_cast(bf16x8, pw);
          const int kbase = mt * 32 + 16 * s + 4 * h;
          {
            const s16x4 lo = *(const s16x4*)(vb + r * AT_VSTRIDE + kbase * 2);
            const s16x4 hi = *(const s16x4*)(vb + r * AT_VSTRIDE + (kbase + 8) * 2);
            const bf16x8 av = __builtin_shufflevector(lo, hi, 0, 1, 2, 3, 4, 5, 6, 7);
            o0 = MFMA32(av, pb, o0);
          }
          {
            const s16x4 lo = *(const s16x4*)(vb + (32 + r) * AT_VSTRIDE + kbase * 2);
            const s16x4 hi = *(const s16x4*)(vb + (32 + r) * AT_VSTRIDE + (kbase + 8) * 2);
            const bf16x8 av = __builtin_shufflevector(lo, hi, 0, 1, 2, 3, 4, 5, 6, 7);
            o1 = MFMA32(av, pb, o1);
          }
        }
    }
    if (more) lstore((kt + 1) & 1);
    __syncthreads();
  }
  if (active) {
    const float lt = lsum + __shfl_xor(lsum, 32);
    const float inv = 1.f / lt;
    bf16_t* dst = YB + (size_t)(qtok + r) * 512 + hd * 64;
#pragma unroll
    for (int g = 0; g < 4; ++g) {
      u32x2 a, b;
      a[0] = pk2(o0[4 * g] * inv, o0[4 * g + 1] * inv); a[1] = pk2(o0[4 * g + 2] * inv, o0[4 * g + 3] * inv);
      b[0] = pk2(o1[4 * g] * inv, o1[4 * g + 1] * inv); b[1] = pk2(o1[4 * g + 2] * inv, o1[4 * g + 3] * inv);
      *(u32x2*)(dst + 8 * g + 4 * h) = a;
      *(u32x2*)(dst + 32 + 8 * g + 4 * h) = b;
    }
  }
}

constexpr int SC_TOK = 32, SC_ARR = SC_TOK * 64 * 4, SC_STAGE = 5 * SC_ARR + SC_TOK * 32 * 4;
static_assert(2 * SC_STAGE <= LDS_BYTES, "lds scan");
DI void scan_job(const Params& p, unsigned char* lds, int head, int rowgrp, int tok0, int nsteps, int init_mode  ,
                 const float* init  , bool use_v, bf16_t* Y  , float* state_out  ) {
  const int tid = tidx(), wave = __builtin_amdgcn_readfirstlane(tid >> 6), lane = tid & 63;
  const bf16_t* SR = (const bf16_t*)(p.ws + O_SIN);
  const bf16_t* SK = SR + (size_t)NT * 512; const bf16_t* SV = SK + (size_t)NT * 512; const bf16_t* SA = SV + (size_t)NT * 512; const bf16_t* SB = SA + (size_t)NT * 512;
  const _Float16* SW = (const _Float16*)(SB + (size_t)NT * 512);
  u32x4 rg[3];
  auto gload = [&](int c) {
    const int tb = tok0 + c * SC_TOK;
#pragma unroll
    for (int i = 0; i < 3; ++i) {
      const int L = tid + NTHREADS * i;
      if (L < 1280) {
        const int arr = L >> 8, tok = (L & 255) >> 3, ch = L & 7;
        const bf16_t* base = arr == 0 ? SA : arr == 1 ? SB : arr == 2 ? (const bf16_t*)SW : arr == 3 ? SK : SR;
        rg[i] = *(const u32x4*)(base + (size_t)(tb + tok) * 512 + head * 64 + ch * 8);
      } else if (L < 1408) {
        const int vl = L - 1280, tok = vl >> 2, hf = vl & 3;
        rg[i] = *(const u32x4*)(SV + (size_t)(tb + tok) * 512 + head * 64 + rowgrp * 32 + hf * 8);
      }
    }
  };
  auto lstore = [&](int buf) {
    unsigned char* b = lds + buf * SC_STAGE;
#pragma unroll
    for (int i = 0; i < 3; ++i) {
      const int L = tid + NTHREADS * i;
      float f[8];
      if (L < 1280) {
        const int arr = L >> 8, tok = (L & 255) >> 3, ch = L & 7;
        if (arr == 2) {
#pragma unroll
          for (int j = 0; j < 4; ++j) {
            const unsigned u = rg[i][j];
            f[2 * j] = (float)__builtin_bit_cast(_Float16, (unsigned short)(u & 0xffffu));
            f[2 * j + 1] = (float)__builtin_bit_cast(_Float16, (unsigned short)(u >> 16));
          }
        } else unpack8(rg[i], f);
        float* d = (float*)(b + arr * SC_ARR + tok * 256 + ch * 32);
        *(f32x4*)d = (f32x4){f[0], f[1], f[2], f[3]};
        *(f32x4*)(d + 4) = (f32x4){f[4], f[5], f[6], f[7]};
      } else if (L < 1408) {
        const int vl = L - 1280, tok = vl >> 2, hf = vl & 3;
        unpack8(rg[i], f);
        if (!use_v) {
#pragma unroll
          for (int j = 0; j < 8; ++j) f[j] = 0.f;
        }
        float* d = (float*)(b + 5 * SC_ARR + tok * 128 + hf * 32);
        *(f32x4*)d = (f32x4){f[0], f[1], f[2], f[3]};
        *(f32x4*)(d + 4) = (f32x4){f[4], f[5], f[6], f[7]};
      }
    }
  };
  const int rl = lane >> 4, c = lane & 15;
  const int vrow = rowgrp * 32 + 4 * wave + rl;
  f32x4 s = {0.f, 0.f, 0.f, 0.f};
  if (init_mode == 1) s = *(const f32x4*)(init + vrow * 64 + 4 * c);
  if (init_mode == 2) { s[0] = (4 * c == vrow) ? 1.f : 0.f; s[1] = (4 * c + 1 == vrow) ? 1.f : 0.f; s[2] = (4 * c + 2 == vrow) ? 1.f : 0.f; s[3] = (4 * c + 3 == vrow) ? 1.f : 0.f; }
  gload(0); lstore(0);
  __syncthreads();
  const int nch = nsteps / SC_TOK;
  for (int ci = 0; ci < nch; ++ci) {
    const bool more = ci + 1 < nch;
    if (more) gload(ci + 1);
    {
      const unsigned char* b = lds + (ci & 1) * SC_STAGE + c * 16;
      const unsigned char* bv = lds + (ci & 1) * SC_STAGE + 5 * SC_ARR + (4 * wave + rl) * 4;
      bf16_t* yp = Y + (size_t)(tok0 + ci * SC_TOK + c) * 512 + head * 64 + vrow;
      f32x4 A4[3], B4[3], W4[3], K4[3], R4[3]; float V1[3];
#define SC_LOAD(slot, t)                                                                                          \
      { A4[slot] = *(const f32x4*)(b + 0 * SC_ARR + (t) * 256); B4[slot] = *(const f32x4*)(b + 1 * SC_ARR + (t) * 256);    \
        W4[slot] = *(const f32x4*)(b + 2 * SC_ARR + (t) * 256); K4[slot] = *(const f32x4*)(b + 3 * SC_ARR + (t) * 256);    \
        R4[slot] = *(const f32x4*)(b + 4 * SC_ARR + (t) * 256); V1[slot] = *(const float*)(bv + (t) * 128); }
      SC_LOAD(0, 0) SC_LOAD(1, 1)
      float ysel = 0.f;
#pragma unroll
      for (int t = 0; t < SC_TOK; ++t) {
        if (t + 2 < SC_TOK) SC_LOAD((t + 2) % 3, t + 2)
        const f32x4 a4 = A4[t % 3], b4 = B4[t % 3], w4 = W4[t % 3], k4 = K4[t % 3], r4 = R4[t % 3];
        const float vv = V1[t % 3];
        const f32x4 vk = vv * k4;
        float sa = (s[0] * a4[0] + s[2] * a4[2]) + (s[1] * a4[1] + s[3] * a4[3]);
        sa = dpp_sum16(sa);
        s = s * w4 + (sa * b4 + vk);
        float y = (s[0] * r4[0] + s[2] * r4[2]) + (s[1] * r4[1] + s[3] * r4[3]);
        y = dpp_sum16(y);
        ysel = (c == (t & 15)) ? y : ysel;
        if ((t & 15) == 15) yp[(size_t)(t - 15) * 512] = f2bf(ysel);
      }
#undef SC_LOAD
    }
    if (more) lstore((ci + 1) & 1);
    __syncthreads();
  }
  *(f32x4*)(state_out + vrow * 64 + 4 * c) = s;
}

constexpr int Q_PSCAN = 8 * (2 + 4 * (SCC - 1)), Q_PATT = 512, Q_SATT = 128, Q_SSCAN = 256, Q_TOTAL = Q_PSCAN + Q_PATT + Q_SATT + Q_SSCAN;
DI void phase3(const Params& p, unsigned char* lds) {
  __shared__ int s_item;
  unsigned* ctr = (unsigned*)(p.ws + O_CTR);
  float* Gb = (float*)(p.ws + O_GH);
  float* Hb = Gb + (size_t)8 * SCC * 4096;
  bf16_t* Y = (bf16_t*)(p.ws + O_Y);
  bf16_t* E = (bf16_t*)(p.ws + O_E);
  for (;;) {
    if (tidx() == 0) s_item = (int)atomicAdd(ctr, 1u);
    __syncthreads();
    const int item = s_item;
    __syncthreads();
    if (item >= Q_TOTAL) break;
    if (item < Q_PSCAN) {
      const int hd = item / (2 + 4 * (SCC - 1)), j = item % (2 + 4 * (SCC - 1));
      if (j < 2) scan_job(p, lds, hd, j, 0, SCL, 0, nullptr, true, Y, Hb + ((size_t)hd * SCC) * 4096);
      else {
        const int jj = j - 2, c = 1 + jj / 4, k = jj % 4;
        if (k < 2) scan_job(p, lds, hd, k, c * SCL, SCL, 0, nullptr, true, Y, Hb + ((size_t)hd * SCC + c) * 4096);
        else scan_job(p, lds, hd, k - 2, c * SCL, SCL, 2, nullptr, false, E, Gb + ((size_t)hd * SCC + c) * 4096);
      }
    } else if (item < Q_PSCAN + Q_PATT) {
      const int k = item - Q_PSCAN, qb = 63 - (k >> 3), hd = k & 7;
      attn_item(p, lds, hd, qb * 256, 8, 0, qb * 4 + 4, (qb * 4 + 4) * 64, true);
    } else if (item < Q_PSCAN + Q_PATT + Q_SATT) {
      const int k = item - Q_PSCAN - Q_PATT, b = k >> 3, hd = k & 7;
      attn_item(p, lds, hd, NP + b * 32, 1, NP + b * SKV, 17, SKV, false);
    } else {
      const int k = item - Q_PSCAN - Q_PATT - Q_SATT, b = k >> 4, hd = (k & 15) >> 1, rg = k & 1;
      scan_job(p, lds, hd, rg, NP + b * 32, 32, 1, p.in[4] + ((size_t)b * 8 + hd) * 4096, true, Y, p.out + F_WKVS + ((size_t)b * 8 + hd) * 4096);
    }
  }
}

DI void phase3b(const Params& p, unsigned char* lds) {
  if (blockIdx.x >= 8) return;
  const int hd = blockIdx.x, tid = tidx();
  const float* Gb = (const float*)(p.ws + O_GH);
  const float* Hb = Gb + (size_t)8 * SCC * 4096;
  bf16_t* SST = (bf16_t*)(p.ws + O_SST);
  float* S = (float*)lds;
  float* Gs = S + 64 * 65;
  const int v = tid >> 3, k0 = (tid & 7) * 8;
  float cur[8];
#pragma unroll
  for (int j = 0; j < 8; ++j) cur[j] = Hb[((size_t)hd * SCC) * 4096 + v * 64 + k0 + j];
  for (int c = 1; c < SCC; ++c) {
    __syncthreads();
#pragma unroll
    for (int j = 0; j < 8; ++j) { S[v * 65 + k0 + j] = cur[j]; Gs[v * 64 + k0 + j] = Gb[((size_t)hd * SCC + c) * 4096 + v * 64 + k0 + j]; }
    *(u32x4*)(SST + ((size_t)c * 8 + hd) * 4096 + v * 64 + k0) = pack8(cur);
    __syncthreads();
    float o[8];
#pragma unroll
    for (int j = 0; j < 8; ++j) o[j] = Hb[((size_t)hd * SCC + c) * 4096 + v * 64 + k0 + j];
    for (int i = 0; i < 64; ++i) {
      const float sv = S[v * 65 + i];
      const f32x4 g0 = *(const f32x4*)(Gs + i * 64 + k0), g1 = *(const f32x4*)(Gs + i * 64 + k0 + 4);
      o[0] += sv * g0[0]; o[1] += sv * g0[1]; o[2] += sv * g0[2]; o[3] += sv * g0[3];
      o[4] += sv * g1[0]; o[5] += sv * g1[1]; o[6] += sv * g1[2]; o[7] += sv * g1[3];
    }
#pragma unroll
    for (int j = 0; j < 8; ++j) cur[j] = o[j];
  }
  float* dst = p.out + F_WKVP + (size_t)hd * 4096 + v * 64 + k0;
  *(f32x4*)dst = (f32x4){cur[0], cur[1], cur[2], cur[3]};
  *(f32x4*)(dst + 4) = (f32x4){cur[4], cur[5], cur[6], cur[7]};
}

DI void phase4a(const Params& p) {
  const int tid = tidx(), lane = tid & 63, r = lane & 31, hh = lane >> 5;
  const int gw = (blockIdx.x * NTHREADS + tid) >> 6, ngw = (gridDim.x * NTHREADS) >> 6;
  const bf16_t* Y = (const bf16_t*)(p.ws + O_Y);
  const bf16_t* E = (const bf16_t*)(p.ws + O_E);
  const bf16_t* SST = (const bf16_t*)(p.ws + O_SST);
  const bf16_t* SV = (const bf16_t*)(p.ws + O_SIN) + 2 * (size_t)NT * 512;
  const bf16_t* G = (const bf16_t*)(p.ws + O_G);
  const float* RK = (const float*)(p.ws + O_RK);
  bf16_t* YA = (bf16_t*)(p.ws + O_YA);
  for (int task = gw; task < (NT / 32) * 8; task += ngw) {
    const int tile = task >> 3, hd = task & 7, t0 = tile * 32, t = t0 + r;
    f32x16 acc[2];
#pragma unroll
    for (int i = 0; i < 16; ++i) { acc[0][i] = 0.f; acc[1][i] = 0.f; }
    const int c = t0 < NP ? t0 / SCL : 0;
    if (c >= 1) {
      const bf16_t* sst = SST + ((size_t)c * 8 + hd) * 4096;
#pragma unroll
      for (int ks = 0; ks < 4; ++ks) {
        const bf16x8 bv = *(const bf16x8*)(E + (size_t)t * 512 + hd * 64 + ks * 16 + hh * 8);
#pragma unroll
        for (int mt = 0; mt < 2; ++mt) {
          const bf16x8 av = *(const bf16x8*)(sst + (mt * 32 + r) * 64 + ks * 16 + hh * 8);
          acc[mt] = MFMA32(av, bv, acc[mt]);
        }
      }
    }
    float sum = 0.f;
#pragma unroll
    for (int mt = 0; mt < 2; ++mt)
#pragma unroll
      for (int g = 0; g < 4; ++g) {
        const u32x2 yv = *(const u32x2*)(Y + (size_t)t * 512 + hd * 64 + mt * 32 + 8 * g + 4 * hh);
        acc[mt][4 * g] += __uint_as_float(yv[0] << 16); acc[mt][4 * g + 1] += __uint_as_float(yv[0] & 0xffff0000u);
        acc[mt][4 * g + 2] += __uint_as_float(yv[1] << 16); acc[mt][4 * g + 3] += __uint_as_float(yv[1] & 0xffff0000u);
        sum += (acc[mt][4 * g] + acc[mt][4 * g + 1]) + (acc[mt][4 * g + 2] + acc[mt][4 * g + 3]);
      }
    sum += __shfl_xor(sum, 32);
    const float mean = sum * (1.f / 64.f);
    float sq = 0.f;
#pragma unroll
    for (int mt = 0; mt < 2; ++mt)
#pragma unroll
      for (int i = 0; i < 16; ++i) { const float d = acc[mt][i] - mean; sq += d * d; }
    sq += __shfl_xor(sq, 32);
    const float rstd = rsqrtf(sq * (1.f / 64.f) + 64e-5f);
    const float bon = RK[(size_t)t * 8 + hd];
#pragma unroll
    for (int mt = 0; mt < 2; ++mt)
#pragma unroll
      for (int g = 0; g < 4; ++g) {
        const int c0 = hd * 64 + mt * 32 + 8 * g + 4 * hh;
        const size_t o = (size_t)t * 512 + c0;
        const f32x4 lg = *(const f32x4*)(p.in[16] + c0), lb = *(const f32x4*)(p.in[17] + c0);
        const u32x2 vv = *(const u32x2*)(SV + o), gg = *(const u32x2*)(G + o);
        const float vf[4] = {__uint_as_float(vv[0] << 16), __uint_as_float(vv[0] & 0xffff0000u), __uint_as_float(vv[1] << 16), __uint_as_float(vv[1] & 0xffff0000u)};
        const float gf[4] = {__uint_as_float(gg[0] << 16), __uint_as_float(gg[0] & 0xffff0000u), __uint_as_float(gg[1] << 16), __uint_as_float(gg[1] & 0xffff0000u)};
        float ov[4];
#pragma unroll
        for (int j = 0; j < 4; ++j) ov[j] = ((acc[mt][4 * g + j] - mean) * rstd * lg[j] + lb[j] + bon * vf[j]) * gf[j];
        u32x2 w; w[0] = pk2(ov[0], ov[1]); w[1] = pk2(ov[2], ov[3]);
        *(u32x2*)(YA + o) = w;
      }
  }
  conv_x(p, (bf16_t*)((unsigned char*)p.out + OO_XB), blockIdx.x * NTHREADS + tidx(), gridDim.x * NTHREADS);
}

DI void phase4(const Params& p, unsigned char* lds) {
  const bf16_t* XB = (const bf16_t*)((unsigned char*)p.out + OO_XB);
  const bf16_t* WIN = (const bf16_t*)(p.ws + O_WIN);
  const bf16_t* YA = (const bf16_t*)(p.ws + O_YA);
  const bf16_t* YB = (const bf16_t*)(p.ws + O_YB);
  bf16_t* M = (bf16_t*)(p.ws + O_M);
  constexpr int NMT = NT / 128, NNT = 8;
  const int lane = tidx() & 63, wave = __builtin_amdgcn_readfirstlane(tidx() >> 6), r = lane & 31, h = lane >> 5, wm = wave & 3, wn = wave >> 2;
  TileIter ti; ti.init(NMT, NNT);
  int tmi, tni;
  while (ti.next(tmi, tni)) {
    const int m0 = tmi * 128, n0 = tni * 128;
    f32x16 accg[1][2], accv[1][2], macc[1][2];
    gemm_mainloop<1, 2>(XB, DM, WIN + (size_t)PABC * DM, DM, DM, m0, n0, 1024, accg, lds);
    gemm_mainloop<1, 2>(YA, 512, (const bf16_t*)(p.ws + O_WPA), 512, 512, m0, n0, 1024, accv, lds);
#pragma unroll
    for (int tn = 0; tn < 2; ++tn)
#pragma unroll
      for (int g = 0; g < 4; ++g) {
        const f32x4 bg = *(const f32x4*)(p.in[24] + n0 + wn * 64 + tn * 32 + 8 * g + 4 * h);
#pragma unroll
        for (int j = 0; j < 4; ++j) macc[0][tn][4 * g + j] = sigmoidf_(accg[0][tn][4 * g + j] + bg[j]) * accv[0][tn][4 * g + j];
      }
    gemm_mainloop<1, 2>(XB, DM, WIN + (size_t)(PABC + 1024) * DM, DM, DM, m0, n0, 1024, accg, lds);
    gemm_mainloop<1, 2>(YB, 512, (const bf16_t*)(p.ws + O_WPB), 512, 512, m0, n0, 1024, accv, lds);
    epilogue_bf16<1, 2, 128>(macc, lds, M, DM, m0, n0, DM, [&](int tm, int tn, int g, int, int coll) {
      const f32x4 bg = *(const f32x4*)(p.in[24] + 1024 + n0 + coll);
      f32x4 o;
#pragma unroll
      for (int j = 0; j < 4; ++j) o[j] = macc[0][tn][4 * g + j] + sigmoidf_(accg[0][tn][4 * g + j] + bg[j]) * accv[0][tn][4 * g + j];
      return o;
    });
  }
}

DI void phase5(const Params& p, unsigned char* lds) {
  const bf16_t* M = (const bf16_t*)(p.ws + O_M);
  bf16_t* Z = (bf16_t*)(p.ws + O_Z);
  constexpr int NMT = NT / 256, NNT = 8;
  TileIter ti; ti.init(NMT, NNT);
  int tmi, tni;
  while (ti.next(tmi, tni)) {
    const int m0 = tmi * 256, n0 = tni * 128;
    f32x16 acc[2][2];
    gemm_mainloop<2, 2>(M, DM, (const bf16_t*)(p.ws + O_WO), DM, DM, m0, n0, 1024, acc, lds);
    epilogue_bf16<2, 2, 128>(acc, lds, Z, DM, m0, n0, DM, [&](int tm, int tn, int g, int rowl, int coll) {
      const f32x4 xv = *(const f32x4*)(xrow(p, m0 + rowl) + n0 + coll);
      return xv * DN_ALPHA + acc4(acc[tm][tn], g);
    });
  }
}
template <bool OUT_BF16>
DI void ln_rows(const bf16_t* src, const float* g, const float* b, bf16_t* dst16, float* dst32) {
  const int gw = (blockIdx.x * NTHREADS + tidx()) >> 6, ngw = (gridDim.x * NTHREADS) >> 6, lane = tidx() & 63;
  for (int t = gw; t < NT; t += ngw) {
    const u32x4* xr = (const u32x4*)(src + (size_t)t * DM) + lane;
    float v[16]; float s = 0.f;
#pragma unroll
    for (int j = 0; j < 2; ++j) { unpack8(xr[64 * j], v + 8 * j); }
#pragma unroll
    for (int j = 0; j < 16; ++j) s += v[j];
    const float mean = wave_sum(s) * (1.f / DM);
    float s2 = 0.f;
#pragma unroll
    for (int j = 0; j < 16; ++j) { v[j] -= mean; s2 += v[j] * v[j]; }
    const float rstd = rsqrtf(wave_sum(s2) * (1.f / DM) + 1e-5f);
#pragma unroll
    for (int j = 0; j < 2; ++j) {
      const int c = 8 * lane + 512 * j;
      const f32x4 g0 = *(const f32x4*)(g + c), g1 = *(const f32x4*)(g + c + 4), b0 = *(const f32x4*)(b + c), b1 = *(const f32x4*)(b + c + 4);
      float o[8];
#pragma unroll
      for (int q = 0; q < 4; ++q) { o[q] = v[8 * j + q] * rstd * g0[q] + b0[q]; o[4 + q] = v[8 * j + 4 + q] * rstd * g1[q] + b1[q]; }
      if (OUT_BF16) *(u32x4*)(dst16 + (size_t)t * DM + c) = pack8(o);
      else { *(f32x4*)(dst32 + (size_t)t * DM + c) = (f32x4){o[0], o[1], o[2], o[3]}; *(f32x4*)(dst32 + (size_t)t * DM + c + 4) = (f32x4){o[4], o[5], o[6], o[7]}; }
    }
  }
}

DI void phase6(const Params& p, unsigned char* lds) {
  const bf16_t* H = (const bf16_t*)(p.ws + O_H);
  bf16_t* ACT = (bf16_t*)(p.ws + O_ACT);
  constexpr int NMT = NT / 256, NNT = 5632 / 128;
  TileIter ti; ti.init(NMT, NNT);
  int tmi, tni;
  while (ti.next(tmi, tni)) {
    const int m0 = tmi * 256, n0 = tni * 128;
    f32x16 acc[2][2];
    gemm_mainloop<2, 2>(H, DM, (const bf16_t*)(p.ws + O_WGU), DM, DM, m0, n0, 5632, acc, lds);
    epilogue_bf16<2, 2, 64>(acc, lds, ACT, DFF, m0, tni * 64, DFF, [&](int tm, int, int g, int, int) {
      f32x4 o;
#pragma unroll
      for (int j = 0; j < 4; ++j) { const float gte = acc[tm][0][4 * g + j], up = acc[tm][1][4 * g + j]; o[j] = gte * sigmoidf_(gte) * up; }
      return o;
    });
  }
}
DI void phase7(const Params& p, unsigned char* lds) {
  const bf16_t* H = (const bf16_t*)(p.ws + O_H);
  const bf16_t* ACT = (const bf16_t*)(p.ws + O_ACT);
  bf16_t* Z2 = (bf16_t*)(p.ws + O_Z2);
  constexpr int NMT = NT / 256, NNT = 8;
  TileIter ti; ti.init(NMT, NNT);
  int tmi, tni;
  while (ti.next(tmi, tni)) {
    const int m0 = tmi * 256, n0 = tni * 128;
    f32x16 acc[2][2];
    gemm_mainloop<2, 2>(ACT, DFF, (const bf16_t*)(p.ws + O_WDN), DFF, DFF, m0, n0, 1024, acc, lds);
    epilogue_bf16<2, 2, 128>(acc, lds, Z2, DM, m0, n0, DM, [&](int tm, int tn, int g, int rowl, int coll) {
      const u32x2 hv = *(const u32x2*)(H + (size_t)(m0 + rowl) * DM + n0 + coll);
      const f32x4 hf = {__uint_as_float(hv[0] << 16), __uint_as_float(hv[0] & 0xffff0000u), __uint_as_float(hv[1] << 16), __uint_as_float(hv[1] & 0xffff0000u)};
      return hf * DN_ALPHA + acc4(acc[tm][tn], g);
    });
  }
}

DI void run_phase(const Params& p, unsigned char* lds, int ph) {
  switch (ph) {
    case 0: phase0(p); break;
    case 1: phase1(p, lds); break;
    case 2: phase2(p, lds); break;
    case 3: phase3(p, lds); break;
    case 4: phase4a(p); break;
    case 5: phase4(p, lds); break;
    case 6: phase5(p, lds); break;
    case 7: ln_rows<true>((const bf16_t*)(p.ws + O_Z), p.in[26], p.in[27], (bf16_t*)(p.ws + O_H), nullptr); break;
    case 8: phase6(p, lds); break;
    case 9: phase7(p, lds); break;
    case 11: phase3b(p, lds); break;
    case 10: ln_rows<false>((const bf16_t*)(p.ws + O_Z2), p.in[30], p.in[31], nullptr, p.out + F_Y); break;
  }
}
constexpr int NPHASES = 11;

DI unsigned ctl_ld(unsigned* p) { return __hip_atomic_load(p, __ATOMIC_RELAXED, __HIP_MEMORY_SCOPE_AGENT); }
DI unsigned ctl_add(unsigned* p, unsigned v) { return __hip_atomic_fetch_add(p, v, __ATOMIC_RELAXED, __HIP_MEMORY_SCOPE_AGENT); }
DI void xbar(unsigned* ctl, unsigned x, unsigned nloc, unsigned nx, unsigned k) {
  asm volatile("s_waitcnt vmcnt(0)" ::: "memory");
  __syncthreads();
  if (threadIdx.x == 0) {
    const unsigned old = ctl_add(&ctl[(24 + x) * 64], 1u);
    if (old + 1u == k * nloc) {
      __builtin_amdgcn_fence(__ATOMIC_RELEASE, "agent");
      asm volatile("s_waitcnt vmcnt(0)" ::: "memory");
      ctl_add(&ctl[40 * 64], 1u);
    }
    while (ctl_ld(&ctl[40 * 64]) < k * nx) __builtin_amdgcn_s_sleep(1);
    __builtin_amdgcn_fence(__ATOMIC_ACQUIRE, "agent");
    asm volatile("s_waitcnt vmcnt(0)" ::: "memory");
  }
  __syncthreads();
}

__global__ void __launch_bounds__(NTHREADS) mega_kernel(Params p) {
  extern __shared__ __attribute__((aligned(16))) unsigned char lds[];
  __shared__ unsigned s_bar[4];
  cg::grid_group grid = cg::this_grid();
  unsigned* ctl = (unsigned*)(p.ws + O_CTR);
  const unsigned x = (unsigned)__builtin_amdgcn_s_getreg((3 << 11) | 20) & 0xFu;
  if (threadIdx.x == 0) ctl_add(&ctl[(8 + x) * 64], 1u);
  grid.sync();
  if (threadIdx.x == 0) {
    unsigned nx = 0;
    for (int i = 0; i < 16; ++i) nx += ctl_ld(&ctl[(8 + i) * 64]) != 0u ? 1u : 0u;
    s_bar[0] = ctl_ld(&ctl[(8 + x) * 64]); s_bar[1] = nx;
  }
  __syncthreads();
  const unsigned nloc = s_bar[0], nx = s_bar[1];
  run_phase(p, lds, 0); xbar(ctl, x, nloc, nx, 1);
  run_phase(p, lds, 1); xbar(ctl, x, nloc, nx, 2);
  run_phase(p, lds, 2); xbar(ctl, x, nloc, nx, 3);
  run_phase(p, lds, 3); xbar(ctl, x, nloc, nx, 4);
  run_phase(p, lds, 11); xbar(ctl, x, nloc, nx, 5);
  run_phase(p, lds, 4); xbar(ctl, x, nloc, nx, 6);
  run_phase(p, lds, 5); xbar(ctl, x, nloc, nx, 7);
  run_phase(p, lds, 6); xbar(ctl, x, nloc, nx, 8);
  run_phase(p, lds, 7); xbar(ctl, x, nloc, nx, 9);
  run_phase(p, lds, 8); xbar(ctl, x, nloc, nx, 10);
  run_phase(p, lds, 9); xbar(ctl, x, nloc, nx, 11);
  run_phase(p, lds, 10);
}
template <int PH> __global__ void __launch_bounds__(NTHREADS) phase_kernel(Params p) {
  extern __shared__ __attribute__((aligned(16))) unsigned char lds[];
  run_phase(p, lds, PH);
}
template <int PH> static void launch_phase(const Params& p, int grid, hipStream_t stream) {
  (void)hipFuncSetAttribute((const void*)phase_kernel<PH>, hipFuncAttributeMaxDynamicSharedMemorySize, LDS_BYTES);
  hipLaunchKernelGGL(phase_kernel<PH>, dim3(grid), dim3(NTHREADS), LDS_BYTES, stream, p);
}

extern "C" void kernel_launch(void* const* d_in, const int* in_sizes, int n_in, void* d_out, int out_size, void* d_ws, size_t ws_size, hipStream_t stream) {
  static int grid_blocks = 0;
  if (grid_blocks == 0) {
    if (n_in != 32 || ws_size < WS_END) { fprintf(stderr, "kernel_launch: unexpected n_in %d or ws_size %zu (< %zu)\n", n_in, ws_size, (size_t)WS_END); grid_blocks = -1; return; }
    int dev = 0, cus = 0, per_cu = 0;
    (void)hipGetDevice(&dev);
    (void)hipDeviceGetAttribute(&cus, hipDeviceAttributeMultiprocessorCount, dev);
#if MULTI_LAUNCH
    per_cu = 1;
#else
    (void)hipFuncSetAttribute((const void*)mega_kernel, hipFuncAttributeMaxDynamicSharedMemorySize, LDS_BYTES);
    (void)hipOccupancyMaxActiveBlocksPerMultiprocessor(&per_cu, (const void*)mega_kernel, NTHREADS, LDS_BYTES);
#endif
    if (per_cu < 1) { fprintf(stderr, "kernel_launch: occupancy query gave %d\n", per_cu); grid_blocks = -1; return; }
    grid_blocks = cus;
  }
  if (grid_blocks < 0) return;
  Params p{};
  for (int i = 0; i < 32; ++i) p.in[i] = (const float*)d_in[i];
  p.out = (float*)d_out;
  p.ws = (unsigned char*)d_ws;
#if MULTI_LAUNCH
  launch_phase<0>(p, grid_blocks, stream); launch_phase<1>(p, grid_blocks, stream); launch_phase<2>(p, grid_blocks, stream); launch_phase<3>(p, grid_blocks, stream); launch_phase<11>(p, grid_blocks, stream);
  launch_phase<4>(p, grid_blocks, stream); launch_phase<5>(p, grid_blocks, stream); launch_phase<6>(p, grid_blocks, stream); launch_phase<7>(p, grid_blocks, stream);
  launch_phase<8>(p, grid_blocks, stream); launch_phase<9>(p, grid_blocks, stream); launch_phase<10>(p, grid_blocks, stream);
#else
  (void)hipMemsetAsync((unsigned char*)d_ws + O_CTR, 0, 16384, stream);
  void* args[] = {&p};
  hipError_t e = hipLaunchCooperativeKernel((void*)mega_kernel, dim3(grid_blocks), dim3(NTHREADS), args, LDS_BYTES, stream);
  if (e != hipSuccess) fprintf(stderr, "cooperative launch failed: %s (grid %d)\n", hipGetErrorString(e), grid_blocks);
#endif
}
```

```cpp
#include <hip/hip_runtime.h>
#include <hip/hip_cooperative_groups.h>
#include <cstdio>
#include <cstdint>
namespace cg = cooperative_groups;


#ifndef PROBE_DUP
#define PROBE_DUP -1
#endif
#ifndef MULTI_LAUNCH
#define MULTI_LAUNCH 0
#endif

#define DI __device__ __forceinline__
typedef unsigned short bf16_t;
typedef short bf16x8 __attribute__((ext_vector_type(8)));
typedef short s16x4 __attribute__((ext_vector_type(4)));
typedef float f32x16 __attribute__((ext_vector_type(16)));
typedef float f32x4 __attribute__((ext_vector_type(4)));
typedef float f32x2 __attribute__((ext_vector_type(2)));
typedef unsigned u32x4 __attribute__((ext_vector_type(4)));
typedef unsigned u32x2 __attribute__((ext_vector_type(2)));
typedef __bf16 bf2_t __attribute__((ext_vector_type(2)));

constexpr int NP = 16384, NS = 512, NT = NP + NS;
constexpr int DM = 1024, ACOLS = 1792, BCOLS = 416, PABC = ACOLS + BCOLS  , NIN = 4256;
constexpr int DFF = 2816;
constexpr int PAST = 1024, DSEQ = 32, DB = 16, SKV = PAST + DSEQ  ;
constexpr int NKV = NP + DB * SKV  , NKVP = NKV + 64;
constexpr float DN_ALPHA = 1.189207115002721f;
constexpr float QSCALE = 0.10206207261596575f * 1.4426950408889634f;

constexpr size_t al256(size_t x) { return (x + 255) & ~(size_t)255; }
constexpr size_t O_WIN = 0;
constexpr size_t O_WUQ = O_WIN + al256((size_t)NIN * 1024 * 2);
constexpr size_t O_WUKV = O_WUQ + al256(768 * 256 * 2);
constexpr size_t O_WPA = O_WUKV + al256(1024 * 128 * 2);
constexpr size_t O_WPB = O_WPA + al256(1024 * 512 * 2);
constexpr size_t O_WO = O_WPB + al256(1024 * 512 * 2);
constexpr size_t O_WGU = O_WO + al256(1024 * 1024 * 2);
constexpr size_t O_WDN = O_WGU + al256((size_t)5632 * 1024 * 2);
constexpr size_t O_WW2 = O_WDN + al256((size_t)1024 * 2816 * 2);
constexpr size_t O_WA2 = O_WW2 + al256(512 * 64 * 2);
constexpr size_t O_WG2 = O_WA2 + al256(512 * 64 * 2);
constexpr size_t O_ROPE = O_WG2 + al256(512 * 128 * 2);
constexpr size_t O_CTR = O_ROPE + al256((size_t)NT * 32 * 4);
constexpr size_t O_PAB = O_CTR + 16384;
constexpr size_t SZ_T512 = (size_t)NT * 512 * 2;
constexpr size_t O_SIN = O_PAB + al256((size_t)NT * PABC * 2);
constexpr size_t O_G = O_SIN + 6 * SZ_T512;
constexpr size_t O_RK = O_G + SZ_T512;
constexpr size_t O_KNB = O_RK + al256((size_t)NT * 8 * 4);
constexpr size_t O_KPEB = O_KNB + al256((size_t)8 * NKVP * 64 * 2);
constexpr int SCC = 4, SCL = NP / SCC;
constexpr size_t O_GH = O_KPEB + al256((size_t)NKVP * 32 * 2);
constexpr size_t O_SST = O_GH + 2 * (size_t)8 * SCC * 4096 * 4;
constexpr size_t WS_END = O_SST + (size_t)SCC * 8 * 4096 * 2;
constexpr size_t O_Y = O_PAB;
constexpr size_t O_E = O_Y + SZ_T512;
constexpr size_t O_YB = O_Y + (size_t)NT * 512 * 4;
constexpr size_t O_YA = O_YB + SZ_T512;
constexpr size_t O_H = O_PAB;
constexpr size_t O_M = O_SIN;
constexpr size_t O_Z = O_SIN + (size_t)NT * 1024 * 2;
constexpr size_t O_Z2 = O_PAB + (size_t)NT * 1024 * 2;
constexpr size_t O_ACT = O_SIN;
constexpr size_t OO_XB = 0;
constexpr size_t OO_Q = 0;
constexpr size_t OO_VT = (size_t)NT * 768 * 2;
constexpr size_t F_Y = 0, F_CKVP = (size_t)NT * 1024, F_KPEP = F_CKVP + (size_t)NP * 128, F_WKVP = F_KPEP + (size_t)NP * 32,
                 F_SHP = F_WKVP + 32768, F_CKVS = F_SHP + 1792, F_KPES = F_CKVS + (size_t)NS * 128, F_WKVS = F_KPES + (size_t)NS * 32,
                 F_SHS = F_WKVS + (size_t)DB * 32768;

constexpr int LDS_CTRL = 3 * 49152;
constexpr int LDS_BYTES = LDS_CTRL + 256;
constexpr int NTHREADS = 512;

struct Params {
  const float* in[32];
  float* out;
  unsigned char* ws;
};

DI int tidx() { int t = threadIdx.x; asm volatile("" : "+v"(t)); return t; }
DI unsigned pk2(float a, float b) { f32x2 v = {a, b}; bf2_t r = __builtin_convertvector(v, bf2_t); return __builtin_bit_cast(unsigned, r); }
DI bf16_t f2bf(float a) { return (bf16_t)(pk2(a, 0.f) & 0xffffu); }
DI float bf2f(bf16_t x) { return __uint_as_float(((unsigned)x) << 16); }
DI void unpack8(u32x4 v, float* f) {
#pragma unroll
  for (int j = 0; j < 4; ++j) { f[2 * j] = __uint_as_float(v[j] << 16); f[2 * j + 1] = __uint_as_float(v[j] & 0xffff0000u); }
}
DI u32x4 pack8(const float* f) { u32x4 o; o[0] = pk2(f[0], f[1]); o[1] = pk2(f[2], f[3]); o[2] = pk2(f[4], f[5]); o[3] = pk2(f[6], f[7]); return o; }
DI float sigmoidf_(float x) { return 1.f / (1.f + __expf(-x)); }
DI float dpp_sum16(float x) {
  x += __builtin_bit_cast(float, __builtin_amdgcn_update_dpp(0, __builtin_bit_cast(int, x), 0xB1, 0xF, 0xF, true));
  x += __builtin_bit_cast(float, __builtin_amdgcn_update_dpp(0, __builtin_bit_cast(int, x), 0x4E, 0xF, 0xF, true));
  x += __builtin_bit_cast(float, __builtin_amdgcn_update_dpp(0, __builtin_bit_cast(int, x), 0x141, 0xF, 0xF, true));
  x += __builtin_bit_cast(float, __builtin_amdgcn_update_dpp(0, __builtin_bit_cast(int, x), 0x140, 0xF, 0xF, true));
  return x;
}
DI float sum32(float x) { x = dpp_sum16(x); x += __shfl_xor(x, 16); return x; }
DI float wave_sum(float v) {
#pragma unroll
  for (int o = 1; o < 64; o <<= 1) v += __shfl_xor(v, o);
  return v;
}
DI int crow(int i, int h) { return (i & 3) + 8 * (i >> 2) + 4 * h; }
#define MFMA32(a, b, c) __builtin_amdgcn_mfma_f32_32x32x16_bf16((a), (b), (c), 0, 0, 0)
DI int slot_of_token(int t) { return t < NP ? t : NP + ((t - NP) >> 5) * SKV + PAST + ((t - NP) & 31); }
DI const float* xrow(const Params& p, int t) { return t < NP ? p.in[0] + (size_t)t * DM : p.in[1] + (size_t)(t - NP) * DM; }

DI void conv_T(const float* W, int K, int N, bf16_t* WT, bool perm, int gtid, int gsz) {
  const int ntask = (K / 8) * N;
  for (int id = gtid; id < ntask; id += gsz) {
    const int kc = id / N, n = id - kc * N, k0 = kc * 8;
    float f[8];
#pragma unroll
    for (int j = 0; j < 8; ++j) f[j] = W[(size_t)(k0 + j) * N + n];
    int row = n;
    if (perm) { const int nt = n >= DFF ? 1 : 0, j = n - nt * DFF; row = 128 * (j >> 6) + 64 * ((j & 63) >> 5) + 32 * nt + (j & 31); }
    *(u32x4*)(WT + (size_t)row * K + k0) = pack8(f);
  }
}
DI void conv_x(const Params& p, bf16_t* XB, int gtid, int gsz) {
  for (int id = gtid; id < NT * 128; id += gsz) {
    const int t = id >> 7, c = (id & 127) * 8;
    const float* src = xrow(p, t) + c;
    f32x4 a = *(const f32x4*)src, b = *(const f32x4*)(src + 4);
    float f[8] = {a[0], a[1], a[2], a[3], b[0], b[1], b[2], b[3]};
    *(u32x4*)(XB + (size_t)t * DM + c) = pack8(f);
  }
}
DI void phase0(const Params& p) {
  const int gtid = blockIdx.x * NTHREADS + tidx(), gsz = gridDim.x * NTHREADS;
  unsigned char* ws = p.ws;
  if (gtid < 64) ((unsigned*)(ws + O_CTR))[gtid] = 0u;
  conv_T(p.in[6], 1024, NIN, (bf16_t*)(ws + O_WIN), false, gtid, gsz);
  conv_T(p.in[20], 256, 768, (bf16_t*)(ws + O_WUQ), false, gtid, gsz);
  conv_T(p.in[22], 128, 1024, (bf16_t*)(ws + O_WUKV), false, gtid, gsz);
  conv_T(p.in[18], 512, 1024, (bf16_t*)(ws + O_WPA), false, gtid, gsz);
  conv_T(p.in[23], 512, 1024, (bf16_t*)(ws + O_WPB), false, gtid, gsz);
  conv_T(p.in[25], 1024, 1024, (bf16_t*)(ws + O_WO), false, gtid, gsz);
  conv_T(p.in[28], 1024, 5632, (bf16_t*)(ws + O_WGU), true, gtid, gsz);
  conv_T(p.in[29], 2816, 1024, (bf16_t*)(ws + O_WDN), false, gtid, gsz);
  conv_T(p.in[9], 64, 512, (bf16_t*)(ws + O_WW2), false, gtid, gsz);
  conv_T(p.in[11], 64, 512, (bf16_t*)(ws + O_WA2), false, gtid, gsz);
  conv_T(p.in[12], 128, 512, (bf16_t*)(ws + O_WG2), false, gtid, gsz);
  conv_x(p, (bf16_t*)((unsigned char*)p.out + OO_XB), gtid, gsz);
  float* rope = (float*)(ws + O_ROPE);
  for (int id = gtid; id < NT * 16; id += gsz) {
    const int t = id >> 4, j = id & 15;
    const int pos = t < NP ? t : PAST + ((t - NP) & 31);
    const float inv = (float)exp2(-(double)j * (13.287712379549449 / 16.0));
    const float ang = (float)pos * inv;
    const double x = (double)ang;
    const double n = rint(x * 0.15915494309189535);
    const float red = (float)(x - n * 6.283185307179586);
    rope[t * 32 + j] = __cosf(red);
    rope[t * 32 + 16 + j] = __sinf(red);
  }
  bf16_t* kpeb = (bf16_t*)(ws + O_KPEB);
  for (int id = gtid; id < DB * PAST * 4; id += gsz) {
    const int row = id >> 2, ch = id & 3, b = row >> 10, j = row & 1023;
    const float* src = p.in[3] + (size_t)row * 32 + ch * 8;
    f32x4 a = *(const f32x4*)src, c = *(const f32x4*)(src + 4);
    float f[8] = {a[0], a[1], a[2], a[3], c[0], c[1], c[2], c[3]};
    *(u32x4*)(kpeb + (size_t)(NP + b * SKV + j) * 32 + ch * 8) = pack8(f);
  }
  bf16_t* knb = (bf16_t*)(ws + O_KNB);
  for (int id = gtid; id < 64 * 32; id += gsz) kpeb[(size_t)NKV * 32 + id] = 0;
  for (int id = gtid; id < 8 * 64 * 64; id += gsz) {
    const int h = id >> 12, rem = id & 4095;
    knb[((size_t)h * NKVP + NKV) * 64 + rem] = 0;
  }
}

template <int TM, int TN, bool ZERO = true>
DI void gemm_mainloop(const bf16_t* __restrict__ A, int lda, const bf16_t* __restrict__ Bt, int ldb, int K, int m0, int n0, int nmax,
                      f32x16 (&acc)[TM][TN], unsigned char* lds) {
  constexpr int BM = 128 * TM, BN = 64 * TN, AG = BM / 64, BG = BN / 64, NLD = AG + BG;
  constexpr int ABYTES = BM * 128, STAGE = (BM + BN) * 128;
  static_assert(3 * STAGE <= LDS_CTRL, "lds");
  const int tid = tidx(), wave = __builtin_amdgcn_readfirstlane(tid >> 6), lane = tid & 63, r = lane & 31, h = lane >> 5, wm = wave & 3, wn = wave >> 2;
  const int lrow = lane >> 3, lpos = lane & 7;
  const bf16_t* ap[AG]; const bf16_t* bp[BG];
#pragma unroll
  for (int i = 0; i < AG; ++i) { const int row = (wave * AG + i) * 8 + lrow, c = lpos ^ ((row >> 1) & 7); ap[i] = A + (size_t)(m0 + row) * lda + c * 8; }
#pragma unroll
  for (int i = 0; i < BG; ++i) { const int row = (wave * BG + i) * 8 + lrow, c = lpos ^ ((row >> 1) & 7); int br = n0 + row; br = br < nmax ? br : nmax - 1; bp[i] = Bt + (size_t)br * ldb + c * 8; }
  if (ZERO) {
#pragma unroll
    for (int tm = 0; tm < TM; ++tm)
#pragma unroll
      for (int tn = 0; tn < TN; ++tn)
#pragma unroll
        for (int i = 0; i < 16; ++i) acc[tm][tn][i] = 0.f;
  }
  auto issue = [&](int kt, int stage) {
    unsigned char* sb = lds + stage * STAGE;
#pragma unroll
    for (int i = 0; i < AG; ++i) __builtin_amdgcn_global_load_lds((const unsigned*)(ap[i] + kt * 64), (unsigned*)(sb + (wave * AG + i) * 1024), 16, 0, 0);
#pragma unroll
    for (int i = 0; i < BG; ++i) __builtin_amdgcn_global_load_lds((const unsigned*)(bp[i] + kt * 64), (unsigned*)(sb + ABYTES + (wave * BG + i) * 1024), 16, 0, 0);
  };
  const int swz = (r >> 1) & 7;
  int koff[4];
#pragma unroll
  for (int ks = 0; ks < 4; ++ks) koff[ks] = ((ks * 2 + h) ^ swz) * 16;
  const int a_rd = (wm * 32 * TM + r) * 128, b_rd = ABYTES + (wn * 32 * TN + r) * 128;
  const int nk = K >> 6;
  asm volatile("s_waitcnt vmcnt(0)" ::: "memory");
  issue(0, 0);
  issue(1, 1);
  for (int kt = 0; kt < nk; ++kt) {
    if (kt + 1 < nk) asm volatile("s_waitcnt vmcnt(%0)" ::"n"(NLD) : "memory");
    else asm volatile("s_waitcnt vmcnt(0)" ::: "memory");
    asm volatile("s_waitcnt lgkmcnt(0)" ::: "memory");
    __builtin_amdgcn_s_barrier();
    if (kt + 2 < nk) issue(kt + 2, (kt + 2) % 3);
    const unsigned char* cur = lds + (kt % 3) * STAGE;
#pragma unroll
    for (int ks = 0; ks < 4; ++ks) {
      bf16x8 af[TM], bfr[TN];
#pragma unroll
      for (int tm = 0; tm < TM; ++tm) af[tm] = *(const bf16x8*)(cur + a_rd + tm * 4096 + koff[ks]);
#pragma unroll
      for (int tn = 0; tn < TN; ++tn) bfr[tn] = *(const bf16x8*)(cur + b_rd + tn * 4096 + koff[ks]);
#pragma unroll
      for (int tm = 0; tm < TM; ++tm)
#pragma unroll
        for (int tn = 0; tn < TN; ++tn) acc[tm][tn] = MFMA32(bfr[tn], af[tm], acc[tm][tn]);
    }
  }
  asm volatile("s_waitcnt lgkmcnt(0)" ::: "memory");
  __builtin_amdgcn_s_barrier();
}

template <int TM, int TN, int OUTC, class F>
DI void epilogue_bf16(const f32x16 (&acc)[TM][TN], unsigned char* lds, bf16_t* out, int ldo, int m0, int c0, int cmax, F f) {
  constexpr int BM = 128 * TM, STRIDE = OUTC * 2 + 16, TNO = OUTC / (32 * 2);
  const int tid = tidx(), wave = __builtin_amdgcn_readfirstlane(tid >> 6), lane = tid & 63, r = lane & 31, h = lane >> 5, wm = wave & 3, wn = wave >> 2;
#pragma unroll
  for (int tm = 0; tm < TM; ++tm)
#pragma unroll
    for (int tn = 0; tn < TNO; ++tn)
#pragma unroll
      for (int g = 0; g < 4; ++g) {
        const int rowl = wm * 32 * TM + tm * 32 + r, coll = wn * 32 * TNO + tn * 32 + 8 * g + 4 * h;
        const f32x4 o = f(tm, tn, g, rowl, coll);
        u32x2 w; w[0] = pk2(o[0], o[1]); w[1] = pk2(o[2], o[3]);
        *(u32x2*)(lds + rowl * STRIDE + coll * 2) = w;
      }
  __syncthreads();
  constexpr int CPR = OUTC / 8;
#pragma unroll
  for (int j = 0; j < BM * CPR / NTHREADS; ++j) {
    const int id = tid + NTHREADS * j, row = id / CPR, c = id % CPR;
    if (c0 + c * 8 < cmax) *(u32x4*)(out + (size_t)(m0 + row) * ldo + c0 + c * 8) = *(const u32x4*)(lds + row * STRIDE + c * 16);
  }
  __syncthreads();
}
DI f32x4 acc4(const f32x16& a, int g) { return (f32x4){a[4 * g], a[4 * g + 1], a[4 * g + 2], a[4 * g + 3]}; }

struct TileIter {
  int nM, nN, total, L, Lend, step;
  DI void init(int nM_, int nN_) {
    nM = nM_; nN = nN_; total = nM * nN;
    const int nx = (gridDim.x & 7) == 0 ? 8 : 1, x = blockIdx.x % nx, local = blockIdx.x / nx;
    step = gridDim.x / nx;
    const int per = (total + nx - 1) / nx;
    L = x * per + local; Lend = (x + 1) * per < total ? (x + 1) * per : total;
  }
  DI bool next(int& tmi, int& tni) {
    if (L >= Lend) return false;
    const int fb = nM >> 2, fullcnt = fb * 4 * nN;
    if (L < fullcnt) { const int band = L / (4 * nN), jj = L - band * 4 * nN; tni = jj >> 2; tmi = band * 4 + (jj & 3); }
    else { const int l2 = L - fullcnt, bm = nM & 3; tni = l2 / bm; tmi = fb * 4 + l2 % bm; }
    L += step; return true;
  }
};

DI void phase1(const Params& p, unsigned char* lds) {
  const bf16_t* XB = (const bf16_t*)((unsigned char*)p.out + OO_XB);
  const bf16_t* WT = (const bf16_t*)(p.ws + O_WIN);
  bf16_t* PAB = (bf16_t*)(p.ws + O_PAB);
  constexpr int NMT = NT / 256, NNT = (PABC + 127) / 128;
  const int lane = tidx() & 63, wave = __builtin_amdgcn_readfirstlane(tidx() >> 6), r = lane & 31, h = lane >> 5, wm = wave & 3, wn = wave >> 2;
  TileIter ti; ti.init(NMT, NNT);
  int tmi, tni;
  while (ti.next(tmi, tni)) {
    const int m0 = tmi * 256, n0 = tni * 128;
    f32x16 acc[2][2];
    gemm_mainloop<2, 2>(XB, DM, WT, DM, DM, m0, n0, PABC, acc, lds);
    if (m0 + 256 > NP - 1 && n0 < ACOLS) {
#pragma unroll
      for (int tm = 0; tm < 2; ++tm) {
        const int row = m0 + wm * 64 + tm * 32 + r;
        const bool lastp = row == NP - 1, lasts = row >= NP && ((row - NP) & 31) == 31;
        if (lastp || lasts) {
          float* dst = lastp ? p.out + F_SHP : p.out + F_SHS + (size_t)((row - NP) >> 5) * ACOLS;
#pragma unroll
          for (int tn = 0; tn < 2; ++tn)
#pragma unroll
            for (int g = 0; g < 4; ++g) {
              const int col = n0 + wn * 64 + tn * 32 + 8 * g + 4 * h;
              if (col < ACOLS) *(f32x4*)(dst + col) = acc4(acc[tm][tn], g);
            }
        }
      }
    }
    epilogue_bf16<2, 2, 128>(acc, lds, PAB, PABC, m0, n0, PABC, [&](int tm, int tn, int g, int, int) { return acc4(acc[tm][tn], g); });
  }
}

constexpr int L2_LORA = 0, L2_K = L2_LORA + 32 * 528, L2_R = L2_K + 32 * 1040, L2A_STG = L2_R + 32 * 1040, L2A_END = L2A_STG + 8 * 32 * 144;
constexpr int L2_CQ = 0, L2_CKV = L2_CQ + 32 * 528, L2B_STG = L2_CKV + 32 * 272, L2B_END = L2B_STG + 8 * 32 * 208;
static_assert(L2A_END <= LDS_BYTES && L2B_END <= LDS_BYTES, "lds p2");
template <int NTL, class F>
DI void stage_store16(unsigned char* stg, int lane, bf16_t* dst  , unsigned row_stride  , F f) {
  constexpr int RS = NTL * 64 + 16, CPR = NTL * 4;
  const int r = lane & 31, h = lane >> 5;
#pragma unroll
  for (int nt = 0; nt < NTL; ++nt)
#pragma unroll
    for (int i = 0; i < 16; ++i) *(unsigned short*)(stg + crow(i, h) * RS + (nt * 32 + r) * 2) = f(nt, i);
  __syncthreads();
#pragma unroll
  for (int j = 0; j < 32 * CPR / 64; ++j) {
    const int id = lane + 64 * j, row = id / CPR, ch = id % CPR;
    *(u32x4*)(dst + (size_t)row * row_stride + ch * 8) = *(const u32x4*)(stg + row * RS + ch * 16);
  }
  __syncthreads();
}

template <int NTL, int KS>
DI void mm32(const unsigned char* ldsA, int strideB, const bf16_t* Bt, int ldb, int lane, f32x16 (&acc)[NTL]) {
  constexpr int KG = (NTL * KS <= 16) ? KS : (NTL <= 2 ? 4 : 2), NG = KS / KG;
  const int r = lane & 31, h = lane >> 5;
#pragma unroll
  for (int nt = 0; nt < NTL; ++nt)
#pragma unroll
    for (int i = 0; i < 16; ++i) acc[nt][i] = 0.f;
  bf16x8 bq[2][KG][NTL];
  const bf16_t* bp = Bt + (size_t)r * ldb + h * 8;
#pragma unroll
  for (int k = 0; k < KG; ++k)
#pragma unroll
    for (int nt = 0; nt < NTL; ++nt) bq[0][k][nt] = *(const bf16x8*)(bp + (size_t)(nt * 32) * ldb + k * 16);
#pragma unroll
  for (int g = 0; g < NG; ++g) {
    if (g + 1 < NG) {
#pragma unroll
      for (int k = 0; k < KG; ++k)
#pragma unroll
        for (int nt = 0; nt < NTL; ++nt) bq[(g + 1) & 1][k][nt] = *(const bf16x8*)(bp + (size_t)(nt * 32) * ldb + ((g + 1) * KG + k) * 16);
    }
    __builtin_amdgcn_sched_barrier(0);
#pragma unroll
    for (int k = 0; k < KG; ++k) {
      const bf16x8 a = *(const bf16x8*)(ldsA + r * strideB + (g * KG + k) * 32 + h * 16);
#pragma unroll
      for (int nt = 0; nt < NTL; ++nt) acc[nt] = MFMA32(a, bq[g & 1][k][nt], acc[nt]);
    }
    __builtin_amdgcn_sched_barrier(0);
  }
}

DI void kv_expand(const Params& p, unsigned char* lds, int w, int lane, int slot0) {
  const int r = lane & 31, h = lane >> 5;
  bf16_t* knb = (bf16_t*)(p.ws + O_KNB);
  bf16_t* vT = (bf16_t*)((unsigned char*)p.out + OO_VT);
  f32x16 acc[4];
  mm32<4, 8>(lds + L2_CKV, 272, (const bf16_t*)(p.ws + O_WUKV) + (size_t)(128 * w) * 128, 128, lane, acc);
  stage_store16<2>((unsigned char*)lds + L2B_STG + w * (32 * 208), lane, knb + ((size_t)w * NKVP + slot0) * 64, 64, [&](int nt, int i) { return f2bf(acc[nt][i]); });
#pragma unroll
  for (int nt = 2; nt < 4; ++nt)
#pragma unroll
    for (int g = 0; g < 4; ++g) {
      u32x2 o; o[0] = pk2(acc[nt][4 * g], acc[nt][4 * g + 1]); o[1] = pk2(acc[nt][4 * g + 2], acc[nt][4 * g + 3]);
      *(u32x2*)(vT + ((unsigned)w * 64 + (nt - 2) * 32 + r) * (unsigned)NKVP + slot0 + 8 * g + 4 * h) = o;
    }
}

DI void p2_token_tile_a(const Params& p, unsigned char* lds, int tile) {
  const int tid = tidx(), wave = __builtin_amdgcn_readfirstlane(tid >> 6), lane = tid & 63, r = lane & 31, h = lane >> 5;
  const int t0 = tile * 32;
  unsigned char* ws = p.ws;
  const bf16_t* PAB = (const bf16_t*)(ws + O_PAB);
  bf16_t* SR = (bf16_t*)(ws + O_SIN);
  bf16_t* SK = SR + (size_t)NT * 512; bf16_t* SV = SK + (size_t)NT * 512; bf16_t* SA = SV + (size_t)NT * 512; bf16_t* SB = SA + (size_t)NT * 512;
  _Float16* SW = (_Float16*)(SB + (size_t)NT * 512);
  bf16_t* G = (bf16_t*)(ws + O_G);
  float* RK = (float*)(ws + O_RK);
  const float* rope = (const float*)(ws + O_ROPE);
#pragma unroll 1
  for (int bt = 0; bt < 2; ++bt) {
    u32x4 rawp[7], rawq[7];
#pragma unroll
    for (int it = 0; it < 7; ++it) {
      const int task = tid + NTHREADS * (bt * 7 + it);
      const int tl = task / 224, ch = task - tl * 224, c0 = ch * 8, t = t0 + tl;
      rawp[it] = *(const u32x4*)(PAB + (size_t)t * PABC + c0);
      rawq[it] = *(const u32x4*)(PAB + (size_t)(t > 0 ? t - 1 : 0) * PABC + c0);
    }
#pragma unroll
    for (int it = 0; it < 7; ++it) {
      const int task = tid + NTHREADS * (bt * 7 + it);
      const int tl = task / 224, ch = task - tl * 224, c0 = ch * 8, t = t0 + tl;
      float pv[8], pr[8];
      unpack8(rawp[it], pv);
      unpack8(rawq[it], pr);
      if (t == 0) {
#pragma unroll
        for (int j = 0; j < 8; ++j) pr[j] = 0.f;
      } else if (t >= NP && ((t - NP) & 31) == 0) {
        const float* sp = p.in[5] + (size_t)((t - NP) >> 5) * ACOLS + c0;
        const f32x4 a = *(const f32x4*)sp, b = *(const f32x4*)(sp + 4);
        pr[0] = a[0]; pr[1] = a[1]; pr[2] = a[2]; pr[3] = a[3]; pr[4] = b[0]; pr[5] = b[1]; pr[6] = b[2]; pr[7] = b[3];
      }
      const f32x4 mu0 = *(const f32x4*)(p.in[7] + c0), mu1 = *(const f32x4*)(p.in[7] + c0 + 4);
      const float mm[8] = {mu0[0], mu0[1], mu0[2], mu0[3], mu1[0], mu1[1], mu1[2], mu1[3]};
      float xs[8];
#pragma unroll
      for (int j = 0; j < 8; ++j) xs[j] = pv[j] + (pr[j] - pv[j]) * mm[j];
      if (c0 < 512) {
        const u32x4 o = pack8(xs);
        *(u32x4*)(SR + (size_t)t * 512 + c0) = o;
        *(u32x4*)(lds + L2_R + tl * 1040 + c0 * 2) = o;
      } else if (c0 < 1024) {
        *(u32x4*)(lds + L2_K + tl * 1040 + (c0 - 512) * 2) = pack8(xs);
      } else if (c0 < 1536) {
        *(u32x4*)(SV + (size_t)t * 512 + (c0 - 1024)) = pack8(xs);
      } else {
        if (c0 < 1600) {
#pragma unroll
          for (int j = 0; j < 8; ++j) { const float e = __expf(2.f * xs[j]); xs[j] = 1.f - 2.f / (e + 1.f); }
        } else if (c0 >= 1664) {
#pragma unroll
          for (int j = 0; j < 8; ++j) xs[j] = sigmoidf_(xs[j]);
        }
        *(u32x4*)(lds + L2_LORA + tl * 528 + (c0 - 1536) * 2) = pack8(xs);
      }
    }
  }
  __syncthreads();
  const int w = wave, cb = 64 * w;
  {
    int r = (tidx() & 31);
    f32x16 acc[2];
    mm32<2, 4>(lds + L2_LORA, 528, (const bf16_t*)(ws + O_WW2) + (size_t)cb * 64, 64, lane, acc);
    const float w00 = p.in[8][cb + r], w01 = p.in[8][cb + 32 + r];
    stage_store16<2>(lds + L2A_STG + w * (32 * 144), lane, (bf16_t*)SW + (size_t)t0 * 512 + cb, 512, [&](int nt, int i) {
      const float z = (nt ? w01 : w00) + acc[nt][i];
      const float sp = fmaxf(-z, 0.f) + __logf(1.f + __expf(-fabsf(z)));
      const float dec = __expf(-__expf(-sp - 0.5f));
      return __builtin_bit_cast(unsigned short, (_Float16)dec);
    });
  }
  __syncthreads();
  {
    int r = (tidx() & 31);
    f32x16 acc[2];
    mm32<2, 4>(lds + L2_LORA + 128, 528, (const bf16_t*)(ws + O_WA2) + (size_t)cb * 64, 64, lane, acc);
    float kkv[2][16];
#pragma unroll
    for (int nt = 0; nt < 2; ++nt) {
      const int c = cb + nt * 32 + r;
      const float a0 = p.in[10][c], kkc = p.in[13][c];
#pragma unroll
      for (int i = 0; i < 16; ++i) {
        acc[nt][i] = sigmoidf_(a0 + acc[nt][i]);
        kkv[nt][i] = bf2f(*(const bf16_t*)(lds + L2_K + crow(i, h) * 1040 + c * 2)) * kkc;
      }
    }
#pragma unroll
    for (int i = 0; i < 16; ++i) {
      const float nsq = sum32(kkv[0][i] * kkv[0][i] + kkv[1][i] * kkv[1][i]);
      const float inv = 1.f / fmaxf(sqrtf(nsq), 1e-12f);
      kkv[0][i] *= inv; kkv[1][i] *= inv;
      __builtin_amdgcn_sched_barrier(0);
    }
    const int c0 = cb + r, c1 = cb + 32 + r;
    const float ka0 = p.in[14][c0], ka1 = p.in[14][c1], rk0 = p.in[15][c0], rk1 = p.in[15][c1];
    unsigned char* stg = lds + L2A_STG + w * (32 * 144);
    stage_store16<2>(stg, lane, SA + (size_t)t0 * 512 + cb, 512, [&](int nt, int i) { return f2bf(-kkv[nt][i]); });
    stage_store16<2>(stg, lane, SB + (size_t)t0 * 512 + cb, 512, [&](int nt, int i) { return f2bf(kkv[nt][i] * acc[nt][i]); });
#pragma unroll
    for (int i = 0; i < 16; ++i) {
      const int tl = crow(i, h);
      const float kr0 = bf2f(*(const bf16_t*)(lds + L2_K + tl * 1040 + c0 * 2)), kr1 = bf2f(*(const bf16_t*)(lds + L2_K + tl * 1040 + c1 * 2));
      const float kh0 = kr0 * (1.f + (acc[0][i] - 1.f) * ka0), kh1 = kr1 * (1.f + (acc[1][i] - 1.f) * ka1);
      kkv[0][i] = kh0; kkv[1][i] = kh1;
      const float rr0 = bf2f(*(const bf16_t*)(lds + L2_R + tl * 1040 + c0 * 2)), rr1 = bf2f(*(const bf16_t*)(lds + L2_R + tl * 1040 + c1 * 2));
      const float sb = sum32(rr0 * kh0 * rk0 + rr1 * kh1 * rk1);
      if (r == 0) RK[(unsigned)(t0 + tl) * 8u + w] = sb;
    }
    stage_store16<2>(stg, lane, SK + (size_t)t0 * 512 + cb, 512, [&](int nt, int i) { return f2bf(kkv[nt][i]); });
  }
  __syncthreads();
  {
    int r = (tidx() & 31);
    f32x16 acc[2];
    mm32<2, 8>(lds + L2_LORA + 256, 528, (const bf16_t*)(ws + O_WG2) + (size_t)cb * 128, 128, lane, acc);
    stage_store16<2>(lds + L2A_STG + w * (32 * 144), lane, G + (size_t)t0 * 512 + cb, 512, [&](int nt, int i) { return f2bf(acc[nt][i]); });
  }
  __syncthreads();
}

DI void p2_token_tile_b(const Params& p, unsigned char* lds, int tile) {
  const int tid = tidx(), wave = __builtin_amdgcn_readfirstlane(tid >> 6), lane = tid & 63, r = lane & 31, h = lane >> 5;
  const int t0 = tile * 32;
  unsigned char* ws = p.ws;
  const bf16_t* PAB = (const bf16_t*)(ws + O_PAB);
  bf16_t* SR = (bf16_t*)(ws + O_SIN);
  bf16_t* SK = SR + (size_t)NT * 512; bf16_t* SV = SK + (size_t)NT * 512; bf16_t* SA = SV + (size_t)NT * 512; bf16_t* SB = SA + (size_t)NT * 512;
  _Float16* SW = (_Float16*)(SB + (size_t)NT * 512);
  bf16_t* G = (bf16_t*)(ws + O_G);
  float* RK = (float*)(ws + O_RK);
  const float* rope = (const float*)(ws + O_ROPE);
  {
    u32x2 vq[4]; unsigned vc[4]; float k1[4], k2[4], rc[4], rs_[4];
#pragma unroll
    for (int q = 0; q < 4; ++q) {
      const int t = t0 + wave * 4 + q;
      const bf16_t* pb = PAB + (size_t)t * PABC + ACOLS;
      vq[q] = *(const u32x2*)(pb + 4 * lane);
      vc[q] = *(const unsigned*)(pb + 256 + 2 * lane);
      k1[q] = bf2f(pb[384 + (lane & 15)]); k2[q] = bf2f(pb[400 + (lane & 15)]);
      rc[q] = rope[t * 32 + (lane & 15)]; rs_[q] = rope[t * 32 + 16 + (lane & 15)];
    }
    const f32x4 gq = *(const f32x4*)(p.in[19] + 4 * lane);
    const f32x2 gkv = *(const f32x2*)(p.in[21] + 2 * lane);
#pragma unroll
    for (int q = 0; q < 4; ++q) {
      const int tl = wave * 4 + q, t = t0 + tl;
      {
        const u32x2 v = vq[q];
        float x[4] = {__uint_as_float(v[0] << 16), __uint_as_float(v[0] & 0xffff0000u), __uint_as_float(v[1] << 16), __uint_as_float(v[1] & 0xffff0000u)};
        const float ss = wave_sum(x[0] * x[0] + x[1] * x[1] + x[2] * x[2] + x[3] * x[3]);
        const float rs = rsqrtf(ss * (1.f / 256.f) + 1e-6f);
        u32x2 o; o[0] = pk2(x[0] * rs * gq[0], x[1] * rs * gq[1]); o[1] = pk2(x[2] * rs * gq[2], x[3] * rs * gq[3]);
        *(u32x2*)(lds + L2_CQ + tl * 528 + lane * 8) = o;
      }
      {
        const unsigned v = vc[q];
        const float x0 = __uint_as_float(v << 16), x1 = __uint_as_float(v & 0xffff0000u);
        const float ss = wave_sum(x0 * x0 + x1 * x1);
        const float rs = rsqrtf(ss * (1.f / 128.f) + 1e-6f);
        const float o0 = x0 * rs * gkv[0], o1 = x1 * rs * gkv[1];
        float* dst = (t < NP) ? p.out + F_CKVP + (size_t)t * 128 : p.out + F_CKVS + (size_t)(t - NP) * 128;
        f32x2 of = {o0, o1};
        *(f32x2*)(dst + 2 * lane) = of;
        *(unsigned*)(lds + L2_CKV + tl * 272 + lane * 4) = pk2(o0, o1);
      }
      if (lane < 16) {
        const float o1 = k1[q] * rc[q] - k2[q] * rs_[q], o2 = k1[q] * rs_[q] + k2[q] * rc[q];
        float* dst = (t < NP) ? p.out + F_KPEP + (size_t)t * 32 : p.out + F_KPES + (size_t)(t - NP) * 32;
        dst[lane] = o1; dst[16 + lane] = o2;
        bf16_t* kp = (bf16_t*)(ws + O_KPEB) + (size_t)slot_of_token(t) * 32;
        kp[lane] = f2bf(o1); kp[16 + lane] = f2bf(o2);
      }
    }
  }
  __syncthreads();
  const int w = wave, cb = 64 * w;
  {
    int r = (tidx() & 31);
    f32x16 acc[3];
    mm32<3, 16>(lds + L2_CQ, 528, (const bf16_t*)(ws + O_WUQ) + (size_t)(96 * w) * 256, 256, lane, acc);
    bf16_t* Q = (bf16_t*)((unsigned char*)p.out + OO_Q);
    const int j = r & 15;
#pragma unroll
    for (int i = 0; i < 16; ++i) {
      const int t = t0 + crow(i, h);
      const float own = acc[2][i], oth = __shfl_xor(own, 16);
      const float c = rope[t * 32 + j], sn = rope[t * 32 + 16 + j];
      acc[2][i] = (r < 16) ? own * c - oth * sn : oth * sn + own * c;
    }
    stage_store16<3>(lds + L2B_STG + w * (32 * 208), lane, Q + (size_t)t0 * 768 + 96 * w, 768, [&](int nt, int i) { return f2bf(acc[nt][i] * QSCALE); });
  }
  __syncthreads();
  kv_expand(p, lds, w, lane, slot_of_token(t0));
  __syncthreads();
}

DI void p2_cache_tile(const Params& p, unsigned char* lds, int ctile) {
  const int tid = tidx(), wave = __builtin_amdgcn_readfirstlane(tid >> 6), lane = tid & 63;
  const int b = ctile >> 5, j0 = (ctile & 31) * 32;
  {
    const int row = tid >> 4, c = (tid & 15) * 8;
    const float* src = p.in[2] + ((size_t)(b * PAST + j0 + row)) * 128 + c;
    f32x4 a = *(const f32x4*)src, d = *(const f32x4*)(src + 4);
    float f[8] = {a[0], a[1], a[2], a[3], d[0], d[1], d[2], d[3]};
    *(u32x4*)(lds + L2_CKV + row * 272 + c * 2) = pack8(f);
  }
  __syncthreads();
  kv_expand(p, lds, wave, lane, NP + b * SKV + j0);
  __syncthreads();
}

DI void phase2(const Params& p, unsigned char* lds) {
  constexpr int NTT = NT / 32, NCT = DB * PAST / 32;
  {
    bf16_t* vT = (bf16_t*)((unsigned char*)p.out + OO_VT);
    for (int id = blockIdx.x * NTHREADS + tidx(); id < 8 * 64 * 64; id += gridDim.x * NTHREADS) vT[(size_t)(id >> 6) * NKVP + NKV + (id & 63)] = 0;
  }
  for (int it = blockIdx.x; it < NTT; it += gridDim.x) p2_token_tile_a(p, lds, it);
  for (int it = blockIdx.x; it < NTT + NCT; it += gridDim.x) {
    if (it < NTT) p2_token_tile_b(p, lds, it); else p2_cache_tile(p, lds, it - NTT);
  }
}

constexpr int AT_KSTRIDE = 208, AT_VSTRIDE = 136, AT_KBYTES = 64 * AT_KSTRIDE, AT_STAGE = AT_KBYTES + 64 * AT_VSTRIDE;

DI void attn_item(const Params& p, unsigned char* lds, int hd, int qtok0, int nact, int slot0, int ntiles, int nvalid, bool causal) {
  const int tid = tidx(), wave = __builtin_amdgcn_readfirstlane(tid >> 6), lane = tid & 63, r = lane & 31, h = lane >> 5;
  const bf16_t* Q = (const bf16_t*)((const unsigned char*)p.out + OO_Q);
  const bf16_t* knb = (const bf16_t*)(p.ws + O_KNB) + (size_t)hd * NKVP * 64;
  const bf16_t* kpeb = (const bf16_t*)(p.ws + O_KPEB);
  const bf16_t* vT = (const bf16_t*)((const unsigned char*)p.out + OO_VT) + (size_t)hd * 64 * NKVP;
  bf16_t* YB = (bf16_t*)(p.ws + O_YB);
  const bool active = wave < nact;
  const int qtok = qtok0 + 32 * wave;
  const int wlim = !active ? 0 : (causal ? (qtok >> 6) + 1 : ntiles);
  bf16x8 qf[6];
  if (active) {
#pragma unroll
    for (int ks = 0; ks < 6; ++ks) qf[ks] = *(const bf16x8*)(Q + (size_t)(qtok + r) * 768 + 96 * hd + ks * 16 + h * 8);
  } else {
#pragma unroll
    for (int ks = 0; ks < 6; ++ks) qf[ks] = (bf16x8){0, 0, 0, 0, 0, 0, 0, 0};
  }
  f32x16 o0, o1;
#pragma unroll
  for (int i = 0; i < 16; ++i) { o0[i] = 0.f; o1[i] = 0.f; }
  float mrun = -1e30f, lsum = 0.f;
  const int k_key = tid >> 3, k_ch = tid & 7;
  const int pe_key = (tid & 255) >> 2, pe_ch = tid & 3;
  const int v_dim = tid >> 3, v_ch = tid & 7;
  u32x4 rk, rpe, rv;
  auto gload = [&](int kt) {
    const int s = slot0 + kt * 64;
    rk = *(const u32x4*)(knb + (size_t)(s + k_key) * 64 + k_ch * 8);
    if (tid < 256) rpe = *(const u32x4*)(kpeb + (size_t)(s + pe_key) * 32 + pe_ch * 8);
    rv = *(const u32x4*)(vT + (size_t)v_dim * NKVP + s + v_ch * 8);
  };
  auto lstore = [&](int buf) {
    unsigned char* b = lds + buf * AT_STAGE;
    *(u32x4*)(b + k_key * AT_KSTRIDE + k_ch * 16) = rk;
    if (tid < 256) *(u32x4*)(b + pe_key * AT_KSTRIDE + 128 + pe_ch * 16) = rpe;
    u32x2 lo = {rv[0], rv[1]}, hi = {rv[2], rv[3]};
    *(u32x2*)(b + AT_KBYTES + v_dim * AT_VSTRIDE + v_ch * 16) = lo;
    *(u32x2*)(b + AT_KBYTES + v_dim * AT_VSTRIDE + v_ch * 16 + 8) = hi;
  };
  gload(0); lstore(0);
  __syncthreads();
  for (int kt = 0; kt < ntiles; ++kt) {
    const bool more = kt + 1 < ntiles;
    if (more) gload(kt + 1);
    if (kt < wlim) {
      const unsigned char* kb = lds + (kt & 1) * AT_STAGE;
      const unsigned char* vb = kb + AT_KBYTES;
      f32x16 s0, s1;
#pragma unroll
      for (int i = 0; i < 16; ++i) { s0[i] = 0.f; s1[i] = 0.f; }
#pragma unroll
      for (int ks = 0; ks < 6; ++ks) {
        const bf16x8 a0 = *(const bf16x8*)(kb + r * AT_KSTRIDE + ks * 32 + h * 16);
        const bf16x8 a1 = *(const bf16x8*)(kb + (32 + r) * AT_KSTRIDE + ks * 32 + h * 16);
        s0 = MFMA32(a0, qf[ks], s0);
        s1 = MFMA32(a1, qf[ks], s1);
      }
      if (kt * 64 + 64 > nvalid) {
#pragma unroll
        for (int i = 0; i < 16; ++i) {
          const int key = kt * 64 + crow(i, h);
          if (key >= nvalid) s0[i] = -1e30f;
          if (key + 32 >= nvalid) s1[i] = -1e30f;
        }
      }
      float mx = s0[0];
#pragma unroll
      for (int i = 1; i < 16; ++i) mx = fmaxf(mx, s0[i]);
#pragma unroll
      for (int i = 0; i < 16; ++i) mx = fmaxf(mx, s1[i]);
      mx = fmaxf(mx, __shfl_xor(mx, 32));
      const float mnew = fmaxf(mrun, mx);
      const float alpha = __builtin_amdgcn_exp2f(mrun - mnew);
      mrun = mnew;
      float rs = 0.f;
#pragma unroll
      for (int i = 0; i < 16; ++i) { s0[i] = __builtin_amdgcn_exp2f(s0[i] - mnew); rs += s0[i]; }
#pragma unroll
      for (int i = 0; i < 16; ++i) { s1[i] = __builtin_amdgcn_exp2f(s1[i] - mnew); rs += s1[i]; }
      lsum = lsum * alpha + rs;
#pragma unroll
      for (int i = 0; i < 16; ++i) { o0[i] *= alpha; o1[i] *= alpha; }
#pragma unroll
      for (int mt = 0; mt < 2; ++mt)
#pragma unroll
        for (int s = 0; s < 2; ++s) {
          const f32x16& sv = mt ? s1 : s0;
          u32x4 pw;
          pw[0] = pk2(sv[8 * s], sv[8 * s + 1]); pw[1] = pk2(sv[8 * s + 2], sv[8 * s + 3]);
          pw[2] = pk2(sv[8 * s + 4], sv[8 * s + 5]); pw[3] = pk2(sv[8 * s + 6], sv[8 * s + 7]);
          const bf16x8 pb = __builtin_bit_cast(bf16x8, pw);
          const int kbase = mt * 32 + 16 * s + 4 * h;
          {
            const s16x4 lo = *(const s16x4*)(vb + r * AT_VSTRIDE + kbase * 2);
            const s16x4 hi = *(const s16x4*)(vb + r * AT_VSTRIDE + (kbase + 8) * 2);
            const bf16x8 av = __builtin_shufflevector(lo, hi, 0, 1, 2, 3, 4, 5, 6, 7);
            o0 = MFMA32(av, pb, o0);
          }
          {
            const s16x4 lo = *(const s16x4*)(vb + (32 + r) * AT_VSTRIDE + kbase * 2);
            const s16x4 hi = *(const s16x4*)(vb + (32 + r) * AT_VSTRIDE + (kbase + 8) * 2);
            const bf16x8 av = __builtin_shufflevector(lo, hi, 0, 1, 2, 3, 4, 5, 6, 7);
            o1 = MFMA32(av, pb, o1);
          }
        }
    }
    if (more) lstore((kt + 1) & 1);
    __syncthreads();
  }
  if (active) {
    const float lt = lsum + __shfl_xor(lsum, 32);
    const float inv = 1.f / lt;
    bf16_t* dst = YB + (size_t)(qtok + r) * 512 + hd * 64;
#pragma unroll
    for (int g = 0; g < 4; ++g) {
      u32x2 a, b;
      a[0] = pk2(o0[4 * g] * inv, o0[4 * g + 1] * inv); a[1] = pk2(o0[4 * g + 2] * inv, o0[4 * g + 3] * inv);
      b[0] = pk2(o1[4 * g] * inv, o1[4 * g + 1] * inv); b[1] = pk2(o1[4 * g + 2] * inv, o1[4 * g + 3] * inv);
      *(u32x2*)(dst + 8 * g + 4 * h) = a;
      *(u32x2*)(dst + 32 + 8 * g + 4 * h) = b;
    }
  }
}

constexpr int SC_TOK = 32, SC_ARR = SC_TOK * 64 * 4, SC_STAGE = 5 * SC_ARR + SC_TOK * 32 * 4;
static_assert(2 * SC_STAGE <= LDS_BYTES, "lds scan");
DI void scan_job(const Params& p, unsigned char* lds, int head, int rowgrp, int tok0, int nsteps, int init_mode  ,
                 const float* init  , bool use_v, bf16_t* Y  , float* state_out  ) {
  const int tid = tidx(), wave = __builtin_amdgcn_readfirstlane(tid >> 6), lane = tid & 63;
  const bf16_t* SR = (const bf16_t*)(p.ws + O_SIN);
  const bf16_t* SK = SR + (size_t)NT * 512; const bf16_t* SV = SK + (size_t)NT * 512; const bf16_t* SA = SV + (size_t)NT * 512; const bf16_t* SB = SA + (size_t)NT * 512;
  const _Float16* SW = (const _Float16*)(SB + (size_t)NT * 512);
  u32x4 rg[3];
  auto gload = [&](int c) {
    const int tb = tok0 + c * SC_TOK;
#pragma unroll
    for (int i = 0; i < 3; ++i) {
      const int L = tid + NTHREADS * i;
      if (L < 1280) {
        const int arr = L >> 8, tok = (L & 255) >> 3, ch = L & 7;
        const bf16_t* base = arr == 0 ? SA : arr == 1 ? SB : arr == 2 ? (const bf16_t*)SW : arr == 3 ? SK : SR;
        rg[i] = *(const u32x4*)(base + (size_t)(tb + tok) * 512 + head * 64 + ch * 8);
      } else if (L < 1408) {
        const int vl = L - 1280, tok = vl >> 2, hf = vl & 3;
        rg[i] = *(const u32x4*)(SV + (size_t)(tb + tok) * 512 + head * 64 + rowgrp * 32 + hf * 8);
      }
    }
  };
  auto lstore = [&](int buf) {
    unsigned char* b = lds + buf * SC_STAGE;
#pragma unroll
    for (int i = 0; i < 3; ++i) {
      const int L = tid + NTHREADS * i;
      float f[8];
      if (L < 1280) {
        const int arr = L >> 8, tok = (L & 255) >> 3, ch = L & 7;
        if (arr == 2) {
#pragma unroll
          for (int j = 0; j < 4; ++j) {
            const unsigned u = rg[i][j];
            f[2 * j] = (float)__builtin_bit_cast(_Float16, (unsigned short)(u & 0xffffu));
            f[2 * j + 1] = (float)__builtin_bit_cast(_Float16, (unsigned short)(u >> 16));
          }
        } else unpack8(rg[i], f);
        float* d = (float*)(b + arr * SC_ARR + tok * 256 + ch * 32);
        *(f32x4*)d = (f32x4){f[0], f[1], f[2], f[3]};
        *(f32x4*)(d + 4) = (f32x4){f[4], f[5], f[6], f[7]};
      } else if (L < 1408) {
        const int vl = L - 1280, tok = vl >> 2, hf = vl & 3;
        unpack8(rg[i], f);
        if (!use_v) {
#pragma unroll
          for (int j = 0; j < 8; ++j) f[j] = 0.f;
        }
        float* d = (float*)(b + 5 * SC_ARR + tok * 128 + hf * 32);
        *(f32x4*)d = (f32x4){f[0], f[1], f[2], f[3]};
        *(f32x4*)(d + 4) = (f32x4){f[4], f[5], f[6], f[7]};
      }
    }
  };
  const int rl = lane >> 4, c = lane & 15;
  const int vrow = rowgrp * 32 + 4 * wave + rl;
  f32x4 s = {0.f, 0.f, 0.f, 0.f};
  if (init_mode == 1) s = *(const f32x4*)(init + vrow * 64 + 4 * c);
  if (init_mode == 2) { s[0] = (4 * c == vrow) ? 1.f : 0.f; s[1] = (4 * c + 1 == vrow) ? 1.f : 0.f; s[2] = (4 * c + 2 == vrow) ? 1.f : 0.f; s[3] = (4 * c + 3 == vrow) ? 1.f : 0.f; }
  gload(0); lstore(0);
  __syncthreads();
  const int nch = nsteps / SC_TOK;
  for (int ci = 0; ci < nch; ++ci) {
    const bool more = ci + 1 < nch;
    if (more) gload(ci + 1);
    {
      const unsigned char* b = lds + (ci & 1) * SC_STAGE + c * 16;
      const unsigned char* bv = lds + (ci & 1) * SC_STAGE + 5 * SC_ARR + (4 * wave + rl) * 4;
      bf16_t* yp = Y + (size_t)(tok0 + ci * SC_TOK + c) * 512 + head * 64 + vrow;
      f32x4 A4[3], B4[3], W4[3], K4[3], R4[3]; float V1[3];
#define SC_LOAD(slot, t)                                                                                          \
      { A4[slot] = *(const f32x4*)(b + 0 * SC_ARR + (t) * 256); B4[slot] = *(const f32x4*)(b + 1 * SC_ARR + (t) * 256);    \
        W4[slot] = *(const f32x4*)(b + 2 * SC_ARR + (t) * 256); K4[slot] = *(const f32x4*)(b + 3 * SC_ARR + (t) * 256);    \
        R4[slot] = *(const f32x4*)(b + 4 * SC_ARR + (t) * 256); V1[slot] = *(const float*)(bv + (t) * 128); }
      SC_LOAD(0, 0) SC_LOAD(1, 1)
      float ysel = 0.f;
#pragma unroll
      for (int t = 0; t < SC_TOK; ++t) {
        if (t + 2 < SC_TOK) SC_LOAD((t + 2) % 3, t + 2)
        const f32x4 a4 = A4[t % 3], b4 = B4[t % 3], w4 = W4[t % 3], k4 = K4[t % 3], r4 = R4[t % 3];
        const float vv = V1[t % 3];
        const f32x4 vk = vv * k4;
        float sa = (s[0] * a4[0] + s[2] * a4[2]) + (s[1] * a4[1] + s[3] * a4[3]);
        sa = dpp_sum16(sa);
        s = s * w4 + (sa * b4 + vk);
        float y = (s[0] * r4[0] + s[2] * r4[2]) + (s[1] * r4[1] + s[3] * r4[3]);
        y = dpp_sum16(y);
        ysel = (c == (t & 15)) ? y : ysel;
        if ((t & 15) == 15) yp[(size_t)(t - 15) * 512] = f2bf(ysel);
      }
#undef SC_LOAD
    }
    if (more) lstore((ci + 1) & 1);
    __syncthreads();
  }
  *(f32x4*)(state_out + vrow * 64 + 4 * c) = s;
}

constexpr int Q_PSCAN = 8 * (2 + 4 * (SCC - 1)), Q_PATT = 512, Q_SATT = 128, Q_SSCAN = 256, Q_TOTAL = Q_PSCAN + Q_PATT + Q_SATT + Q_SSCAN;
DI void phase3(const Params& p, unsigned char* lds) {
  volatile int* s_itemp = (volatile int*)(lds + LDS_CTRL);
  unsigned* ctr = (unsigned*)(p.ws + O_CTR);
  float* Gb = (float*)(p.ws + O_GH);
  float* Hb = Gb + (size_t)8 * SCC * 4096;
  bf16_t* Y = (bf16_t*)(p.ws + O_Y);
  bf16_t* E = (bf16_t*)(p.ws + O_E);
  for (;;) {
    if (tidx() == 0) *s_itemp = (int)atomicAdd(ctr, 1u);
    __syncthreads();
    const int item = *s_itemp;
    __syncthreads();
    if (item >= Q_TOTAL) break;
    if (item < Q_PSCAN) {
      const int hd = item / (2 + 4 * (SCC - 1)), j = item % (2 + 4 * (SCC - 1));
      if (j < 2) scan_job(p, lds, hd, j, 0, SCL, 0, nullptr, true, Y, Hb + ((size_t)hd * SCC) * 4096);
      else {
        const int jj = j - 2, c = 1 + jj / 4, k = jj % 4;
        if (k < 2) scan_job(p, lds, hd, k, c * SCL, SCL, 0, nullptr, true, Y, Hb + ((size_t)hd * SCC + c) * 4096);
        else scan_job(p, lds, hd, k - 2, c * SCL, SCL, 2, nullptr, false, E, Gb + ((size_t)hd * SCC + c) * 4096);
      }
    } else if (item < Q_PSCAN + Q_PATT) {
      const int k = item - Q_PSCAN, qb = 63 - (k >> 3), hd = k & 7;
      attn_item(p, lds, hd, qb * 256, 8, 0, qb * 4 + 4, (qb * 4 + 4) * 64, true);
    } else if (item < Q_PSCAN + Q_PATT + Q_SATT) {
      const int k = item - Q_PSCAN - Q_PATT, b = k >> 3, hd = k & 7;
      attn_item(p, lds, hd, NP + b * 32, 1, NP + b * SKV, 17, SKV, false);
    } else {
      const int k = item - Q_PSCAN - Q_PATT - Q_SATT, b = k >> 4, hd = (k & 15) >> 1, rg = k & 1;
      scan_job(p, lds, hd, rg, NP + b * 32, 32, 1, p.in[4] + ((size_t)b * 8 + hd) * 4096, true, Y, p.out + F_WKVS + ((size_t)b * 8 + hd) * 4096);
    }
  }
}

DI void phase3b(const Params& p, unsigned char* lds) {
  if (blockIdx.x >= 8) return;
  const int hd = blockIdx.x, tid = tidx();
  const float* Gb = (const float*)(p.ws + O_GH);
  const float* Hb = Gb + (size_t)8 * SCC * 4096;
  bf16_t* SST = (bf16_t*)(p.ws + O_SST);
  float* S = (float*)lds;
  float* Gs = S + 64 * 65;
  const int v = tid >> 3, k0 = (tid & 7) * 8;
  float cur[8];
#pragma unroll
  for (int j = 0; j < 8; ++j) cur[j] = Hb[((size_t)hd * SCC) * 4096 + v * 64 + k0 + j];
  for (int c = 1; c < SCC; ++c) {
    __syncthreads();
#pragma unroll
    for (int j = 0; j < 8; ++j) { S[v * 65 + k0 + j] = cur[j]; Gs[v * 64 + k0 + j] = Gb[((size_t)hd * SCC + c) * 4096 + v * 64 + k0 + j]; }
    *(u32x4*)(SST + ((size_t)c * 8 + hd) * 4096 + v * 64 + k0) = pack8(cur);
    __syncthreads();
    float o[8];
#pragma unroll
    for (int j = 0; j < 8; ++j) o[j] = Hb[((size_t)hd * SCC + c) * 4096 + v * 64 + k0 + j];
    for (int i = 0; i < 64; ++i) {
      const float sv = S[v * 65 + i];
      const f32x4 g0 = *(const f32x4*)(Gs + i * 64 + k0), g1 = *(const f32x4*)(Gs + i * 64 + k0 + 4);
      o[0] += sv * g0[0]; o[1] += sv * g0[1]; o[2] += sv * g0[2]; o[3] += sv * g0[3];
      o[4] += sv * g1[0]; o[5] += sv * g1[1]; o[6] += sv * g1[2]; o[7] += sv * g1[3];
    }
#pragma unroll
    for (int j = 0; j < 8; ++j) cur[j] = o[j];
  }
  float* dst = p.out + F_WKVP + (size_t)hd * 4096 + v * 64 + k0;
  *(f32x4*)dst = (f32x4){cur[0], cur[1], cur[2], cur[3]};
  *(f32x4*)(dst + 4) = (f32x4){cur[4], cur[5], cur[6], cur[7]};
}

DI void phase4a(const Params& p) {
  const int tid = tidx(), lane = tid & 63, r = lane & 31, hh = lane >> 5;
  const int gw = (blockIdx.x * NTHREADS + tid) >> 6, ngw = (gridDim.x * NTHREADS) >> 6;
  const bf16_t* Y = (const bf16_t*)(p.ws + O_Y);
  const bf16_t* E = (const bf16_t*)(p.ws + O_E);
  const bf16_t* SST = (const bf16_t*)(p.ws + O_SST);
  const bf16_t* SV = (const bf16_t*)(p.ws + O_SIN) + 2 * (size_t)NT * 512;
  const bf16_t* G = (const bf16_t*)(p.ws + O_G);
  const float* RK = (const float*)(p.ws + O_RK);
  bf16_t* YA = (bf16_t*)(p.ws + O_YA);
  for (int task = gw; task < (NT / 32) * 8; task += ngw) {
    const int tile = task >> 3, hd = task & 7, t0 = tile * 32, t = t0 + r;
    f32x16 acc[2];
#pragma unroll
    for (int i = 0; i < 16; ++i) { acc[0][i] = 0.f; acc[1][i] = 0.f; }
    const int c = t0 < NP ? t0 / SCL : 0;
    if (c >= 1) {
      const bf16_t* sst = SST + ((size_t)c * 8 + hd) * 4096;
#pragma unroll
      for (int ks = 0; ks < 4; ++ks) {
        const bf16x8 bv = *(const bf16x8*)(E + (size_t)t * 512 + hd * 64 + ks * 16 + hh * 8);
#pragma unroll
        for (int mt = 0; mt < 2; ++mt) {
          const bf16x8 av = *(const bf16x8*)(sst + (mt * 32 + r) * 64 + ks * 16 + hh * 8);
          acc[mt] = MFMA32(av, bv, acc[mt]);
        }
      }
    }
    float sum = 0.f;
#pragma unroll
    for (int mt = 0; mt < 2; ++mt)
#pragma unroll
      for (int g = 0; g < 4; ++g) {
        const u32x2 yv = *(const u32x2*)(Y + (size_t)t * 512 + hd * 64 + mt * 32 + 8 * g + 4 * hh);
        acc[mt][4 * g] += __uint_as_float(yv[0] << 16); acc[mt][4 * g + 1] += __uint_as_float(yv[0] & 0xffff0000u);
        acc[mt][4 * g + 2] += __uint_as_float(yv[1] << 16); acc[mt][4 * g + 3] += __uint_as_float(yv[1] & 0xffff0000u);
        sum += (acc[mt][4 * g] + acc[mt][4 * g + 1]) + (acc[mt][4 * g + 2] + acc[mt][4 * g + 3]);
      }
    sum += __shfl_xor(sum, 32);
    const float mean = sum * (1.f / 64.f);
    float sq = 0.f;
#pragma unroll
    for (int mt = 0; mt < 2; ++mt)
#pragma unroll
      for (int i = 0; i < 16; ++i) { const float d = acc[mt][i] - mean; sq += d * d; }
    sq += __shfl_xor(sq, 32);
    const float rstd = rsqrtf(sq * (1.f / 64.f) + 64e-5f);
    const float bon = RK[(size_t)t * 8 + hd];
#pragma unroll
    for (int mt = 0; mt < 2; ++mt)
#pragma unroll
      for (int g = 0; g < 4; ++g) {
        const int c0 = hd * 64 + mt * 32 + 8 * g + 4 * hh;
        const size_t o = (size_t)t * 512 + c0;
        const f32x4 lg = *(const f32x4*)(p.in[16] + c0), lb = *(const f32x4*)(p.in[17] + c0);
        const u32x2 vv = *(const u32x2*)(SV + o), gg = *(const u32x2*)(G + o);
        const float vf[4] = {__uint_as_float(vv[0] << 16), __uint_as_float(vv[0] & 0xffff0000u), __uint_as_float(vv[1] << 16), __uint_as_float(vv[1] & 0xffff0000u)};
        const float gf[4] = {__uint_as_float(gg[0] << 16), __uint_as_float(gg[0] & 0xffff0000u), __uint_as_float(gg[1] << 16), __uint_as_float(gg[1] & 0xffff0000u)};
        float ov[4];
#pragma unroll
        for (int j = 0; j < 4; ++j) ov[j] = ((acc[mt][4 * g + j] - mean) * rstd * lg[j] + lb[j] + bon * vf[j]) * gf[j];
        u32x2 w; w[0] = pk2(ov[0], ov[1]); w[1] = pk2(ov[2], ov[3]);
        *(u32x2*)(YA + o) = w;
      }
  }
  conv_x(p, (bf16_t*)((unsigned char*)p.out + OO_XB), blockIdx.x * NTHREADS + tidx(), gridDim.x * NTHREADS);
}

DI void phase4(const Params& p, unsigned char* lds) {
  const bf16_t* XB = (const bf16_t*)((unsigned char*)p.out + OO_XB);
  const bf16_t* WIN = (const bf16_t*)(p.ws + O_WIN);
  const bf16_t* YA = (const bf16_t*)(p.ws + O_YA);
  const bf16_t* YB = (const bf16_t*)(p.ws + O_YB);
  bf16_t* M = (bf16_t*)(p.ws + O_M);
  constexpr int NMT = NT / 128, NNT = 8;
  const int lane = tidx() & 63, wave = __builtin_amdgcn_readfirstlane(tidx() >> 6), r = lane & 31, h = lane >> 5, wm = wave & 3, wn = wave >> 2;
  TileIter ti; ti.init(NMT, NNT);
  int tmi, tni;
  while (ti.next(tmi, tni)) {
    const int m0 = tmi * 128, n0 = tni * 128;
    f32x16 accg[1][2], accv[1][2], macc[1][2];
    gemm_mainloop<1, 2>(XB, DM, WIN + (size_t)PABC * DM, DM, DM, m0, n0, 1024, accg, lds);
    gemm_mainloop<1, 2>(YA, 512, (const bf16_t*)(p.ws + O_WPA), 512, 512, m0, n0, 1024, accv, lds);
#pragma unroll
    for (int tn = 0; tn < 2; ++tn)
#pragma unroll
      for (int g = 0; g < 4; ++g) {
        const f32x4 bg = *(const f32x4*)(p.in[24] + n0 + wn * 64 + tn * 32 + 8 * g + 4 * h);
#pragma unroll
        for (int j = 0; j < 4; ++j) macc[0][tn][4 * g + j] = sigmoidf_(accg[0][tn][4 * g + j] + bg[j]) * accv[0][tn][4 * g + j];
      }
    gemm_mainloop<1, 2>(XB, DM, WIN + (size_t)(PABC + 1024) * DM, DM, DM, m0, n0, 1024, accg, lds);
    gemm_mainloop<1, 2>(YB, 512, (const bf16_t*)(p.ws + O_WPB), 512, 512, m0, n0, 1024, accv, lds);
    epilogue_bf16<1, 2, 128>(macc, lds, M, DM, m0, n0, DM, [&](int tm, int tn, int g, int, int coll) {
      const f32x4 bg = *(const f32x4*)(p.in[24] + 1024 + n0 + coll);
      f32x4 o;
#pragma unroll
      for (int j = 0; j < 4; ++j) o[j] = macc[0][tn][4 * g + j] + sigmoidf_(accg[0][tn][4 * g + j] + bg[j]) * accv[0][tn][4 * g + j];
      return o;
    });
  }
}

DI void phase5(const Params& p, unsigned char* lds) {
  const bf16_t* M = (const bf16_t*)(p.ws + O_M);
  bf16_t* Z = (bf16_t*)(p.ws + O_Z);
  constexpr int NMT = NT / 256, NNT = 8;
  TileIter ti; ti.init(NMT, NNT);
  int tmi, tni;
  while (ti.next(tmi, tni)) {
    const int m0 = tmi * 256, n0 = tni * 128;
    f32x16 acc[2][2];
    gemm_mainloop<2, 2>(M, DM, (const bf16_t*)(p.ws + O_WO), DM, DM, m0, n0, 1024, acc, lds);
    epilogue_bf16<2, 2, 128>(acc, lds, Z, DM, m0, n0, DM, [&](int tm, int tn, int g, int rowl, int coll) {
      const f32x4 xv = *(const f32x4*)(xrow(p, m0 + rowl) + n0 + coll);
      return xv * DN_ALPHA + acc4(acc[tm][tn], g);
    });
  }
}
template <bool OUT_BF16>
DI void ln_rows(const bf16_t* src, const float* g, const float* b, bf16_t* dst16, float* dst32) {
  const int gw = (blockIdx.x * NTHREADS + tidx()) >> 6, ngw = (gridDim.x * NTHREADS) >> 6, lane = tidx() & 63;
  for (int t = gw; t < NT; t += ngw) {
    const u32x4* xr = (const u32x4*)(src + (size_t)t * DM) + lane;
    float v[16]; float s = 0.f;
#pragma unroll
    for (int j = 0; j < 2; ++j) { unpack8(xr[64 * j], v + 8 * j); }
#pragma unroll
    for (int j = 0; j < 16; ++j) s += v[j];
    const float mean = wave_sum(s) * (1.f / DM);
    float s2 = 0.f;
#pragma unroll
    for (int j = 0; j < 16; ++j) { v[j] -= mean; s2 += v[j] * v[j]; }
    const float rstd = rsqrtf(wave_sum(s2) * (1.f / DM) + 1e-5f);
#pragma unroll
    for (int j = 0; j < 2; ++j) {
      const int c = 8 * lane + 512 * j;
      const f32x4 g0 = *(const f32x4*)(g + c), g1 = *(const f32x4*)(g + c + 4), b0 = *(const f32x4*)(b + c), b1 = *(const f32x4*)(b + c + 4);
      float o[8];
#pragma unroll
      for (int q = 0; q < 4; ++q) { o[q] = v[8 * j + q] * rstd * g0[q] + b0[q]; o[4 + q] = v[8 * j + 4 + q] * rstd * g1[q] + b1[q]; }
      if (OUT_BF16) *(u32x4*)(dst16 + (size_t)t * DM + c) = pack8(o);
      else { *(f32x4*)(dst32 + (size_t)t * DM + c) = (f32x4){o[0], o[1], o[2], o[3]}; *(f32x4*)(dst32 + (size_t)t * DM + c + 4) = (f32x4){o[4], o[5], o[6], o[7]}; }
    }
  }
}

DI void phase6(const Params& p, unsigned char* lds) {
  const bf16_t* H = (const bf16_t*)(p.ws + O_H);
  bf16_t* ACT = (bf16_t*)(p.ws + O_ACT);
  constexpr int NMT = NT / 256, NNT = 5632 / 128;
  TileIter ti; ti.init(NMT, NNT);
  int tmi, tni;
  while (ti.next(tmi, tni)) {
    const int m0 = tmi * 256, n0 = tni * 128;
    f32x16 acc[2][2];
    gemm_mainloop<2, 2>(H, DM, (const bf16_t*)(p.ws + O_WGU), DM, DM, m0, n0, 5632, acc, lds);
    epilogue_bf16<2, 2, 64>(acc, lds, ACT, DFF, m0, tni * 64, DFF, [&](int tm, int, int g, int, int) {
      f32x4 o;
#pragma unroll
      for (int j = 0; j < 4; ++j) { const float gte = acc[tm][0][4 * g + j], up = acc[tm][1][4 * g + j]; o[j] = gte * sigmoidf_(gte) * up; }
      return o;
    });
  }
}
DI void phase7(const Params& p, unsigned char* lds) {
  const bf16_t* H = (const bf16_t*)(p.ws + O_H);
  const bf16_t* ACT = (const bf16_t*)(p.ws + O_ACT);
  bf16_t* Z2 = (bf16_t*)(p.ws + O_Z2);
  constexpr int NMT = NT / 256, NNT = 8;
  TileIter ti; ti.init(NMT, NNT);
  int tmi, tni;
  while (ti.next(tmi, tni)) {
    const int m0 = tmi * 256, n0 = tni * 128;
    f32x16 acc[2][2];
    gemm_mainloop<2, 2>(ACT, DFF, (const bf16_t*)(p.ws + O_WDN), DFF, DFF, m0, n0, 1024, acc, lds);
    epilogue_bf16<2, 2, 128>(acc, lds, Z2, DM, m0, n0, DM, [&](int tm, int tn, int g, int rowl, int coll) {
      const u32x2 hv = *(const u32x2*)(H + (size_t)(m0 + rowl) * DM + n0 + coll);
      const f32x4 hf = {__uint_as_float(hv[0] << 16), __uint_as_float(hv[0] & 0xffff0000u), __uint_as_float(hv[1] << 16), __uint_as_float(hv[1] & 0xffff0000u)};
      return hf * DN_ALPHA + acc4(acc[tm][tn], g);
    });
  }
}

DI void run_phase(const Params& p, unsigned char* lds, int ph) {
  switch (ph) {
    case 0: phase0(p); break;
    case 1: phase1(p, lds); break;
    case 2: phase2(p, lds); break;
    case 3: phase3(p, lds); break;
    case 4: phase4a(p); break;
    case 5: phase4(p, lds); break;
    case 6: phase5(p, lds); break;
    case 7: ln_rows<true>((const bf16_t*)(p.ws + O_Z), p.in[26], p.in[27], (bf16_t*)(p.ws + O_H), nullptr); break;
    case 8: phase6(p, lds); break;
    case 9: phase7(p, lds); break;
    case 11: phase3b(p, lds); break;
    case 10: ln_rows<false>((const bf16_t*)(p.ws + O_Z2), p.in[30], p.in[31], nullptr, p.out + F_Y); break;
  }
}
constexpr int NPHASES = 11;

DI unsigned ctl_ld(unsigned* p) { return __hip_atomic_load(p, __ATOMIC_RELAXED, __HIP_MEMORY_SCOPE_AGENT); }
DI unsigned ctl_add(unsigned* p, unsigned v) { return __hip_atomic_fetch_add(p, v, __ATOMIC_RELAXED, __HIP_MEMORY_SCOPE_AGENT); }
DI void xbar(unsigned* ctl, unsigned x, unsigned nloc, unsigned nx, unsigned k) {
  asm volatile("s_waitcnt vmcnt(0)" ::: "memory");
  __syncthreads();
  if (threadIdx.x == 0) {
    const unsigned old = ctl_add(&ctl[(24 + x) * 64], 1u);
    if (old + 1u == k * nloc) {
      __builtin_amdgcn_fence(__ATOMIC_RELEASE, "agent");
      asm volatile("s_waitcnt vmcnt(0)" ::: "memory");
      ctl_add(&ctl[40 * 64], 1u);
    }
    while (ctl_ld(&ctl[40 * 64]) < k * nx) __builtin_amdgcn_s_sleep(1);
    __builtin_amdgcn_fence(__ATOMIC_ACQUIRE, "agent");
    asm volatile("s_waitcnt vmcnt(0)" ::: "memory");
  }
  __syncthreads();
}

__global__ void __launch_bounds__(NTHREADS) mega_kernel(Params p) {
  extern __shared__ __attribute__((aligned(16))) unsigned char lds[];
  volatile unsigned* s_bar = (volatile unsigned*)(lds + LDS_CTRL + 16);
  cg::grid_group grid = cg::this_grid();
  unsigned* ctl = (unsigned*)(p.ws + O_CTR);
  const unsigned x = (unsigned)__builtin_amdgcn_s_getreg((3 << 11) | 20) & 0xFu;
  if (threadIdx.x == 0) ctl_add(&ctl[(8 + x) * 64], 1u);
  run_phase(p, lds, 0); grid.sync();
  if (threadIdx.x == 0) {
    unsigned nx = 0;
    for (int i = 0; i < 16; ++i) nx += ctl_ld(&ctl[(8 + i) * 64]) != 0u ? 1u : 0u;
    s_bar[0] = ctl_ld(&ctl[(8 + x) * 64]); s_bar[1] = nx;
  }
  __syncthreads();
  const unsigned nloc = __builtin_amdgcn_readfirstlane(s_bar[0]), nx = __builtin_amdgcn_readfirstlane(s_bar[1]);
  run_phase(p, lds, 1); xbar(ctl, x, nloc, nx, 1);
  run_phase(p, lds, 2); xbar(ctl, x, nloc, nx, 2);
  run_phase(p, lds, 3); xbar(ctl, x, nloc, nx, 3);
  run_phase(p, lds, 11); xbar(ctl, x, nloc, nx, 4);
  run_phase(p, lds, 4); xbar(ctl, x, nloc, nx, 5);
  run_phase(p, lds, 5); xbar(ctl, x, nloc, nx, 6);
  run_phase(p, lds, 6); xbar(ctl, x, nloc, nx, 7);
  run_phase(p, lds, 7); xbar(ctl, x, nloc, nx, 8);
  run_phase(p, lds, 8); xbar(ctl, x, nloc, nx, 9);
  run_phase(p, lds, 9); xbar(ctl, x, nloc, nx, 10);
  run_phase(p, lds, 10);
}
template <int PH> __global__ void __launch_bounds__(NTHREADS) phase_kernel(Params p) {
  extern __shared__ __attribute__((aligned(16))) unsigned char lds[];
  run_phase(p, lds, PH);
}
template <int PH> static void launch_phase(const Params& p, int grid, hipStream_t stream) {
  (void)hipFuncSetAttribute((const void*)phase_kernel<PH>, hipFuncAttributeMaxDynamicSharedMemorySize, LDS_BYTES);
  hipLaunchKernelGGL(phase_kernel<PH>, dim3(grid), dim3(NTHREADS), LDS_BYTES, stream, p);
}

extern "C" void kernel_launch(void* const* d_in, const int* in_sizes, int n_in, void* d_out, int out_size, void* d_ws, size_t ws_size, hipStream_t stream) {
  static int grid_blocks = 0;
  if (grid_blocks == 0) {
    if (n_in != 32 || ws_size < WS_END) { fprintf(stderr, "kernel_launch: unexpected n_in %d or ws_size %zu (< %zu)\n", n_in, ws_size, (size_t)WS_END); grid_blocks = -1; return; }
    int dev = 0, cus = 0, per_cu = 0;
    (void)hipGetDevice(&dev);
    (void)hipDeviceGetAttribute(&cus, hipDeviceAttributeMultiprocessorCount, dev);
#if MULTI_LAUNCH
    per_cu = 1;
#else
    (void)hipFuncSetAttribute((const void*)mega_kernel, hipFuncAttributeMaxDynamicSharedMemorySize, LDS_BYTES);
    (void)hipOccupancyMaxActiveBlocksPerMultiprocessor(&per_cu, (const void*)mega_kernel, NTHREADS, LDS_BYTES);
#endif
    if (per_cu < 1) { fprintf(stderr, "kernel_launch: occupancy query gave %d\n", per_cu); grid_blocks = -1; return; }
    grid_blocks = cus;
  }
  if (grid_blocks < 0) return;
  Params p{};
  for (int i = 0; i < 32; ++i) p.in[i] = (const float*)d_in[i];
  p.out = (float*)d_out;
  p.ws = (unsigned char*)d_ws;
#if MULTI_LAUNCH
  launch_phase<0>(p, grid_blocks, stream); launch_phase<1>(p, grid_blocks, stream); launch_phase<2>(p, grid_blocks, stream); launch_phase<3>(p, grid_blocks, stream); launch_phase<11>(p, grid_blocks, stream);
  launch_phase<4>(p, grid_blocks, stream); launch_phase<5>(p, grid_blocks, stream); launch_phase<6>(p, grid_blocks, stream); launch_phase<7>(p, grid_blocks, stream);
  launch_phase<8>(p, grid_blocks, stream); launch_phase<9>(p, grid_blocks, stream); launch_phase<10>(p, grid_blocks, stream);
#else
  (void)hipMemsetAsync((unsigned char*)d_ws + O_CTR, 0, 16384, stream);
  void* args[] = {&p};
  hipError_t e = hipLaunchCooperativeKernel((void*)mega_kernel, dim3(grid_blocks), dim3(NTHREADS), args, LDS_BYTES, stream);
  if (e != hipSuccess) fprintf(stderr, "cooperative launch failed: %s (grid %d)\n", hipGetErrorString(e), grid_blocks);
#endif
}
```

```cpp
#include <hip/hip_runtime.h>
#include <hip/hip_cooperative_groups.h>
#include <cstdio>
#include <cstdint>
namespace cg = cooperative_groups;


#ifndef PROBE_DUP
#define PROBE_DUP -1
#endif
#ifndef MULTI_LAUNCH
#define MULTI_LAUNCH 0
#endif

#define DI __device__ __forceinline__
typedef unsigned short bf16_t;
typedef short bf16x8 __attribute__((ext_vector_type(8)));
typedef short s16x4 __attribute__((ext_vector_type(4)));
typedef float f32x16 __attribute__((ext_vector_type(16)));
typedef float f32x4 __attribute__((ext_vector_type(4)));
typedef float f32x2 __attribute__((ext_vector_type(2)));
typedef unsigned u32x4 __attribute__((ext_vector_type(4)));
typedef unsigned u32x2 __attribute__((ext_vector_type(2)));
typedef __bf16 bf2_t __attribute__((ext_vector_type(2)));

constexpr int NP = 16384, NS = 512, NT = NP + NS;
constexpr int DM = 1024, ACOLS = 1792, BCOLS = 416, PABC = ACOLS + BCOLS  , NIN = 4256;
constexpr int DFF = 2816;
constexpr int PAST = 1024, DSEQ = 32, DB = 16, SKV = PAST + DSEQ  ;
constexpr int NKV = NP + DB * SKV  , NKVP = NKV + 64;
constexpr float DN_ALPHA = 1.189207115002721f;
constexpr float QSCALE = 0.10206207261596575f * 1.4426950408889634f;

constexpr size_t al256(size_t x) { return (x + 255) & ~(size_t)255; }
constexpr size_t O_WIN = 0;
constexpr size_t O_WUQ = O_WIN + al256((size_t)NIN * 1024 * 2);
constexpr size_t O_WUKV = O_WUQ + al256(768 * 256 * 2);
constexpr size_t O_WPA = O_WUKV + al256(1024 * 128 * 2);
constexpr size_t O_WPB = O_WPA + al256(1024 * 512 * 2);
constexpr size_t O_WO = O_WPB + al256(1024 * 512 * 2);
constexpr size_t O_WGU = O_WO + al256(1024 * 1024 * 2);
constexpr size_t O_WDN = O_WGU + al256((size_t)5632 * 1024 * 2);
constexpr size_t O_WW2 = O_WDN + al256((size_t)1024 * 2816 * 2);
constexpr size_t O_WA2 = O_WW2 + al256(512 * 64 * 2);
constexpr size_t O_WG2 = O_WA2 + al256(512 * 64 * 2);
constexpr size_t O_ROPE = O_WG2 + al256(512 * 128 * 2);
constexpr size_t O_CTR = O_ROPE + al256((size_t)NT * 32 * 4);
constexpr size_t O_PAB = O_CTR + 16384;
constexpr size_t SZ_T512 = (size_t)NT * 512 * 2;
constexpr size_t O_SIN = O_PAB + al256((size_t)NT * PABC * 2);
constexpr size_t O_G = O_SIN + 6 * SZ_T512;
constexpr size_t O_RK = O_G + SZ_T512;
constexpr size_t O_KNB = O_RK + al256((size_t)NT * 8 * 4);
constexpr size_t O_KPEB = O_KNB + al256((size_t)8 * NKVP * 64 * 2);
constexpr int SCC = 4, SCL = NP / SCC;
constexpr size_t O_GH = O_KPEB + al256((size_t)NKVP * 32 * 2);
constexpr size_t O_SST = O_GH + 2 * (size_t)8 * SCC * 4096 * 4;
constexpr size_t WS_END = O_SST + (size_t)SCC * 8 * 4096 * 2;
constexpr size_t O_Y = O_PAB;
constexpr size_t O_E = O_Y + SZ_T512;
constexpr size_t O_YB = O_Y + (size_t)NT * 512 * 4;
constexpr size_t O_YA = O_YB + SZ_T512;
constexpr size_t O_H = O_PAB;
constexpr size_t O_M = O_SIN;
constexpr size_t O_Z = O_SIN + (size_t)NT * 1024 * 2;
constexpr size_t O_Z2 = O_PAB + (size_t)NT * 1024 * 2;
constexpr size_t O_ACT = O_SIN;
constexpr size_t OO_XB = 0;
constexpr size_t OO_Q = 0;
constexpr size_t OO_VT = (size_t)NT * 768 * 2;
constexpr size_t F_Y = 0, F_CKVP = (size_t)NT * 1024, F_KPEP = F_CKVP + (size_t)NP * 128, F_WKVP = F_KPEP + (size_t)NP * 32,
                 F_SHP = F_WKVP + 32768, F_CKVS = F_SHP + 1792, F_KPES = F_CKVS + (size_t)NS * 128, F_WKVS = F_KPES + (size_t)NS * 32,
                 F_SHS = F_WKVS + (size_t)DB * 32768;

constexpr int LDS_CTRL = 3 * 49152;
constexpr int LDS_BYTES = LDS_CTRL + 256;
constexpr int NTHREADS = 512;

struct Params {
  const float* in[32];
  float* out;
  unsigned char* ws;
};

DI int tidx() { int t = threadIdx.x; asm volatile("" : "+v"(t)); return t; }
DI unsigned pk2(float a, float b) { f32x2 v = {a, b}; bf2_t r = __builtin_convertvector(v, bf2_t); return __builtin_bit_cast(unsigned, r); }
DI bf16_t f2bf(float a) { return (bf16_t)(pk2(a, 0.f) & 0xffffu); }
DI float bf2f(bf16_t x) { return __uint_as_float(((unsigned)x) << 16); }
DI void unpack8(u32x4 v, float* f) {
#pragma unroll
  for (int j = 0; j < 4; ++j) { f[2 * j] = __uint_as_float(v[j] << 16); f[2 * j + 1] = __uint_as_float(v[j] & 0xffff0000u); }
}
DI u32x4 pack8(const float* f) { u32x4 o; o[0] = pk2(f[0], f[1]); o[1] = pk2(f[2], f[3]); o[2] = pk2(f[4], f[5]); o[3] = pk2(f[6], f[7]); return o; }
DI float sigmoidf_(float x) { return 1.f / (1.f + __expf(-x)); }
DI float dpp_sum16(float x) {
  x += __builtin_bit_cast(float, __builtin_amdgcn_update_dpp(0, __builtin_bit_cast(int, x), 0xB1, 0xF, 0xF, true));
  x += __builtin_bit_cast(float, __builtin_amdgcn_update_dpp(0, __builtin_bit_cast(int, x), 0x4E, 0xF, 0xF, true));
  x += __builtin_bit_cast(float, __builtin_amdgcn_update_dpp(0, __builtin_bit_cast(int, x), 0x141, 0xF, 0xF, true));
  x += __builtin_bit_cast(float, __builtin_amdgcn_update_dpp(0, __builtin_bit_cast(int, x), 0x140, 0xF, 0xF, true));
  return x;
}
DI float sum32(float x) { x = dpp_sum16(x); x += __shfl_xor(x, 16); return x; }
DI float wave_sum(float v) {
#pragma unroll
  for (int o = 1; o < 64; o <<= 1) v += __shfl_xor(v, o);
  return v;
}
DI int crow(int i, int h) { return (i & 3) + 8 * (i >> 2) + 4 * h; }
#define MFMA32(a, b, c) __builtin_amdgcn_mfma_f32_32x32x16_bf16((a), (b), (c), 0, 0, 0)
DI int slot_of_token(int t) { return t < NP ? t : NP + ((t - NP) >> 5) * SKV + PAST + ((t - NP) & 31); }
DI const float* xrow(const Params& p, int t) { return t < NP ? p.in[0] + (size_t)t * DM : p.in[1] + (size_t)(t - NP) * DM; }

DI void conv_T(const float* W, int K, int N, bf16_t* WT, int mode, int gtid, int gsz) {
  const int ntask = (K / 8) * N;
  for (int id = gtid; id < ntask; id += gsz) {
    const int kc = id / N, n = id - kc * N, k0 = kc * 8;
    float f[8];
#pragma unroll
    for (int j = 0; j < 8; ++j) f[j] = W[(size_t)(k0 + j) * N + n];
    if (mode == 2) {
      *(u32x4*)(WT + ((size_t)((n >> 5) * (K >> 4) + (k0 >> 4)) * 64 + ((k0 >> 3) & 1) * 32 + (n & 31)) * 8) = pack8(f);
      continue;
    }
    int row = n;
    if (mode == 1) { const int nt = n >= DFF ? 1 : 0, j = n - nt * DFF; row = 128 * (j >> 6) + 64 * ((j & 63) >> 5) + 32 * nt + (j & 31); }
    *(u32x4*)(WT + (size_t)row * K + k0) = pack8(f);
  }
}
DI void conv_x(const Params& p, bf16_t* XB, int gtid, int gsz) {
  for (int id = gtid; id < NT * 128; id += gsz) {
    const int t = id >> 7, c = (id & 127) * 8;
    const float* src = xrow(p, t) + c;
    f32x4 a = *(const f32x4*)src, b = *(const f32x4*)(src + 4);
    float f[8] = {a[0], a[1], a[2], a[3], b[0], b[1], b[2], b[3]};
    *(u32x4*)(XB + (size_t)t * DM + c) = pack8(f);
  }
}
DI void phase0(const Params& p) {
  const int gtid = blockIdx.x * NTHREADS + tidx(), gsz = gridDim.x * NTHREADS;
  unsigned char* ws = p.ws;
  if (gtid < 64) ((unsigned*)(ws + O_CTR))[gtid] = 0u;
  conv_T(p.in[6], 1024, NIN, (bf16_t*)(ws + O_WIN), 0, gtid, gsz);
  conv_T(p.in[20], 256, 768, (bf16_t*)(ws + O_WUQ), 2, gtid, gsz);
  conv_T(p.in[22], 128, 1024, (bf16_t*)(ws + O_WUKV), 2, gtid, gsz);
  conv_T(p.in[18], 512, 1024, (bf16_t*)(ws + O_WPA), 0, gtid, gsz);
  conv_T(p.in[23], 512, 1024, (bf16_t*)(ws + O_WPB), 0, gtid, gsz);
  conv_T(p.in[25], 1024, 1024, (bf16_t*)(ws + O_WO), 0, gtid, gsz);
  conv_T(p.in[28], 1024, 5632, (bf16_t*)(ws + O_WGU), 1, gtid, gsz);
  conv_T(p.in[29], 2816, 1024, (bf16_t*)(ws + O_WDN), 0, gtid, gsz);
  conv_T(p.in[9], 64, 512, (bf16_t*)(ws + O_WW2), 2, gtid, gsz);
  conv_T(p.in[11], 64, 512, (bf16_t*)(ws + O_WA2), 2, gtid, gsz);
  conv_T(p.in[12], 128, 512, (bf16_t*)(ws + O_WG2), 2, gtid, gsz);
  conv_x(p, (bf16_t*)((unsigned char*)p.out + OO_XB), gtid, gsz);
  float* rope = (float*)(ws + O_ROPE);
  for (int id = gtid; id < NT * 16; id += gsz) {
    const int t = id >> 4, j = id & 15;
    const int pos = t < NP ? t : PAST + ((t - NP) & 31);
    const float inv = (float)exp2(-(double)j * (13.287712379549449 / 16.0));
    const float ang = (float)pos * inv;
    const double x = (double)ang;
    const double n = rint(x * 0.15915494309189535);
    const float red = (float)(x - n * 6.283185307179586);
    rope[t * 32 + j] = __cosf(red);
    rope[t * 32 + 16 + j] = __sinf(red);
  }
  bf16_t* kpeb = (bf16_t*)(ws + O_KPEB);
  for (int id = gtid; id < DB * PAST * 4; id += gsz) {
    const int row = id >> 2, ch = id & 3, b = row >> 10, j = row & 1023;
    const float* src = p.in[3] + (size_t)row * 32 + ch * 8;
    f32x4 a = *(const f32x4*)src, c = *(const f32x4*)(src + 4);
    float f[8] = {a[0], a[1], a[2], a[3], c[0], c[1], c[2], c[3]};
    *(u32x4*)(kpeb + (size_t)(NP + b * SKV + j) * 32 + ch * 8) = pack8(f);
  }
  bf16_t* knb = (bf16_t*)(ws + O_KNB);
  for (int id = gtid; id < 64 * 32; id += gsz) kpeb[(size_t)NKV * 32 + id] = 0;
  for (int id = gtid; id < 8 * 64 * 64; id += gsz) {
    const int h = id >> 12, rem = id & 4095;
    knb[((size_t)h * NKVP + NKV) * 64 + rem] = 0;
  }
}

template <int TM, int TN, bool ZERO = true>
DI void gemm_mainloop(const bf16_t* __restrict__ A, int lda, const bf16_t* __restrict__ Bt, int ldb, int K, int m0, int n0, int nmax,
                      f32x16 (&acc)[TM][TN], unsigned char* lds) {
  constexpr int BM = 128 * TM, BN = 64 * TN, AG = BM / 64, BG = BN / 64, NLD = AG + BG;
  constexpr int ABYTES = BM * 128, STAGE = (BM + BN) * 128;
  static_assert(3 * STAGE <= LDS_CTRL, "lds");
  const int tid = tidx(), wave = __builtin_amdgcn_readfirstlane(tid >> 6), lane = tid & 63, r = lane & 31, h = lane >> 5, wm = wave & 3, wn = wave >> 2;
  const int lrow = lane >> 3, lpos = lane & 7;
  const bf16_t* ap[AG]; const bf16_t* bp[BG];
#pragma unroll
  for (int i = 0; i < AG; ++i) { const int row = (wave * AG + i) * 8 + lrow, c = lpos ^ ((row >> 1) & 7); ap[i] = A + (size_t)(m0 + row) * lda + c * 8; }
#pragma unroll
  for (int i = 0; i < BG; ++i) { const int row = (wave * BG + i) * 8 + lrow, c = lpos ^ ((row >> 1) & 7); int br = n0 + row; br = br < nmax ? br : nmax - 1; bp[i] = Bt + (size_t)br * ldb + c * 8; }
  if (ZERO) {
#pragma unroll
    for (int tm = 0; tm < TM; ++tm)
#pragma unroll
      for (int tn = 0; tn < TN; ++tn)
#pragma unroll
        for (int i = 0; i < 16; ++i) acc[tm][tn][i] = 0.f;
  }
  auto issue = [&](int kt, int stage) {
    unsigned char* sb = lds + stage * STAGE;
#pragma unroll
    for (int i = 0; i < AG; ++i) __builtin_amdgcn_global_load_lds((const unsigned*)(ap[i] + kt * 64), (unsigned*)(sb + (wave * AG + i) * 1024), 16, 0, 0);
#pragma unroll
    for (int i = 0; i < BG; ++i) __builtin_amdgcn_global_load_lds((const unsigned*)(bp[i] + kt * 64), (unsigned*)(sb + ABYTES + (wave * BG + i) * 1024), 16, 0, 0);
  };
  const int swz = (r >> 1) & 7;
  int koff[4];
#pragma unroll
  for (int ks = 0; ks < 4; ++ks) koff[ks] = ((ks * 2 + h) ^ swz) * 16;
  const int a_rd = (wm * 32 * TM + r) * 128, b_rd = ABYTES + (wn * 32 * TN + r) * 128;
  const int nk = K >> 6;
  asm volatile("s_waitcnt vmcnt(0)" ::: "memory");
  issue(0, 0);
  issue(1, 1);
  for (int kt = 0; kt < nk; ++kt) {
    if (kt + 1 < nk) asm volatile("s_waitcnt vmcnt(%0)" ::"n"(NLD) : "memory");
    else asm volatile("s_waitcnt vmcnt(0)" ::: "memory");
    asm volatile("s_waitcnt lgkmcnt(0)" ::: "memory");
    __builtin_amdgcn_s_barrier();
    if (kt + 2 < nk) issue(kt + 2, (kt + 2) % 3);
    const unsigned char* cur = lds + (kt % 3) * STAGE;
#pragma unroll
    for (int ks = 0; ks < 4; ++ks) {
      bf16x8 af[TM], bfr[TN];
#pragma unroll
      for (int tm = 0; tm < TM; ++tm) af[tm] = *(const bf16x8*)(cur + a_rd + tm * 4096 + koff[ks]);
#pragma unroll
      for (int tn = 0; tn < TN; ++tn) bfr[tn] = *(const bf16x8*)(cur + b_rd + tn * 4096 + koff[ks]);
#pragma unroll
      for (int tm = 0; tm < TM; ++tm)
#pragma unroll
        for (int tn = 0; tn < TN; ++tn) acc[tm][tn] = MFMA32(bfr[tn], af[tm], acc[tm][tn]);
    }
  }
  asm volatile("s_waitcnt lgkmcnt(0)" ::: "memory");
  __builtin_amdgcn_s_barrier();
}

template <int TM, int TN, int OUTC, class F>
DI void epilogue_bf16(const f32x16 (&acc)[TM][TN], unsigned char* lds, bf16_t* out, int ldo, int m0, int c0, int cmax, F f) {
  constexpr int BM = 128 * TM, STRIDE = OUTC * 2 + 16, TNO = OUTC / (32 * 2);
  const int tid = tidx(), wave = __builtin_amdgcn_readfirstlane(tid >> 6), lane = tid & 63, r = lane & 31, h = lane >> 5, wm = wave & 3, wn = wave >> 2;
#pragma unroll
  for (int tm = 0; tm < TM; ++tm)
#pragma unroll
    for (int tn = 0; tn < TNO; ++tn)
#pragma unroll
      for (int g = 0; g < 4; ++g) {
        const int rowl = wm * 32 * TM + tm * 32 + r, coll = wn * 32 * TNO + tn * 32 + 8 * g + 4 * h;
        const f32x4 o = f(tm, tn, g, rowl, coll);
        u32x2 w; w[0] = pk2(o[0], o[1]); w[1] = pk2(o[2], o[3]);
        *(u32x2*)(lds + rowl * STRIDE + coll * 2) = w;
      }
  __syncthreads();
  constexpr int CPR = OUTC / 8;
#pragma unroll
  for (int j = 0; j < BM * CPR / NTHREADS; ++j) {
    const int id = tid + NTHREADS * j, row = id / CPR, c = id % CPR;
    if (c0 + c * 8 < cmax) *(u32x4*)(out + (size_t)(m0 + row) * ldo + c0 + c * 8) = *(const u32x4*)(lds + row * STRIDE + c * 16);
  }
  __syncthreads();
}
DI f32x4 acc4(const f32x16& a, int g) { return (f32x4){a[4 * g], a[4 * g + 1], a[4 * g + 2], a[4 * g + 3]}; }

struct TileIter {
  int nM, nN, total, L, Lend, step;
  DI void init(int nM_, int nN_) {
    nM = nM_; nN = nN_; total = nM * nN;
    const int nx = (gridDim.x & 7) == 0 ? 8 : 1, x = blockIdx.x % nx, local = blockIdx.x / nx;
    step = gridDim.x / nx;
    const int per = (total + nx - 1) / nx;
    L = x * per + local; Lend = (x + 1) * per < total ? (x + 1) * per : total;
  }
  DI bool next(int& tmi, int& tni) {
    if (L >= Lend) return false;
    const int fb = nM >> 2, fullcnt = fb * 4 * nN;
    if (L < fullcnt) { const int band = L / (4 * nN), jj = L - band * 4 * nN; tni = jj >> 2; tmi = band * 4 + (jj & 3); }
    else { const int l2 = L - fullcnt, bm = nM & 3; tni = l2 / bm; tmi = fb * 4 + l2 % bm; }
    L += step; return true;
  }
};

DI void phase1(const Params& p, unsigned char* lds) {
  const bf16_t* XB = (const bf16_t*)((unsigned char*)p.out + OO_XB);
  const bf16_t* WT = (const bf16_t*)(p.ws + O_WIN);
  bf16_t* PAB = (bf16_t*)(p.ws + O_PAB);
  constexpr int NMT = NT / 256, NNT = (PABC + 127) / 128;
  const int lane = tidx() & 63, wave = __builtin_amdgcn_readfirstlane(tidx() >> 6), r = lane & 31, h = lane >> 5, wm = wave & 3, wn = wave >> 2;
  TileIter ti; ti.init(NMT, NNT);
  int tmi, tni;
  while (ti.next(tmi, tni)) {
    const int m0 = tmi * 256, n0 = tni * 128;
    f32x16 acc[2][2];
    gemm_mainloop<2, 2>(XB, DM, WT, DM, DM, m0, n0, PABC, acc, lds);
    if (m0 + 256 > NP - 1 && n0 < ACOLS) {
#pragma unroll
      for (int tm = 0; tm < 2; ++tm) {
        const int row = m0 + wm * 64 + tm * 32 + r;
        const bool lastp = row == NP - 1, lasts = row >= NP && ((row - NP) & 31) == 31;
        if (lastp || lasts) {
          float* dst = lastp ? p.out + F_SHP : p.out + F_SHS + (size_t)((row - NP) >> 5) * ACOLS;
#pragma unroll
          for (int tn = 0; tn < 2; ++tn)
#pragma unroll
            for (int g = 0; g < 4; ++g) {
              const int col = n0 + wn * 64 + tn * 32 + 8 * g + 4 * h;
              if (col < ACOLS) *(f32x4*)(dst + col) = acc4(acc[tm][tn], g);
            }
        }
      }
    }
    epilogue_bf16<2, 2, 128>(acc, lds, PAB, PABC, m0, n0, PABC, [&](int tm, int tn, int g, int, int) { return acc4(acc[tm][tn], g); });
  }
}

constexpr int L2_LORA = 0, L2_K = L2_LORA + 32 * 528, L2_R = L2_K + 32 * 1040, L2A_STG = L2_R + 32 * 1040, L2A_END = L2A_STG + 8 * 32 * 144;
constexpr int L2_CQ = 0, L2_CKV = L2_CQ + 32 * 528, L2B_STG = L2_CKV + 32 * 272, L2B_END = L2B_STG + 8 * 32 * 208;
static_assert(L2A_END <= LDS_BYTES && L2B_END <= LDS_BYTES, "lds p2");
template <int NTL, class F>
DI void stage_store16(unsigned char* stg, int lane, bf16_t* dst  , unsigned row_stride  , F f) {
  constexpr int RS = NTL * 64 + 16, CPR = NTL * 4;
  const int r = lane & 31, h = lane >> 5;
#pragma unroll
  for (int nt = 0; nt < NTL; ++nt)
#pragma unroll
    for (int i = 0; i < 16; ++i) *(unsigned short*)(stg + crow(i, h) * RS + (nt * 32 + r) * 2) = f(nt, i);
  __syncthreads();
#pragma unroll
  for (int j = 0; j < 32 * CPR / 64; ++j) {
    const int id = lane + 64 * j, row = id / CPR, ch = id % CPR;
    *(u32x4*)(dst + (size_t)row * row_stride + ch * 8) = *(const u32x4*)(stg + row * RS + ch * 16);
  }
  __syncthreads();
}

template <int NTL, int KS>
DI void mm32(const unsigned char* ldsA, int strideB, const bf16_t* Bt, int ldb, int lane, f32x16 (&acc)[NTL]) {
  constexpr int KG = (NTL * KS <= 16) ? KS : (NTL <= 2 ? 4 : 2), NG = KS / KG;
  const int r = lane & 31, h = lane >> 5;
#pragma unroll
  for (int nt = 0; nt < NTL; ++nt)
#pragma unroll
    for (int i = 0; i < 16; ++i) acc[nt][i] = 0.f;
  bf16x8 bq[2][KG][NTL];
  const bf16_t* bp = Bt + lane * 8;
#pragma unroll
  for (int k = 0; k < KG; ++k)
#pragma unroll
    for (int nt = 0; nt < NTL; ++nt) bq[0][k][nt] = *(const bf16x8*)(bp + (size_t)(nt * KS + k) * 512);
#pragma unroll
  for (int g = 0; g < NG; ++g) {
    if (g + 1 < NG) {
#pragma unroll
      for (int k = 0; k < KG; ++k)
#pragma unroll
        for (int nt = 0; nt < NTL; ++nt) bq[(g + 1) & 1][k][nt] = *(const bf16x8*)(bp + (size_t)(nt * KS + (g + 1) * KG + k) * 512);
    }
    __builtin_amdgcn_sched_barrier(0);
#pragma unroll
    for (int k = 0; k < KG; ++k) {
      const bf16x8 a = *(const bf16x8*)(ldsA + r * strideB + (g * KG + k) * 32 + h * 16);
#pragma unroll
      for (int nt = 0; nt < NTL; ++nt) acc[nt] = MFMA32(a, bq[g & 1][k][nt], acc[nt]);
    }
    __builtin_amdgcn_sched_barrier(0);
  }
}

DI void kv_expand(const Params& p, unsigned char* lds, int w, int lane, int slot0) {
  const int r = lane & 31, h = lane >> 5;
  bf16_t* knb = (bf16_t*)(p.ws + O_KNB);
  bf16_t* vT = (bf16_t*)((unsigned char*)p.out + OO_VT);
  f32x16 acc[4];
  mm32<4, 8>(lds + L2_CKV, 272, (const bf16_t*)(p.ws + O_WUKV) + (size_t)(128 * w) * 128, 128, lane, acc);
  stage_store16<2>((unsigned char*)lds + L2B_STG + w * (32 * 208), lane, knb + ((size_t)w * NKVP + slot0) * 64, 64, [&](int nt, int i) { return f2bf(acc[nt][i]); });
#pragma unroll
  for (int nt = 2; nt < 4; ++nt)
#pragma unroll
    for (int g = 0; g < 4; ++g) {
      u32x2 o; o[0] = pk2(acc[nt][4 * g], acc[nt][4 * g + 1]); o[1] = pk2(acc[nt][4 * g + 2], acc[nt][4 * g + 3]);
      *(u32x2*)(vT + ((unsigned)w * 64 + (nt - 2) * 32 + r) * (unsigned)NKVP + slot0 + 8 * g + 4 * h) = o;
    }
}

DI void p2_token_tile_a(const Params& p, unsigned char* lds, int tile) {
  const int tid = tidx(), wave = __builtin_amdgcn_readfirstlane(tid >> 6), lane = tid & 63, r = lane & 31, h = lane >> 5;
  const int t0 = tile * 32;
  unsigned char* ws = p.ws;
  const bf16_t* PAB = (const bf16_t*)(ws + O_PAB);
  bf16_t* SR = (bf16_t*)(ws + O_SIN);
  bf16_t* SK = SR + (size_t)NT * 512; bf16_t* SV = SK + (size_t)NT * 512; bf16_t* SA = SV + (size_t)NT * 512; bf16_t* SB = SA + (size_t)NT * 512;
  _Float16* SW = (_Float16*)(SB + (size_t)NT * 512);
  bf16_t* G = (bf16_t*)(ws + O_G);
  float* RK = (float*)(ws + O_RK);
  const float* rope = (const float*)(ws + O_ROPE);
#pragma unroll 1
  for (int bt = 0; bt < 2; ++bt) {
    u32x4 rawp[7], rawq[7];
#pragma unroll
    for (int it = 0; it < 7; ++it) {
      const int task = tid + NTHREADS * (bt * 7 + it);
      const int tl = task / 224, ch = task - tl * 224, c0 = ch * 8, t = t0 + tl;
      rawp[it] = *(const u32x4*)(PAB + (size_t)t * PABC + c0);
      rawq[it] = *(const u32x4*)(PAB + (size_t)(t > 0 ? t - 1 : 0) * PABC + c0);
    }
#pragma unroll
    for (int it = 0; it < 7; ++it) {
      const int task = tid + NTHREADS * (bt * 7 + it);
      const int tl = task / 224, ch = task - tl * 224, c0 = ch * 8, t = t0 + tl;
      float pv[8], pr[8];
      unpack8(rawp[it], pv);
      unpack8(rawq[it], pr);
      if (t == 0) {
#pragma unroll
        for (int j = 0; j < 8; ++j) pr[j] = 0.f;
      } else if (t >= NP && ((t - NP) & 31) == 0) {
        const float* sp = p.in[5] + (size_t)((t - NP) >> 5) * ACOLS + c0;
        const f32x4 a = *(const f32x4*)sp, b = *(const f32x4*)(sp + 4);
        pr[0] = a[0]; pr[1] = a[1]; pr[2] = a[2]; pr[3] = a[3]; pr[4] = b[0]; pr[5] = b[1]; pr[6] = b[2]; pr[7] = b[3];
      }
      const f32x4 mu0 = *(const f32x4*)(p.in[7] + c0), mu1 = *(const f32x4*)(p.in[7] + c0 + 4);
      const float mm[8] = {mu0[0], mu0[1], mu0[2], mu0[3], mu1[0], mu1[1], mu1[2], mu1[3]};
      float xs[8];
#pragma unroll
      for (int j = 0; j < 8; ++j) xs[j] = pv[j] + (pr[j] - pv[j]) * mm[j];
      if (c0 < 512) {
        const u32x4 o = pack8(xs);
        *(u32x4*)(SR + (size_t)t * 512 + c0) = o;
        *(u32x4*)(lds + L2_R + tl * 1040 + c0 * 2) = o;
      } else if (c0 < 1024) {
        *(u32x4*)(lds + L2_K + tl * 1040 + (c0 - 512) * 2) = pack8(xs);
      } else if (c0 < 1536) {
        *(u32x4*)(SV + (size_t)t * 512 + (c0 - 1024)) = pack8(xs);
      } else {
        if (c0 < 1600) {
#pragma unroll
          for (int j = 0; j < 8; ++j) { const float e = __expf(2.f * xs[j]); xs[j] = 1.f - 2.f / (e + 1.f); }
        } else if (c0 >= 1664) {
#pragma unroll
          for (int j = 0; j < 8; ++j) xs[j] = sigmoidf_(xs[j]);
        }
        *(u32x4*)(lds + L2_LORA + tl * 528 + (c0 - 1536) * 2) = pack8(xs);
      }
    }
  }
  __syncthreads();
  const int w = wave, cb = 64 * w;
  {
    int r = (tidx() & 31);
    f32x16 acc[2];
    mm32<2, 4>(lds + L2_LORA, 528, (const bf16_t*)(ws + O_WW2) + (size_t)cb * 64, 64, lane, acc);
    const float w00 = p.in[8][cb + r], w01 = p.in[8][cb + 32 + r];
    stage_store16<2>(lds + L2A_STG + w * (32 * 144), lane, (bf16_t*)SW + (size_t)t0 * 512 + cb, 512, [&](int nt, int i) {
      const float z = (nt ? w01 : w00) + acc[nt][i];
      const float sp = fmaxf(-z, 0.f) + __logf(1.f + __expf(-fabsf(z)));
      const float dec = __expf(-__expf(-sp - 0.5f));
      return __builtin_bit_cast(unsigned short, (_Float16)dec);
    });
  }
  __syncthreads();
  {
    int r = (tidx() & 31);
    f32x16 acc[2];
    mm32<2, 4>(lds + L2_LORA + 128, 528, (const bf16_t*)(ws + O_WA2) + (size_t)cb * 64, 64, lane, acc);
    float kkv[2][16];
#pragma unroll
    for (int nt = 0; nt < 2; ++nt) {
      const int c = cb + nt * 32 + r;
      const float a0 = p.in[10][c], kkc = p.in[13][c];
#pragma unroll
      for (int i = 0; i < 16; ++i) {
        acc[nt][i] = sigmoidf_(a0 + acc[nt][i]);
        kkv[nt][i] = bf2f(*(const bf16_t*)(lds + L2_K + crow(i, h) * 1040 + c * 2)) * kkc;
      }
    }
#pragma unroll
    for (int i = 0; i < 16; ++i) {
      const float nsq = sum32(kkv[0][i] * kkv[0][i] + kkv[1][i] * kkv[1][i]);
      const float inv = 1.f / fmaxf(sqrtf(nsq), 1e-12f);
      kkv[0][i] *= inv; kkv[1][i] *= inv;
      __builtin_amdgcn_sched_barrier(0);
    }
    const int c0 = cb + r, c1 = cb + 32 + r;
    const float ka0 = p.in[14][c0], ka1 = p.in[14][c1], rk0 = p.in[15][c0], rk1 = p.in[15][c1];
    unsigned char* stg = lds + L2A_STG + w * (32 * 144);
    stage_store16<2>(stg, lane, SA + (size_t)t0 * 512 + cb, 512, [&](int nt, int i) { return f2bf(-kkv[nt][i]); });
    stage_store16<2>(stg, lane, SB + (size_t)t0 * 512 + cb, 512, [&](int nt, int i) { return f2bf(kkv[nt][i] * acc[nt][i]); });
#pragma unroll
    for (int i = 0; i < 16; ++i) {
      const int tl = crow(i, h);
      const float kr0 = bf2f(*(const bf16_t*)(lds + L2_K + tl * 1040 + c0 * 2)), kr1 = bf2f(*(const bf16_t*)(lds + L2_K + tl * 1040 + c1 * 2));
      const float kh0 = kr0 * (1.f + (acc[0][i] - 1.f) * ka0), kh1 = kr1 * (1.f + (acc[1][i] - 1.f) * ka1);
      kkv[0][i] = kh0; kkv[1][i] = kh1;
      const float rr0 = bf2f(*(const bf16_t*)(lds + L2_R + tl * 1040 + c0 * 2)), rr1 = bf2f(*(const bf16_t*)(lds + L2_R + tl * 1040 + c1 * 2));
      const float sb = sum32(rr0 * kh0 * rk0 + rr1 * kh1 * rk1);
      if (r == 0) RK[(unsigned)(t0 + tl) * 8u + w] = sb;
    }
    stage_store16<2>(stg, lane, SK + (size_t)t0 * 512 + cb, 512, [&](int nt, int i) { return f2bf(kkv[nt][i]); });
  }
  __syncthreads();
  {
    int r = (tidx() & 31);
    f32x16 acc[2];
    mm32<2, 8>(lds + L2_LORA + 256, 528, (const bf16_t*)(ws + O_WG2) + (size_t)cb * 128, 128, lane, acc);
    stage_store16<2>(lds + L2A_STG + w * (32 * 144), lane, G + (size_t)t0 * 512 + cb, 512, [&](int nt, int i) { return f2bf(acc[nt][i]); });
  }
  __syncthreads();
}

DI void p2_token_tile_b(const Params& p, unsigned char* lds, int tile) {
  const int tid = tidx(), wave = __builtin_amdgcn_readfirstlane(tid >> 6), lane = tid & 63, r = lane & 31, h = lane >> 5;
  const int t0 = tile * 32;
  unsigned char* ws = p.ws;
  const bf16_t* PAB = (const bf16_t*)(ws + O_PAB);
  bf16_t* SR = (bf16_t*)(ws + O_SIN);
  bf16_t* SK = SR + (size_t)NT * 512; bf16_t* SV = SK + (size_t)NT * 512; bf16_t* SA = SV + (size_t)NT * 512; bf16_t* SB = SA + (size_t)NT * 512;
  _Float16* SW = (_Float16*)(SB + (size_t)NT * 512);
  bf16_t* G = (bf16_t*)(ws + O_G);
  float* RK = (float*)(ws + O_RK);
  const float* rope = (const float*)(ws + O_ROPE);
  {
    u32x2 vq[4]; unsigned vc[4]; float k1[4], k2[4], rc[4], rs_[4];
#pragma unroll
    for (int q = 0; q < 4; ++q) {
      const int t = t0 + wave * 4 + q;
      const bf16_t* pb = PAB + (size_t)t * PABC + ACOLS;
      vq[q] = *(const u32x2*)(pb + 4 * lane);
      vc[q] = *(const unsigned*)(pb + 256 + 2 * lane);
      k1[q] = bf2f(pb[384 + (lane & 15)]); k2[q] = bf2f(pb[400 + (lane & 15)]);
      rc[q] = rope[t * 32 + (lane & 15)]; rs_[q] = rope[t * 32 + 16 + (lane & 15)];
    }
    const f32x4 gq = *(const f32x4*)(p.in[19] + 4 * lane);
    const f32x2 gkv = *(const f32x2*)(p.in[21] + 2 * lane);
#pragma unroll
    for (int q = 0; q < 4; ++q) {
      const int tl = wave * 4 + q, t = t0 + tl;
      {
        const u32x2 v = vq[q];
        float x[4] = {__uint_as_float(v[0] << 16), __uint_as_float(v[0] & 0xffff0000u), __uint_as_float(v[1] << 16), __uint_as_float(v[1] & 0xffff0000u)};
        const float ss = wave_sum(x[0] * x[0] + x[1] * x[1] + x[2] * x[2] + x[3] * x[3]);
        const float rs = rsqrtf(ss * (1.f / 256.f) + 1e-6f);
        u32x2 o; o[0] = pk2(x[0] * rs * gq[0], x[1] * rs * gq[1]); o[1] = pk2(x[2] * rs * gq[2], x[3] * rs * gq[3]);
        *(u32x2*)(lds + L2_CQ + tl * 528 + lane * 8) = o;
      }
      {
        const unsigned v = vc[q];
        const float x0 = __uint_as_float(v << 16), x1 = __uint_as_float(v & 0xffff0000u);
        const float ss = wave_sum(x0 * x0 + x1 * x1);
        const float rs = rsqrtf(ss * (1.f / 128.f) + 1e-6f);
        const float o0 = x0 * rs * gkv[0], o1 = x1 * rs * gkv[1];
        float* dst = (t < NP) ? p.out + F_CKVP + (size_t)t * 128 : p.out + F_CKVS + (size_t)(t - NP) * 128;
        f32x2 of = {o0, o1};
        *(f32x2*)(dst + 2 * lane) = of;
        *(unsigned*)(lds + L2_CKV + tl * 272 + lane * 4) = pk2(o0, o1);
      }
      if (lane < 16) {
        const float o1 = k1[q] * rc[q] - k2[q] * rs_[q], o2 = k1[q] * rs_[q] + k2[q] * rc[q];
        float* dst = (t < NP) ? p.out + F_KPEP + (size_t)t * 32 : p.out + F_KPES + (size_t)(t - NP) * 32;
        dst[lane] = o1; dst[16 + lane] = o2;
        bf16_t* kp = (bf16_t*)(ws + O_KPEB) + (size_t)slot_of_token(t) * 32;
        kp[lane] = f2bf(o1); kp[16 + lane] = f2bf(o2);
      }
    }
  }
  __syncthreads();
  const int w = wave, cb = 64 * w;
  {
    int r = (tidx() & 31);
    f32x16 acc[3];
    mm32<3, 16>(lds + L2_CQ, 528, (const bf16_t*)(ws + O_WUQ) + (size_t)(96 * w) * 256, 256, lane, acc);
    bf16_t* Q = (bf16_t*)((unsigned char*)p.out + OO_Q);
    const int j = r & 15;
#pragma unroll
    for (int i = 0; i < 16; ++i) {
      const int t = t0 + crow(i, h);
      const float own = acc[2][i], oth = __shfl_xor(own, 16);
      const float c = rope[t * 32 + j], sn = rope[t * 32 + 16 + j];
      acc[2][i] = (r < 16) ? own * c - oth * sn : oth * sn + own * c;
    }
    stage_store16<3>(lds + L2B_STG + w * (32 * 208), lane, Q + (size_t)t0 * 768 + 96 * w, 768, [&](int nt, int i) { return f2bf(acc[nt][i] * QSCALE); });
  }
  __syncthreads();
  kv_expand(p, lds, w, lane, slot_of_token(t0));
  __syncthreads();
}

DI void p2_cache_tile(const Params& p, unsigned char* lds, int ctile) {
  const int tid = tidx(), wave = __builtin_amdgcn_readfirstlane(tid >> 6), lane = tid & 63;
  const int b = ctile >> 5, j0 = (ctile & 31) * 32;
  {
    const int row = tid >> 4, c = (tid & 15) * 8;
    const float* src = p.in[2] + ((size_t)(b * PAST + j0 + row)) * 128 + c;
    f32x4 a = *(const f32x4*)src, d = *(const f32x4*)(src + 4);
    float f[8] = {a[0], a[1], a[2], a[3], d[0], d[1], d[2], d[3]};
    *(u32x4*)(lds + L2_CKV + row * 272 + c * 2) = pack8(f);
  }
  __syncthreads();
  kv_expand(p, lds, wave, lane, NP + b * SKV + j0);
  __syncthreads();
}

DI void phase2(const Params& p, unsigned char* lds) {
  constexpr int NTT = NT / 32, NCT = DB * PAST / 32;
  {
    bf16_t* vT = (bf16_t*)((unsigned char*)p.out + OO_VT);
    for (int id = blockIdx.x * NTHREADS + tidx(); id < 8 * 64 * 64; id += gridDim.x * NTHREADS) vT[(size_t)(id >> 6) * NKVP + NKV + (id & 63)] = 0;
  }
  for (int it = blockIdx.x; it < NTT; it += gridDim.x) p2_token_tile_a(p, lds, it);
  for (int it = blockIdx.x; it < NTT + NCT; it += gridDim.x) {
    if (it < NTT) p2_token_tile_b(p, lds, it); else p2_cache_tile(p, lds, it - NTT);
  }
}

constexpr int AT_KSTRIDE = 208, AT_VSTRIDE = 136, AT_KBYTES = 64 * AT_KSTRIDE, AT_STAGE = AT_KBYTES + 64 * AT_VSTRIDE;

DI void attn_item(const Params& p, unsigned char* lds, int hd, int qtok0, int nact, int slot0, int ntiles, int nvalid, bool causal) {
  const int tid = tidx(), wave = __builtin_amdgcn_readfirstlane(tid >> 6), lane = tid & 63, r = lane & 31, h = lane >> 5;
  const bf16_t* Q = (const bf16_t*)((const unsigned char*)p.out + OO_Q);
  const bf16_t* knb = (const bf16_t*)(p.ws + O_KNB) + (size_t)hd * NKVP * 64;
  const bf16_t* kpeb = (const bf16_t*)(p.ws + O_KPEB);
  const bf16_t* vT = (const bf16_t*)((const unsigned char*)p.out + OO_VT) + (size_t)hd * 64 * NKVP;
  bf16_t* YB = (bf16_t*)(p.ws + O_YB);
  const bool active = wave < nact;
  const int qtok = qtok0 + 32 * wave;
  const int wlim = !active ? 0 : (causal ? (qtok >> 6) + 1 : ntiles);
  bf16x8 qf[6];
  if (active) {
#pragma unroll
    for (int ks = 0; ks < 6; ++ks) qf[ks] = *(const bf16x8*)(Q + (size_t)(qtok + r) * 768 + 96 * hd + ks * 16 + h * 8);
  } else {
#pragma unroll
    for (int ks = 0; ks < 6; ++ks) qf[ks] = (bf16x8){0, 0, 0, 0, 0, 0, 0, 0};
  }
  f32x16 o0, o1;
#pragma unroll
  for (int i = 0; i < 16; ++i) { o0[i] = 0.f; o1[i] = 0.f; }
  float mrun = -1e30f, lsum = 0.f;
  const int k_key = tid >> 3, k_ch = tid & 7;
  const int pe_key = (tid & 255) >> 2, pe_ch = tid & 3;
  const int v_dim = tid >> 3, v_ch = tid & 7;
  u32x4 rk, rpe, rv;
  auto gload = [&](int kt) {
    const int s = slot0 + kt * 64;
    rk = *(const u32x4*)(knb + (size_t)(s + k_key) * 64 + k_ch * 8);
    if (tid < 256) rpe = *(const u32x4*)(kpeb + (size_t)(s + pe_key) * 32 + pe_ch * 8);
    rv = *(const u32x4*)(vT + (size_t)v_dim * NKVP + s + v_ch * 8);
  };
  auto lstore = [&](int buf) {
    unsigned char* b = lds + buf * AT_STAGE;
    *(u32x4*)(b + k_key * AT_KSTRIDE + k_ch * 16) = rk;
    if (tid < 256) *(u32x4*)(b + pe_key * AT_KSTRIDE + 128 + pe_ch * 16) = rpe;
    u32x2 lo = {rv[0], rv[1]}, hi = {rv[2], rv[3]};
    *(u32x2*)(b + AT_KBYTES + v_dim * AT_VSTRIDE + v_ch * 16) = lo;
    *(u32x2*)(b + AT_KBYTES + v_dim * AT_VSTRIDE + v_ch * 16 + 8) = hi;
  };
  gload(0); lstore(0);
  __syncthreads();
  for (int kt = 0; kt < ntiles; ++kt) {
    const bool more = kt + 1 < ntiles;
    if (more) gload(kt + 1);
    if (kt < wlim) {
      const unsigned char* kb = lds + (kt & 1) * AT_STAGE;
      const unsigned char* vb = kb + AT_KBYTES;
      f32x16 s0, s1;
#pragma unroll
      for (int i = 0; i < 16; ++i) { s0[i] = 0.f; s1[i] = 0.f; }
#pragma unroll
      for (int ks = 0; ks < 6; ++ks) {
        const bf16x8 a0 = *(const bf16x8*)(kb + r * AT_KSTRIDE + ks * 32 + h * 16);
        const bf16x8 a1 = *(const bf16x8*)(kb + (32 + r) * AT_KSTRIDE + ks * 32 + h * 16);
        s0 = MFMA32(a0, qf[ks], s0);
        s1 = MFMA32(a1, qf[ks], s1);
      }
      if (kt * 64 + 64 > nvalid) {
#pragma unroll
        for (int i = 0; i < 16; ++i) {
          const int key = kt * 64 + crow(i, h);
          if (key >= nvalid) s0[i] = -1e30f;
          if (key + 32 >= nvalid) s1[i] = -1e30f;
        }
      }
      float mx = s0[0];
#pragma unroll
      for (int i = 1; i < 16; ++i) mx = fmaxf(mx, s0[i]);
#pragma unroll
      for (int i = 0; i < 16; ++i) mx = fmaxf(mx, s1[i]);
      mx = fmaxf(mx, __shfl_xor(mx, 32));
      const float mnew = fmaxf(mrun, mx);
      const float alpha = __builtin_amdgcn_exp2f(mrun - mnew);
      mrun = mnew;
      float rs = 0.f;
#pragma unroll
      for (int i = 0; i < 16; ++i) { s0[i] = __builtin_amdgcn_exp2f(s0[i] - mnew); rs += s0[i]; }
#pragma unroll
      for (int i = 0; i < 16; ++i) { s1[i] = __builtin_amdgcn_exp2f(s1[i] - mnew); rs += s1[i]; }
      lsum = lsum * alpha + rs;
#pragma unroll
      for (int i = 0; i < 16; ++i) { o0[i] *= alpha; o1[i] *= alpha; }
#pragma unroll
      for (int mt = 0; mt < 2; ++mt)
#pragma unroll
        for (int s = 0; s < 2; ++s) {
          const f32x16& sv = mt ? s1 : s0;
          u32x4 pw;
          pw[0] = pk2(sv[8 * s], sv[8 * s + 1]); pw[1] = pk2(sv[8 * s + 2], sv[8 * s + 3]);
          pw[2] = pk2(sv[8 * s + 4], sv[8 * s + 5]); pw[3] = pk2(sv[8 * s + 6], sv[8 * s + 7]);
          const bf16x8 pb = __builtin_bit_cast(bf16x8, pw);
          const int kbase = mt * 32 + 16 * s + 4 * h;
          {
            const s16x4 lo = *(const s16x4*)(vb + r * AT_VSTRIDE + kbase * 2);
            const s16x4 hi = *(const s16x4*)(vb + r * AT_VSTRIDE + (kbase + 8) * 2);
            const bf16x8 av = __builtin_shufflevector(lo, hi, 0, 1, 2, 3, 4, 5, 6, 7);
            o0 = MFMA32(av, pb, o0);
          }
          {
            const s16x4 lo = *(const s16x4*)(vb + (32 + r) * AT_VSTRIDE + kbase * 2);
            const s16x4 hi = *(const s16x4*)(vb + (32 + r) * AT_VSTRIDE + (kbase + 8) * 2);
            const bf16x8 av = __builtin_shufflevector(lo, hi, 0, 1, 2, 3, 4, 5, 6, 7);
            o1 = MFMA32(av, pb, o1);
          }
        }
    }
    if (more) lstore((kt + 1) & 1);
    __syncthreads();
  }
  if (active) {
    const float lt = lsum + __shfl_xor(lsum, 32);
    const float inv = 1.f / lt;
    bf16_t* dst = YB + (size_t)(qtok + r) * 512 + hd * 64;
#pragma unroll
    for (int g = 0; g < 4; ++g) {
      u32x2 a, b;
      a[0] = pk2(o0[4 * g] * inv, o0[4 * g + 1] * inv); a[1] = pk2(o0[4 * g + 2] * inv, o0[4 * g + 3] * inv);
      b[0] = pk2(o1[4 * g] * inv, o1[4 * g + 1] * inv); b[1] = pk2(o1[4 * g + 2] * inv, o1[4 * g + 3] * inv);
      *(u32x2*)(dst + 8 * g + 4 * h) = a;
      *(u32x2*)(dst + 32 + 8 * g + 4 * h) = b;
    }
  }
}

constexpr int SC_TOK = 32, SC_ARR = SC_TOK * 64 * 4, SC_STAGE = 5 * SC_ARR + SC_TOK * 32 * 4;
static_assert(2 * SC_STAGE <= LDS_BYTES, "lds scan");
DI void scan_job(const Params& p, unsigned char* lds, int head, int rowgrp, int tok0, int nsteps, int init_mode  ,
                 const float* init  , bool use_v, bf16_t* Y  , float* state_out  ) {
  const int tid = tidx(), wave = __builtin_amdgcn_readfirstlane(tid >> 6), lane = tid & 63;
  const bf16_t* SR = (const bf16_t*)(p.ws + O_SIN);
  const bf16_t* SK = SR + (size_t)NT * 512; const bf16_t* SV = SK + (size_t)NT * 512; const bf16_t* SA = SV + (size_t)NT * 512; const bf16_t* SB = SA + (size_t)NT * 512;
  const _Float16* SW = (const _Float16*)(SB + (size_t)NT * 512);
  u32x4 rg[3];
  auto gload = [&](int c) {
    const int tb = tok0 + c * SC_TOK;
#pragma unroll
    for (int i = 0; i < 3; ++i) {
      const int L = tid + NTHREADS * i;
      if (L < 1280) {
        const int arr = L >> 8, tok = (L & 255) >> 3, ch = L & 7;
        const bf16_t* base = arr == 0 ? SA : arr == 1 ? SB : arr == 2 ? (const bf16_t*)SW : arr == 3 ? SK : SR;
        rg[i] = *(const u32x4*)(base + (size_t)(tb + tok) * 512 + head * 64 + ch * 8);
      } else if (L < 1408) {
        const int vl = L - 1280, tok = vl >> 2, hf = vl & 3;
        rg[i] = *(const u32x4*)(SV + (size_t)(tb + tok) * 512 + head * 64 + rowgrp * 32 + hf * 8);
      }
    }
  };
  auto lstore = [&](int buf) {
    unsigned char* b = lds + buf * SC_STAGE;
#pragma unroll
    for (int i = 0; i < 3; ++i) {
      const int L = tid + NTHREADS * i;
      float f[8];
      if (L < 1280) {
        const int arr = L >> 8, tok = (L & 255) >> 3, ch = L & 7;
        if (arr == 2) {
#pragma unroll
          for (int j = 0; j < 4; ++j) {
            const unsigned u = rg[i][j];
            f[2 * j] = (float)__builtin_bit_cast(_Float16, (unsigned short)(u & 0xffffu));
            f[2 * j + 1] = (float)__builtin_bit_cast(_Float16, (unsigned short)(u >> 16));
          }
        } else unpack8(rg[i], f);
        float* d = (float*)(b + arr * SC_ARR + tok * 256 + ch * 32);
        *(f32x4*)d = (f32x4){f[0], f[1], f[2], f[3]};
        *(f32x4*)(d + 4) = (f32x4){f[4], f[5], f[6], f[7]};
      } else if (L < 1408) {
        const int vl = L - 1280, tok = vl >> 2, hf = vl & 3;
        unpack8(rg[i], f);
        if (!use_v) {
#pragma unroll
          for (int j = 0; j < 8; ++j) f[j] = 0.f;
        }
        float* d = (float*)(b + 5 * SC_ARR + tok * 128 + hf * 32);
        *(f32x4*)d = (f32x4){f[0], f[1], f[2], f[3]};
        *(f32x4*)(d + 4) = (f32x4){f[4], f[5], f[6], f[7]};
      }
    }
  };
  const int rl = lane >> 4, c = lane & 15;
  const int vrow = rowgrp * 32 + 4 * wave + rl;
  f32x4 s = {0.f, 0.f, 0.f, 0.f};
  if (init_mode == 1) s = *(const f32x4*)(init + vrow * 64 + 4 * c);
  if (init_mode == 2) { s[0] = (4 * c == vrow) ? 1.f : 0.f; s[1] = (4 * c + 1 == vrow) ? 1.f : 0.f; s[2] = (4 * c + 2 == vrow) ? 1.f : 0.f; s[3] = (4 * c + 3 == vrow) ? 1.f : 0.f; }
  gload(0); lstore(0);
  __syncthreads();
  const int nch = nsteps / SC_TOK;
  for (int ci = 0; ci < nch; ++ci) {
    const bool more = ci + 1 < nch;
    if (more) gload(ci + 1);
    {
      const unsigned char* b = lds + (ci & 1) * SC_STAGE + c * 16;
      const unsigned char* bv = lds + (ci & 1) * SC_STAGE + 5 * SC_ARR + (4 * wave + rl) * 4;
      bf16_t* yp = Y + (size_t)(tok0 + ci * SC_TOK + c) * 512 + head * 64 + vrow;
      f32x4 A4[3], B4[3], W4[3], K4[3], R4[3]; float V1[3];
#define SC_LOAD(slot, t)                                                                                          \
      { A4[slot] = *(const f32x4*)(b + 0 * SC_ARR + (t) * 256); B4[slot] = *(const f32x4*)(b + 1 * SC_ARR + (t) * 256);    \
        W4[slot] = *(const f32x4*)(b + 2 * SC_ARR + (t) * 256); K4[slot] = *(const f32x4*)(b + 3 * SC_ARR + (t) * 256);    \
        R4[slot] = *(const f32x4*)(b + 4 * SC_ARR + (t) * 256); V1[slot] = *(const float*)(bv + (t) * 128); }
      SC_LOAD(0, 0) SC_LOAD(1, 1)
      float ysel = 0.f;
#pragma unroll
      for (int t = 0; t < SC_TOK; ++t) {
        if (t + 2 < SC_TOK) SC_LOAD((t + 2) % 3, t + 2)
        const f32x4 a4 = A4[t % 3], b4 = B4[t % 3], w4 = W4[t % 3], k4 = K4[t % 3], r4 = R4[t % 3];
        const float vv = V1[t % 3];
        const f32x4 vk = vv * k4;
        float sa = (s[0] * a4[0] + s[2] * a4[2]) + (s[1] * a4[1] + s[3] * a4[3]);
        sa = dpp_sum16(sa);
        s = s * w4 + (sa * b4 + vk);
        float y = (s[0] * r4[0] + s[2] * r4[2]) + (s[1] * r4[1] + s[3] * r4[3]);
        y = dpp_sum16(y);
        ysel = (c == (t & 15)) ? y : ysel;
        if ((t & 15) == 15) yp[(size_t)(t - 15) * 512] = f2bf(ysel);
      }
#undef SC_LOAD
    }
    if (more) lstore((ci + 1) & 1);
    __syncthreads();
  }
  *(f32x4*)(state_out + vrow * 64 + 4 * c) = s;
}

constexpr int Q_PSCAN = 8 * (2 + 4 * (SCC - 1)), Q_PATT = 512, Q_SATT = 128, Q_SSCAN = 256, Q_TOTAL = Q_PSCAN + Q_PATT + Q_SATT + Q_SSCAN;
DI void phase3(const Params& p, unsigned char* lds) {
  volatile int* s_itemp = (volatile int*)(lds + LDS_CTRL);
  unsigned* ctr = (unsigned*)(p.ws + O_CTR);
  float* Gb = (float*)(p.ws + O_GH);
  float* Hb = Gb + (size_t)8 * SCC * 4096;
  bf16_t* Y = (bf16_t*)(p.ws + O_Y);
  bf16_t* E = (bf16_t*)(p.ws + O_E);
  for (;;) {
    if (tidx() == 0) *s_itemp = (int)atomicAdd(ctr, 1u);
    __syncthreads();
    const int item = *s_itemp;
    __syncthreads();
    if (item >= Q_TOTAL) break;
    if (item < Q_PSCAN) {
      const int hd = item / (2 + 4 * (SCC - 1)), j = item % (2 + 4 * (SCC - 1));
      if (j < 2) scan_job(p, lds, hd, j, 0, SCL, 0, nullptr, true, Y, Hb + ((size_t)hd * SCC) * 4096);
      else {
        const int jj = j - 2, c = 1 + jj / 4, k = jj % 4;
        if (k < 2) scan_job(p, lds, hd, k, c * SCL, SCL, 0, nullptr, true, Y, Hb + ((size_t)hd * SCC + c) * 4096);
        else scan_job(p, lds, hd, k - 2, c * SCL, SCL, 2, nullptr, false, E, Gb + ((size_t)hd * SCC + c) * 4096);
      }
    } else if (item < Q_PSCAN + Q_PATT) {
      const int k = item - Q_PSCAN, qb = 63 - (k >> 3), hd = k & 7;
      attn_item(p, lds, hd, qb * 256, 8, 0, qb * 4 + 4, (qb * 4 + 4) * 64, true);
    } else if (item < Q_PSCAN + Q_PATT + Q_SATT) {
      const int k = item - Q_PSCAN - Q_PATT, b = k >> 3, hd = k & 7;
      attn_item(p, lds, hd, NP + b * 32, 1, NP + b * SKV, 17, SKV, false);
    } else {
      const int k = item - Q_PSCAN - Q_PATT - Q_SATT, b = k >> 4, hd = (k & 15) >> 1, rg = k & 1;
      scan_job(p, lds, hd, rg, NP + b * 32, 32, 1, p.in[4] + ((size_t)b * 8 + hd) * 4096, true, Y, p.out + F_WKVS + ((size_t)b * 8 + hd) * 4096);
    }
  }
}

DI void phase3b(const Params& p, unsigned char* lds) {
  if (blockIdx.x >= 8) return;
  const int hd = blockIdx.x, tid = tidx();
  const float* Gb = (const float*)(p.ws + O_GH);
  const float* Hb = Gb + (size_t)8 * SCC * 4096;
  bf16_t* SST = (bf16_t*)(p.ws + O_SST);
  float* S = (float*)lds;
  float* Gs = S + 64 * 65;
  const int v = tid >> 3, k0 = (tid & 7) * 8;
  float cur[8];
#pragma unroll
  for (int j = 0; j < 8; ++j) cur[j] = Hb[((size_t)hd * SCC) * 4096 + v * 64 + k0 + j];
  for (int c = 1; c < SCC; ++c) {
    __syncthreads();
#pragma unroll
    for (int j = 0; j < 8; ++j) { S[v * 65 + k0 + j] = cur[j]; Gs[v * 64 + k0 + j] = Gb[((size_t)hd * SCC + c) * 4096 + v * 64 + k0 + j]; }
    *(u32x4*)(SST + ((size_t)c * 8 + hd) * 4096 + v * 64 + k0) = pack8(cur);
    __syncthreads();
    float o[8];
#pragma unroll
    for (int j = 0; j < 8; ++j) o[j] = Hb[((size_t)hd * SCC + c) * 4096 + v * 64 + k0 + j];
    for (int i = 0; i < 64; ++i) {
      const float sv = S[v * 65 + i];
      const f32x4 g0 = *(const f32x4*)(Gs + i * 64 + k0), g1 = *(const f32x4*)(Gs + i * 64 + k0 + 4);
      o[0] += sv * g0[0]; o[1] += sv * g0[1]; o[2] += sv * g0[2]; o[3] += sv * g0[3];
      o[4] += sv * g1[0]; o[5] += sv * g1[1]; o[6] += sv * g1[2]; o[7] += sv * g1[3];
    }
#pragma unroll
    for (int j = 0; j < 8; ++j) cur[j] = o[j];
  }
  float* dst = p.out + F_WKVP + (size_t)hd * 4096 + v * 64 + k0;
  *(f32x4*)dst = (f32x4){cur[0], cur[1], cur[2], cur[3]};
  *(f32x4*)(dst + 4) = (f32x4){cur[4], cur[5], cur[6], cur[7]};
}

DI void phase4a(const Params& p) {
  const int tid = tidx(), lane = tid & 63, r = lane & 31, hh = lane >> 5;
  const int gw = (blockIdx.x * NTHREADS + tid) >> 6, ngw = (gridDim.x * NTHREADS) >> 6;
  const bf16_t* Y = (const bf16_t*)(p.ws + O_Y);
  const bf16_t* E = (const bf16_t*)(p.ws + O_E);
  const bf16_t* SST = (const bf16_t*)(p.ws + O_SST);
  const bf16_t* SV = (const bf16_t*)(p.ws + O_SIN) + 2 * (size_t)NT * 512;
  const bf16_t* G = (const bf16_t*)(p.ws + O_G);
  const float* RK = (const float*)(p.ws + O_RK);
  bf16_t* YA = (bf16_t*)(p.ws + O_YA);
  for (int task = gw; task < (NT / 32) * 8; task += ngw) {
    const int tile = task >> 3, hd = task & 7, t0 = tile * 32, t = t0 + r;
    f32x16 acc[2];
#pragma unroll
    for (int i = 0; i < 16; ++i) { acc[0][i] = 0.f; acc[1][i] = 0.f; }
    const int c = t0 < NP ? t0 / SCL : 0;
    if (c >= 1) {
      const bf16_t* sst = SST + ((size_t)c * 8 + hd) * 4096;
#pragma unroll
      for (int ks = 0; ks < 4; ++ks) {
        const bf16x8 bv = *(const bf16x8*)(E + (size_t)t * 512 + hd * 64 + ks * 16 + hh * 8);
#pragma unroll
        for (int mt = 0; mt < 2; ++mt) {
          const bf16x8 av = *(const bf16x8*)(sst + (mt * 32 + r) * 64 + ks * 16 + hh * 8);
          acc[mt] = MFMA32(av, bv, acc[mt]);
        }
      }
    }
    float sum = 0.f;
#pragma unroll
    for (int mt = 0; mt < 2; ++mt)
#pragma unroll
      for (int g = 0; g < 4; ++g) {
        const u32x2 yv = *(const u32x2*)(Y + (size_t)t * 512 + hd * 64 + mt * 32 + 8 * g + 4 * hh);
        acc[mt][4 * g] += __uint_as_float(yv[0] << 16); acc[mt][4 * g + 1] += __uint_as_float(yv[0] & 0xffff0000u);
        acc[mt][4 * g + 2] += __uint_as_float(yv[1] << 16); acc[mt][4 * g + 3] += __uint_as_float(yv[1] & 0xffff0000u);
        sum += (acc[mt][4 * g] + acc[mt][4 * g + 1]) + (acc[mt][4 * g + 2] + acc[mt][4 * g + 3]);
      }
    sum += __shfl_xor(sum, 32);
    const float mean = sum * (1.f / 64.f);
    float sq = 0.f;
#pragma unroll
    for (int mt = 0; mt < 2; ++mt)
#pragma unroll
      for (int i = 0; i < 16; ++i) { const float d = acc[mt][i] - mean; sq += d * d; }
    sq += __shfl_xor(sq, 32);
    const float rstd = rsqrtf(sq * (1.f / 64.f) + 64e-5f);
    const float bon = RK[(size_t)t * 8 + hd];
#pragma unroll
    for (int mt = 0; mt < 2; ++mt)
#pragma unroll
      for (int g = 0; g < 4; ++g) {
        const int c0 = hd * 64 + mt * 32 + 8 * g + 4 * hh;
        const size_t o = (size_t)t * 512 + c0;
        const f32x4 lg = *(const f32x4*)(p.in[16] + c0), lb = *(const f32x4*)(p.in[17] + c0);
        const u32x2 vv = *(const u32x2*)(SV + o), gg = *(const u32x2*)(G + o);
        const float vf[4] = {__uint_as_float(vv[0] << 16), __uint_as_float(vv[0] & 0xffff0000u), __uint_as_float(vv[1] << 16), __uint_as_float(vv[1] & 0xffff0000u)};
        const float gf[4] = {__uint_as_float(gg[0] << 16), __uint_as_float(gg[0] & 0xffff0000u), __uint_as_float(gg[1] << 16), __uint_as_float(gg[1] & 0xffff0000u)};
        float ov[4];
#pragma unroll
        for (int j = 0; j < 4; ++j) ov[j] = ((acc[mt][4 * g + j] - mean) * rstd * lg[j] + lb[j] + bon * vf[j]) * gf[j];
        u32x2 w; w[0] = pk2(ov[0], ov[1]); w[1] = pk2(ov[2], ov[3]);
        *(u32x2*)(YA + o) = w;
      }
  }
  conv_x(p, (bf16_t*)((unsigned char*)p.out + OO_XB), blockIdx.x * NTHREADS + tidx(), gridDim.x * NTHREADS);
}

DI void phase4(const Params& p, unsigned char* lds) {
  const bf16_t* XB = (const bf16_t*)((unsigned char*)p.out + OO_XB);
  const bf16_t* WIN = (const bf16_t*)(p.ws + O_WIN);
  const bf16_t* YA = (const bf16_t*)(p.ws + O_YA);
  const bf16_t* YB = (const bf16_t*)(p.ws + O_YB);
  bf16_t* M = (bf16_t*)(p.ws + O_M);
  constexpr int NMT = NT / 128, NNT = 8;
  const int lane = tidx() & 63, wave = __builtin_amdgcn_readfirstlane(tidx() >> 6), r = lane & 31, h = lane >> 5, wm = wave & 3, wn = wave >> 2;
  TileIter ti; ti.init(NMT, NNT);
  int tmi, tni;
  while (ti.next(tmi, tni)) {
    const int m0 = tmi * 128, n0 = tni * 128;
    f32x16 accg[1][2], accv[1][2], macc[1][2];
    gemm_mainloop<1, 2>(XB, DM, WIN + (size_t)PABC * DM, DM, DM, m0, n0, 1024, accg, lds);
    gemm_mainloop<1, 2>(YA, 512, (const bf16_t*)(p.ws + O_WPA), 512, 512, m0, n0, 1024, accv, lds);
#pragma unroll
    for (int tn = 0; tn < 2; ++tn)
#pragma unroll
      for (int g = 0; g < 4; ++g) {
        const f32x4 bg = *(const f32x4*)(p.in[24] + n0 + wn * 64 + tn * 32 + 8 * g + 4 * h);
#pragma unroll
        for (int j = 0; j < 4; ++j) macc[0][tn][4 * g + j] = sigmoidf_(accg[0][tn][4 * g + j] + bg[j]) * accv[0][tn][4 * g + j];
      }
    gemm_mainloop<1, 2>(XB, DM, WIN + (size_t)(PABC + 1024) * DM, DM, DM, m0, n0, 1024, accg, lds);
    gemm_mainloop<1, 2>(YB, 512, (const bf16_t*)(p.ws + O_WPB), 512, 512, m0, n0, 1024, accv, lds);
    epilogue_bf16<1, 2, 128>(macc, lds, M, DM, m0, n0, DM, [&](int tm, int tn, int g, int, int coll) {
      const f32x4 bg = *(const f32x4*)(p.in[24] + 1024 + n0 + coll);
      f32x4 o;
#pragma unroll
      for (int j = 0; j < 4; ++j) o[j] = macc[0][tn][4 * g + j] + sigmoidf_(accg[0][tn][4 * g + j] + bg[j]) * accv[0][tn][4 * g + j];
      return o;
    });
  }
}

template <int TM>
DI void p5_tile(const Params& p, unsigned char* lds, int m0, int n0) {
  const bf16_t* M = (const bf16_t*)(p.ws + O_M);
  bf16_t* Z = (bf16_t*)(p.ws + O_Z);
  f32x16 acc[TM][2];
  gemm_mainloop<TM, 2>(M, DM, (const bf16_t*)(p.ws + O_WO), DM, DM, m0, n0, 1024, acc, lds);
  epilogue_bf16<TM, 2, 128>(acc, lds, Z, DM, m0, n0, DM, [&](int tm, int tn, int g, int rowl, int coll) {
    const f32x4 xv = *(const f32x4*)(xrow(p, m0 + rowl) + n0 + coll);
    return xv * DN_ALPHA + acc4(acc[tm][tn], g);
  });
}
DI bool small_tile_of_block(int& m0, int& n0) {
  const int j = blockIdx.x >> 3;
  if (gridDim.x != 256 || (blockIdx.x & 7) != (j & 7)) return false;
  m0 = NP + (j >> 3) * 128; n0 = (j & 7) * 128; return true;
}
DI void phase5(const Params& p, unsigned char* lds) {
  if (gridDim.x == 256) {
    TileIter ti; ti.init(NP / 256, 8);
    int tmi, tni;
    while (ti.next(tmi, tni)) p5_tile<2>(p, lds, tmi * 256, tni * 128);
    int m0, n0;
    if (small_tile_of_block(m0, n0)) p5_tile<1>(p, lds, m0, n0);
  } else {
    TileIter ti; ti.init(NT / 256, 8);
    int tmi, tni;
    while (ti.next(tmi, tni)) p5_tile<2>(p, lds, tmi * 256, tni * 128);
  }
}
template <bool OUT_BF16>
DI void ln_rows(const bf16_t* src, const float* g, const float* b, bf16_t* dst16, float* dst32) {
  const int gw = (blockIdx.x * NTHREADS + tidx()) >> 6, ngw = (gridDim.x * NTHREADS) >> 6, lane = tidx() & 63;
  for (int t = gw; t < NT; t += ngw) {
    const u32x4* xr = (const u32x4*)(src + (size_t)t * DM) + lane;
    float v[16]; float s = 0.f;
#pragma unroll
    for (int j = 0; j < 2; ++j) { unpack8(xr[64 * j], v + 8 * j); }
#pragma unroll
    for (int j = 0; j < 16; ++j) s += v[j];
    const float mean = wave_sum(s) * (1.f / DM);
    float s2 = 0.f;
#pragma unroll
    for (int j = 0; j < 16; ++j) { v[j] -= mean; s2 += v[j] * v[j]; }
    const float rstd = rsqrtf(wave_sum(s2) * (1.f / DM) + 1e-5f);
#pragma unroll
    for (int j = 0; j < 2; ++j) {
      const int c = 8 * lane + 512 * j;
      const f32x4 g0 = *(const f32x4*)(g + c), g1 = *(const f32x4*)(g + c + 4), b0 = *(const f32x4*)(b + c), b1 = *(const f32x4*)(b + c + 4);
      float o[8];
#pragma unroll
      for (int q = 0; q < 4; ++q) { o[q] = v[8 * j + q] * rstd * g0[q] + b0[q]; o[4 + q] = v[8 * j + 4 + q] * rstd * g1[q] + b1[q]; }
      if (OUT_BF16) *(u32x4*)(dst16 + (size_t)t * DM + c) = pack8(o);
      else { *(f32x4*)(dst32 + (size_t)t * DM + c) = (f32x4){o[0], o[1], o[2], o[3]}; *(f32x4*)(dst32 + (size_t)t * DM + c + 4) = (f32x4){o[4], o[5], o[6], o[7]}; }
    }
  }
}

DI void phase6(const Params& p, unsigned char* lds) {
  const bf16_t* H = (const bf16_t*)(p.ws + O_H);
  bf16_t* ACT = (bf16_t*)(p.ws + O_ACT);
  constexpr int NMT = NT / 256, NNT = 5632 / 128;
  TileIter ti; ti.init(NMT, NNT);
  int tmi, tni;
  while (ti.next(tmi, tni)) {
    const int m0 = tmi * 256, n0 = tni * 128;
    f32x16 acc[2][2];
    gemm_mainloop<2, 2>(H, DM, (const bf16_t*)(p.ws + O_WGU), DM, DM, m0, n0, 5632, acc, lds);
    epilogue_bf16<2, 2, 64>(acc, lds, ACT, DFF, m0, tni * 64, DFF, [&](int tm, int, int g, int, int) {
      f32x4 o;
#pragma unroll
      for (int j = 0; j < 4; ++j) { const float gte = acc[tm][0][4 * g + j], up = acc[tm][1][4 * g + j]; o[j] = gte * sigmoidf_(gte) * up; }
      return o;
    });
  }
}
template <int TM>
DI void p7_tile(const Params& p, unsigned char* lds, int m0, int n0) {
  const bf16_t* H = (const bf16_t*)(p.ws + O_H);
  const bf16_t* ACT = (const bf16_t*)(p.ws + O_ACT);
  bf16_t* Z2 = (bf16_t*)(p.ws + O_Z2);
  f32x16 acc[TM][2];
  gemm_mainloop<TM, 2>(ACT, DFF, (const bf16_t*)(p.ws + O_WDN), DFF, DFF, m0, n0, 1024, acc, lds);
  epilogue_bf16<TM, 2, 128>(acc, lds, Z2, DM, m0, n0, DM, [&](int tm, int tn, int g, int rowl, int coll) {
    const u32x2 hv = *(const u32x2*)(H + (size_t)(m0 + rowl) * DM + n0 + coll);
    const f32x4 hf = {__uint_as_float(hv[0] << 16), __uint_as_float(hv[0] & 0xffff0000u), __uint_as_float(hv[1] << 16), __uint_as_float(hv[1] & 0xffff0000u)};
    return hf * DN_ALPHA + acc4(acc[tm][tn], g);
  });
}
DI void phase7(const Params& p, unsigned char* lds) {
  if (gridDim.x == 256) {
    TileIter ti; ti.init(NP / 256, 8);
    int tmi, tni;
    while (ti.next(tmi, tni)) p7_tile<2>(p, lds, tmi * 256, tni * 128);
    int m0, n0;
    if (small_tile_of_block(m0, n0)) p7_tile<1>(p, lds, m0, n0);
  } else {
    TileIter ti; ti.init(NT / 256, 8);
    int tmi, tni;
    while (ti.next(tmi, tni)) p7_tile<2>(p, lds, tmi * 256, tni * 128);
  }
}

DI void run_phase(const Params& p, unsigned char* lds, int ph) {
  switch (ph) {
    case 0: phase0(p); break;
    case 1: phase1(p, lds); break;
    case 2: phase2(p, lds); break;
    case 3: phase3(p, lds); break;
    case 4: phase4a(p); break;
    case 5: phase4(p, lds); break;
    case 6: phase5(p, lds); break;
    case 7: ln_rows<true>((const bf16_t*)(p.ws + O_Z), p.in[26], p.in[27], (bf16_t*)(p.ws + O_H), nullptr); break;
    case 8: phase6(p, lds); break;
    case 9: phase7(p, lds); break;
    case 11: phase3b(p, lds); break;
    case 10: ln_rows<false>((const bf16_t*)(p.ws + O_Z2), p.in[30], p.in[31], nullptr, p.out + F_Y); break;
  }
}
constexpr int NPHASES = 11;

DI unsigned ctl_ld(unsigned* p) { return __hip_atomic_load(p, __ATOMIC_RELAXED, __HIP_MEMORY_SCOPE_AGENT); }
DI unsigned ctl_add(unsigned* p, unsigned v) { return __hip_atomic_fetch_add(p, v, __ATOMIC_RELAXED, __HIP_MEMORY_SCOPE_AGENT); }
DI void xbar(unsigned* ctl, unsigned x, unsigned nloc, unsigned nx, unsigned k) {
  asm volatile("s_waitcnt vmcnt(0)" ::: "memory");
  __syncthreads();
  if (threadIdx.x == 0) {
    const unsigned old = ctl_add(&ctl[(24 + x) * 64], 1u);
    if (old + 1u == k * nloc) {
      __builtin_amdgcn_fence(__ATOMIC_RELEASE, "agent");
      asm volatile("s_waitcnt vmcnt(0)" ::: "memory");
      ctl_add(&ctl[40 * 64], 1u);
    }
    while (ctl_ld(&ctl[40 * 64]) < k * nx) __builtin_amdgcn_s_sleep(1);
    __builtin_amdgcn_fence(__ATOMIC_ACQUIRE, "agent");
    asm volatile("s_waitcnt vmcnt(0)" ::: "memory");
  }
  __syncthreads();
}

__global__ void __launch_bounds__(NTHREADS) mega_kernel(Params p) {
  extern __shared__ __attribute__((aligned(16))) unsigned char lds[];
  volatile unsigned* s_bar = (volatile unsigned*)(lds + LDS_CTRL + 16);
  cg::grid_group grid = cg::this_grid();
  unsigned* ctl = (unsigned*)(p.ws + O_CTR);
  const unsigned x = (unsigned)__builtin_amdgcn_s_getreg((3 << 11) | 20) & 0xFu;
  if (threadIdx.x == 0) ctl_add(&ctl[(8 + x) * 64], 1u);
  run_phase(p, lds, 0); grid.sync();
  if (threadIdx.x == 0) {
    unsigned nx = 0;
    for (int i = 0; i < 16; ++i) nx += ctl_ld(&ctl[(8 + i) * 64]) != 0u ? 1u : 0u;
    s_bar[0] = ctl_ld(&ctl[(8 + x) * 64]); s_bar[1] = nx;
  }
  __syncthreads();
  const unsigned nloc = __builtin_amdgcn_readfirstlane(s_bar[0]), nx = __builtin_amdgcn_readfirstlane(s_bar[1]);
  run_phase(p, lds, 1); xbar(ctl, x, nloc, nx, 1);
  run_phase(p, lds, 2); xbar(ctl, x, nloc, nx, 2);
  run_phase(p, lds, 3); xbar(ctl, x, nloc, nx, 3);
  run_phase(p, lds, 11); xbar(ctl, x, nloc, nx, 4);
  run_phase(p, lds, 4); xbar(ctl, x, nloc, nx, 5);
  run_phase(p, lds, 5); xbar(ctl, x, nloc, nx, 6);
  run_phase(p, lds, 6); xbar(ctl, x, nloc, nx, 7);
  run_phase(p, lds, 7); xbar(ctl, x, nloc, nx, 8);
  run_phase(p, lds, 8); xbar(ctl, x, nloc, nx, 9);
  run_phase(p, lds, 9); xbar(ctl, x, nloc, nx, 10);
  run_phase(p, lds, 10);
}
template <int PH> __global__ void __launch_bounds__(NTHREADS) phase_kernel(Params p) {
  extern __shared__ __attribute__((aligned(16))) unsigned char lds[];
  run_phase(p, lds, PH);
}
template <int PH> static void launch_phase(const Params& p, int grid, hipStream_t stream) {
  (void)hipFuncSetAttribute((const void*)phase_kernel<PH>, hipFuncAttributeMaxDynamicSharedMemorySize, LDS_BYTES);
  hipLaunchKernelGGL(phase_kernel<PH>, dim3(grid), dim3(NTHREADS), LDS_BYTES, stream, p);
}

extern "C" void kernel_launch(void* const* d_in, const int* in_sizes, int n_in, void* d_out, int out_size, void* d_ws, size_t ws_size, hipStream_t stream) {
  static int grid_blocks = 0;
  if (grid_blocks == 0) {
    if (n_in != 32 || ws_size < WS_END) { fprintf(stderr, "kernel_launch: unexpected n_in %d or ws_size %zu (< %zu)\n", n_in, ws_size, (size_t)WS_END); grid_blocks = -1; return; }
    int dev = 0, cus = 0, per_cu = 0;
    (void)hipGetDevice(&dev);
    (void)hipDeviceGetAttribute(&cus, hipDeviceAttributeMultiprocessorCount, dev);
#if MULTI_LAUNCH
    per_cu = 1;
#else
    (void)hipFuncSetAttribute((const void*)mega_kernel, hipFuncAttributeMaxDynamicSharedMemorySize, LDS_BYTES);
    (void)hipOccupancyMaxActiveBlocksPerMultiprocessor(&per_cu, (const void*)mega_kernel, NTHREADS, LDS_BYTES);
#endif
    if (per_cu < 1) { fprintf(stderr, "kernel_launch: occupancy query gave %d\n", per_cu); grid_blocks = -1; return; }
    grid_blocks = cus;
  }
  if (grid_blocks < 0) return;
  Params p{};
  for (int i = 0; i < 32; ++i) p.in[i] = (const float*)d_in[i];
  p.out = (float*)d_out;
  p.ws = (unsigned char*)d_ws;
#if MULTI_LAUNCH
  launch_phase<0>(p, grid_blocks, stream); launch_phase<1>(p, grid_blocks, stream); launch_phase<2>(p, grid_blocks, stream); launch_phase<3>(p, grid_blocks, stream); launch_phase<11>(p, grid_blocks, stream);
  launch_phase<4>(p, grid_blocks, stream); launch_phase<5>(p, grid_blocks, stream); launch_phase<6>(p, grid_blocks, stream); launch_phase<7>(p, grid_blocks, stream);
  launch_phase<8>(p, grid_blocks, stream); launch_phase<9>(p, grid_blocks, stream); launch_phase<10>(p, grid_blocks, stream);
#else
  (void)hipMemsetAsync((unsigned char*)d_ws + O_CTR, 0, 16384, stream);
  void* args[] = {&p};
  hipError_t e = hipLaunchCooperativeKernel((void*)mega_kernel, dim3(grid_blocks), dim3(NTHREADS), args, LDS_BYTES, stream);
  if (e != hipSuccess) fprintf(stderr, "cooperative launch failed: %s (grid %d)\n", hipGetErrorString(e), grid_blocks);
#endif
}
```

```cpp
#include <hip/hip_runtime.h>
#include <hip/hip_cooperative_groups.h>
#include <cstdio>
#include <cstdint>
namespace cg = cooperative_groups;


#ifndef PROBE_DUP
#define PROBE_DUP -1
#endif
#ifndef MULTI_LAUNCH
#define MULTI_LAUNCH 0
#endif

#define DI __device__ __forceinline__
typedef unsigned short bf16_t;
typedef short bf16x8 __attribute__((ext_vector_type(8)));
typedef short s16x4 __attribute__((ext_vector_type(4)));
typedef float f32x16 __attribute__((ext_vector_type(16)));
typedef float f32x4 __attribute__((ext_vector_type(4)));
typedef float f32x2 __attribute__((ext_vector_type(2)));
typedef unsigned u32x4 __attribute__((ext_vector_type(4)));
typedef unsigned u32x2 __attribute__((ext_vector_type(2)));
typedef __bf16 bf2_t __attribute__((ext_vector_type(2)));

constexpr int NP = 16384, NS = 512, NT = NP + NS;
constexpr int DM = 1024, ACOLS = 1792, BCOLS = 416, PABC = ACOLS + BCOLS  , NIN = 4256;
constexpr int DFF = 2816;
constexpr int PAST = 1024, DSEQ = 32, DB = 16, SKV = PAST + DSEQ  ;
constexpr int NKV = NP + DB * SKV  , NKVP = NKV + 64;
constexpr float DN_ALPHA = 1.189207115002721f;
constexpr float QSCALE = 0.10206207261596575f * 1.4426950408889634f;

constexpr size_t al256(size_t x) { return (x + 255) & ~(size_t)255; }
constexpr size_t O_WIN = 0;
constexpr size_t O_WUQ = O_WIN + al256((size_t)NIN * 1024 * 2);
constexpr size_t O_WUKV = O_WUQ + al256(768 * 256 * 2);
constexpr size_t O_WPA = O_WUKV + al256(1024 * 128 * 2);
constexpr size_t O_WPB = O_WPA + al256(1024 * 512 * 2);
constexpr size_t O_WO = O_WPB + al256(1024 * 512 * 2);
constexpr size_t O_WGU = O_WO + al256(1024 * 1024 * 2);
constexpr size_t O_WDN = O_WGU + al256((size_t)5632 * 1024 * 2);
constexpr size_t O_WW2 = O_WDN + al256((size_t)1024 * 2816 * 2);
constexpr size_t O_WA2 = O_WW2 + al256(512 * 64 * 2);
constexpr size_t O_WG2 = O_WA2 + al256(512 * 64 * 2);
constexpr size_t O_ROPE = O_WG2 + al256(512 * 128 * 2);
constexpr size_t O_CTR = O_ROPE + al256((size_t)NT * 32 * 4);
constexpr size_t O_PAB = O_CTR + 16384;
constexpr size_t SZ_T512 = (size_t)NT * 512 * 2;
constexpr size_t O_SIN = O_PAB + al256((size_t)NT * PABC * 2);
constexpr size_t O_G = O_SIN + 6 * SZ_T512;
constexpr size_t O_RK = O_G + SZ_T512;
constexpr size_t O_KNB = O_RK + al256((size_t)NT * 8 * 4);
constexpr size_t O_KPEB = O_KNB + al256((size_t)8 * NKVP * 64 * 2);
constexpr int SCC = 4, SCL = NP / SCC;
constexpr size_t O_GH = O_KPEB + al256((size_t)NKVP * 32 * 2);
constexpr size_t O_SST = O_GH + 2 * (size_t)8 * SCC * 4096 * 4;
constexpr size_t WS_END = O_SST + (size_t)SCC * 8 * 4096 * 2;
constexpr size_t O_Y = O_PAB;
constexpr size_t O_E = O_Y + SZ_T512;
constexpr size_t O_YB = O_Y + (size_t)NT * 512 * 4;
constexpr size_t O_YA = O_YB + SZ_T512;
constexpr size_t O_H = O_PAB;
constexpr size_t O_M = O_SIN;
constexpr size_t O_Z = O_SIN + (size_t)NT * 1024 * 2;
constexpr size_t O_Z2 = O_PAB + (size_t)NT * 1024 * 2;
constexpr size_t O_ACT = O_SIN;
constexpr size_t OO_XB = 0;
constexpr size_t OO_Q = 0;
constexpr size_t OO_VT = (size_t)NT * 768 * 2;
constexpr size_t F_Y = 0, F_CKVP = (size_t)NT * 1024, F_KPEP = F_CKVP + (size_t)NP * 128, F_WKVP = F_KPEP + (size_t)NP * 32,
                 F_SHP = F_WKVP + 32768, F_CKVS = F_SHP + 1792, F_KPES = F_CKVS + (size_t)NS * 128, F_WKVS = F_KPES + (size_t)NS * 32,
                 F_SHS = F_WKVS + (size_t)DB * 32768;

constexpr int LDS_CTRL = 3 * 49152;
constexpr int LDS_BYTES = LDS_CTRL + 256;
constexpr int NTHREADS = 512;

struct Params {
  const float* in[32];
  float* out;
  unsigned char* ws;
};

DI int tidx() { int t = threadIdx.x; asm volatile("" : "+v"(t)); return t; }
DI unsigned pk2(float a, float b) { f32x2 v = {a, b}; bf2_t r = __builtin_convertvector(v, bf2_t); return __builtin_bit_cast(unsigned, r); }
DI bf16_t f2bf(float a) { return (bf16_t)(pk2(a, 0.f) & 0xffffu); }
DI float bf2f(bf16_t x) { return __uint_as_float(((unsigned)x) << 16); }
DI void unpack8(u32x4 v, float* f) {
#pragma unroll
  for (int j = 0; j < 4; ++j) { f[2 * j] = __uint_as_float(v[j] << 16); f[2 * j + 1] = __uint_as_float(v[j] & 0xffff0000u); }
}
DI u32x4 pack8(const float* f) { u32x4 o; o[0] = pk2(f[0], f[1]); o[1] = pk2(f[2], f[3]); o[2] = pk2(f[4], f[5]); o[3] = pk2(f[6], f[7]); return o; }
DI float sigmoidf_(float x) { return 1.f / (1.f + __expf(-x)); }
DI float dpp_sum16(float x) {
  x += __builtin_bit_cast(float, __builtin_amdgcn_update_dpp(0, __builtin_bit_cast(int, x), 0xB1, 0xF, 0xF, true));
  x += __builtin_bit_cast(float, __builtin_amdgcn_update_dpp(0, __builtin_bit_cast(int, x), 0x4E, 0xF, 0xF, true));
  x += __builtin_bit_cast(float, __builtin_amdgcn_update_dpp(0, __builtin_bit_cast(int, x), 0x141, 0xF, 0xF, true));
  x += __builtin_bit_cast(float, __builtin_amdgcn_update_dpp(0, __builtin_bit_cast(int, x), 0x140, 0xF, 0xF, true));
  return x;
}
DI float sum32(float x) { x = dpp_sum16(x); x += __shfl_xor(x, 16); return x; }
DI float wave_sum(float v) {
#pragma unroll
  for (int o = 1; o < 64; o <<= 1) v += __shfl_xor(v, o);
  return v;
}
DI int crow(int i, int h) { return (i & 3) + 8 * (i >> 2) + 4 * h; }
#define MFMA32(a, b, c) __builtin_amdgcn_mfma_f32_32x32x16_bf16((a), (b), (c), 0, 0, 0)
DI int slot_of_token(int t) { return t < NP ? t : NP + ((t - NP) >> 5) * SKV + PAST + ((t - NP) & 31); }
DI const float* xrow(const Params& p, int t) { return t < NP ? p.in[0] + (size_t)t * DM : p.in[1] + (size_t)(t - NP) * DM; }

DI void conv_T(const float* W, int K, int N, bf16_t* WT, int mode, int gtid, int gsz) {
  const int ntask = (K / 8) * N;
  for (int id = gtid; id < ntask; id += gsz) {
    const int kc = id / N, n = id - kc * N, k0 = kc * 8;
    float f[8];
#pragma unroll
    for (int j = 0; j < 8; ++j) f[j] = W[(size_t)(k0 + j) * N + n];
    if (mode == 2) {
      *(u32x4*)(WT + ((size_t)((n >> 5) * (K >> 4) + (k0 >> 4)) * 64 + ((k0 >> 3) & 1) * 32 + (n & 31)) * 8) = pack8(f);
      continue;
    }
    int row = n;
    if (mode == 1) { const int nt = n >= DFF ? 1 : 0, j = n - nt * DFF; row = 128 * (j >> 6) + 64 * ((j & 63) >> 5) + 32 * nt + (j & 31); }
    *(u32x4*)(WT + (size_t)row * K + k0) = pack8(f);
  }
}
DI void conv_T_lds(const float* W, int K, int N, bf16_t* WT, int mode, unsigned char* lds, int gw, int ngw, int wave, int lane) {
  float* scr = (float*)(lds + wave * (64 * 33 * 4));
  const int nblk = N >> 5, nitem = (K >> 6) * nblk;
  for (int item = gw; item < nitem; item += ngw) {
    const int kb = item / nblk, nb = item - kb * nblk, k0 = kb * 64, n0 = nb * 32;
#pragma unroll 8
    for (int i = 0; i < 32; ++i) { const int kk = 2 * i + (lane >> 5); scr[kk * 33 + (lane & 31)] = W[(size_t)(k0 + kk) * N + n0 + (lane & 31)]; }
    asm volatile("s_waitcnt lgkmcnt(0)" ::: "memory");
    const int c = lane & 7;
#pragma unroll
    for (int j = 0; j < 4; ++j) {
      const int nl = (lane >> 3) + 8 * j;
      const float* sp = scr + (8 * c) * 33 + nl;
      float f[8];
#pragma unroll
      for (int q = 0; q < 8; ++q) f[q] = sp[q * 33];
      int row = n0 + nl;
      if (mode == 1) { const int nt = row >= DFF ? 1 : 0, jj = row - nt * DFF; row = 128 * (jj >> 6) + 64 * ((jj & 63) >> 5) + 32 * nt + (jj & 31); }
      *(u32x4*)(WT + (size_t)row * K + k0 + 8 * c) = pack8(f);
    }
    asm volatile("s_waitcnt lgkmcnt(0)" ::: "memory");
  }
}
DI void conv_x(const Params& p, bf16_t* XB, int gtid, int gsz) {
  for (int id = gtid; id < NT * 128; id += gsz) {
    const int t = id >> 7, c = (id & 127) * 8;
    const float* src = xrow(p, t) + c;
    f32x4 a = *(const f32x4*)src, b = *(const f32x4*)(src + 4);
    float f[8] = {a[0], a[1], a[2], a[3], b[0], b[1], b[2], b[3]};
    *(u32x4*)(XB + (size_t)t * DM + c) = pack8(f);
  }
}
DI void phase0(const Params& p, unsigned char* lds) {
  const int tid0 = tidx(), gtid = blockIdx.x * NTHREADS + tid0, gsz = gridDim.x * NTHREADS;
  const int wave0 = __builtin_amdgcn_readfirstlane(tid0 >> 6), lane0 = tid0 & 63, gw = blockIdx.x * 8 + wave0, ngw = gridDim.x * 8;
  unsigned char* ws = p.ws;
  if (gtid < 64) ((unsigned*)(ws + O_CTR))[gtid] = 0u;
  conv_T_lds(p.in[6], 1024, NIN, (bf16_t*)(ws + O_WIN), 0, lds, gw, ngw, wave0, lane0);
  conv_T(p.in[20], 256, 768, (bf16_t*)(ws + O_WUQ), 2, gtid, gsz);
  conv_T(p.in[22], 128, 1024, (bf16_t*)(ws + O_WUKV), 2, gtid, gsz);
  conv_T_lds(p.in[18], 512, 1024, (bf16_t*)(ws + O_WPA), 0, lds, gw, ngw, wave0, lane0);
  conv_T_lds(p.in[23], 512, 1024, (bf16_t*)(ws + O_WPB), 0, lds, gw, ngw, wave0, lane0);
  conv_T_lds(p.in[25], 1024, 1024, (bf16_t*)(ws + O_WO), 0, lds, gw, ngw, wave0, lane0);
  conv_T_lds(p.in[28], 1024, 5632, (bf16_t*)(ws + O_WGU), 1, lds, gw, ngw, wave0, lane0);
  conv_T_lds(p.in[29], 2816, 1024, (bf16_t*)(ws + O_WDN), 0, lds, gw, ngw, wave0, lane0);
  conv_T(p.in[9], 64, 512, (bf16_t*)(ws + O_WW2), 2, gtid, gsz);
  conv_T(p.in[11], 64, 512, (bf16_t*)(ws + O_WA2), 2, gtid, gsz);
  conv_T(p.in[12], 128, 512, (bf16_t*)(ws + O_WG2), 2, gtid, gsz);
  conv_x(p, (bf16_t*)((unsigned char*)p.out + OO_XB), gtid, gsz);
  float* rope = (float*)(ws + O_ROPE);
  for (int id = gtid; id < NT * 16; id += gsz) {
    const int t = id >> 4, j = id & 15;
    const int pos = t < NP ? t : PAST + ((t - NP) & 31);
    const float inv = (float)exp2(-(double)j * (13.287712379549449 / 16.0));
    const float ang = (float)pos * inv;
    const double x = (double)ang;
    const double n = rint(x * 0.15915494309189535);
    const float red = (float)(x - n * 6.283185307179586);
    rope[t * 32 + j] = __cosf(red);
    rope[t * 32 + 16 + j] = __sinf(red);
  }
  bf16_t* kpeb = (bf16_t*)(ws + O_KPEB);
  for (int id = gtid; id < DB * PAST * 4; id += gsz) {
    const int row = id >> 2, ch = id & 3, b = row >> 10, j = row & 1023;
    const float* src = p.in[3] + (size_t)row * 32 + ch * 8;
    f32x4 a = *(const f32x4*)src, c = *(const f32x4*)(src + 4);
    float f[8] = {a[0], a[1], a[2], a[3], c[0], c[1], c[2], c[3]};
    *(u32x4*)(kpeb + (size_t)(NP + b * SKV + j) * 32 + ch * 8) = pack8(f);
  }
  bf16_t* knb = (bf16_t*)(ws + O_KNB);
  for (int id = gtid; id < 64 * 32; id += gsz) kpeb[(size_t)NKV * 32 + id] = 0;
  for (int id = gtid; id < 8 * 64 * 64; id += gsz) {
    const int h = id >> 12, rem = id & 4095;
    knb[((size_t)h * NKVP + NKV) * 64 + rem] = 0;
  }
}

template <int TM, int TN, bool ZERO = true>
DI void gemm_mainloop(const bf16_t* __restrict__ A, int lda, const bf16_t* __restrict__ Bt, int ldb, int K, int m0, int n0, int nmax,
                      f32x16 (&acc)[TM][TN], unsigned char* lds) {
  constexpr int BM = 128 * TM, BN = 64 * TN, AG = BM / 64, BG = BN / 64, NLD = AG + BG;
  constexpr int ABYTES = BM * 128, STAGE = (BM + BN) * 128;
  static_assert(3 * STAGE <= LDS_CTRL, "lds");
  const int tid = tidx(), wave = __builtin_amdgcn_readfirstlane(tid >> 6), lane = tid & 63, r = lane & 31, h = lane >> 5, wm = wave & 3, wn = wave >> 2;
  const int lrow = lane >> 3, lpos = lane & 7;
  const bf16_t* ap[AG]; const bf16_t* bp[BG];
#pragma unroll
  for (int i = 0; i < AG; ++i) { const int row = (wave * AG + i) * 8 + lrow, c = lpos ^ ((row >> 1) & 7); ap[i] = A + (size_t)(m0 + row) * lda + c * 8; }
#pragma unroll
  for (int i = 0; i < BG; ++i) { const int row = (wave * BG + i) * 8 + lrow, c = lpos ^ ((row >> 1) & 7); int br = n0 + row; br = br < nmax ? br : nmax - 1; bp[i] = Bt + (size_t)br * ldb + c * 8; }
  if (ZERO) {
#pragma unroll
    for (int tm = 0; tm < TM; ++tm)
#pragma unroll
      for (int tn = 0; tn < TN; ++tn)
#pragma unroll
        for (int i = 0; i < 16; ++i) acc[tm][tn][i] = 0.f;
  }
  auto issue = [&](int kt, int stage) {
    unsigned char* sb = lds + stage * STAGE;
#pragma unroll
    for (int i = 0; i < AG; ++i) __builtin_amdgcn_global_load_lds((const unsigned*)(ap[i] + kt * 64), (unsigned*)(sb + (wave * AG + i) * 1024), 16, 0, 0);
#pragma unroll
    for (int i = 0; i < BG; ++i) __builtin_amdgcn_global_load_lds((const unsigned*)(bp[i] + kt * 64), (unsigned*)(sb + ABYTES + (wave * BG + i) * 1024), 16, 0, 0);
  };
  const int swz = (r >> 1) & 7;
  int koff[4];
#pragma unroll
  for (int ks = 0; ks < 4; ++ks) koff[ks] = ((ks * 2 + h) ^ swz) * 16;
  const int a_rd = (wm * 32 * TM + r) * 128, b_rd = ABYTES + (wn * 32 * TN + r) * 128;
  const int nk = K >> 6;
  asm volatile("s_waitcnt vmcnt(0)" ::: "memory");
  issue(0, 0);
  issue(1, 1);
  for (int kt = 0; kt < nk; ++kt) {
    if (kt + 1 < nk) asm volatile("s_waitcnt vmcnt(%0)" ::"n"(NLD) : "memory");
    else asm volatile("s_waitcnt vmcnt(0)" ::: "memory");
    asm volatile("s_waitcnt lgkmcnt(0)" ::: "memory");
    __builtin_amdgcn_s_barrier();
    if (kt + 2 < nk) issue(kt + 2, (kt + 2) % 3);
    const unsigned char* cur = lds + (kt % 3) * STAGE;
#pragma unroll
    for (int ks = 0; ks < 4; ++ks) {
      bf16x8 af[TM], bfr[TN];
#pragma unroll
      for (int tm = 0; tm < TM; ++tm) af[tm] = *(const bf16x8*)(cur + a_rd + tm * 4096 + koff[ks]);
#pragma unroll
      for (int tn = 0; tn < TN; ++tn) bfr[tn] = *(const bf16x8*)(cur + b_rd + tn * 4096 + koff[ks]);
#pragma unroll
      for (int tm = 0; tm < TM; ++tm)
#pragma unroll
        for (int tn = 0; tn < TN; ++tn) acc[tm][tn] = MFMA32(bfr[tn], af[tm], acc[tm][tn]);
    }
  }
  asm volatile("s_waitcnt lgkmcnt(0)" ::: "memory");
  __builtin_amdgcn_s_barrier();
}

template <int TM, int TN, int OUTC, class F>
DI void epilogue_bf16(const f32x16 (&acc)[TM][TN], unsigned char* lds, bf16_t* out, int ldo, int m0, int c0, int cmax, F f) {
  constexpr int BM = 128 * TM, STRIDE = OUTC * 2 + 16, TNO = OUTC / (32 * 2);
  const int tid = tidx(), wave = __builtin_amdgcn_readfirstlane(tid >> 6), lane = tid & 63, r = lane & 31, h = lane >> 5, wm = wave & 3, wn = wave >> 2;
#pragma unroll
  for (int tm = 0; tm < TM; ++tm)
#pragma unroll
    for (int tn = 0; tn < TNO; ++tn)
#pragma unroll
      for (int g = 0; g < 4; ++g) {
        const int rowl = wm * 32 * TM + tm * 32 + r, coll = wn * 32 * TNO + tn * 32 + 8 * g + 4 * h;
        const f32x4 o = f(tm, tn, g, rowl, coll);
        u32x2 w; w[0] = pk2(o[0], o[1]); w[1] = pk2(o[2], o[3]);
        *(u32x2*)(lds + rowl * STRIDE + coll * 2) = w;
      }
  __syncthreads();
  constexpr int CPR = OUTC / 8;
#pragma unroll
  for (int j = 0; j < BM * CPR / NTHREADS; ++j) {
    const int id = tid + NTHREADS * j, row = id / CPR, c = id % CPR;
    if (c0 + c * 8 < cmax) *(u32x4*)(out + (size_t)(m0 + row) * ldo + c0 + c * 8) = *(const u32x4*)(lds + row * STRIDE + c * 16);
  }
  __syncthreads();
}
DI f32x4 acc4(const f32x16& a, int g) { return (f32x4){a[4 * g], a[4 * g + 1], a[4 * g + 2], a[4 * g + 3]}; }

struct TileIter {
  int nM, nN, total, L, Lend, step;
  DI void init(int nM_, int nN_) {
    nM = nM_; nN = nN_; total = nM * nN;
    const int nx = (gridDim.x & 7) == 0 ? 8 : 1, x = blockIdx.x % nx, local = blockIdx.x / nx;
    step = gridDim.x / nx;
    const int per = (total + nx - 1) / nx;
    L = x * per + local; Lend = (x + 1) * per < total ? (x + 1) * per : total;
  }
  DI bool next(int& tmi, int& tni) {
    if (L >= Lend) return false;
    const int fb = nM >> 2, fullcnt = fb * 4 * nN;
    if (L < fullcnt) { const int band = L / (4 * nN), jj = L - band * 4 * nN; tni = jj >> 2; tmi = band * 4 + (jj & 3); }
    else { const int l2 = L - fullcnt, bm = nM & 3; tni = l2 / bm; tmi = fb * 4 + l2 % bm; }
    L += step; return true;
  }
};

DI void phase1(const Params& p, unsigned char* lds) {
  const bf16_t* XB = (const bf16_t*)((unsigned char*)p.out + OO_XB);
  const bf16_t* WT = (const bf16_t*)(p.ws + O_WIN);
  bf16_t* PAB = (bf16_t*)(p.ws + O_PAB);
  constexpr int NMT = NT / 256, NNT = (PABC + 127) / 128;
  const int lane = tidx() & 63, wave = __builtin_amdgcn_readfirstlane(tidx() >> 6), r = lane & 31, h = lane >> 5, wm = wave & 3, wn = wave >> 2;
  TileIter ti; ti.init(NMT, NNT);
  int tmi, tni;
  while (ti.next(tmi, tni)) {
    const int m0 = tmi * 256, n0 = tni * 128;
    f32x16 acc[2][2];
    gemm_mainloop<2, 2>(XB, DM, WT, DM, DM, m0, n0, PABC, acc, lds);
    if (m0 + 256 > NP - 1 && n0 < ACOLS) {
#pragma unroll
      for (int tm = 0; tm < 2; ++tm) {
        const int row = m0 + wm * 64 + tm * 32 + r;
        const bool lastp = row == NP - 1, lasts = row >= NP && ((row - NP) & 31) == 31;
        if (lastp || lasts) {
          float* dst = lastp ? p.out + F_SHP : p.out + F_SHS + (size_t)((row - NP) >> 5) * ACOLS;
#pragma unroll
          for (int tn = 0; tn < 2; ++tn)
#pragma unroll
            for (int g = 0; g < 4; ++g) {
              const int col = n0 + wn * 64 + tn * 32 + 8 * g + 4 * h;
              if (col < ACOLS) *(f32x4*)(dst + col) = acc4(acc[tm][tn], g);
            }
        }
      }
    }
    epilogue_bf16<2, 2, 128>(acc, lds, PAB, PABC, m0, n0, PABC, [&](int tm, int tn, int g, int, int) { return acc4(acc[tm][tn], g); });
  }
}

constexpr int L2_LORA = 0, L2_K = L2_LORA + 32 * 528, L2_R = L2_K + 32 * 1040, L2A_STG = L2_R + 32 * 1040, L2A_END = L2A_STG + 8 * 32 * 144;
constexpr int L2_CQ = 0, L2_CKV = L2_CQ + 32 * 528, L2B_STG = L2_CKV + 32 * 272, L2B_END = L2B_STG + 8 * 32 * 208;
static_assert(L2A_END <= LDS_BYTES && L2B_END <= LDS_BYTES, "lds p2");
template <int NTL, class F>
DI void stage_store16(unsigned char* stg, int lane, bf16_t* dst  , unsigned row_stride  , F f) {
  constexpr int RS = NTL * 64 + 16, CPR = NTL * 4;
  const int r = lane & 31, h = lane >> 5;
#pragma unroll
  for (int nt = 0; nt < NTL; ++nt)
#pragma unroll
    for (int i = 0; i < 16; ++i) *(unsigned short*)(stg + crow(i, h) * RS + (nt * 32 + r) * 2) = f(nt, i);
  __syncthreads();
#pragma unroll
  for (int j = 0; j < 32 * CPR / 64; ++j) {
    const int id = lane + 64 * j, row = id / CPR, ch = id % CPR;
    *(u32x4*)(dst + (size_t)row * row_stride + ch * 8) = *(const u32x4*)(stg + row * RS + ch * 16);
  }
  __syncthreads();
}

template <int NTL, int KS>
DI void mm32(const unsigned char* ldsA, int strideB, const bf16_t* Bt, int ldb, int lane, f32x16 (&acc)[NTL]) {
  constexpr int KG = (NTL * KS <= 16) ? KS : (NTL <= 2 ? 4 : 2), NG = KS / KG;
  const int r = lane & 31, h = lane >> 5;
#pragma unroll
  for (int nt = 0; nt < NTL; ++nt)
#pragma unroll
    for (int i = 0; i < 16; ++i) acc[nt][i] = 0.f;
  bf16x8 bq[2][KG][NTL];
  const bf16_t* bp = Bt + lane * 8;
#pragma unroll
  for (int k = 0; k < KG; ++k)
#pragma unroll
    for (int nt = 0; nt < NTL; ++nt) bq[0][k][nt] = *(const bf16x8*)(bp + (size_t)(nt * KS + k) * 512);
#pragma unroll
  for (int g = 0; g < NG; ++g) {
    if (g + 1 < NG) {
#pragma unroll
      for (int k = 0; k < KG; ++k)
#pragma unroll
        for (int nt = 0; nt < NTL; ++nt) bq[(g + 1) & 1][k][nt] = *(const bf16x8*)(bp + (size_t)(nt * KS + (g + 1) * KG + k) * 512);
    }
    __builtin_amdgcn_sched_barrier(0);
#pragma unroll
    for (int k = 0; k < KG; ++k) {
      const bf16x8 a = *(const bf16x8*)(ldsA + r * strideB + (g * KG + k) * 32 + h * 16);
#pragma unroll
      for (int nt = 0; nt < NTL; ++nt) acc[nt] = MFMA32(a, bq[g & 1][k][nt], acc[nt]);
    }
    __builtin_amdgcn_sched_barrier(0);
  }
}

DI void kv_expand(const Params& p, unsigned char* lds, int w, int lane, int slot0) {
  const int r = lane & 31, h = lane >> 5;
  bf16_t* knb = (bf16_t*)(p.ws + O_KNB);
  bf16_t* vT = (bf16_t*)((unsigned char*)p.out + OO_VT);
  f32x16 acc[4];
  mm32<4, 8>(lds + L2_CKV, 272, (const bf16_t*)(p.ws + O_WUKV) + (size_t)(128 * w) * 128, 128, lane, acc);
  stage_store16<2>((unsigned char*)lds + L2B_STG + w * (32 * 208), lane, knb + ((size_t)w * NKVP + slot0) * 64, 64, [&](int nt, int i) { return f2bf(acc[nt][i]); });
#pragma unroll
  for (int nt = 2; nt < 4; ++nt)
#pragma unroll
    for (int g = 0; g < 4; ++g) {
      u32x2 o; o[0] = pk2(acc[nt][4 * g], acc[nt][4 * g + 1]); o[1] = pk2(acc[nt][4 * g + 2], acc[nt][4 * g + 3]);
      *(u32x2*)(vT + ((unsigned)w * 64 + (nt - 2) * 32 + r) * (unsigned)NKVP + slot0 + 8 * g + 4 * h) = o;
    }
}

DI void p2_token_tile_a(const Params& p, unsigned char* lds, int tile) {
  const int tid = tidx(), wave = __builtin_amdgcn_readfirstlane(tid >> 6), lane = tid & 63, r = lane & 31, h = lane >> 5;
  const int t0 = tile * 32;
  unsigned char* ws = p.ws;
  const bf16_t* PAB = (const bf16_t*)(ws + O_PAB);
  bf16_t* SR = (bf16_t*)(ws + O_SIN);
  bf16_t* SK = SR + (size_t)NT * 512; bf16_t* SV = SK + (size_t)NT * 512; bf16_t* SA = SV + (size_t)NT * 512; bf16_t* SB = SA + (size_t)NT * 512;
  _Float16* SW = (_Float16*)(SB + (size_t)NT * 512);
  bf16_t* G = (bf16_t*)(ws + O_G);
  float* RK = (float*)(ws + O_RK);
  const float* rope = (const float*)(ws + O_ROPE);
#pragma unroll 1
  for (int bt = 0; bt < 2; ++bt) {
    u32x4 rawp[7], rawq[7];
#pragma unroll
    for (int it = 0; it < 7; ++it) {
      const int task = tid + NTHREADS * (bt * 7 + it);
      const int tl = task / 224, ch = task - tl * 224, c0 = ch * 8, t = t0 + tl;
      rawp[it] = *(const u32x4*)(PAB + (size_t)t * PABC + c0);
      rawq[it] = *(const u32x4*)(PAB + (size_t)(t > 0 ? t - 1 : 0) * PABC + c0);
    }
#pragma unroll
    for (int it = 0; it < 7; ++it) {
      const int task = tid + NTHREADS * (bt * 7 + it);
      const int tl = task / 224, ch = task - tl * 224, c0 = ch * 8, t = t0 + tl;
      float pv[8], pr[8];
      unpack8(rawp[it], pv);
      unpack8(rawq[it], pr);
      if (t == 0) {
#pragma unroll
        for (int j = 0; j < 8; ++j) pr[j] = 0.f;
      } else if (t >= NP && ((t - NP) & 31) == 0) {
        const float* sp = p.in[5] + (size_t)((t - NP) >> 5) * ACOLS + c0;
        const f32x4 a = *(const f32x4*)sp, b = *(const f32x4*)(sp + 4);
        pr[0] = a[0]; pr[1] = a[1]; pr[2] = a[2]; pr[3] = a[3]; pr[4] = b[0]; pr[5] = b[1]; pr[6] = b[2]; pr[7] = b[3];
      }
      const f32x4 mu0 = *(const f32x4*)(p.in[7] + c0), mu1 = *(const f32x4*)(p.in[7] + c0 + 4);
      const float mm[8] = {mu0[0], mu0[1], mu0[2], mu0[3], mu1[0], mu1[1], mu1[2], mu1[3]};
      float xs[8];
#pragma unroll
      for (int j = 0; j < 8; ++j) xs[j] = pv[j] + (pr[j] - pv[j]) * mm[j];
      if (c0 < 512) {
        const u32x4 o = pack8(xs);
        *(u32x4*)(SR + (size_t)t * 512 + c0) = o;
        *(u32x4*)(lds + L2_R + tl * 1040 + c0 * 2) = o;
      } else if (c0 < 1024) {
        *(u32x4*)(lds + L2_K + tl * 1040 + (c0 - 512) * 2) = pack8(xs);
      } else if (c0 < 1536) {
        *(u32x4*)(SV + (size_t)t * 512 + (c0 - 1024)) = pack8(xs);
      } else {
        if (c0 < 1600) {
#pragma unroll
          for (int j = 0; j < 8; ++j) { const float e = __expf(2.f * xs[j]); xs[j] = 1.f - 2.f / (e + 1.f); }
        } else if (c0 >= 1664) {
#pragma unroll
          for (int j = 0; j < 8; ++j) xs[j] = sigmoidf_(xs[j]);
        }
        *(u32x4*)(lds + L2_LORA + tl * 528 + (c0 - 1536) * 2) = pack8(xs);
      }
    }
  }
  __syncthreads();
  const int w = wave, cb = 64 * w;
  {
    int r = (tidx() & 31);
    f32x16 acc[2];
    mm32<2, 4>(lds + L2_LORA, 528, (const bf16_t*)(ws + O_WW2) + (size_t)cb * 64, 64, lane, acc);
    const float w00 = p.in[8][cb + r], w01 = p.in[8][cb + 32 + r];
    stage_store16<2>(lds + L2A_STG + w * (32 * 144), lane, (bf16_t*)SW + (size_t)t0 * 512 + cb, 512, [&](int nt, int i) {
      const float z = (nt ? w01 : w00) + acc[nt][i];
      const float sp = fmaxf(-z, 0.f) + __logf(1.f + __expf(-fabsf(z)));
      const float dec = __expf(-__expf(-sp - 0.5f));
      return __builtin_bit_cast(unsigned short, (_Float16)dec);
    });
  }
  __syncthreads();
  {
    int r = (tidx() & 31);
    f32x16 acc[2];
    mm32<2, 4>(lds + L2_LORA + 128, 528, (const bf16_t*)(ws + O_WA2) + (size_t)cb * 64, 64, lane, acc);
    float kkv[2][16];
#pragma unroll
    for (int nt = 0; nt < 2; ++nt) {
      const int c = cb + nt * 32 + r;
      const float a0 = p.in[10][c], kkc = p.in[13][c];
#pragma unroll
      for (int i = 0; i < 16; ++i) {
        acc[nt][i] = sigmoidf_(a0 + acc[nt][i]);
        kkv[nt][i] = bf2f(*(const bf16_t*)(lds + L2_K + crow(i, h) * 1040 + c * 2)) * kkc;
      }
    }
#pragma unroll
    for (int i = 0; i < 16; ++i) {
      const float nsq = sum32(kkv[0][i] * kkv[0][i] + kkv[1][i] * kkv[1][i]);
      const float inv = 1.f / fmaxf(sqrtf(nsq), 1e-12f);
      kkv[0][i] *= inv; kkv[1][i] *= inv;
      __builtin_amdgcn_sched_barrier(0);
    }
    const int c0 = cb + r, c1 = cb + 32 + r;
    const float ka0 = p.in[14][c0], ka1 = p.in[14][c1], rk0 = p.in[15][c0], rk1 = p.in[15][c1];
    unsigned char* stg = lds + L2A_STG + w * (32 * 144);
    stage_store16<2>(stg, lane, SA + (size_t)t0 * 512 + cb, 512, [&](int nt, int i) { return f2bf(-kkv[nt][i]); });
    stage_store16<2>(stg, lane, SB + (size_t)t0 * 512 + cb, 512, [&](int nt, int i) { return f2bf(kkv[nt][i] * acc[nt][i]); });
#pragma unroll
    for (int i = 0; i < 16; ++i) {
      const int tl = crow(i, h);
      const float kr0 = bf2f(*(const bf16_t*)(lds + L2_K + tl * 1040 + c0 * 2)), kr1 = bf2f(*(const bf16_t*)(lds + L2_K + tl * 1040 + c1 * 2));
      const float kh0 = kr0 * (1.f + (acc[0][i] - 1.f) * ka0), kh1 = kr1 * (1.f + (acc[1][i] - 1.f) * ka1);
      kkv[0][i] = kh0; kkv[1][i] = kh1;
      const float rr0 = bf2f(*(const bf16_t*)(lds + L2_R + tl * 1040 + c0 * 2)), rr1 = bf2f(*(const bf16_t*)(lds + L2_R + tl * 1040 + c1 * 2));
      const float sb = sum32(rr0 * kh0 * rk0 + rr1 * kh1 * rk1);
      if (r == 0) RK[(unsigned)(t0 + tl) * 8u + w] = sb;
    }
    stage_store16<2>(stg, lane, SK + (size_t)t0 * 512 + cb, 512, [&](int nt, int i) { return f2bf(kkv[nt][i]); });
  }
  __syncthreads();
  {
    int r = (tidx() & 31);
    f32x16 acc[2];
    mm32<2, 8>(lds + L2_LORA + 256, 528, (const bf16_t*)(ws + O_WG2) + (size_t)cb * 128, 128, lane, acc);
    stage_store16<2>(lds + L2A_STG + w * (32 * 144), lane, G + (size_t)t0 * 512 + cb, 512, [&](int nt, int i) { return f2bf(acc[nt][i]); });
  }
  __syncthreads();
}

DI void p2_token_tile_b(const Params& p, unsigned char* lds, int tile) {
  const int tid = tidx(), wave = __builtin_amdgcn_readfirstlane(tid >> 6), lane = tid & 63, r = lane & 31, h = lane >> 5;
  const int t0 = tile * 32;
  unsigned char* ws = p.ws;
  const bf16_t* PAB = (const bf16_t*)(ws + O_PAB);
  bf16_t* SR = (bf16_t*)(ws + O_SIN);
  bf16_t* SK = SR + (size_t)NT * 512; bf16_t* SV = SK + (size_t)NT * 512; bf16_t* SA = SV + (size_t)NT * 512; bf16_t* SB = SA + (size_t)NT * 512;
  _Float16* SW = (_Float16*)(SB + (size_t)NT * 512);
  bf16_t* G = (bf16_t*)(ws + O_G);
  float* RK = (float*)(ws + O_RK);
  const float* rope = (const float*)(ws + O_ROPE);
  {
    u32x2 vq[4]; unsigned vc[4]; float k1[4], k2[4], rc[4], rs_[4];
#pragma unroll
    for (int q = 0; q < 4; ++q) {
      const int t = t0 + wave * 4 + q;
      const bf16_t* pb = PAB + (size_t)t * PABC + ACOLS;
      vq[q] = *(const u32x2*)(pb + 4 * lane);
      vc[q] = *(const unsigned*)(pb + 256 + 2 * lane);
      k1[q] = bf2f(pb[384 + (lane & 15)]); k2[q] = bf2f(pb[400 + (lane & 15)]);
      rc[q] = rope[t * 32 + (lane & 15)]; rs_[q] = rope[t * 32 + 16 + (lane & 15)];
    }
    const f32x4 gq = *(const f32x4*)(p.in[19] + 4 * lane);
    const f32x2 gkv = *(const f32x2*)(p.in[21] + 2 * lane);
#pragma unroll
    for (int q = 0; q < 4; ++q) {
      const int tl = wave * 4 + q, t = t0 + tl;
      {
        const u32x2 v = vq[q];
        float x[4] = {__uint_as_float(v[0] << 16), __uint_as_float(v[0] & 0xffff0000u), __uint_as_float(v[1] << 16), __uint_as_float(v[1] & 0xffff0000u)};
        const float ss = wave_sum(x[0] * x[0] + x[1] * x[1] + x[2] * x[2] + x[3] * x[3]);
        const float rs = rsqrtf(ss * (1.f / 256.f) + 1e-6f);
        u32x2 o; o[0] = pk2(x[0] * rs * gq[0], x[1] * rs * gq[1]); o[1] = pk2(x[2] * rs * gq[2], x[3] * rs * gq[3]);
        *(u32x2*)(lds + L2_CQ + tl * 528 + lane * 8) = o;
      }
      {
        const unsigned v = vc[q];
        const float x0 = __uint_as_float(v << 16), x1 = __uint_as_float(v & 0xffff0000u);
        const float ss = wave_sum(x0 * x0 + x1 * x1);
        const float rs = rsqrtf(ss * (1.f / 128.f) + 1e-6f);
        const float o0 = x0 * rs * gkv[0], o1 = x1 * rs * gkv[1];
        float* dst = (t < NP) ? p.out + F_CKVP + (size_t)t * 128 : p.out + F_CKVS + (size_t)(t - NP) * 128;
        f32x2 of = {o0, o1};
        *(f32x2*)(dst + 2 * lane) = of;
        *(unsigned*)(lds + L2_CKV + tl * 272 + lane * 4) = pk2(o0, o1);
      }
      if (lane < 16) {
        const float o1 = k1[q] * rc[q] - k2[q] * rs_[q], o2 = k1[q] * rs_[q] + k2[q] * rc[q];
        float* dst = (t < NP) ? p.out + F_KPEP + (size_t)t * 32 : p.out + F_KPES + (size_t)(t - NP) * 32;
        dst[lane] = o1; dst[16 + lane] = o2;
        bf16_t* kp = (bf16_t*)(ws + O_KPEB) + (size_t)slot_of_token(t) * 32;
        kp[lane] = f2bf(o1); kp[16 + lane] = f2bf(o2);
      }
    }
  }
  __syncthreads();
  const int w = wave, cb = 64 * w;
  {
    int r = (tidx() & 31);
    f32x16 acc[3];
    mm32<3, 16>(lds + L2_CQ, 528, (const bf16_t*)(ws + O_WUQ) + (size_t)(96 * w) * 256, 256, lane, acc);
    bf16_t* Q = (bf16_t*)((unsigned char*)p.out + OO_Q);
    const int j = r & 15;
#pragma unroll
    for (int i = 0; i < 16; ++i) {
      const int t = t0 + crow(i, h);
      const float own = acc[2][i], oth = __shfl_xor(own, 16);
      const float c = rope[t * 32 + j], sn = rope[t * 32 + 16 + j];
      acc[2][i] = (r < 16) ? own * c - oth * sn : oth * sn + own * c;
    }
    stage_store16<3>(lds + L2B_STG + w * (32 * 208), lane, Q + (size_t)t0 * 768 + 96 * w, 768, [&](int nt, int i) { return f2bf(acc[nt][i] * QSCALE); });
  }
  __syncthreads();
  kv_expand(p, lds, w, lane, slot_of_token(t0));
  __syncthreads();
}

DI void p2_cache_tile(const Params& p, unsigned char* lds, int ctile) {
  const int tid = tidx(), wave = __builtin_amdgcn_readfirstlane(tid >> 6), lane = tid & 63;
  const int b = ctile >> 5, j0 = (ctile & 31) * 32;
  {
    const int row = tid >> 4, c = (tid & 15) * 8;
    const float* src = p.in[2] + ((size_t)(b * PAST + j0 + row)) * 128 + c;
    f32x4 a = *(const f32x4*)src, d = *(const f32x4*)(src + 4);
    float f[8] = {a[0], a[1], a[2], a[3], d[0], d[1], d[2], d[3]};
    *(u32x4*)(lds + L2_CKV + row * 272 + c * 2) = pack8(f);
  }
  __syncthreads();
  kv_expand(p, lds, wave, lane, NP + b * SKV + j0);
  __syncthreads();
}

DI void phase2(const Params& p, unsigned char* lds) {
  constexpr int NTT = NT / 32, NCT = DB * PAST / 32;
  {
    bf16_t* vT = (bf16_t*)((unsigned char*)p.out + OO_VT);
    for (int id = blockIdx.x * NTHREADS + tidx(); id < 8 * 64 * 64; id += gridDim.x * NTHREADS) vT[(size_t)(id >> 6) * NKVP + NKV + (id & 63)] = 0;
  }
  for (int it = blockIdx.x; it < NTT; it += gridDim.x) p2_token_tile_a(p, lds, it);
  for (int it = blockIdx.x; it < NTT + NCT; it += gridDim.x) {
    if (it < NTT) p2_token_tile_b(p, lds, it); else p2_cache_tile(p, lds, it - NTT);
  }
}

constexpr int AT_KSTRIDE = 208, AT_VSTRIDE = 136, AT_KBYTES = 64 * AT_KSTRIDE, AT_STAGE = AT_KBYTES + 64 * AT_VSTRIDE;

DI void attn_item(const Params& p, unsigned char* lds, int hd, int qtok0, int nact, int slot0, int ntiles, int nvalid, bool causal) {
  const int tid = tidx(), wave = __builtin_amdgcn_readfirstlane(tid >> 6), lane = tid & 63, r = lane & 31, h = lane >> 5;
  const bf16_t* Q = (const bf16_t*)((const unsigned char*)p.out + OO_Q);
  const bf16_t* knb = (const bf16_t*)(p.ws + O_KNB) + (size_t)hd * NKVP * 64;
  const bf16_t* kpeb = (const bf16_t*)(p.ws + O_KPEB);
  const bf16_t* vT = (const bf16_t*)((const unsigned char*)p.out + OO_VT) + (size_t)hd * 64 * NKVP;
  bf16_t* YB = (bf16_t*)(p.ws + O_YB);
  const bool active = wave < nact;
  const int qtok = qtok0 + 32 * wave;
  const int wlim = !active ? 0 : (causal ? (qtok >> 6) + 1 : ntiles);
  bf16x8 qf[6];
  if (active) {
#pragma unroll
    for (int ks = 0; ks < 6; ++ks) qf[ks] = *(const bf16x8*)(Q + (size_t)(qtok + r) * 768 + 96 * hd + ks * 16 + h * 8);
  } else {
#pragma unroll
    for (int ks = 0; ks < 6; ++ks) qf[ks] = (bf16x8){0, 0, 0, 0, 0, 0, 0, 0};
  }
  f32x16 o0, o1;
#pragma unroll
  for (int i = 0; i < 16; ++i) { o0[i] = 0.f; o1[i] = 0.f; }
  float mrun = -1e30f, lsum = 0.f;
  const int k_key = tid >> 3, k_ch = tid & 7;
  const int pe_key = (tid & 255) >> 2, pe_ch = tid & 3;
  const int v_dim = tid >> 3, v_ch = tid & 7;
  u32x4 rk, rpe, rv;
  auto gload = [&](int kt) {
    const int s = slot0 + kt * 64;
    rk = *(const u32x4*)(knb + (size_t)(s + k_key) * 64 + k_ch * 8);
    if (tid < 256) rpe = *(const u32x4*)(kpeb + (size_t)(s + pe_key) * 32 + pe_ch * 8);
    rv = *(const u32x4*)(vT + (size_t)v_dim * NKVP + s + v_ch * 8);
  };
  auto lstore = [&](int buf) {
    unsigned char* b = lds + buf * AT_STAGE;
    *(u32x4*)(b + k_key * AT_KSTRIDE + k_ch * 16) = rk;
    if (tid < 256) *(u32x4*)(b + pe_key * AT_KSTRIDE + 128 + pe_ch * 16) = rpe;
    u32x2 lo = {rv[0], rv[1]}, hi = {rv[2], rv[3]};
    *(u32x2*)(b + AT_KBYTES + v_dim * AT_VSTRIDE + v_ch * 16) = lo;
    *(u32x2*)(b + AT_KBYTES + v_dim * AT_VSTRIDE + v_ch * 16 + 8) = hi;
  };
  gload(0); lstore(0);
  __syncthreads();
  for (int kt = 0; kt < ntiles; ++kt) {
    const bool more = kt + 1 < ntiles;
    if (more) gload(kt + 1);
    if (kt < wlim) {
      const unsigned char* kb = lds + (kt & 1) * AT_STAGE;
      const unsigned char* vb = kb + AT_KBYTES;
      f32x16 s0, s1;
#pragma unroll
      for (int i = 0; i < 16; ++i) { s0[i] = 0.f; s1[i] = 0.f; }
#pragma unroll
      for (int ks = 0; ks < 6; ++ks) {
        const bf16x8 a0 = *(const bf16x8*)(kb + r * AT_KSTRIDE + ks * 32 + h * 16);
        const bf16x8 a1 = *(const bf16x8*)(kb + (32 + r) * AT_KSTRIDE + ks * 32 + h * 16);
        s0 = MFMA32(a0, qf[ks], s0);
        s1 = MFMA32(a1, qf[ks], s1);
      }
      if (kt * 64 + 64 > nvalid) {
#pragma unroll
        for (int i = 0; i < 16; ++i) {
          const int key = kt * 64 + crow(i, h);
          if (key >= nvalid) s0[i] = -1e30f;
          if (key + 32 >= nvalid) s1[i] = -1e30f;
        }
      }
      float mx = s0[0];
#pragma unroll
      for (int i = 1; i < 16; ++i) mx = fmaxf(mx, s0[i]);
#pragma unroll
      for (int i = 0; i < 16; ++i) mx = fmaxf(mx, s1[i]);
      mx = fmaxf(mx, __shfl_xor(mx, 32));
      const float mnew = fmaxf(mrun, mx);
      const float alpha = __builtin_amdgcn_exp2f(mrun - mnew);
      mrun = mnew;
      float rs = 0.f;
#pragma unroll
      for (int i = 0; i < 16; ++i) { s0[i] = __builtin_amdgcn_exp2f(s0[i] - mnew); rs += s0[i]; }
#pragma unroll
      for (int i = 0; i < 16; ++i) { s1[i] = __builtin_amdgcn_exp2f(s1[i] - mnew); rs += s1[i]; }
      lsum = lsum * alpha + rs;
#pragma unroll
      for (int i = 0; i < 16; ++i) { o0[i] *= alpha; o1[i] *= alpha; }
#pragma unroll
      for (int mt = 0; mt < 2; ++mt)
#pragma unroll
        for (int s = 0; s < 2; ++s) {
          const f32x16& sv = mt ? s1 : s0;
          u32x4 pw;
          pw[0] = pk2(sv[8 * s], sv[8 * s + 1]); pw[1] = pk2(sv[8 * s + 2], sv[8 * s + 3]);
          pw[2] = pk2(sv[8 * s + 4], sv[8 * s + 5]); pw[3] = pk2(sv[8 * s + 6], sv[8 * s + 7]);
          const bf16x8 pb = __builtin_bit_cast(bf16x8, pw);
          const int kbase = mt * 32 + 16 * s + 4 * h;
          {
            const s16x4 lo = *(const s16x4*)(vb + r * AT_VSTRIDE + kbase * 2);
            const s16x4 hi = *(const s16x4*)(vb + r * AT_VSTRIDE + (kbase + 8) * 2);
            const bf16x8 av = __builtin_shufflevector(lo, hi, 0, 1, 2, 3, 4, 5, 6, 7);
            o0 = MFMA32(av, pb, o0);
          }
          {
            const s16x4 lo = *(const s16x4*)(vb + (32 + r) * AT_VSTRIDE + kbase * 2);
            const s16x4 hi = *(const s16x4*)(vb + (32 + r) * AT_VSTRIDE + (kbase + 8) * 2);
            const bf16x8 av = __builtin_shufflevector(lo, hi, 0, 1, 2, 3, 4, 5, 6, 7);
            o1 = MFMA32(av, pb, o1);
          }
        }
    }
    if (more) lstore((kt + 1) & 1);
    __syncthreads();
  }
  if (active) {
    const float lt = lsum + __shfl_xor(lsum, 32);
    const float inv = 1.f / lt;
    bf16_t* dst = YB + (size_t)(qtok + r) * 512 + hd * 64;
#pragma unroll
    for (int g = 0; g < 4; ++g) {
      u32x2 a, b;
      a[0] = pk2(o0[4 * g] * inv, o0[4 * g + 1] * inv); a[1] = pk2(o0[4 * g + 2] * inv, o0[4 * g + 3] * inv);
      b[0] = pk2(o1[4 * g] * inv, o1[4 * g + 1] * inv); b[1] = pk2(o1[4 * g + 2] * inv, o1[4 * g + 3] * inv);
      *(u32x2*)(dst + 8 * g + 4 * h) = a;
      *(u32x2*)(dst + 32 + 8 * g + 4 * h) = b;
    }
  }
}

constexpr int SC_TOK = 32, SC_ARR = SC_TOK * 64 * 4, SC_STAGE = 5 * SC_ARR + SC_TOK * 32 * 4;
static_assert(2 * SC_STAGE <= LDS_BYTES, "lds scan");
DI void scan_job(const Params& p, unsigned char* lds, int head, int rowgrp, int tok0, int nsteps, int init_mode  ,
                 const float* init  , bool use_v, bf16_t* Y  , float* state_out  ) {
  const int tid = tidx(), wave = __builtin_amdgcn_readfirstlane(tid >> 6), lane = tid & 63;
  const bf16_t* SR = (const bf16_t*)(p.ws + O_SIN);
  const bf16_t* SK = SR + (size_t)NT * 512; const bf16_t* SV = SK + (size_t)NT * 512; const bf16_t* SA = SV + (size_t)NT * 512; const bf16_t* SB = SA + (size_t)NT * 512;
  const _Float16* SW = (const _Float16*)(SB + (size_t)NT * 512);
  u32x4 rg[3];
  auto gload = [&](int c) {
    const int tb = tok0 + c * SC_TOK;
#pragma unroll
    for (int i = 0; i < 3; ++i) {
      const int L = tid + NTHREADS * i;
      if (L < 1280) {
        const int arr = L >> 8, tok = (L & 255) >> 3, ch = L & 7;
        const bf16_t* base = arr == 0 ? SA : arr == 1 ? SB : arr == 2 ? (const bf16_t*)SW : arr == 3 ? SK : SR;
        rg[i] = *(const u32x4*)(base + (size_t)(tb + tok) * 512 + head * 64 + ch * 8);
      } else if (L < 1408) {
        const int vl = L - 1280, tok = vl >> 2, hf = vl & 3;
        rg[i] = *(const u32x4*)(SV + (size_t)(tb + tok) * 512 + head * 64 + rowgrp * 32 + hf * 8);
      }
    }
  };
  auto lstore = [&](int buf) {
    unsigned char* b = lds + buf * SC_STAGE;
#pragma unroll
    for (int i = 0; i < 3; ++i) {
      const int L = tid + NTHREADS * i;
      float f[8];
      if (L < 1280) {
        const int arr = L >> 8, tok = (L & 255) >> 3, ch = L & 7;
        if (arr == 2) {
#pragma unroll
          for (int j = 0; j < 4; ++j) {
            const unsigned u = rg[i][j];
            f[2 * j] = (float)__builtin_bit_cast(_Float16, (unsigned short)(u & 0xffffu));
            f[2 * j + 1] = (float)__builtin_bit_cast(_Float16, (unsigned short)(u >> 16));
          }
        } else unpack8(rg[i], f);
        float* d = (float*)(b + arr * SC_ARR + tok * 256 + ch * 32);
        *(f32x4*)d = (f32x4){f[0], f[1], f[2], f[3]};
        *(f32x4*)(d + 4) = (f32x4){f[4], f[5], f[6], f[7]};
      } else if (L < 1408) {
        const int vl = L - 1280, tok = vl >> 2, hf = vl & 3;
        unpack8(rg[i], f);
        if (!use_v) {
#pragma unroll
          for (int j = 0; j < 8; ++j) f[j] = 0.f;
        }
        float* d = (float*)(b + 5 * SC_ARR + tok * 128 + hf * 32);
        *(f32x4*)d = (f32x4){f[0], f[1], f[2], f[3]};
        *(f32x4*)(d + 4) = (f32x4){f[4], f[5], f[6], f[7]};
      }
    }
  };
  const int rl = lane >> 4, c = lane & 15;
  const int vrow = rowgrp * 32 + 4 * wave + rl;
  f32x4 s = {0.f, 0.f, 0.f, 0.f};
  if (init_mode == 1) s = *(const f32x4*)(init + vrow * 64 + 4 * c);
  if (init_mode == 2) { s[0] = (4 * c == vrow) ? 1.f : 0.f; s[1] = (4 * c + 1 == vrow) ? 1.f : 0.f; s[2] = (4 * c + 2 == vrow) ? 1.f : 0.f; s[3] = (4 * c + 3 == vrow) ? 1.f : 0.f; }
  gload(0); lstore(0);
  __syncthreads();
  const int nch = nsteps / SC_TOK;
  for (int ci = 0; ci < nch; ++ci) {
    const bool more = ci + 1 < nch;
    if (more) gload(ci + 1);
    {
      const unsigned char* b = lds + (ci & 1) * SC_STAGE + c * 16;
      const unsigned char* bv = lds + (ci & 1) * SC_STAGE + 5 * SC_ARR + (4 * wave + rl) * 4;
      bf16_t* yp = Y + (size_t)(tok0 + ci * SC_TOK + c) * 512 + head * 64 + vrow;
      f32x4 A4[3], B4[3], W4[3], K4[3], R4[3]; float V1[3];
#define SC_LOAD(slot, t)                                                                                          \
      { A4[slot] = *(const f32x4*)(b + 0 * SC_ARR + (t) * 256); B4[slot] = *(const f32x4*)(b + 1 * SC_ARR + (t) * 256);    \
        W4[slot] = *(const f32x4*)(b + 2 * SC_ARR + (t) * 256); K4[slot] = *(const f32x4*)(b + 3 * SC_ARR + (t) * 256);    \
        R4[slot] = *(const f32x4*)(b + 4 * SC_ARR + (t) * 256); V1[slot] = *(const float*)(bv + (t) * 128); }
      SC_LOAD(0, 0) SC_LOAD(1, 1)
      float ysel = 0.f;
#pragma unroll
      for (int t = 0; t < SC_TOK; ++t) {
        if (t + 2 < SC_TOK) SC_LOAD((t + 2) % 3, t + 2)
        const f32x4 a4 = A4[t % 3], b4 = B4[t % 3], w4 = W4[t % 3], k4 = K4[t % 3], r4 = R4[t % 3];
        const float vv = V1[t % 3];
        const f32x4 vk = vv * k4;
        float sa = (s[0] * a4[0] + s[2] * a4[2]) + (s[1] * a4[1] + s[3] * a4[3]);
        sa = dpp_sum16(sa);
        s = s * w4 + (sa * b4 + vk);
        float y = (s[0] * r4[0] + s[2] * r4[2]) + (s[1] * r4[1] + s[3] * r4[3]);
        y = dpp_sum16(y);
        ysel = (c == (t & 15)) ? y : ysel;
        if ((t & 15) == 15) yp[(size_t)(t - 15) * 512] = f2bf(ysel);
      }
#undef SC_LOAD
    }
    if (more) lstore((ci + 1) & 1);
    __syncthreads();
  }
  *(f32x4*)(state_out + vrow * 64 + 4 * c) = s;
}

constexpr int Q_PSCAN = 8 * (2 + 4 * (SCC - 1)), Q_PATT = 512, Q_SATT = 128, Q_SSCAN = 256, Q_TOTAL = Q_PSCAN + Q_PATT + Q_SATT + Q_SSCAN;
DI void phase3(const Params& p, unsigned char* lds) {
  volatile int* s_itemp = (volatile int*)(lds + LDS_CTRL);
  unsigned* ctr = (unsigned*)(p.ws + O_CTR);
  float* Gb = (float*)(p.ws + O_GH);
  float* Hb = Gb + (size_t)8 * SCC * 4096;
  bf16_t* Y = (bf16_t*)(p.ws + O_Y);
  bf16_t* E = (bf16_t*)(p.ws + O_E);
  for (;;) {
    if (tidx() == 0) *s_itemp = (int)atomicAdd(ctr, 1u);
    __syncthreads();
    const int item = *s_itemp;
    __syncthreads();
    if (item >= Q_TOTAL) break;
    if (item < Q_PSCAN) {
      const int hd = item / (2 + 4 * (SCC - 1)), j = item % (2 + 4 * (SCC - 1));
      if (j < 2) scan_job(p, lds, hd, j, 0, SCL, 0, nullptr, true, Y, Hb + ((size_t)hd * SCC) * 4096);
      else {
        const int jj = j - 2, c = 1 + jj / 4, k = jj % 4;
        if (k < 2) scan_job(p, lds, hd, k, c * SCL, SCL, 0, nullptr, true, Y, Hb + ((size_t)hd * SCC + c) * 4096);
        else scan_job(p, lds, hd, k - 2, c * SCL, SCL, 2, nullptr, false, E, Gb + ((size_t)hd * SCC + c) * 4096);
      }
    } else if (item < Q_PSCAN + Q_PATT) {
      const int k = item - Q_PSCAN, qb = 63 - (k >> 3), hd = k & 7;
      attn_item(p, lds, hd, qb * 256, 8, 0, qb * 4 + 4, (qb * 4 + 4) * 64, true);
    } else if (item < Q_PSCAN + Q_PATT + Q_SATT) {
      const int k = item - Q_PSCAN - Q_PATT, b = k >> 3, hd = k & 7;
      attn_item(p, lds, hd, NP + b * 32, 1, NP + b * SKV, 17, SKV, false);
    } else {
      const int k = item - Q_PSCAN - Q_PATT - Q_SATT, b = k >> 4, hd = (k & 15) >> 1, rg = k & 1;
      scan_job(p, lds, hd, rg, NP + b * 32, 32, 1, p.in[4] + ((size_t)b * 8 + hd) * 4096, true, Y, p.out + F_WKVS + ((size_t)b * 8 + hd) * 4096);
    }
  }
}

DI void phase3b(const Params& p, unsigned char* lds) {
  if (blockIdx.x >= 8) return;
  const int hd = blockIdx.x, tid = tidx();
  const float* Gb = (const float*)(p.ws + O_GH);
  const float* Hb = Gb + (size_t)8 * SCC * 4096;
  bf16_t* SST = (bf16_t*)(p.ws + O_SST);
  float* S = (float*)lds;
  float* Gs = S + 64 * 65;
  const int v = tid >> 3, k0 = (tid & 7) * 8;
  float cur[8];
#pragma unroll
  for (int j = 0; j < 8; ++j) cur[j] = Hb[((size_t)hd * SCC) * 4096 + v * 64 + k0 + j];
  for (int c = 1; c < SCC; ++c) {
    __syncthreads();
#pragma unroll
    for (int j = 0; j < 8; ++j) { S[v * 65 + k0 + j] = cur[j]; Gs[v * 64 + k0 + j] = Gb[((size_t)hd * SCC + c) * 4096 + v * 64 + k0 + j]; }
    *(u32x4*)(SST + ((size_t)c * 8 + hd) * 4096 + v * 64 + k0) = pack8(cur);
    __syncthreads();
    float o[8];
#pragma unroll
    for (int j = 0; j < 8; ++j) o[j] = Hb[((size_t)hd * SCC + c) * 4096 + v * 64 + k0 + j];
    for (int i = 0; i < 64; ++i) {
      const float sv = S[v * 65 + i];
      const f32x4 g0 = *(const f32x4*)(Gs + i * 64 + k0), g1 = *(const f32x4*)(Gs + i * 64 + k0 + 4);
      o[0] += sv * g0[0]; o[1] += sv * g0[1]; o[2] += sv * g0[2]; o[3] += sv * g0[3];
      o[4] += sv * g1[0]; o[5] += sv * g1[1]; o[6] += sv * g1[2]; o[7] += sv * g1[3];
    }
#pragma unroll
    for (int j = 0; j < 8; ++j) cur[j] = o[j];
  }
  float* dst = p.out + F_WKVP + (size_t)hd * 4096 + v * 64 + k0;
  *(f32x4*)dst = (f32x4){cur[0], cur[1], cur[2], cur[3]};
  *(f32x4*)(dst + 4) = (f32x4){cur[4], cur[5], cur[6], cur[7]};
}

DI void phase4a(const Params& p) {
  const int tid = tidx(), lane = tid & 63, r = lane & 31, hh = lane >> 5;
  const int gw = (blockIdx.x * NTHREADS + tid) >> 6, ngw = (gridDim.x * NTHREADS) >> 6;
  const bf16_t* Y = (const bf16_t*)(p.ws + O_Y);
  const bf16_t* E = (const bf16_t*)(p.ws + O_E);
  const bf16_t* SST = (const bf16_t*)(p.ws + O_SST);
  const bf16_t* SV = (const bf16_t*)(p.ws + O_SIN) + 2 * (size_t)NT * 512;
  const bf16_t* G = (const bf16_t*)(p.ws + O_G);
  const float* RK = (const float*)(p.ws + O_RK);
  bf16_t* YA = (bf16_t*)(p.ws + O_YA);
  for (int task = gw; task < (NT / 32) * 8; task += ngw) {
    const int tile = task >> 3, hd = task & 7, t0 = tile * 32, t = t0 + r;
    f32x16 acc[2];
#pragma unroll
    for (int i = 0; i < 16; ++i) { acc[0][i] = 0.f; acc[1][i] = 0.f; }
    const int c = t0 < NP ? t0 / SCL : 0;
    if (c >= 1) {
      const bf16_t* sst = SST + ((size_t)c * 8 + hd) * 4096;
#pragma unroll
      for (int ks = 0; ks < 4; ++ks) {
        const bf16x8 bv = *(const bf16x8*)(E + (size_t)t * 512 + hd * 64 + ks * 16 + hh * 8);
#pragma unroll
        for (int mt = 0; mt < 2; ++mt) {
          const bf16x8 av = *(const bf16x8*)(sst + (mt * 32 + r) * 64 + ks * 16 + hh * 8);
          acc[mt] = MFMA32(av, bv, acc[mt]);
        }
      }
    }
    float sum = 0.f;
#pragma unroll
    for (int mt = 0; mt < 2; ++mt)
#pragma unroll
      for (int g = 0; g < 4; ++g) {
        const u32x2 yv = *(const u32x2*)(Y + (size_t)t * 512 + hd * 64 + mt * 32 + 8 * g + 4 * hh);
        acc[mt][4 * g] += __uint_as_float(yv[0] << 16); acc[mt][4 * g + 1] += __uint_as_float(yv[0] & 0xffff0000u);
        acc[mt][4 * g + 2] += __uint_as_float(yv[1] << 16); acc[mt][4 * g + 3] += __uint_as_float(yv[1] & 0xffff0000u);
        sum += (acc[mt][4 * g] + acc[mt][4 * g + 1]) + (acc[mt][4 * g + 2] + acc[mt][4 * g + 3]);
      }
    sum += __shfl_xor(sum, 32);
    const float mean = sum * (1.f / 64.f);
    float sq = 0.f;
#pragma unroll
    for (int mt = 0; mt < 2; ++mt)
#pragma unroll
      for (int i = 0; i < 16; ++i) { const float d = acc[mt][i] - mean; sq += d * d; }
    sq += __shfl_xor(sq, 32);
    const float rstd = rsqrtf(sq * (1.f / 64.f) + 64e-5f);
    const float bon = RK[(size_t)t * 8 + hd];
#pragma unroll
    for (int mt = 0; mt < 2; ++mt)
#pragma unroll
      for (int g = 0; g < 4; ++g) {
        const int c0 = hd * 64 + mt * 32 + 8 * g + 4 * hh;
        const size_t o = (size_t)t * 512 + c0;
        const f32x4 lg = *(const f32x4*)(p.in[16] + c0), lb = *(const f32x4*)(p.in[17] + c0);
        const u32x2 vv = *(const u32x2*)(SV + o), gg = *(const u32x2*)(G + o);
        const float vf[4] = {__uint_as_float(vv[0] << 16), __uint_as_float(vv[0] & 0xffff0000u), __uint_as_float(vv[1] << 16), __uint_as_float(vv[1] & 0xffff0000u)};
        const float gf[4] = {__uint_as_float(gg[0] << 16), __uint_as_float(gg[0] & 0xffff0000u), __uint_as_float(gg[1] << 16), __uint_as_float(gg[1] & 0xffff0000u)};
        float ov[4];
#pragma unroll
        for (int j = 0; j < 4; ++j) ov[j] = ((acc[mt][4 * g + j] - mean) * rstd * lg[j] + lb[j] + bon * vf[j]) * gf[j];
        u32x2 w; w[0] = pk2(ov[0], ov[1]); w[1] = pk2(ov[2], ov[3]);
        *(u32x2*)(YA + o) = w;
      }
  }
  conv_x(p, (bf16_t*)((unsigned char*)p.out + OO_XB), blockIdx.x * NTHREADS + tidx(), gridDim.x * NTHREADS);
}

DI bool small_tile_of_block(int& m0, int& n0) {
  const int j = blockIdx.x >> 3;
  if (gridDim.x != 256 || (blockIdx.x & 7) != (j & 7)) return false;
  m0 = NP + (j >> 3) * 128; n0 = (j & 7) * 128; return true;
}
template <int TM>
DI void p4_tile(const Params& p, unsigned char* lds, int m0, int n0) {
  const bf16_t* XB = (const bf16_t*)((unsigned char*)p.out + OO_XB);
  const bf16_t* WIN = (const bf16_t*)(p.ws + O_WIN);
  const bf16_t* YA = (const bf16_t*)(p.ws + O_YA);
  const bf16_t* YB = (const bf16_t*)(p.ws + O_YB);
  bf16_t* M = (bf16_t*)(p.ws + O_M);
  const int tid = tidx(), lane = tid & 63, h = lane >> 5, wn = __builtin_amdgcn_readfirstlane(tid >> 6) >> 2;
  f32x16 accg[TM][2], accv[TM][2];
  gemm_mainloop<TM, 2>(YB, 512, (const bf16_t*)(p.ws + O_WPB), 512, 512, m0, n0, 1024, accv, lds);
  gemm_mainloop<TM, 2>(XB, DM, WIN + (size_t)(PABC + 1024) * DM, DM, DM, m0, n0, 1024, accg, lds);
#pragma unroll
  for (int tn = 0; tn < 2; ++tn)
#pragma unroll
    for (int g = 0; g < 4; ++g) {
      const f32x4 bg = *(const f32x4*)(p.in[24] + 1024 + n0 + wn * 64 + tn * 32 + 8 * g + 4 * h);
#pragma unroll
      for (int tm = 0; tm < TM; ++tm)
#pragma unroll
        for (int j = 0; j < 4; ++j) accv[tm][tn][4 * g + j] *= sigmoidf_(accg[tm][tn][4 * g + j] + bg[j]);
      __builtin_amdgcn_sched_barrier(0);
    }
  gemm_mainloop<TM, 2>(XB, DM, WIN + (size_t)PABC * DM, DM, DM, m0, n0, 1024, accg, lds);
#pragma unroll
  for (int tn = 0; tn < 2; ++tn)
#pragma unroll
    for (int g = 0; g < 4; ++g) {
      const f32x4 bg = *(const f32x4*)(p.in[24] + n0 + wn * 64 + tn * 32 + 8 * g + 4 * h);
#pragma unroll
      for (int tm = 0; tm < TM; ++tm)
#pragma unroll
        for (int j = 0; j < 4; ++j) {
          const float e = __expf(-(accg[tm][tn][4 * g + j] + bg[j]));
          accv[tm][tn][4 * g + j] *= (1.f + e);
          accg[tm][tn][4 * g + j] = 1.f / (1.f + e);
        }
      __builtin_amdgcn_sched_barrier(0);
    }
  gemm_mainloop<TM, 2, false>(YA, 512, (const bf16_t*)(p.ws + O_WPA), 512, 512, m0, n0, 1024, accv, lds);
  epilogue_bf16<TM, 2, 128>(accv, lds, M, DM, m0, n0, DM, [&](int tm, int tn, int g, int, int) { return acc4(accg[tm][tn], g) * acc4(accv[tm][tn], g); });
}
DI void phase4(const Params& p, unsigned char* lds) {
  if (gridDim.x == 256) {
    TileIter ti; ti.init(NP / 256, 8);
    int tmi, tni;
    while (ti.next(tmi, tni)) p4_tile<2>(p, lds, tmi * 256, tni * 128);
    int m0, n0;
    if (small_tile_of_block(m0, n0)) p4_tile<1>(p, lds, m0, n0);
  } else {
    TileIter ti; ti.init(NT / 128, 8);
    int tmi, tni;
    while (ti.next(tmi, tni)) p4_tile<1>(p, lds, tmi * 128, tni * 128);
  }
}

template <int TM>
DI void p5_tile(const Params& p, unsigned char* lds, int m0, int n0) {
  const bf16_t* M = (const bf16_t*)(p.ws + O_M);
  bf16_t* Z = (bf16_t*)(p.ws + O_Z);
  f32x16 acc[TM][2];
  gemm_mainloop<TM, 2>(M, DM, (const bf16_t*)(p.ws + O_WO), DM, DM, m0, n0, 1024, acc, lds);
  epilogue_bf16<TM, 2, 128>(acc, lds, Z, DM, m0, n0, DM, [&](int tm, int tn, int g, int rowl, int coll) {
    const f32x4 xv = *(const f32x4*)(xrow(p, m0 + rowl) + n0 + coll);
    return xv * DN_ALPHA + acc4(acc[tm][tn], g);
  });
}
DI void phase5(const Params& p, unsigned char* lds) {
  if (gridDim.x == 256) {
    TileIter ti; ti.init(NP / 256, 8);
    int tmi, tni;
    while (ti.next(tmi, tni)) p5_tile<2>(p, lds, tmi * 256, tni * 128);
    int m0, n0;
    if (small_tile_of_block(m0, n0)) p5_tile<1>(p, lds, m0, n0);
  } else {
    TileIter ti; ti.init(NT / 256, 8);
    int tmi, tni;
    while (ti.next(tmi, tni)) p5_tile<2>(p, lds, tmi * 256, tni * 128);
  }
}
template <bool OUT_BF16>
DI void ln_rows(const bf16_t* src, const float* g, const float* b, bf16_t* dst16, float* dst32) {
  const int gw = (blockIdx.x * NTHREADS + tidx()) >> 6, ngw = (gridDim.x * NTHREADS) >> 6, lane = tidx() & 63;
  for (int t = gw; t < NT; t += ngw) {
    const u32x4* xr = (const u32x4*)(src + (size_t)t * DM) + lane;
    float v[16]; float s = 0.f;
#pragma unroll
    for (int j = 0; j < 2; ++j) { unpack8(xr[64 * j], v + 8 * j); }
#pragma unroll
    for (int j = 0; j < 16; ++j) s += v[j];
    const float mean = wave_sum(s) * (1.f / DM);
    float s2 = 0.f;
#pragma unroll
    for (int j = 0; j < 16; ++j) { v[j] -= mean; s2 += v[j] * v[j]; }
    const float rstd = rsqrtf(wave_sum(s2) * (1.f / DM) + 1e-5f);
#pragma unroll
    for (int j = 0; j < 2; ++j) {
      const int c = 8 * lane + 512 * j;
      const f32x4 g0 = *(const f32x4*)(g + c), g1 = *(const f32x4*)(g + c + 4), b0 = *(const f32x4*)(b + c), b1 = *(const f32x4*)(b + c + 4);
      float o[8];
#pragma unroll
      for (int q = 0; q < 4; ++q) { o[q] = v[8 * j + q] * rstd * g0[q] + b0[q]; o[4 + q] = v[8 * j + 4 + q] * rstd * g1[q] + b1[q]; }
      if (OUT_BF16) *(u32x4*)(dst16 + (size_t)t * DM + c) = pack8(o);
      else { *(f32x4*)(dst32 + (size_t)t * DM + c) = (f32x4){o[0], o[1], o[2], o[3]}; *(f32x4*)(dst32 + (size_t)t * DM + c + 4) = (f32x4){o[4], o[5], o[6], o[7]}; }
    }
  }
}

DI void phase6(const Params& p, unsigned char* lds) {
  const bf16_t* H = (const bf16_t*)(p.ws + O_H);
  bf16_t* ACT = (bf16_t*)(p.ws + O_ACT);
  constexpr int NMT = NT / 256, NNT = 5632 / 128;
  TileIter ti; ti.init(NMT, NNT);
  int tmi, tni;
  while (ti.next(tmi, tni)) {
    const int m0 = tmi * 256, n0 = tni * 128;
    f32x16 acc[2][2];
    gemm_mainloop<2, 2>(H, DM, (const bf16_t*)(p.ws + O_WGU), DM, DM, m0, n0, 5632, acc, lds);
    epilogue_bf16<2, 2, 64>(acc, lds, ACT, DFF, m0, tni * 64, DFF, [&](int tm, int, int g, int, int) {
      f32x4 o;
#pragma unroll
      for (int j = 0; j < 4; ++j) { const float gte = acc[tm][0][4 * g + j], up = acc[tm][1][4 * g + j]; o[j] = gte * sigmoidf_(gte) * up; }
      return o;
    });
  }
}
template <int TM>
DI void p7_tile(const Params& p, unsigned char* lds, int m0, int n0) {
  const bf16_t* H = (const bf16_t*)(p.ws + O_H);
  const bf16_t* ACT = (const bf16_t*)(p.ws + O_ACT);
  bf16_t* Z2 = (bf16_t*)(p.ws + O_Z2);
  f32x16 acc[TM][2];
  gemm_mainloop<TM, 2>(ACT, DFF, (const bf16_t*)(p.ws + O_WDN), DFF, DFF, m0, n0, 1024, acc, lds);
  epilogue_bf16<TM, 2, 128>(acc, lds, Z2, DM, m0, n0, DM, [&](int tm, int tn, int g, int rowl, int coll) {
    const u32x2 hv = *(const u32x2*)(H + (size_t)(m0 + rowl) * DM + n0 + coll);
    const f32x4 hf = {__uint_as_float(hv[0] << 16), __uint_as_float(hv[0] & 0xffff0000u), __uint_as_float(hv[1] << 16), __uint_as_float(hv[1] & 0xffff0000u)};
    return hf * DN_ALPHA + acc4(acc[tm][tn], g);
  });
}
DI void phase7(const Params& p, unsigned char* lds) {
  if (gridDim.x == 256) {
    TileIter ti; ti.init(NP / 256, 8);
    int tmi, tni;
    while (ti.next(tmi, tni)) p7_tile<2>(p, lds, tmi * 256, tni * 128);
    int m0, n0;
    if (small_tile_of_block(m0, n0)) p7_tile<1>(p, lds, m0, n0);
  } else {
    TileIter ti; ti.init(NT / 256, 8);
    int tmi, tni;
    while (ti.next(tmi, tni)) p7_tile<2>(p, lds, tmi * 256, tni * 128);
  }
}

DI void run_phase(const Params& p, unsigned char* lds, int ph) {
  switch (ph) {
    case 0: phase0(p, lds); break;
    case 1: phase1(p, lds); break;
    case 2: phase2(p, lds); break;
    case 3: phase3(p, lds); break;
    case 4: phase4a(p); break;
    case 5: phase4(p, lds); break;
    case 6: phase5(p, lds); break;
    case 7: ln_rows<true>((const bf16_t*)(p.ws + O_Z), p.in[26], p.in[27], (bf16_t*)(p.ws + O_H), nullptr); break;
    case 8: phase6(p, lds); break;
    case 9: phase7(p, lds); break;
    case 11: phase3b(p, lds); break;
    case 10: ln_rows<false>((const bf16_t*)(p.ws + O_Z2), p.in[30], p.in[31], nullptr, p.out + F_Y); break;
  }
}
constexpr int NPHASES = 11;

DI unsigned ctl_ld(unsigned* p) { return __hip_atomic_load(p, __ATOMIC_RELAXED, __HIP_MEMORY_SCOPE_AGENT); }
DI unsigned ctl_add(unsigned* p, unsigned v) { return __hip_atomic_fetch_add(p, v, __ATOMIC_RELAXED, __HIP_MEMORY_SCOPE_AGENT); }
DI void xbar(unsigned* ctl, unsigned x, unsigned nloc, unsigned nx, unsigned k) {
  asm volatile("s_waitcnt vmcnt(0)" ::: "memory");
  __syncthreads();
  if (threadIdx.x == 0) {
    const unsigned old = ctl_add(&ctl[(24 + x) * 64], 1u);
    if (old + 1u == k * nloc) {
      __builtin_amdgcn_fence(__ATOMIC_RELEASE, "agent");
      asm volatile("s_waitcnt vmcnt(0)" ::: "memory");
      ctl_add(&ctl[40 * 64], 1u);
    }
    while (ctl_ld(&ctl[40 * 64]) < k * nx) __builtin_amdgcn_s_sleep(1);
    __builtin_amdgcn_fence(__ATOMIC_ACQUIRE, "agent");
    asm volatile("s_waitcnt vmcnt(0)" ::: "memory");
  }
  __syncthreads();
}

__global__ void __launch_bounds__(NTHREADS) mega_kernel(Params p) {
  extern __shared__ __attribute__((aligned(16))) unsigned char lds[];
  volatile unsigned* s_bar = (volatile unsigned*)(lds + LDS_CTRL + 16);
  cg::grid_group grid = cg::this_grid();
  unsigned* ctl = (unsigned*)(p.ws + O_CTR);
  const unsigned x = (unsigned)__builtin_amdgcn_s_getreg((3 << 11) | 20) & 0xFu;
  if (threadIdx.x == 0) ctl_add(&ctl[(8 + x) * 64], 1u);
  run_phase(p, lds, 0); grid.sync();
  if (threadIdx.x == 0) {
    unsigned nx = 0;
    for (int i = 0; i < 16; ++i) nx += ctl_ld(&ctl[(8 + i) * 64]) != 0u ? 1u : 0u;
    s_bar[0] = ctl_ld(&ctl[(8 + x) * 64]); s_bar[1] = nx;
  }
  __syncthreads();
  const unsigned nloc = __builtin_amdgcn_readfirstlane(s_bar[0]), nx = __builtin_amdgcn_readfirstlane(s_bar[1]);
  run_phase(p, lds, 1); xbar(ctl, x, nloc, nx, 1);
  run_phase(p, lds, 2); xbar(ctl, x, nloc, nx, 2);
  run_phase(p, lds, 3); xbar(ctl, x, nloc, nx, 3);
  run_phase(p, lds, 11); xbar(ctl, x, nloc, nx, 4);
  run_phase(p, lds, 4); xbar(ctl, x, nloc, nx, 5);
  run_phase(p, lds, 5); xbar(ctl, x, nloc, nx, 6);
  run_phase(p, lds, 6); xbar(ctl, x, nloc, nx, 7);
  run_phase(p, lds, 7); xbar(ctl, x, nloc, nx, 8);
  run_phase(p, lds, 8); xbar(ctl, x, nloc, nx, 9);
  run_phase(p, lds, 9); xbar(ctl, x, nloc, nx, 10);
  run_phase(p, lds, 10);
}
template <int PH> __global__ void __launch_bounds__(NTHREADS) phase_kernel(Params p) {
  extern __shared__ __attribute__((aligned(16))) unsigned char lds[];
  run_phase(p, lds, PH);
}
template <int PH> static void launch_phase(const Params& p, int grid, hipStream_t stream) {
  (void)hipFuncSetAttribute((const void*)phase_kernel<PH>, hipFuncAttributeMaxDynamicSharedMemorySize, LDS_BYTES);
  hipLaunchKernelGGL(phase_kernel<PH>, dim3(grid), dim3(NTHREADS), LDS_BYTES, stream, p);
}

extern "C" void kernel_launch(void* const* d_in, const int* in_sizes, int n_in, void* d_out, int out_size, void* d_ws, size_t ws_size, hipStream_t stream) {
  static int grid_blocks = 0;
  if (grid_blocks == 0) {
    if (n_in != 32 || ws_size < WS_END) { fprintf(stderr, "kernel_launch: unexpected n_in %d or ws_size %zu (< %zu)\n", n_in, ws_size, (size_t)WS_END); grid_blocks = -1; return; }
    int dev = 0, cus = 0, per_cu = 0;
    (void)hipGetDevice(&dev);
    (void)hipDeviceGetAttribute(&cus, hipDeviceAttributeMultiprocessorCount, dev);
#if MULTI_LAUNCH
    per_cu = 1;
#else
    (void)hipFuncSetAttribute((const void*)mega_kernel, hipFuncAttributeMaxDynamicSharedMemorySize, LDS_BYTES);
    (void)hipOccupancyMaxActiveBlocksPerMultiprocessor(&per_cu, (const void*)mega_kernel, NTHREADS, LDS_BYTES);
#endif
    if (per_cu < 1) { fprintf(stderr, "kernel_launch: occupancy query gave %d\n", per_cu); grid_blocks = -1; return; }
    grid_blocks = cus;
  }
  if (grid_blocks < 0) return;
  Params p{};
  for (int i = 0; i < 32; ++i) p.in[i] = (const float*)d_in[i];
  p.out = (float*)d_out;
  p.ws = (unsigned char*)d_ws;
#if MULTI_LAUNCH
  launch_phase<0>(p, grid_blocks, stream); launch_phase<1>(p, grid_blocks, stream); launch_phase<2>(p, grid_blocks, stream); launch_phase<3>(p, grid_blocks, stream); launch_phase<11>(p, grid_blocks, stream);
  launch_phase<4>(p, grid_blocks, stream); launch_phase<5>(p, grid_blocks, stream); launch_phase<6>(p, grid_blocks, stream); launch_phase<7>(p, grid_blocks, stream);
  launch_phase<8>(p, grid_blocks, stream); launch_phase<9>(p, grid_blocks, stream); launch_phase<10>(p, grid_blocks, stream);
#else
  (void)hipMemsetAsync((unsigned char*)d_ws + O_CTR, 0, 16384, stream);
  void* args[] = {&p};
  hipError_t e = hipLaunchCooperativeKernel((void*)mega_kernel, dim3(grid_blocks), dim3(NTHREADS), args, LDS_BYTES, stream);
  if (e != hipSuccess) fprintf(stderr, "cooperative launch failed: %s (grid %d)\n", hipGetErrorString(e), grid_blocks);
#endif
}
```

```cpp
#include <hip/hip_runtime.h>
#include <hip/hip_cooperative_groups.h>
#include <cstdio>
#include <cstdint>
namespace cg = cooperative_groups;


#ifndef PROBE_DUP
#define PROBE_DUP -1
#endif
#ifndef MULTI_LAUNCH
#define MULTI_LAUNCH 0
#endif

#define DI __device__ __forceinline__
typedef unsigned short bf16_t;
typedef short bf16x8 __attribute__((ext_vector_type(8)));
typedef short s16x4 __attribute__((ext_vector_type(4)));
typedef float f32x16 __attribute__((ext_vector_type(16)));
typedef float f32x4 __attribute__((ext_vector_type(4)));
typedef float f32x2 __attribute__((ext_vector_type(2)));
typedef unsigned u32x4 __attribute__((ext_vector_type(4)));
typedef unsigned u32x2 __attribute__((ext_vector_type(2)));
typedef __bf16 bf2_t __attribute__((ext_vector_type(2)));

constexpr int NP = 16384, NS = 512, NT = NP + NS;
constexpr int DM = 1024, ACOLS = 1792, BCOLS = 416, PABC = ACOLS + BCOLS  , NIN = 4256;
constexpr int DFF = 2816;
constexpr int PAST = 1024, DSEQ = 32, DB = 16, SKV = PAST + DSEQ  ;
constexpr int NKV = NP + DB * SKV  , NKVP = NKV + 64;
constexpr float DN_ALPHA = 1.189207115002721f;
constexpr float QSCALE = 0.10206207261596575f * 1.4426950408889634f;

constexpr size_t al256(size_t x) { return (x + 255) & ~(size_t)255; }
constexpr size_t O_WIN = 0;
constexpr size_t O_WUQ = O_WIN + al256((size_t)NIN * 1024 * 2);
constexpr size_t O_WUKV = O_WUQ + al256(768 * 256 * 2);
constexpr size_t O_WPA = O_WUKV + al256(1024 * 128 * 2);
constexpr size_t O_WPB = O_WPA + al256(1024 * 512 * 2);
constexpr size_t O_WO = O_WPB + al256(1024 * 512 * 2);
constexpr size_t O_WGU = O_WO + al256(1024 * 1024 * 2);
constexpr size_t O_WDN = O_WGU + al256((size_t)5632 * 1024 * 2);
constexpr size_t O_WW2 = O_WDN + al256((size_t)1024 * 2816 * 2);
constexpr size_t O_WA2 = O_WW2 + al256(512 * 64 * 2);
constexpr size_t O_WG2 = O_WA2 + al256(512 * 64 * 2);
constexpr size_t O_ROPE = O_WG2 + al256(512 * 128 * 2);
constexpr size_t O_CTR = O_ROPE + al256((size_t)NT * 32 * 4);
constexpr size_t O_PAB = O_CTR + 16384;
constexpr size_t SZ_T512 = (size_t)NT * 512 * 2;
constexpr size_t O_SIN = O_PAB + al256((size_t)NT * PABC * 2);
constexpr size_t O_G = O_SIN + 6 * SZ_T512;
constexpr size_t O_RK = O_G + SZ_T512;
constexpr size_t O_KNB = O_RK + al256((size_t)NT * 8 * 4);
constexpr size_t O_KPEB = O_KNB + al256((size_t)8 * NKVP * 64 * 2);
constexpr int SCC = 8, SCL = NP / SCC;
constexpr size_t WS_END = O_KPEB + al256((size_t)NKVP * 32 * 2);
constexpr size_t O_Y = O_PAB;
constexpr size_t O_E = O_Y + SZ_T512;
constexpr size_t O_YB = O_Y + (size_t)NT * 512 * 4;
constexpr size_t O_YA = O_YB + SZ_T512;
constexpr size_t O_H = O_PAB;
constexpr size_t O_M = O_SIN;
constexpr size_t O_Z = O_SIN + (size_t)NT * 1024 * 2;
constexpr size_t O_Z2 = O_PAB + (size_t)NT * 1024 * 2;
constexpr size_t O_ACT = O_SIN;
constexpr size_t OO_XB = 0;
constexpr size_t OO_Q = 0;
constexpr size_t OO_VT = (size_t)NT * 768 * 2;
constexpr size_t OO_GH = OO_VT + (size_t)8 * 64 * NKVP * 2;
constexpr size_t OO_SST = OO_GH + 2 * (size_t)8 * SCC * 4096 * 4;
static_assert(OO_SST + (size_t)SCC * 8 * 4096 * 2 <= (size_t)NT * 1024 * 4, "d_out scratch");
constexpr size_t F_Y = 0, F_CKVP = (size_t)NT * 1024, F_KPEP = F_CKVP + (size_t)NP * 128, F_WKVP = F_KPEP + (size_t)NP * 32,
                 F_SHP = F_WKVP + 32768, F_CKVS = F_SHP + 1792, F_KPES = F_CKVS + (size_t)NS * 128, F_WKVS = F_KPES + (size_t)NS * 32,
                 F_SHS = F_WKVS + (size_t)DB * 32768;

constexpr int LDS_CTRL = 3 * 49152;
constexpr int LDS_BYTES = LDS_CTRL + 256;
constexpr int NTHREADS = 512;

struct Params {
  const float* in[32];
  float* out;
  unsigned char* ws;
};

DI int tidx() { int t = threadIdx.x; asm volatile("" : "+v"(t)); return t; }
DI unsigned pk2(float a, float b) { f32x2 v = {a, b}; bf2_t r = __builtin_convertvector(v, bf2_t); return __builtin_bit_cast(unsigned, r); }
DI bf16_t f2bf(float a) { return (bf16_t)(pk2(a, 0.f) & 0xffffu); }
DI float bf2f(bf16_t x) { return __uint_as_float(((unsigned)x) << 16); }
DI void unpack8(u32x4 v, float* f) {
#pragma unroll
  for (int j = 0; j < 4; ++j) { f[2 * j] = __uint_as_float(v[j] << 16); f[2 * j + 1] = __uint_as_float(v[j] & 0xffff0000u); }
}
DI u32x4 pack8(const float* f) { u32x4 o; o[0] = pk2(f[0], f[1]); o[1] = pk2(f[2], f[3]); o[2] = pk2(f[4], f[5]); o[3] = pk2(f[6], f[7]); return o; }
DI float sigmoidf_(float x) { return 1.f / (1.f + __expf(-x)); }
DI float dpp_sum16(float x) {
  x += __builtin_bit_cast(float, __builtin_amdgcn_update_dpp(0, __builtin_bit_cast(int, x), 0xB1, 0xF, 0xF, true));
  x += __builtin_bit_cast(float, __builtin_amdgcn_update_dpp(0, __builtin_bit_cast(int, x), 0x4E, 0xF, 0xF, true));
  x += __builtin_bit_cast(float, __builtin_amdgcn_update_dpp(0, __builtin_bit_cast(int, x), 0x141, 0xF, 0xF, true));
  x += __builtin_bit_cast(float, __builtin_amdgcn_update_dpp(0, __builtin_bit_cast(int, x), 0x140, 0xF, 0xF, true));
  return x;
}
DI float sum32(float x) { x = dpp_sum16(x); x += __shfl_xor(x, 16); return x; }
DI float wave_sum(float v) {
#pragma unroll
  for (int o = 1; o < 64; o <<= 1) v += __shfl_xor(v, o);
  return v;
}
DI int crow(int i, int h) { return (i & 3) + 8 * (i >> 2) + 4 * h; }
#define MFMA32(a, b, c) __builtin_amdgcn_mfma_f32_32x32x16_bf16((a), (b), (c), 0, 0, 0)
DI int slot_of_token(int t) { return t < NP ? t : NP + ((t - NP) >> 5) * SKV + PAST + ((t - NP) & 31); }
DI const float* xrow(const Params& p, int t) { return t < NP ? p.in[0] + (size_t)t * DM : p.in[1] + (size_t)(t - NP) * DM; }

DI void conv_T(const float* W, int K, int N, bf16_t* WT, int mode, int gtid, int gsz) {
  const int ntask = (K / 8) * N;
  for (int id = gtid; id < ntask; id += gsz) {
    const int kc = id / N, n = id - kc * N, k0 = kc * 8;
    float f[8];
#pragma unroll
    for (int j = 0; j < 8; ++j) f[j] = W[(size_t)(k0 + j) * N + n];
    if (mode == 2) {
      *(u32x4*)(WT + ((size_t)((n >> 5) * (K >> 4) + (k0 >> 4)) * 64 + ((k0 >> 3) & 1) * 32 + (n & 31)) * 8) = pack8(f);
      continue;
    }
    int row = n;
    if (mode == 1) { const int nt = n >= DFF ? 1 : 0, j = n - nt * DFF; row = 128 * (j >> 6) + 64 * ((j & 63) >> 5) + 32 * nt + (j & 31); }
    *(u32x4*)(WT + (size_t)row * K + k0) = pack8(f);
  }
}
DI void conv_T_lds(const float* W, int K, int N, bf16_t* WT, int mode, unsigned char* lds, int gw, int ngw, int wave, int lane) {
  float* scr = (float*)(lds + wave * (64 * 33 * 4));
  const int nblk = N >> 5, nitem = (K >> 6) * nblk;
  for (int item = gw; item < nitem; item += ngw) {
    const int kb = item / nblk, nb = item - kb * nblk, k0 = kb * 64, n0 = nb * 32;
#pragma unroll 8
    for (int i = 0; i < 32; ++i) { const int kk = 2 * i + (lane >> 5); scr[kk * 33 + (lane & 31)] = W[(size_t)(k0 + kk) * N + n0 + (lane & 31)]; }
    asm volatile("s_waitcnt lgkmcnt(0)" ::: "memory");
    const int c = lane & 7;
#pragma unroll
    for (int j = 0; j < 4; ++j) {
      const int nl = (lane >> 3) + 8 * j;
      const float* sp = scr + (8 * c) * 33 + nl;
      float f[8];
#pragma unroll
      for (int q = 0; q < 8; ++q) f[q] = sp[q * 33];
      int row = n0 + nl;
      if (mode == 1) { const int nt = row >= DFF ? 1 : 0, jj = row - nt * DFF; row = 256 * (jj >> 7) + 128 * ((jj & 127) >> 6) + 32 * (2 * ((jj & 63) >> 5) + nt) + (jj & 31); }
      *(u32x4*)(WT + (size_t)row * K + k0 + 8 * c) = pack8(f);
    }
    asm volatile("s_waitcnt lgkmcnt(0)" ::: "memory");
  }
}
DI void conv_x(const Params& p, bf16_t* XB, int gtid, int gsz) {
  for (int id = gtid; id < NT * 128; id += gsz) {
    const int t = id >> 7, c = (id & 127) * 8;
    const float* src = xrow(p, t) + c;
    f32x4 a = *(const f32x4*)src, b = *(const f32x4*)(src + 4);
    float f[8] = {a[0], a[1], a[2], a[3], b[0], b[1], b[2], b[3]};
    *(u32x4*)(XB + (size_t)t * DM + c) = pack8(f);
  }
}
DI void phase0(const Params& p, unsigned char* lds) {
  const int tid0 = tidx(), gtid = blockIdx.x * NTHREADS + tid0, gsz = gridDim.x * NTHREADS;
  const int wave0 = __builtin_amdgcn_readfirstlane(tid0 >> 6), lane0 = tid0 & 63, gw = blockIdx.x * 8 + wave0, ngw = gridDim.x * 8;
  unsigned char* ws = p.ws;
  if (gtid < 64) ((unsigned*)(ws + O_CTR))[gtid] = 0u;
  conv_T_lds(p.in[6], 1024, NIN, (bf16_t*)(ws + O_WIN), 0, lds, gw, ngw, wave0, lane0);
  conv_T(p.in[20], 256, 768, (bf16_t*)(ws + O_WUQ), 2, gtid, gsz);
  conv_T(p.in[22], 128, 1024, (bf16_t*)(ws + O_WUKV), 2, gtid, gsz);
  conv_T_lds(p.in[18], 512, 1024, (bf16_t*)(ws + O_WPA), 0, lds, gw, ngw, wave0, lane0);
  conv_T_lds(p.in[23], 512, 1024, (bf16_t*)(ws + O_WPB), 0, lds, gw, ngw, wave0, lane0);
  conv_T_lds(p.in[25], 1024, 1024, (bf16_t*)(ws + O_WO), 0, lds, gw, ngw, wave0, lane0);
  conv_T_lds(p.in[28], 1024, 5632, (bf16_t*)(ws + O_WGU), 1, lds, gw, ngw, wave0, lane0);
  conv_T_lds(p.in[29], 2816, 1024, (bf16_t*)(ws + O_WDN), 0, lds, gw, ngw, wave0, lane0);
  conv_T(p.in[9], 64, 512, (bf16_t*)(ws + O_WW2), 2, gtid, gsz);
  conv_T(p.in[11], 64, 512, (bf16_t*)(ws + O_WA2), 2, gtid, gsz);
  conv_T(p.in[12], 128, 512, (bf16_t*)(ws + O_WG2), 2, gtid, gsz);
  conv_x(p, (bf16_t*)((unsigned char*)p.out + OO_XB), gtid, gsz);
  float* rope = (float*)(ws + O_ROPE);
  for (int id = gtid; id < NT * 16; id += gsz) {
    const int t = id >> 4, j = id & 15;
    const int pos = t < NP ? t : PAST + ((t - NP) & 31);
    const float inv = (float)exp2(-(double)j * (13.287712379549449 / 16.0));
    const float ang = (float)pos * inv;
    const double x = (double)ang;
    const double n = rint(x * 0.15915494309189535);
    const float red = (float)(x - n * 6.283185307179586);
    rope[t * 32 + j] = __cosf(red);
    rope[t * 32 + 16 + j] = __sinf(red);
  }
  bf16_t* kpeb = (bf16_t*)(ws + O_KPEB);
  for (int id = gtid; id < DB * PAST * 4; id += gsz) {
    const int row = id >> 2, ch = id & 3, b = row >> 10, j = row & 1023;
    const float* src = p.in[3] + (size_t)row * 32 + ch * 8;
    f32x4 a = *(const f32x4*)src, c = *(const f32x4*)(src + 4);
    float f[8] = {a[0], a[1], a[2], a[3], c[0], c[1], c[2], c[3]};
    *(u32x4*)(kpeb + (size_t)(NP + b * SKV + j) * 32 + ch * 8) = pack8(f);
  }
  bf16_t* knb = (bf16_t*)(ws + O_KNB);
  for (int id = gtid; id < 64 * 32; id += gsz) kpeb[(size_t)NKV * 32 + id] = 0;
  for (int id = gtid; id < 8 * 64 * 64; id += gsz) {
    const int h = id >> 12, rem = id & 4095;
    knb[((size_t)h * NKVP + NKV) * 64 + rem] = 0;
  }
}

template <int TM, int TN, bool ZERO = true, int NST = 3>
DI void gemm_mainloop(const bf16_t* __restrict__ A, int lda, const bf16_t* __restrict__ Bt, int ldb, int K, int m0, int n0, int nmax,
                      f32x16 (&acc)[TM][TN], unsigned char* lds) {
  constexpr int BM = 128 * TM, BN = 64 * TN, AG = BM / 64, BG = BN / 64, NLD = AG + BG;
  constexpr int ABYTES = BM * 128, STAGE = (BM + BN) * 128;
  static_assert(NST * STAGE <= LDS_CTRL && (NST == 2 || NST == 3), "lds");
  const int tid = tidx(), wave = __builtin_amdgcn_readfirstlane(tid >> 6), lane = tid & 63, r = lane & 31, h = lane >> 5, wm = wave & 3, wn = wave >> 2;
  const int lrow = lane >> 3, lpos = lane & 7;
  const bf16_t* ap[AG]; const bf16_t* bp[BG];
#pragma unroll
  for (int i = 0; i < AG; ++i) { const int row = (wave * AG + i) * 8 + lrow, c = lpos ^ ((row >> 1) & 7); ap[i] = A + (size_t)(m0 + row) * lda + c * 8; }
#pragma unroll
  for (int i = 0; i < BG; ++i) { const int row = (wave * BG + i) * 8 + lrow, c = lpos ^ ((row >> 1) & 7); int br = n0 + row; br = br < nmax ? br : nmax - 1; bp[i] = Bt + (size_t)br * ldb + c * 8; }
  if (ZERO) {
#pragma unroll
    for (int tm = 0; tm < TM; ++tm)
#pragma unroll
      for (int tn = 0; tn < TN; ++tn)
#pragma unroll
        for (int i = 0; i < 16; ++i) acc[tm][tn][i] = 0.f;
  }
  auto issue = [&](int kt, int stage) {
    unsigned char* sb = lds + stage * STAGE;
#pragma unroll
    for (int i = 0; i < AG; ++i) __builtin_amdgcn_global_load_lds((const unsigned*)(ap[i] + kt * 64), (unsigned*)(sb + (wave * AG + i) * 1024), 16, 0, 0);
#pragma unroll
    for (int i = 0; i < BG; ++i) __builtin_amdgcn_global_load_lds((const unsigned*)(bp[i] + kt * 64), (unsigned*)(sb + ABYTES + (wave * BG + i) * 1024), 16, 0, 0);
  };
  const int swz = (r >> 1) & 7;
  int koff[4];
#pragma unroll
  for (int ks = 0; ks < 4; ++ks) koff[ks] = ((ks * 2 + h) ^ swz) * 16;
  const int a_rd = (wm * 32 * TM + r) * 128, b_rd = ABYTES + (wn * 32 * TN + r) * 128;
  const int nk = K >> 6;
  asm volatile("s_waitcnt vmcnt(0)" ::: "memory");
  issue(0, 0);
  if (NST == 3) issue(1, 1);
  for (int kt = 0; kt < nk; ++kt) {
    if (NST == 3 && kt + 1 < nk) asm volatile("s_waitcnt vmcnt(%0)" ::"n"(NLD) : "memory");
    else asm volatile("s_waitcnt vmcnt(0)" ::: "memory");
    asm volatile("s_waitcnt lgkmcnt(0)" ::: "memory");
    __builtin_amdgcn_s_barrier();
    if (NST == 3) { if (kt + 2 < nk) issue(kt + 2, (kt + 2) % 3); }
    else { if (kt + 1 < nk) issue(kt + 1, (kt + 1) & 1); }
    const unsigned char* cur = lds + (kt % NST) * STAGE;
#pragma unroll
    for (int ks = 0; ks < 4; ++ks) {
      bf16x8 af[TM], bfr[TN];
#pragma unroll
      for (int tm = 0; tm < TM; ++tm) af[tm] = *(const bf16x8*)(cur + a_rd + tm * 4096 + koff[ks]);
#pragma unroll
      for (int tn = 0; tn < TN; ++tn) bfr[tn] = *(const bf16x8*)(cur + b_rd + tn * 4096 + koff[ks]);
#pragma unroll
      for (int tm = 0; tm < TM; ++tm)
#pragma unroll
        for (int tn = 0; tn < TN; ++tn) acc[tm][tn] = MFMA32(bfr[tn], af[tm], acc[tm][tn]);
    }
  }
  asm volatile("s_waitcnt lgkmcnt(0)" ::: "memory");
  __builtin_amdgcn_s_barrier();
}

template <int TM, int TN, int OUTC, class F>
DI void epilogue_bf16(const f32x16 (&acc)[TM][TN], unsigned char* lds, bf16_t* out, int ldo, int m0, int c0, int cmax, F f) {
  constexpr int BM = 128 * TM, STRIDE = OUTC * 2 + 16, TNO = OUTC / (32 * 2);
  const int tid = tidx(), wave = __builtin_amdgcn_readfirstlane(tid >> 6), lane = tid & 63, r = lane & 31, h = lane >> 5, wm = wave & 3, wn = wave >> 2;
#pragma unroll
  for (int tm = 0; tm < TM; ++tm)
#pragma unroll
    for (int tn = 0; tn < TNO; ++tn)
#pragma unroll
      for (int g = 0; g < 4; ++g) {
        const int rowl = wm * 32 * TM + tm * 32 + r, coll = wn * 32 * TNO + tn * 32 + 8 * g + 4 * h;
        const f32x4 o = f(tm, tn, g, rowl, coll);
        u32x2 w; w[0] = pk2(o[0], o[1]); w[1] = pk2(o[2], o[3]);
        *(u32x2*)(lds + rowl * STRIDE + coll * 2) = w;
      }
  __syncthreads();
  constexpr int CPR = OUTC / 8;
#pragma unroll
  for (int j = 0; j < BM * CPR / NTHREADS; ++j) {
    const int id = tid + NTHREADS * j, row = id / CPR, c = id % CPR;
    if (c0 + c * 8 < cmax) *(u32x4*)(out + (size_t)(m0 + row) * ldo + c0 + c * 8) = *(const u32x4*)(lds + row * STRIDE + c * 16);
  }
  __syncthreads();
}
DI f32x4 acc4(const f32x16& a, int g) { return (f32x4){a[4 * g], a[4 * g + 1], a[4 * g + 2], a[4 * g + 3]}; }

struct TileIter {
  int nM, nN, total, L, Lend, step;
  DI void init(int nM_, int nN_) {
    nM = nM_; nN = nN_; total = nM * nN;
    const int nx = (gridDim.x & 7) == 0 ? 8 : 1, x = blockIdx.x % nx, local = blockIdx.x / nx;
    step = gridDim.x / nx;
    const int per = (total + nx - 1) / nx;
    L = x * per + local; Lend = (x + 1) * per < total ? (x + 1) * per : total;
  }
  DI bool next(int& tmi, int& tni) {
    if (L >= Lend) return false;
    const int fb = nM >> 2, fullcnt = fb * 4 * nN;
    if (L < fullcnt) { const int band = L / (4 * nN), jj = L - band * 4 * nN; tni = jj >> 2; tmi = band * 4 + (jj & 3); }
    else { const int l2 = L - fullcnt, bm = nM & 3; tni = l2 / bm; tmi = fb * 4 + l2 % bm; }
    L += step; return true;
  }
};

DI void phase1(const Params& p, unsigned char* lds) {
  const bf16_t* XB = (const bf16_t*)((unsigned char*)p.out + OO_XB);
  const bf16_t* WT = (const bf16_t*)(p.ws + O_WIN);
  bf16_t* PAB = (bf16_t*)(p.ws + O_PAB);
  constexpr int NMT = NT / 256, NNT = (PABC + 127) / 128;
  const int lane = tidx() & 63, wave = __builtin_amdgcn_readfirstlane(tidx() >> 6), r = lane & 31, h = lane >> 5, wm = wave & 3, wn = wave >> 2;
  TileIter ti; ti.init(NMT, NNT);
  int tmi, tni;
  while (ti.next(tmi, tni)) {
    const int m0 = tmi * 256, n0 = tni * 128;
    f32x16 acc[2][2];
    gemm_mainloop<2, 2>(XB, DM, WT, DM, DM, m0, n0, PABC, acc, lds);
    if (m0 + 256 > NP - 1 && n0 < ACOLS) {
#pragma unroll
      for (int tm = 0; tm < 2; ++tm) {
        const int row = m0 + wm * 64 + tm * 32 + r;
        const bool lastp = row == NP - 1, lasts = row >= NP && ((row - NP) & 31) == 31;
        if (lastp || lasts) {
          float* dst = lastp ? p.out + F_SHP : p.out + F_SHS + (size_t)((row - NP) >> 5) * ACOLS;
#pragma unroll
          for (int tn = 0; tn < 2; ++tn)
#pragma unroll
            for (int g = 0; g < 4; ++g) {
              const int col = n0 + wn * 64 + tn * 32 + 8 * g + 4 * h;
              if (col < ACOLS) *(f32x4*)(dst + col) = acc4(acc[tm][tn], g);
            }
        }
      }
    }
    epilogue_bf16<2, 2, 128>(acc, lds, PAB, PABC, m0, n0, PABC, [&](int tm, int tn, int g, int, int) { return acc4(acc[tm][tn], g); });
  }
}

constexpr int L2_LORA = 0, L2_K = L2_LORA + 32 * 528, L2_R = L2_K + 32 * 1040, L2A_STG = L2_R + 32 * 1040, L2A_END = L2A_STG + 8 * 32 * 144;
constexpr int L2_CQ = 0, L2_CKV = L2_CQ + 32 * 528, L2B_STG = L2_CKV + 32 * 272, L2B_END = L2B_STG + 8 * 32 * 208;
static_assert(L2A_END <= LDS_BYTES && L2B_END <= LDS_BYTES, "lds p2");
template <int NTL, class F>
DI void stage_store16(unsigned char* stg, int lane, bf16_t* dst  , unsigned row_stride  , F f) {
  constexpr int RS = NTL * 64 + 16, CPR = NTL * 4;
  const int r = lane & 31, h = lane >> 5;
#pragma unroll
  for (int nt = 0; nt < NTL; ++nt)
#pragma unroll
    for (int i = 0; i < 16; ++i) *(unsigned short*)(stg + crow(i, h) * RS + (nt * 32 + r) * 2) = f(nt, i);
  __syncthreads();
#pragma unroll
  for (int j = 0; j < 32 * CPR / 64; ++j) {
    const int id = lane + 64 * j, row = id / CPR, ch = id % CPR;
    *(u32x4*)(dst + (size_t)row * row_stride + ch * 8) = *(const u32x4*)(stg + row * RS + ch * 16);
  }
  __syncthreads();
}

template <int NTL, int KS>
DI void mm32(const unsigned char* ldsA, int strideB, const bf16_t* Bt, int ldb, int lane, f32x16 (&acc)[NTL]) {
  constexpr int KG = (NTL * KS <= 16) ? KS : (NTL <= 2 ? 4 : 2), NG = KS / KG;
  const int r = lane & 31, h = lane >> 5;
#pragma unroll
  for (int nt = 0; nt < NTL; ++nt)
#pragma unroll
    for (int i = 0; i < 16; ++i) acc[nt][i] = 0.f;
  bf16x8 bq[2][KG][NTL];
  const bf16_t* bp = Bt + lane * 8;
#pragma unroll
  for (int k = 0; k < KG; ++k)
#pragma unroll
    for (int nt = 0; nt < NTL; ++nt) bq[0][k][nt] = *(const bf16x8*)(bp + (size_t)(nt * KS + k) * 512);
#pragma unroll
  for (int g = 0; g < NG; ++g) {
    if (g + 1 < NG) {
#pragma unroll
      for (int k = 0; k < KG; ++k)
#pragma unroll
        for (int nt = 0; nt < NTL; ++nt) bq[(g + 1) & 1][k][nt] = *(const bf16x8*)(bp + (size_t)(nt * KS + (g + 1) * KG + k) * 512);
    }
    __builtin_amdgcn_sched_barrier(0);
#pragma unroll
    for (int k = 0; k < KG; ++k) {
      const bf16x8 a = *(const bf16x8*)(ldsA + r * strideB + (g * KG + k) * 32 + h * 16);
#pragma unroll
      for (int nt = 0; nt < NTL; ++nt) acc[nt] = MFMA32(a, bq[g & 1][k][nt], acc[nt]);
    }
    __builtin_amdgcn_sched_barrier(0);
  }
}

DI void kv_expand(const Params& p, unsigned char* lds, int w, int lane, int slot0) {
  const int r = lane & 31, h = lane >> 5;
  bf16_t* knb = (bf16_t*)(p.ws + O_KNB);
  bf16_t* vT = (bf16_t*)((unsigned char*)p.out + OO_VT);
  f32x16 acc[4];
  mm32<4, 8>(lds + L2_CKV, 272, (const bf16_t*)(p.ws + O_WUKV) + (size_t)(128 * w) * 128, 128, lane, acc);
  stage_store16<2>((unsigned char*)lds + L2B_STG + w * (32 * 208), lane, knb + ((size_t)w * NKVP + slot0) * 64, 64, [&](int nt, int i) { return f2bf(acc[nt][i]); });
#pragma unroll
  for (int nt = 2; nt < 4; ++nt)
#pragma unroll
    for (int g = 0; g < 4; ++g) {
      u32x2 o; o[0] = pk2(acc[nt][4 * g], acc[nt][4 * g + 1]); o[1] = pk2(acc[nt][4 * g + 2], acc[nt][4 * g + 3]);
      *(u32x2*)(vT + ((unsigned)w * 64 + (nt - 2) * 32 + r) * (unsigned)NKVP + slot0 + 8 * g + 4 * h) = o;
    }
}

DI void p2_token_tile_a(const Params& p, unsigned char* lds, int tile) {
  const int tid = tidx(), wave = __builtin_amdgcn_readfirstlane(tid >> 6), lane = tid & 63, r = lane & 31, h = lane >> 5;
  const int t0 = tile * 32;
  unsigned char* ws = p.ws;
  const bf16_t* PAB = (const bf16_t*)(ws + O_PAB);
  bf16_t* SR = (bf16_t*)(ws + O_SIN);
  bf16_t* SK = SR + (size_t)NT * 512; bf16_t* SV = SK + (size_t)NT * 512; bf16_t* SA = SV + (size_t)NT * 512; bf16_t* SB = SA + (size_t)NT * 512;
  _Float16* SW = (_Float16*)(SB + (size_t)NT * 512);
  bf16_t* G = (bf16_t*)(ws + O_G);
  float* RK = (float*)(ws + O_RK);
  const float* rope = (const float*)(ws + O_ROPE);
#pragma unroll 1
  for (int bt = 0; bt < 2; ++bt) {
    u32x4 rawp[7], rawq[7];
#pragma unroll
    for (int it = 0; it < 7; ++it) {
      const int task = tid + NTHREADS * (bt * 7 + it);
      const int tl = task / 224, ch = task - tl * 224, c0 = ch * 8, t = t0 + tl;
      rawp[it] = *(const u32x4*)(PAB + (size_t)t * PABC + c0);
      rawq[it] = *(const u32x4*)(PAB + (size_t)(t > 0 ? t - 1 : 0) * PABC + c0);
    }
#pragma unroll
    for (int it = 0; it < 7; ++it) {
      const int task = tid + NTHREADS * (bt * 7 + it);
      const int tl = task / 224, ch = task - tl * 224, c0 = ch * 8, t = t0 + tl;
      float pv[8], pr[8];
      unpack8(rawp[it], pv);
      unpack8(rawq[it], pr);
      if (t == 0) {
#pragma unroll
        for (int j = 0; j < 8; ++j) pr[j] = 0.f;
      } else if (t >= NP && ((t - NP) & 31) == 0) {
        const float* sp = p.in[5] + (size_t)((t - NP) >> 5) * ACOLS + c0;
        const f32x4 a = *(const f32x4*)sp, b = *(const f32x4*)(sp + 4);
        pr[0] = a[0]; pr[1] = a[1]; pr[2] = a[2]; pr[3] = a[3]; pr[4] = b[0]; pr[5] = b[1]; pr[6] = b[2]; pr[7] = b[3];
      }
      const f32x4 mu0 = *(const f32x4*)(p.in[7] + c0), mu1 = *(const f32x4*)(p.in[7] + c0 + 4);
      const float mm[8] = {mu0[0], mu0[1], mu0[2], mu0[3], mu1[0], mu1[1], mu1[2], mu1[3]};
      float xs[8];
#pragma unroll
      for (int j = 0; j < 8; ++j) xs[j] = pv[j] + (pr[j] - pv[j]) * mm[j];
      if (c0 < 512) {
        const u32x4 o = pack8(xs);
        *(u32x4*)(SR + (size_t)t * 512 + c0) = o;
        *(u32x4*)(lds + L2_R + tl * 1040 + c0 * 2) = o;
      } else if (c0 < 1024) {
        *(u32x4*)(lds + L2_K + tl * 1040 + (c0 - 512) * 2) = pack8(xs);
      } else if (c0 < 1536) {
        *(u32x4*)(SV + (size_t)t * 512 + (c0 - 1024)) = pack8(xs);
      } else {
        if (c0 < 1600) {
#pragma unroll
          for (int j = 0; j < 8; ++j) { const float e = __expf(2.f * xs[j]); xs[j] = 1.f - 2.f / (e + 1.f); }
        } else if (c0 >= 1664) {
#pragma unroll
          for (int j = 0; j < 8; ++j) xs[j] = sigmoidf_(xs[j]);
        }
        *(u32x4*)(lds + L2_LORA + tl * 528 + (c0 - 1536) * 2) = pack8(xs);
      }
    }
  }
  __syncthreads();
  const int w = wave, cb = 64 * w;
  {
    int r = (tidx() & 31);
    f32x16 acc[2];
    mm32<2, 4>(lds + L2_LORA, 528, (const bf16_t*)(ws + O_WW2) + (size_t)cb * 64, 64, lane, acc);
    const float w00 = p.in[8][cb + r], w01 = p.in[8][cb + 32 + r];
    stage_store16<2>(lds + L2A_STG + w * (32 * 144), lane, (bf16_t*)SW + (size_t)t0 * 512 + cb, 512, [&](int nt, int i) {
      const float z = (nt ? w01 : w00) + acc[nt][i];
      const float sp = fmaxf(-z, 0.f) + __logf(1.f + __expf(-fabsf(z)));
      const float dec = __expf(-__expf(-sp - 0.5f));
      return __builtin_bit_cast(unsigned short, (_Float16)dec);
    });
  }
  __syncthreads();
  {
    int r = (tidx() & 31);
    f32x16 acc[2];
    mm32<2, 4>(lds + L2_LORA + 128, 528, (const bf16_t*)(ws + O_WA2) + (size_t)cb * 64, 64, lane, acc);
    float kkv[2][16];
#pragma unroll
    for (int nt = 0; nt < 2; ++nt) {
      const int c = cb + nt * 32 + r;
      const float a0 = p.in[10][c], kkc = p.in[13][c];
#pragma unroll
      for (int i = 0; i < 16; ++i) {
        acc[nt][i] = sigmoidf_(a0 + acc[nt][i]);
        kkv[nt][i] = bf2f(*(const bf16_t*)(lds + L2_K + crow(i, h) * 1040 + c * 2)) * kkc;
      }
    }
#pragma unroll
    for (int i = 0; i < 16; ++i) {
      const float nsq = sum32(kkv[0][i] * kkv[0][i] + kkv[1][i] * kkv[1][i]);
      const float inv = 1.f / fmaxf(sqrtf(nsq), 1e-12f);
      kkv[0][i] *= inv; kkv[1][i] *= inv;
      __builtin_amdgcn_sched_barrier(0);
    }
    const int c0 = cb + r, c1 = cb + 32 + r;
    const float ka0 = p.in[14][c0], ka1 = p.in[14][c1], rk0 = p.in[15][c0], rk1 = p.in[15][c1];
    unsigned char* stg = lds + L2A_STG + w * (32 * 144);
    stage_store16<2>(stg, lane, SA + (size_t)t0 * 512 + cb, 512, [&](int nt, int i) { return f2bf(-kkv[nt][i]); });
    stage_store16<2>(stg, lane, SB + (size_t)t0 * 512 + cb, 512, [&](int nt, int i) { return f2bf(kkv[nt][i] * acc[nt][i]); });
#pragma unroll
    for (int i = 0; i < 16; ++i) {
      const int tl = crow(i, h);
      const float kr0 = bf2f(*(const bf16_t*)(lds + L2_K + tl * 1040 + c0 * 2)), kr1 = bf2f(*(const bf16_t*)(lds + L2_K + tl * 1040 + c1 * 2));
      const float kh0 = kr0 * (1.f + (acc[0][i] - 1.f) * ka0), kh1 = kr1 * (1.f + (acc[1][i] - 1.f) * ka1);
      kkv[0][i] = kh0; kkv[1][i] = kh1;
      const float rr0 = bf2f(*(const bf16_t*)(lds + L2_R + tl * 1040 + c0 * 2)), rr1 = bf2f(*(const bf16_t*)(lds + L2_R + tl * 1040 + c1 * 2));
      const float sb = sum32(rr0 * kh0 * rk0 + rr1 * kh1 * rk1);
      if (r == 0) RK[(unsigned)(t0 + tl) * 8u + w] = sb;
    }
    stage_store16<2>(stg, lane, SK + (size_t)t0 * 512 + cb, 512, [&](int nt, int i) { return f2bf(kkv[nt][i]); });
  }
  __syncthreads();
  {
    int r = (tidx() & 31);
    f32x16 acc[2];
    mm32<2, 8>(lds + L2_LORA + 256, 528, (const bf16_t*)(ws + O_WG2) + (size_t)cb * 128, 128, lane, acc);
    stage_store16<2>(lds + L2A_STG + w * (32 * 144), lane, G + (size_t)t0 * 512 + cb, 512, [&](int nt, int i) { return f2bf(acc[nt][i]); });
  }
  __syncthreads();
}

DI void p2_token_tile_b(const Params& p, unsigned char* lds, int tile) {
  const int tid = tidx(), wave = __builtin_amdgcn_readfirstlane(tid >> 6), lane = tid & 63, r = lane & 31, h = lane >> 5;
  const int t0 = tile * 32;
  unsigned char* ws = p.ws;
  const bf16_t* PAB = (const bf16_t*)(ws + O_PAB);
  bf16_t* SR = (bf16_t*)(ws + O_SIN);
  bf16_t* SK = SR + (size_t)NT * 512; bf16_t* SV = SK + (size_t)NT * 512; bf16_t* SA = SV + (size_t)NT * 512; bf16_t* SB = SA + (size_t)NT * 512;
  _Float16* SW = (_Float16*)(SB + (size_t)NT * 512);
  bf16_t* G = (bf16_t*)(ws + O_G);
  float* RK = (float*)(ws + O_RK);
  const float* rope = (const float*)(ws + O_ROPE);
  {
    u32x2 vq[4]; unsigned vc[4]; float k1[4], k2[4], rc[4], rs_[4];
#pragma unroll
    for (int q = 0; q < 4; ++q) {
      const int t = t0 + wave * 4 + q;
      const bf16_t* pb = PAB + (size_t)t * PABC + ACOLS;
      vq[q] = *(const u32x2*)(pb + 4 * lane);
      vc[q] = *(const unsigned*)(pb + 256 + 2 * lane);
      k1[q] = bf2f(pb[384 + (lane & 15)]); k2[q] = bf2f(pb[400 + (lane & 15)]);
      rc[q] = rope[t * 32 + (lane & 15)]; rs_[q] = rope[t * 32 + 16 + (lane & 15)];
    }
    const f32x4 gq = *(const f32x4*)(p.in[19] + 4 * lane);
    const f32x2 gkv = *(const f32x2*)(p.in[21] + 2 * lane);
#pragma unroll
    for (int q = 0; q < 4; ++q) {
      const int tl = wave * 4 + q, t = t0 + tl;
      {
        const u32x2 v = vq[q];
        float x[4] = {__uint_as_float(v[0] << 16), __uint_as_float(v[0] & 0xffff0000u), __uint_as_float(v[1] << 16), __uint_as_float(v[1] & 0xffff0000u)};
        const float ss = wave_sum(x[0] * x[0] + x[1] * x[1] + x[2] * x[2] + x[3] * x[3]);
        const float rs = rsqrtf(ss * (1.f / 256.f) + 1e-6f);
        u32x2 o; o[0] = pk2(x[0] * rs * gq[0], x[1] * rs * gq[1]); o[1] = pk2(x[2] * rs * gq[2], x[3] * rs * gq[3]);
        *(u32x2*)(lds + L2_CQ + tl * 528 + lane * 8) = o;
      }
      {
        const unsigned v = vc[q];
        const float x0 = __uint_as_float(v << 16), x1 = __uint_as_float(v & 0xffff0000u);
        const float ss = wave_sum(x0 * x0 + x1 * x1);
        const float rs = rsqrtf(ss * (1.f / 128.f) + 1e-6f);
        const float o0 = x0 * rs * gkv[0], o1 = x1 * rs * gkv[1];
        float* dst = (t < NP) ? p.out + F_CKVP + (size_t)t * 128 : p.out + F_CKVS + (size_t)(t - NP) * 128;
        f32x2 of = {o0, o1};
        *(f32x2*)(dst + 2 * lane) = of;
        *(unsigned*)(lds + L2_CKV + tl * 272 + lane * 4) = pk2(o0, o1);
      }
      if (lane < 16) {
        const float o1 = k1[q] * rc[q] - k2[q] * rs_[q], o2 = k1[q] * rs_[q] + k2[q] * rc[q];
        float* dst = (t < NP) ? p.out + F_KPEP + (size_t)t * 32 : p.out + F_KPES + (size_t)(t - NP) * 32;
        dst[lane] = o1; dst[16 + lane] = o2;
        bf16_t* kp = (bf16_t*)(ws + O_KPEB) + (size_t)slot_of_token(t) * 32;
        kp[lane] = f2bf(o1); kp[16 + lane] = f2bf(o2);
      }
    }
  }
  __syncthreads();
  const int w = wave, cb = 64 * w;
  {
    int r = (tidx() & 31);
    f32x16 acc[3];
    mm32<3, 16>(lds + L2_CQ, 528, (const bf16_t*)(ws + O_WUQ) + (size_t)(96 * w) * 256, 256, lane, acc);
    bf16_t* Q = (bf16_t*)((unsigned char*)p.out + OO_Q);
    const int j = r & 15;
#pragma unroll
    for (int i = 0; i < 16; ++i) {
      const int t = t0 + crow(i, h);
      const float own = acc[2][i], oth = __shfl_xor(own, 16);
      const float c = rope[t * 32 + j], sn = rope[t * 32 + 16 + j];
      acc[2][i] = (r < 16) ? own * c - oth * sn : oth * sn + own * c;
    }
    stage_store16<3>(lds + L2B_STG + w * (32 * 208), lane, Q + (size_t)t0 * 768 + 96 * w, 768, [&](int nt, int i) { return f2bf(acc[nt][i] * QSCALE); });
  }
  __syncthreads();
  kv_expand(p, lds, w, lane, slot_of_token(t0));
  __syncthreads();
}

DI void p2_cache_tile(const Params& p, unsigned char* lds, int ctile) {
  const int tid = tidx(), wave = __builtin_amdgcn_readfirstlane(tid >> 6), lane = tid & 63;
  const int b = ctile >> 5, j0 = (ctile & 31) * 32;
  {
    const int row = tid >> 4, c = (tid & 15) * 8;
    const float* src = p.in[2] + ((size_t)(b * PAST + j0 + row)) * 128 + c;
    f32x4 a = *(const f32x4*)src, d = *(const f32x4*)(src + 4);
    float f[8] = {a[0], a[1], a[2], a[3], d[0], d[1], d[2], d[3]};
    *(u32x4*)(lds + L2_CKV + row * 272 + c * 2) = pack8(f);
  }
  __syncthreads();
  kv_expand(p, lds, wave, lane, NP + b * SKV + j0);
  __syncthreads();
}

DI void phase2(const Params& p, unsigned char* lds) {
  constexpr int NTT = NT / 32, NCT = DB * PAST / 32;
  {
    bf16_t* vT = (bf16_t*)((unsigned char*)p.out + OO_VT);
    for (int id = blockIdx.x * NTHREADS + tidx(); id < 8 * 64 * 64; id += gridDim.x * NTHREADS) vT[(size_t)(id >> 6) * NKVP + NKV + (id & 63)] = 0;
  }
  unsigned* ctr2 = (unsigned*)(p.ws + O_CTR) + 16;
  volatile int* s_itemp = (volatile int*)(lds + LDS_CTRL);
  for (;;) {
    if (tidx() == 0) *s_itemp = (int)atomicAdd(ctr2, 1u);
    __syncthreads();
    const int item = *s_itemp;
    __syncthreads();
    if (item >= 2 * NTT + NCT) break;
    if (item < NTT) p2_token_tile_b(p, lds, item);
    else if (item < 2 * NTT) p2_token_tile_a(p, lds, item - NTT);
    else p2_cache_tile(p, lds, item - 2 * NTT);
  }
}

constexpr int AT_KSTRIDE = 208, AT_VSTRIDE = 136, AT_KBYTES = 64 * AT_KSTRIDE, AT_STAGE = AT_KBYTES + 64 * AT_VSTRIDE;

DI void attn_item(const Params& p, unsigned char* lds, int hd, int qtok0, int nact, int slot0, int ntiles, int nvalid, bool causal) {
  const int tid = tidx(), wave = __builtin_amdgcn_readfirstlane(tid >> 6), lane = tid & 63, r = lane & 31, h = lane >> 5;
  const bf16_t* Q = (const bf16_t*)((const unsigned char*)p.out + OO_Q);
  const bf16_t* knb = (const bf16_t*)(p.ws + O_KNB) + (size_t)hd * NKVP * 64;
  const bf16_t* kpeb = (const bf16_t*)(p.ws + O_KPEB);
  const bf16_t* vT = (const bf16_t*)((const unsigned char*)p.out + OO_VT) + (size_t)hd * 64 * NKVP;
  bf16_t* YB = (bf16_t*)(p.ws + O_YB);
  const bool active = wave < nact;
  const int qtok = qtok0 + 32 * wave;
  const int wlim = !active ? 0 : (causal ? (qtok >> 6) + 1 : ntiles);
  bf16x8 qf[6];
  if (active) {
#pragma unroll
    for (int ks = 0; ks < 6; ++ks) qf[ks] = *(const bf16x8*)(Q + (size_t)(qtok + r) * 768 + 96 * hd + ks * 16 + h * 8);
  } else {
#pragma unroll
    for (int ks = 0; ks < 6; ++ks) qf[ks] = (bf16x8){0, 0, 0, 0, 0, 0, 0, 0};
  }
  f32x16 o0, o1;
#pragma unroll
  for (int i = 0; i < 16; ++i) { o0[i] = 0.f; o1[i] = 0.f; }
  float mrun = 0.f, lsum = 0.f;
  const int k_key = tid >> 3, k_ch = tid & 7;
  const int pe_key = (tid & 255) >> 2, pe_ch = tid & 3;
  const int v_dim = tid >> 3, v_ch = tid & 7;
  u32x4 rk, rpe, rv;
  auto gload = [&](int kt) {
    const int s = slot0 + kt * 64;
    rk = *(const u32x4*)(knb + (size_t)(s + k_key) * 64 + k_ch * 8);
    if (tid < 256) rpe = *(const u32x4*)(kpeb + (size_t)(s + pe_key) * 32 + pe_ch * 8);
    rv = *(const u32x4*)(vT + (size_t)v_dim * NKVP + s + v_ch * 8);
  };
  auto lstore = [&](int buf) {
    unsigned char* b = lds + buf * AT_STAGE;
    *(u32x4*)(b + k_key * AT_KSTRIDE + k_ch * 16) = rk;
    if (tid < 256) *(u32x4*)(b + pe_key * AT_KSTRIDE + 128 + pe_ch * 16) = rpe;
    u32x2 lo = {rv[0], rv[1]}, hi = {rv[2], rv[3]};
    *(u32x2*)(b + AT_KBYTES + v_dim * AT_VSTRIDE + v_ch * 16) = lo;
    *(u32x2*)(b + AT_KBYTES + v_dim * AT_VSTRIDE + v_ch * 16 + 8) = hi;
  };
  gload(0); lstore(0);
  __syncthreads();
  for (int kt = 0; kt < ntiles; ++kt) {
    const bool more = kt + 1 < ntiles;
    if (more) gload(kt + 1);
    if (kt < wlim) {
      const unsigned char* kb = lds + (kt & 1) * AT_STAGE;
      const unsigned char* vb = kb + AT_KBYTES;
      f32x16 s0, s1;
      const float nm = -mrun;
#pragma unroll
      for (int i = 0; i < 16; ++i) { s0[i] = nm; s1[i] = nm; }
#pragma unroll
      for (int ks = 0; ks < 6; ++ks) {
        const bf16x8 a0 = *(const bf16x8*)(kb + r * AT_KSTRIDE + ks * 32 + h * 16);
        const bf16x8 a1 = *(const bf16x8*)(kb + (32 + r) * AT_KSTRIDE + ks * 32 + h * 16);
        s0 = MFMA32(a0, qf[ks], s0);
        s1 = MFMA32(a1, qf[ks], s1);
      }
      if (kt * 64 + 64 > nvalid) {
#pragma unroll
        for (int i = 0; i < 16; ++i) {
          const int key = kt * 64 + crow(i, h);
          if (key >= nvalid) s0[i] = -1e30f;
          if (key + 32 >= nvalid) s1[i] = -1e30f;
        }
      }
      float mx = s0[0];
#pragma unroll
      for (int i = 1; i < 16; ++i) mx = fmaxf(mx, s0[i]);
#pragma unroll
      for (int i = 0; i < 16; ++i) mx = fmaxf(mx, s1[i]);
      mx = fmaxf(mx, __shfl_xor(mx, 32));
      const bool far = fabsf(mx) > 20.f && mx > -1e29f;
      if (__builtin_amdgcn_ballot_w64(far) != 0ull) {
        const float delta = far ? mx : 0.f;
        const float alpha = __builtin_amdgcn_exp2f(-delta);
        mrun += delta; lsum *= alpha;
#pragma unroll
        for (int i = 0; i < 16; ++i) { o0[i] *= alpha; o1[i] *= alpha; s0[i] -= delta; s1[i] -= delta; }
      }
      float rs = 0.f;
#pragma unroll
      for (int i = 0; i < 16; ++i) { s0[i] = __builtin_amdgcn_exp2f(s0[i]); rs += s0[i]; }
#pragma unroll
      for (int i = 0; i < 16; ++i) { s1[i] = __builtin_amdgcn_exp2f(s1[i]); rs += s1[i]; }
      lsum += rs;
#pragma unroll
      for (int mt = 0; mt < 2; ++mt)
#pragma unroll
        for (int s = 0; s < 2; ++s) {
          const f32x16& sv = mt ? s1 : s0;
          u32x4 pw;
          pw[0] = pk2(sv[8 * s], sv[8 * s + 1]); pw[1] = pk2(sv[8 * s + 2], sv[8 * s + 3]);
          pw[2] = pk2(sv[8 * s + 4], sv[8 * s + 5]); pw[3] = pk2(sv[8 * s + 6], sv[8 * s + 7]);
          const bf16x8 pb = __builtin_bit_cast(bf16x8, pw);
          const int kbase = mt * 32 + 16 * s + 4 * h;
          {
            const s16x4 lo = *(const s16x4*)(vb + r * AT_VSTRIDE + kbase * 2);
            const s16x4 hi = *(const s16x4*)(vb + r * AT_VSTRIDE + (kbase + 8) * 2);
            const bf16x8 av = __builtin_shufflevector(lo, hi, 0, 1, 2, 3, 4, 5, 6, 7);
            o0 = MFMA32(av, pb, o0);
          }
          {
            const s16x4 lo = *(const s16x4*)(vb + (32 + r) * AT_VSTRIDE + kbase * 2);
            const s16x4 hi = *(const s16x4*)(vb + (32 + r) * AT_VSTRIDE + (kbase + 8) * 2);
            const bf16x8 av = __builtin_shufflevector(lo, hi, 0, 1, 2, 3, 4, 5, 6, 7);
            o1 = MFMA32(av, pb, o1);
          }
        }
    }
    if (more) lstore((kt + 1) & 1);
    __syncthreads();
  }
  if (active) {
    const float lt = lsum + __shfl_xor(lsum, 32);
    const float inv = 1.f / lt;
    bf16_t* dst = YB + (size_t)(qtok + r) * 512 + hd * 64;
#pragma unroll
    for (int g = 0; g < 4; ++g) {
      u32x2 a, b;
      a[0] = pk2(o0[4 * g] * inv, o0[4 * g + 1] * inv); a[1] = pk2(o0[4 * g + 2] * inv, o0[4 * g + 3] * inv);
      b[0] = pk2(o1[4 * g] * inv, o1[4 * g + 1] * inv); b[1] = pk2(o1[4 * g + 2] * inv, o1[4 * g + 3] * inv);
      *(u32x2*)(dst + 8 * g + 4 * h) = a;
      *(u32x2*)(dst + 32 + 8 * g + 4 * h) = b;
    }
  }
}

constexpr int SC_TOK = 32, SC_ARR = SC_TOK * 64 * 4, SC_STAGE = 5 * SC_ARR + SC_TOK * 32 * 4;
static_assert(2 * SC_STAGE <= LDS_BYTES, "lds scan");
template <bool DUAL>
DI void scan_job(const Params& p, unsigned char* lds, int head, int rowgrp, int tok0, int nsteps, int init_mode  ,
                 const float* init  , bool use_v, bf16_t* Y  , float* state_out  , bf16_t* Y2 = nullptr, float* state2 = nullptr) {
  const int tid = tidx(), wave = __builtin_amdgcn_readfirstlane(tid >> 6), lane = tid & 63;
  const bf16_t* SR = (const bf16_t*)(p.ws + O_SIN);
  const bf16_t* SK = SR + (size_t)NT * 512; const bf16_t* SV = SK + (size_t)NT * 512; const bf16_t* SA = SV + (size_t)NT * 512; const bf16_t* SB = SA + (size_t)NT * 512;
  const _Float16* SW = (const _Float16*)(SB + (size_t)NT * 512);
  u32x4 rg[3];
  auto gload = [&](int c) {
    const int tb = tok0 + c * SC_TOK;
#pragma unroll
    for (int i = 0; i < 3; ++i) {
      const int L = tid + NTHREADS * i;
      if (L < 1280) {
        const int arr = L >> 8, tok = (L & 255) >> 3, ch = L & 7;
        const bf16_t* base = arr == 0 ? SA : arr == 1 ? SB : arr == 2 ? (const bf16_t*)SW : arr == 3 ? SK : SR;
        rg[i] = *(const u32x4*)(base + (size_t)(tb + tok) * 512 + head * 64 + ch * 8);
      } else if (L < 1408) {
        const int vl = L - 1280, tok = vl >> 2, hf = vl & 3;
        rg[i] = *(const u32x4*)(SV + (size_t)(tb + tok) * 512 + head * 64 + rowgrp * 32 + hf * 8);
      }
    }
  };
  auto lstore = [&](int buf) {
    unsigned char* b = lds + buf * SC_STAGE;
#pragma unroll
    for (int i = 0; i < 3; ++i) {
      const int L = tid + NTHREADS * i;
      float f[8];
      if (L < 1280) {
        const int arr = L >> 8, tok = (L & 255) >> 3, ch = L & 7;
        if (arr == 2) {
#pragma unroll
          for (int j = 0; j < 4; ++j) {
            const unsigned u = rg[i][j];
            f[2 * j] = (float)__builtin_bit_cast(_Float16, (unsigned short)(u & 0xffffu));
            f[2 * j + 1] = (float)__builtin_bit_cast(_Float16, (unsigned short)(u >> 16));
          }
        } else unpack8(rg[i], f);
        float* d = (float*)(b + arr * SC_ARR + tok * 256 + ch * 32);
        *(f32x4*)d = (f32x4){f[0], f[1], f[2], f[3]};
        *(f32x4*)(d + 4) = (f32x4){f[4], f[5], f[6], f[7]};
      } else if (L < 1408) {
        const int vl = L - 1280, tok = vl >> 2, hf = vl & 3;
        unpack8(rg[i], f);
        if (!use_v) {
#pragma unroll
          for (int j = 0; j < 8; ++j) f[j] = 0.f;
        }
        float* d = (float*)(b + 5 * SC_ARR + tok * 128 + hf * 32);
        *(f32x4*)d = (f32x4){f[0], f[1], f[2], f[3]};
        *(f32x4*)(d + 4) = (f32x4){f[4], f[5], f[6], f[7]};
      }
    }
  };
  const int rl = lane >> 4, c = lane & 15;
  const int vrow = rowgrp * 32 + 4 * wave + rl;
  f32x4 s = {0.f, 0.f, 0.f, 0.f};
  if (init_mode == 1) s = *(const f32x4*)(init + vrow * 64 + 4 * c);
  if (init_mode == 2) { s[0] = (4 * c == vrow) ? 1.f : 0.f; s[1] = (4 * c + 1 == vrow) ? 1.f : 0.f; s[2] = (4 * c + 2 == vrow) ? 1.f : 0.f; s[3] = (4 * c + 3 == vrow) ? 1.f : 0.f; }
  f32x4 s2 = {(4 * c == vrow) ? 1.f : 0.f, (4 * c + 1 == vrow) ? 1.f : 0.f, (4 * c + 2 == vrow) ? 1.f : 0.f, (4 * c + 3 == vrow) ? 1.f : 0.f};
  gload(0); lstore(0);
  __syncthreads();
  const int nch = nsteps / SC_TOK;
  for (int ci = 0; ci < nch; ++ci) {
    const bool more = ci + 1 < nch;
    if (more) gload(ci + 1);
    {
      const unsigned char* b = lds + (ci & 1) * SC_STAGE + c * 16;
      const unsigned char* bv = lds + (ci & 1) * SC_STAGE + 5 * SC_ARR + (4 * wave + rl) * 4;
      bf16_t* yp = Y + (size_t)(tok0 + ci * SC_TOK + c) * 512 + head * 64 + vrow;
      bf16_t* yp2 = DUAL ? Y2 + (size_t)(tok0 + ci * SC_TOK + c) * 512 + head * 64 + vrow : nullptr;
      f32x4 A4[3], B4[3], W4[3], K4[3], R4[3]; float V1[3];
#define SC_LOAD(slot, t)                                                                                          \
      { A4[slot] = *(const f32x4*)(b + 0 * SC_ARR + (t) * 256); B4[slot] = *(const f32x4*)(b + 1 * SC_ARR + (t) * 256);    \
        W4[slot] = *(const f32x4*)(b + 2 * SC_ARR + (t) * 256); K4[slot] = *(const f32x4*)(b + 3 * SC_ARR + (t) * 256);    \
        R4[slot] = *(const f32x4*)(b + 4 * SC_ARR + (t) * 256); V1[slot] = *(const float*)(bv + (t) * 128); }
      SC_LOAD(0, 0) SC_LOAD(1, 1)
      float ysel = 0.f, ysel2 = 0.f;
#pragma unroll
      for (int t = 0; t < SC_TOK; ++t) {
        if (t + 2 < SC_TOK) SC_LOAD((t + 2) % 3, t + 2)
        const f32x4 a4 = A4[t % 3], b4 = B4[t % 3], w4 = W4[t % 3], k4 = K4[t % 3], r4 = R4[t % 3];
        const float vv = V1[t % 3];
        const f32x4 vk = vv * k4;
        float sa = (s[0] * a4[0] + s[2] * a4[2]) + (s[1] * a4[1] + s[3] * a4[3]);
        sa = dpp_sum16(sa);
        s = s * w4 + (sa * b4 + vk);
        float y = (s[0] * r4[0] + s[2] * r4[2]) + (s[1] * r4[1] + s[3] * r4[3]);
        y = dpp_sum16(y);
        ysel = (c == (t & 15)) ? y : ysel;
        if ((t & 15) == 15) yp[(size_t)(t - 15) * 512] = f2bf(ysel);
        if (DUAL) {
          float sb = (s2[0] * a4[0] + s2[2] * a4[2]) + (s2[1] * a4[1] + s2[3] * a4[3]);
          sb = dpp_sum16(sb);
          s2 = s2 * w4 + sb * b4;
          float y2 = (s2[0] * r4[0] + s2[2] * r4[2]) + (s2[1] * r4[1] + s2[3] * r4[3]);
          y2 = dpp_sum16(y2);
          ysel2 = (c == (t & 15)) ? y2 : ysel2;
          if ((t & 15) == 15) yp2[(size_t)(t - 15) * 512] = f2bf(ysel2);
        }
      }
#undef SC_LOAD
    }
    if (more) lstore((ci + 1) & 1);
    __syncthreads();
  }
  *(f32x4*)(state_out + vrow * 64 + 4 * c) = s;
  if (DUAL) *(f32x4*)(state2 + vrow * 64 + 4 * c) = s2;
}

constexpr int Q_PSCAN = 8 * (2 + 2 * (SCC - 1)), Q_PATT = 512, Q_SATT = 128, Q_SSCAN = 256, Q_TOTAL = Q_PSCAN + Q_PATT + Q_SATT + Q_SSCAN;
DI void phase3(const Params& p, unsigned char* lds) {
  volatile int* s_itemp = (volatile int*)(lds + LDS_CTRL);
  unsigned* ctr = (unsigned*)(p.ws + O_CTR);
  float* Gb = (float*)((unsigned char*)p.out + OO_GH);
  float* Hb = Gb + (size_t)8 * SCC * 4096;
  bf16_t* Y = (bf16_t*)(p.ws + O_Y);
  bf16_t* E = (bf16_t*)(p.ws + O_E);
  for (;;) {
    if (tidx() == 0) *s_itemp = (int)atomicAdd(ctr, 1u);
    __syncthreads();
    const int item = *s_itemp;
    __syncthreads();
    if (item >= Q_TOTAL) break;
    if (item < Q_PSCAN) {
      const int hd = item / (2 + 2 * (SCC - 1)), j = item % (2 + 2 * (SCC - 1));
      if (j < 2) scan_job<false>(p, lds, hd, j, 0, SCL, 0, nullptr, true, Y, Hb + ((size_t)hd * SCC) * 4096);
      else {
        const int jj = j - 2, c = 1 + (jj >> 1), k = jj & 1;
        scan_job<true>(p, lds, hd, k, c * SCL, SCL, 0, nullptr, true, Y, Hb + ((size_t)hd * SCC + c) * 4096, E, Gb + ((size_t)hd * SCC + c) * 4096);
      }
    } else if (item < Q_PSCAN + Q_PATT) {
      const int k = item - Q_PSCAN, qb = 63 - (k >> 3), hd = k & 7;
      attn_item(p, lds, hd, qb * 256, 8, 0, qb * 4 + 4, (qb * 4 + 4) * 64, true);
    } else if (item < Q_PSCAN + Q_PATT + Q_SATT) {
      const int k = item - Q_PSCAN - Q_PATT, b = k >> 3, hd = k & 7;
      attn_item(p, lds, hd, NP + b * 32, 1, NP + b * SKV, 17, SKV, false);
    } else {
      const int k = item - Q_PSCAN - Q_PATT - Q_SATT, b = k >> 4, hd = (k & 15) >> 1, rg = k & 1;
      scan_job<false>(p, lds, hd, rg, NP + b * 32, 32, 1, p.in[4] + ((size_t)b * 8 + hd) * 4096, true, Y, p.out + F_WKVS + ((size_t)b * 8 + hd) * 4096);
    }
  }
}

DI void phase3b(const Params& p, unsigned char* lds) {
  if (blockIdx.x >= 8) return;
  const int hd = blockIdx.x, tid = tidx();
  const float* Gb = (const float*)((unsigned char*)p.out + OO_GH);
  const float* Hb = Gb + (size_t)8 * SCC * 4096;
  bf16_t* SST = (bf16_t*)((unsigned char*)p.out + OO_SST);
  float* S = (float*)lds;
  float* Gs = S + 64 * 65;
  const int v = tid >> 3, k0 = (tid & 7) * 8;
  float cur[8];
#pragma unroll
  for (int j = 0; j < 8; ++j) cur[j] = Hb[((size_t)hd * SCC) * 4096 + v * 64 + k0 + j];
  for (int c = 1; c < SCC; ++c) {
    __syncthreads();
#pragma unroll
    for (int j = 0; j < 8; ++j) { S[v * 65 + k0 + j] = cur[j]; Gs[v * 64 + k0 + j] = Gb[((size_t)hd * SCC + c) * 4096 + v * 64 + k0 + j]; }
    *(u32x4*)(SST + ((size_t)c * 8 + hd) * 4096 + v * 64 + k0) = pack8(cur);
    __syncthreads();
    float o[8];
#pragma unroll
    for (int j = 0; j < 8; ++j) o[j] = Hb[((size_t)hd * SCC + c) * 4096 + v * 64 + k0 + j];
    for (int i = 0; i < 64; ++i) {
      const float sv = S[v * 65 + i];
      const f32x4 g0 = *(const f32x4*)(Gs + i * 64 + k0), g1 = *(const f32x4*)(Gs + i * 64 + k0 + 4);
      o[0] += sv * g0[0]; o[1] += sv * g0[1]; o[2] += sv * g0[2]; o[3] += sv * g0[3];
      o[4] += sv * g1[0]; o[5] += sv * g1[1]; o[6] += sv * g1[2]; o[7] += sv * g1[3];
    }
#pragma unroll
    for (int j = 0; j < 8; ++j) cur[j] = o[j];
  }
  float* dst = p.out + F_WKVP + (size_t)hd * 4096 + v * 64 + k0;
  *(f32x4*)dst = (f32x4){cur[0], cur[1], cur[2], cur[3]};
  *(f32x4*)(dst + 4) = (f32x4){cur[4], cur[5], cur[6], cur[7]};
}

DI void phase4a(const Params& p) {
  const int tid = tidx(), lane = tid & 63, r = lane & 31, hh = lane >> 5;
  const int gw = (blockIdx.x * NTHREADS + tid) >> 6, ngw = (gridDim.x * NTHREADS) >> 6;
  const bf16_t* Y = (const bf16_t*)(p.ws + O_Y);
  const bf16_t* E = (const bf16_t*)(p.ws + O_E);
  const bf16_t* SST = (const bf16_t*)((unsigned char*)p.out + OO_SST);
  const bf16_t* SV = (const bf16_t*)(p.ws + O_SIN) + 2 * (size_t)NT * 512;
  const bf16_t* G = (const bf16_t*)(p.ws + O_G);
  const float* RK = (const float*)(p.ws + O_RK);
  bf16_t* YA = (bf16_t*)(p.ws + O_YA);
  for (int task = gw; task < (NT / 32) * 8; task += ngw) {
    const int tile = task >> 3, hd = task & 7, t0 = tile * 32, t = t0 + r;
    f32x16 acc[2];
#pragma unroll
    for (int i = 0; i < 16; ++i) { acc[0][i] = 0.f; acc[1][i] = 0.f; }
    const int c = t0 < NP ? t0 / SCL : 0;
    if (c >= 1) {
      const bf16_t* sst = SST + ((size_t)c * 8 + hd) * 4096;
#pragma unroll
      for (int ks = 0; ks < 4; ++ks) {
        const bf16x8 bv = *(const bf16x8*)(E + (size_t)t * 512 + hd * 64 + ks * 16 + hh * 8);
#pragma unroll
        for (int mt = 0; mt < 2; ++mt) {
          const bf16x8 av = *(const bf16x8*)(sst + (mt * 32 + r) * 64 + ks * 16 + hh * 8);
          acc[mt] = MFMA32(av, bv, acc[mt]);
        }
      }
    }
    float sum = 0.f;
#pragma unroll
    for (int mt = 0; mt < 2; ++mt)
#pragma unroll
      for (int g = 0; g < 4; ++g) {
        const u32x2 yv = *(const u32x2*)(Y + (size_t)t * 512 + hd * 64 + mt * 32 + 8 * g + 4 * hh);
        acc[mt][4 * g] += __uint_as_float(yv[0] << 16); acc[mt][4 * g + 1] += __uint_as_float(yv[0] & 0xffff0000u);
        acc[mt][4 * g + 2] += __uint_as_float(yv[1] << 16); acc[mt][4 * g + 3] += __uint_as_float(yv[1] & 0xffff0000u);
        sum += (acc[mt][4 * g] + acc[mt][4 * g + 1]) + (acc[mt][4 * g + 2] + acc[mt][4 * g + 3]);
      }
    sum += __shfl_xor(sum, 32);
    const float mean = sum * (1.f / 64.f);
    float sq = 0.f;
#pragma unroll
    for (int mt = 0; mt < 2; ++mt)
#pragma unroll
      for (int i = 0; i < 16; ++i) { const float d = acc[mt][i] - mean; sq += d * d; }
    sq += __shfl_xor(sq, 32);
    const float rstd = rsqrtf(sq * (1.f / 64.f) + 64e-5f);
    const float bon = RK[(size_t)t * 8 + hd];
#pragma unroll
    for (int mt = 0; mt < 2; ++mt)
#pragma unroll
      for (int g = 0; g < 4; ++g) {
        const int c0 = hd * 64 + mt * 32 + 8 * g + 4 * hh;
        const size_t o = (size_t)t * 512 + c0;
        const f32x4 lg = *(const f32x4*)(p.in[16] + c0), lb = *(const f32x4*)(p.in[17] + c0);
        const u32x2 vv = *(const u32x2*)(SV + o), gg = *(const u32x2*)(G + o);
        const float vf[4] = {__uint_as_float(vv[0] << 16), __uint_as_float(vv[0] & 0xffff0000u), __uint_as_float(vv[1] << 16), __uint_as_float(vv[1] & 0xffff0000u)};
        const float gf[4] = {__uint_as_float(gg[0] << 16), __uint_as_float(gg[0] & 0xffff0000u), __uint_as_float(gg[1] << 16), __uint_as_float(gg[1] & 0xffff0000u)};
        float ov[4];
#pragma unroll
        for (int j = 0; j < 4; ++j) ov[j] = ((acc[mt][4 * g + j] - mean) * rstd * lg[j] + lb[j] + bon * vf[j]) * gf[j];
        u32x2 w; w[0] = pk2(ov[0], ov[1]); w[1] = pk2(ov[2], ov[3]);
        *(u32x2*)(YA + o) = w;
      }
  }
  conv_x(p, (bf16_t*)((unsigned char*)p.out + OO_XB), blockIdx.x * NTHREADS + tidx(), gridDim.x * NTHREADS);
}

DI bool small_tile_of_block(int& m0, int& n0) {
  const int j = blockIdx.x >> 3;
  if (gridDim.x != 256 || (blockIdx.x & 7) != (j & 7)) return false;
  m0 = NP + (j >> 3) * 128; n0 = (j & 7) * 128; return true;
}
template <int TM>
DI void p4_tile(const Params& p, unsigned char* lds, int m0, int n0) {
  const bf16_t* XB = (const bf16_t*)((unsigned char*)p.out + OO_XB);
  const bf16_t* WIN = (const bf16_t*)(p.ws + O_WIN);
  const bf16_t* YA = (const bf16_t*)(p.ws + O_YA);
  const bf16_t* YB = (const bf16_t*)(p.ws + O_YB);
  bf16_t* M = (bf16_t*)(p.ws + O_M);
  const int tid = tidx(), lane = tid & 63, h = lane >> 5, wn = __builtin_amdgcn_readfirstlane(tid >> 6) >> 2;
  f32x16 accg[TM][2], accv[TM][2];
  gemm_mainloop<TM, 2>(YB, 512, (const bf16_t*)(p.ws + O_WPB), 512, 512, m0, n0, 1024, accv, lds);
  gemm_mainloop<TM, 2>(XB, DM, WIN + (size_t)(PABC + 1024) * DM, DM, DM, m0, n0, 1024, accg, lds);
#pragma unroll
  for (int tn = 0; tn < 2; ++tn)
#pragma unroll
    for (int g = 0; g < 4; ++g) {
      const f32x4 bg = *(const f32x4*)(p.in[24] + 1024 + n0 + wn * 64 + tn * 32 + 8 * g + 4 * h);
#pragma unroll
      for (int tm = 0; tm < TM; ++tm)
#pragma unroll
        for (int j = 0; j < 4; ++j) accv[tm][tn][4 * g + j] *= sigmoidf_(accg[tm][tn][4 * g + j] + bg[j]);
      __builtin_amdgcn_sched_barrier(0);
    }
  gemm_mainloop<TM, 2>(XB, DM, WIN + (size_t)PABC * DM, DM, DM, m0, n0, 1024, accg, lds);
#pragma unroll
  for (int tn = 0; tn < 2; ++tn)
#pragma unroll
    for (int g = 0; g < 4; ++g) {
      const f32x4 bg = *(const f32x4*)(p.in[24] + n0 + wn * 64 + tn * 32 + 8 * g + 4 * h);
#pragma unroll
      for (int tm = 0; tm < TM; ++tm)
#pragma unroll
        for (int j = 0; j < 4; ++j) {
          const float e = __expf(-(accg[tm][tn][4 * g + j] + bg[j]));
          accv[tm][tn][4 * g + j] *= (1.f + e);
          accg[tm][tn][4 * g + j] = 1.f / (1.f + e);
        }
      __builtin_amdgcn_sched_barrier(0);
    }
  gemm_mainloop<TM, 2, false>(YA, 512, (const bf16_t*)(p.ws + O_WPA), 512, 512, m0, n0, 1024, accv, lds);
  epilogue_bf16<TM, 2, 128>(accv, lds, M, DM, m0, n0, DM, [&](int tm, int tn, int g, int, int) { return acc4(accg[tm][tn], g) * acc4(accv[tm][tn], g); });
}
DI void phase4(const Params& p, unsigned char* lds) {
  if (gridDim.x == 256) {
    TileIter ti; ti.init(NP / 256, 8);
    int tmi, tni;
    while (ti.next(tmi, tni)) p4_tile<2>(p, lds, tmi * 256, tni * 128);
    int m0, n0;
    if (small_tile_of_block(m0, n0)) p4_tile<1>(p, lds, m0, n0);
  } else {
    TileIter ti; ti.init(NT / 128, 8);
    int tmi, tni;
    while (ti.next(tmi, tni)) p4_tile<1>(p, lds, tmi * 128, tni * 128);
  }
}

template <int TM>
DI void p5_tile(const Params& p, unsigned char* lds, int m0, int n0) {
  const bf16_t* M = (const bf16_t*)(p.ws + O_M);
  bf16_t* Z = (bf16_t*)(p.ws + O_Z);
  f32x16 acc[TM][2];
  gemm_mainloop<TM, 2>(M, DM, (const bf16_t*)(p.ws + O_WO), DM, DM, m0, n0, 1024, acc, lds);
  epilogue_bf16<TM, 2, 128>(acc, lds, Z, DM, m0, n0, DM, [&](int tm, int tn, int g, int rowl, int coll) {
    const f32x4 xv = *(const f32x4*)(xrow(p, m0 + rowl) + n0 + coll);
    return xv * DN_ALPHA + acc4(acc[tm][tn], g);
  });
}
DI void phase5(const Params& p, unsigned char* lds) {
  if (gridDim.x == 256) {
    TileIter ti; ti.init(NP / 256, 8);
    int tmi, tni;
    while (ti.next(tmi, tni)) p5_tile<2>(p, lds, tmi * 256, tni * 128);
    int m0, n0;
    if (small_tile_of_block(m0, n0)) p5_tile<1>(p, lds, m0, n0);
  } else {
    TileIter ti; ti.init(NT / 256, 8);
    int tmi, tni;
    while (ti.next(tmi, tni)) p5_tile<2>(p, lds, tmi * 256, tni * 128);
  }
}
template <bool OUT_BF16>
DI void ln_rows(const bf16_t* src, const float* g, const float* b, bf16_t* dst16, float* dst32) {
  const int gw = (blockIdx.x * NTHREADS + tidx()) >> 6, ngw = (gridDim.x * NTHREADS) >> 6, lane = tidx() & 63;
  for (int t = gw; t < NT; t += ngw) {
    const u32x4* xr = (const u32x4*)(src + (size_t)t * DM) + lane;
    float v[16]; float s = 0.f;
#pragma unroll
    for (int j = 0; j < 2; ++j) { unpack8(xr[64 * j], v + 8 * j); }
#pragma unroll
    for (int j = 0; j < 16; ++j) s += v[j];
    const float mean = wave_sum(s) * (1.f / DM);
    float s2 = 0.f;
#pragma unroll
    for (int j = 0; j < 16; ++j) { v[j] -= mean; s2 += v[j] * v[j]; }
    const float rstd = rsqrtf(wave_sum(s2) * (1.f / DM) + 1e-5f);
#pragma unroll
    for (int j = 0; j < 2; ++j) {
      const int c = 8 * lane + 512 * j;
      const f32x4 g0 = *(const f32x4*)(g + c), g1 = *(const f32x4*)(g + c + 4), b0 = *(const f32x4*)(b + c), b1 = *(const f32x4*)(b + c + 4);
      float o[8];
#pragma unroll
      for (int q = 0; q < 4; ++q) { o[q] = v[8 * j + q] * rstd * g0[q] + b0[q]; o[4 + q] = v[8 * j + 4 + q] * rstd * g1[q] + b1[q]; }
      if (OUT_BF16) *(u32x4*)(dst16 + (size_t)t * DM + c) = pack8(o);
      else { *(f32x4*)(dst32 + (size_t)t * DM + c) = (f32x4){o[0], o[1], o[2], o[3]}; *(f32x4*)(dst32 + (size_t)t * DM + c + 4) = (f32x4){o[4], o[5], o[6], o[7]}; }
    }
  }
}

DI void phase6(const Params& p, unsigned char* lds) {
  const bf16_t* H = (const bf16_t*)(p.ws + O_H);
  bf16_t* ACT = (bf16_t*)(p.ws + O_ACT);
  constexpr int NMT = NT / 256, NNT = 5632 / 256;
  TileIter ti; ti.init(NMT, NNT);
  int tmi, tni;
  while (ti.next(tmi, tni)) {
    const int m0 = tmi * 256, n0 = tni * 256;
    f32x16 acc[2][4];
    gemm_mainloop<2, 4, true, 2>(H, DM, (const bf16_t*)(p.ws + O_WGU), DM, DM, m0, n0, 5632, acc, lds);
    epilogue_bf16<2, 4, 128>(acc, lds, ACT, DFF, m0, tni * 128, DFF, [&](int tm, int q, int g, int, int) {
      f32x4 o;
#pragma unroll
      for (int j = 0; j < 4; ++j) { const float gte = acc[tm][2 * q][4 * g + j], up = acc[tm][2 * q + 1][4 * g + j]; o[j] = gte * sigmoidf_(gte) * up; }
      return o;
    });
  }
}
template <int TM>
DI void p7_tile(const Params& p, unsigned char* lds, int m0, int n0) {
  const bf16_t* H = (const bf16_t*)(p.ws + O_H);
  const bf16_t* ACT = (const bf16_t*)(p.ws + O_ACT);
  bf16_t* Z2 = (bf16_t*)(p.ws + O_Z2);
  f32x16 acc[TM][2];
  gemm_mainloop<TM, 2>(ACT, DFF, (const bf16_t*)(p.ws + O_WDN), DFF, DFF, m0, n0, 1024, acc, lds);
  epilogue_bf16<TM, 2, 128>(acc, lds, Z2, DM, m0, n0, DM, [&](int tm, int tn, int g, int rowl, int coll) {
    const u32x2 hv = *(const u32x2*)(H + (size_t)(m0 + rowl) * DM + n0 + coll);
    const f32x4 hf = {__uint_as_float(hv[0] << 16), __uint_as_float(hv[0] & 0xffff0000u), __uint_as_float(hv[1] << 16), __uint_as_float(hv[1] & 0xffff0000u)};
    return hf * DN_ALPHA + acc4(acc[tm][tn], g);
  });
}
DI void phase7(const Params& p, unsigned char* lds) {
  if (gridDim.x == 256) {
    TileIter ti; ti.init(NP / 256, 8);
    int tmi, tni;
    while (ti.next(tmi, tni)) p7_tile<2>(p, lds, tmi * 256, tni * 128);
    int m0, n0;
    if (small_tile_of_block(m0, n0)) p7_tile<1>(p, lds, m0, n0);
  } else {
    TileIter ti; ti.init(NT / 256, 8);
    int tmi, tni;
    while (ti.next(tmi, tni)) p7_tile<2>(p, lds, tmi * 256, tni * 128);
  }
}

DI void run_phase(const Params& p, unsigned char* lds, int ph) {
  switch (ph) {
    case 0: phase0(p, lds); break;
    case 1: phase1(p, lds); break;
    case 2: phase2(p, lds); break;
    case 3: phase3(p, lds); break;
    case 4: phase4a(p); break;
    case 5: phase4(p, lds); break;
    case 6: phase5(p, lds); break;
    case 7: ln_rows<true>((const bf16_t*)(p.ws + O_Z), p.in[26], p.in[27], (bf16_t*)(p.ws + O_H), nullptr); break;
    case 8: phase6(p, lds); break;
    case 9: phase7(p, lds); break;
    case 11: phase3b(p, lds); break;
    case 10: ln_rows<false>((const bf16_t*)(p.ws + O_Z2), p.in[30], p.in[31], nullptr, p.out + F_Y); break;
  }
}
constexpr int NPHASES = 11;

DI unsigned ctl_ld(unsigned* p) { return __hip_atomic_load(p, __ATOMIC_RELAXED, __HIP_MEMORY_SCOPE_AGENT); }
DI unsigned ctl_add(unsigned* p, unsigned v) { return __hip_atomic_fetch_add(p, v, __ATOMIC_RELAXED, __HIP_MEMORY_SCOPE_AGENT); }
DI void xbar(unsigned* ctl, unsigned x, unsigned nloc, unsigned nx, unsigned k) {
  asm volatile("s_waitcnt vmcnt(0)" ::: "memory");
  __syncthreads();
  if (threadIdx.x == 0) {
    const unsigned old = ctl_add(&ctl[(24 + x) * 64], 1u);
    if (old + 1u == k * nloc) {
      __builtin_amdgcn_fence(__ATOMIC_RELEASE, "agent");
      asm volatile("s_waitcnt vmcnt(0)" ::: "memory");
      ctl_add(&ctl[40 * 64], 1u);
    }
    while (ctl_ld(&ctl[40 * 64]) < k * nx) __builtin_amdgcn_s_sleep(1);
    __builtin_amdgcn_fence(__ATOMIC_ACQUIRE, "agent");
    asm volatile("s_waitcnt vmcnt(0)" ::: "memory");
  }
  __syncthreads();
}

__global__ void __launch_bounds__(NTHREADS) mega_kernel(Params p) {
  extern __shared__ __attribute__((aligned(16))) unsigned char lds[];
  volatile unsigned* s_bar = (volatile unsigned*)(lds + LDS_CTRL + 16);
  cg::grid_group grid = cg::this_grid();
  unsigned* ctl = (unsigned*)(p.ws + O_CTR);
  const unsigned x = (unsigned)__builtin_amdgcn_s_getreg((3 << 11) | 20) & 0xFu;
  if (threadIdx.x == 0) ctl_add(&ctl[(8 + x) * 64], 1u);
  run_phase(p, lds, 0); grid.sync();
  if (threadIdx.x == 0) {
    unsigned nx = 0;
    for (int i = 0; i < 16; ++i) nx += ctl_ld(&ctl[(8 + i) * 64]) != 0u ? 1u : 0u;
    s_bar[0] = ctl_ld(&ctl[(8 + x) * 64]); s_bar[1] = nx;
  }
  __syncthreads();
  const unsigned nloc = __builtin_amdgcn_readfirstlane(s_bar[0]), nx = __builtin_amdgcn_readfirstlane(s_bar[1]);
  run_phase(p, lds, 1); xbar(ctl, x, nloc, nx, 1);
  run_phase(p, lds, 2); xbar(ctl, x, nloc, nx, 2);
  run_phase(p, lds, 3); xbar(ctl, x, nloc, nx, 3);
  run_phase(p, lds, 11); xbar(ctl, x, nloc, nx, 4);
  run_phase(p, lds, 4); xbar(ctl, x, nloc, nx, 5);
  run_phase(p, lds, 5); xbar(ctl, x, nloc, nx, 6);
  run_phase(p, lds, 6); xbar(ctl, x, nloc, nx, 7);
  run_phase(p, lds, 7); xbar(ctl, x, nloc, nx, 8);
  run_phase(p, lds, 8); xbar(ctl, x, nloc, nx, 9);
  run_phase(p, lds, 9); xbar(ctl, x, nloc, nx, 10);
  run_phase(p, lds, 10);
}
template <int PH> __global__ void __launch_bounds__(NTHREADS) phase_kernel(Params p) {
  extern __shared__ __attribute__((aligned(16))) unsigned char lds[];
  run_phase(p, lds, PH);
}
template <int PH> static void launch_phase(const Params& p, int grid, hipStream_t stream) {
  (void)hipFuncSetAttribute((const void*)phase_kernel<PH>, hipFuncAttributeMaxDynamicSharedMemorySize, LDS_BYTES);
  hipLaunchKernelGGL(phase_kernel<PH>, dim3(grid), dim3(NTHREADS), LDS_BYTES, stream, p);
}

extern "C" void kernel_launch(void* const* d_in, const int* in_sizes, int n_in, void* d_out, int out_size, void* d_ws, size_t ws_size, hipStream_t stream) {
  static int grid_blocks = 0;
  if (grid_blocks == 0) {
    if (n_in != 32 || ws_size < WS_END) { fprintf(stderr, "kernel_launch: unexpected n_in %d or ws_size %zu (< %zu)\n", n_in, ws_size, (size_t)WS_END); grid_blocks = -1; return; }
    int dev = 0, cus = 0, per_cu = 0;
    (void)hipGetDevice(&dev);
    (void)hipDeviceGetAttribute(&cus, hipDeviceAttributeMultiprocessorCount, dev);
#if MULTI_LAUNCH
    per_cu = 1;
#else
    (void)hipFuncSetAttribute((const void*)mega_kernel, hipFuncAttributeMaxDynamicSharedMemorySize, LDS_BYTES);
    (void)hipOccupancyMaxActiveBlocksPerMultiprocessor(&per_cu, (const void*)mega_kernel, NTHREADS, LDS_BYTES);
#endif
    if (per_cu < 1) { fprintf(stderr, "kernel_launch: occupancy query gave %d\n", per_cu); grid_blocks = -1; return; }
    grid_blocks = cus;
  }
  if (grid_blocks < 0) return;
  Params p{};
  for (int i = 0; i < 32; ++i) p.in[i] = (const float*)d_in[i];
  p.out = (float*)d_out;
  p.ws = (unsigned char*)d_ws;
#if MULTI_LAUNCH
  launch_phase<0>(p, grid_blocks, stream); launch_phase<1>(p, grid_blocks, stream); launch_phase<2>(p, grid_blocks, stream); launch_phase<3>(p, grid_blocks, stream); launch_phase<11>(p, grid_blocks, stream);
  launch_phase<4>(p, grid_blocks, stream); launch_phase<5>(p, grid_blocks, stream); launch_phase<6>(p, grid_blocks, stream); launch_phase<7>(p, grid_blocks, stream);
  launch_phase<8>(p, grid_blocks, stream); launch_phase<9>(p, grid_blocks, stream); launch_phase<10>(p, grid_blocks, stream);
#else
  (void)hipMemsetAsync((unsigned char*)d_ws + O_CTR, 0, 16384, stream);
  void* args[] = {&p};
  hipError_t e = hipLaunchCooperativeKernel((void*)mega_kernel, dim3(grid_blocks), dim3(NTHREADS), args, LDS_BYTES, stream);
  if (e != hipSuccess) fprintf(stderr, "cooperative launch failed: %s (grid %d)\n", hipGetErrorString(e), grid_blocks);
#endif
}
```

```cpp
#include <hip/hip_runtime.h>
#include <hip/hip_cooperative_groups.h>
#include <cstdio>
#include <cstdint>
namespace cg = cooperative_groups;


#ifndef PROBE_DUP
#define PROBE_DUP -1
#endif
#ifndef MULTI_LAUNCH
#define MULTI_LAUNCH 0
#endif

#define DI __device__ __forceinline__
typedef unsigned short bf16_t;
typedef short bf16x8 __attribute__((ext_vector_type(8)));
typedef short s16x4 __attribute__((ext_vector_type(4)));
typedef float f32x16 __attribute__((ext_vector_type(16)));
typedef float f32x4 __attribute__((ext_vector_type(4)));
typedef float f32x2 __attribute__((ext_vector_type(2)));
typedef unsigned u32x4 __attribute__((ext_vector_type(4)));
typedef unsigned u32x2 __attribute__((ext_vector_type(2)));
typedef __bf16 bf2_t __attribute__((ext_vector_type(2)));

constexpr int NP = 16384, NS = 512, NT = NP + NS;
constexpr int DM = 1024, ACOLS = 1792, BCOLS = 416, PABC = ACOLS + BCOLS  , NIN = 4256;
constexpr int DFF = 2816;
constexpr int PAST = 1024, DSEQ = 32, DB = 16, SKV = PAST + DSEQ  ;
constexpr int NKV = NP + DB * SKV  , NKVP = NKV + 64;
constexpr float DN_ALPHA = 1.189207115002721f;
constexpr float QSCALE = 0.10206207261596575f * 1.4426950408889634f;

constexpr size_t al256(size_t x) { return (x + 255) & ~(size_t)255; }
constexpr size_t O_WIN = 0;
constexpr size_t O_WUQ = O_WIN + al256((size_t)NIN * 1024 * 2);
constexpr size_t O_WUKV = O_WUQ + al256(768 * 256 * 2);
constexpr size_t O_WPA = O_WUKV + al256(1024 * 128 * 2);
constexpr size_t O_WPB = O_WPA + al256(1024 * 512 * 2);
constexpr size_t O_WO = O_WPB + al256(1024 * 512 * 2);
constexpr size_t O_WGU = O_WO + al256(1024 * 1024 * 2);
constexpr size_t O_WDN = O_WGU + al256((size_t)5632 * 1024 * 2);
constexpr size_t O_WW2 = O_WDN + al256((size_t)1024 * 2816 * 2);
constexpr size_t O_WA2 = O_WW2 + al256(512 * 64 * 2);
constexpr size_t O_WG2 = O_WA2 + al256(512 * 64 * 2);
constexpr size_t O_ROPE = O_WG2 + al256(512 * 128 * 2);
constexpr size_t O_CTR = O_ROPE + al256((size_t)NT * 32 * 4);
constexpr size_t O_PAB = O_CTR + 16384;
constexpr size_t SZ_T512 = (size_t)NT * 512 * 2;
constexpr size_t O_SIN = O_PAB + al256((size_t)NT * PABC * 2);
constexpr size_t O_G = O_SIN + 6 * SZ_T512;
constexpr size_t O_RK = O_G + SZ_T512;
constexpr size_t O_KNB = O_RK + al256((size_t)NT * 8 * 4);
constexpr size_t O_KPEB = O_KNB + al256((size_t)8 * NKVP * 64 * 2);
constexpr int SCC = 8, SCL = NP / SCC;
constexpr size_t WS_END = O_KPEB + al256((size_t)NKVP * 32 * 2);
constexpr size_t O_Y = O_PAB;
constexpr size_t O_E = O_Y + SZ_T512;
constexpr size_t O_YB = O_Y + (size_t)NT * 512 * 4;
constexpr size_t O_YA = O_YB + SZ_T512;
constexpr size_t O_H = O_PAB;
constexpr size_t O_M = O_SIN;
constexpr size_t O_Z = O_SIN + (size_t)NT * 1024 * 2;
constexpr size_t O_Z2 = O_PAB + (size_t)NT * 1024 * 2;
constexpr size_t O_ACT = O_SIN;
constexpr size_t OO_XB = 0;
constexpr size_t OO_Q = 0;
constexpr size_t OO_VT = (size_t)NT * 768 * 2;
constexpr size_t OO_GH = OO_VT + (size_t)8 * 64 * NKVP * 2;
constexpr size_t OO_SST = OO_GH + 2 * (size_t)8 * SCC * 4096 * 4;
static_assert(OO_SST + (size_t)SCC * 8 * 4096 * 2 <= (size_t)NT * 1024 * 4, "d_out scratch");
constexpr size_t F_Y = 0, F_CKVP = (size_t)NT * 1024, F_KPEP = F_CKVP + (size_t)NP * 128, F_WKVP = F_KPEP + (size_t)NP * 32,
                 F_SHP = F_WKVP + 32768, F_CKVS = F_SHP + 1792, F_KPES = F_CKVS + (size_t)NS * 128, F_WKVS = F_KPES + (size_t)NS * 32,
                 F_SHS = F_WKVS + (size_t)DB * 32768;

constexpr int LDS_CTRL = 3 * 49152;
constexpr int LDS_BYTES = LDS_CTRL + 256;
constexpr int NTHREADS = 512;

struct Params {
  const float* in[32];
  float* out;
  unsigned char* ws;
};

DI int tidx() { int t = threadIdx.x; asm volatile("" : "+v"(t)); return t; }
DI unsigned pk2(float a, float b) { f32x2 v = {a, b}; bf2_t r = __builtin_convertvector(v, bf2_t); return __builtin_bit_cast(unsigned, r); }
DI bf16_t f2bf(float a) { return (bf16_t)(pk2(a, 0.f) & 0xffffu); }
DI float bf2f(bf16_t x) { return __uint_as_float(((unsigned)x) << 16); }
DI void unpack8(u32x4 v, float* f) {
#pragma unroll
  for (int j = 0; j < 4; ++j) { f[2 * j] = __uint_as_float(v[j] << 16); f[2 * j + 1] = __uint_as_float(v[j] & 0xffff0000u); }
}
DI u32x4 pack8(const float* f) { u32x4 o; o[0] = pk2(f[0], f[1]); o[1] = pk2(f[2], f[3]); o[2] = pk2(f[4], f[5]); o[3] = pk2(f[6], f[7]); return o; }
DI float sigmoidf_(float x) { return 1.f / (1.f + __expf(-x)); }
DI float dpp_sum16(float x) {
  x += __builtin_bit_cast(float, __builtin_amdgcn_update_dpp(0, __builtin_bit_cast(int, x), 0xB1, 0xF, 0xF, true));
  x += __builtin_bit_cast(float, __builtin_amdgcn_update_dpp(0, __builtin_bit_cast(int, x), 0x4E, 0xF, 0xF, true));
  x += __builtin_bit_cast(float, __builtin_amdgcn_update_dpp(0, __builtin_bit_cast(int, x), 0x141, 0xF, 0xF, true));
  x += __builtin_bit_cast(float, __builtin_amdgcn_update_dpp(0, __builtin_bit_cast(int, x), 0x140, 0xF, 0xF, true));
  return x;
}
DI float sum32(float x) { x = dpp_sum16(x); x += __shfl_xor(x, 16); return x; }
DI float wave_sum(float v) {
#pragma unroll
  for (int o = 1; o < 64; o <<= 1) v += __shfl_xor(v, o);
  return v;
}
DI int crow(int i, int h) { return (i & 3) + 8 * (i >> 2) + 4 * h; }
#define MFMA32(a, b, c) __builtin_amdgcn_mfma_f32_32x32x16_bf16((a), (b), (c), 0, 0, 0)
DI int slot_of_token(int t) { return t < NP ? t : NP + ((t - NP) >> 5) * SKV + PAST + ((t - NP) & 31); }
DI const float* xrow(const Params& p, int t) { return t < NP ? p.in[0] + (size_t)t * DM : p.in[1] + (size_t)(t - NP) * DM; }

DI void conv_T(const float* W, int K, int N, bf16_t* WT, int mode, int gtid, int gsz) {
  const int ntask = (K / 8) * N;
  for (int id = gtid; id < ntask; id += gsz) {
    const int kc = id / N, n = id - kc * N, k0 = kc * 8;
    float f[8];
#pragma unroll
    for (int j = 0; j < 8; ++j) f[j] = W[(size_t)(k0 + j) * N + n];
    if (mode == 2) {
      *(u32x4*)(WT + ((size_t)((n >> 5) * (K >> 4) + (k0 >> 4)) * 64 + ((k0 >> 3) & 1) * 32 + (n & 31)) * 8) = pack8(f);
      continue;
    }
    int row = n;
    if (mode == 1) { const int nt = n >= DFF ? 1 : 0, j = n - nt * DFF; row = 128 * (j >> 6) + 64 * ((j & 63) >> 5) + 32 * nt + (j & 31); }
    *(u32x4*)(WT + (size_t)row * K + k0) = pack8(f);
  }
}
DI void conv_T_lds(const float* W, int K, int N, bf16_t* WT, int mode, unsigned char* lds, int gw, int ngw, int wave, int lane) {
  float* scr = (float*)(lds + wave * (64 * 33 * 4));
  const int nblk = N >> 5, nitem = (K >> 6) * nblk;
  for (int item = gw; item < nitem; item += ngw) {
    const int kb = item / nblk, nb = item - kb * nblk, k0 = kb * 64, n0 = nb * 32;
#pragma unroll 8
    for (int i = 0; i < 32; ++i) { const int kk = 2 * i + (lane >> 5); scr[kk * 33 + (lane & 31)] = W[(size_t)(k0 + kk) * N + n0 + (lane & 31)]; }
    asm volatile("s_waitcnt lgkmcnt(0)" ::: "memory");
    const int c = lane & 7;
#pragma unroll
    for (int j = 0; j < 4; ++j) {
      const int nl = (lane >> 3) + 8 * j;
      const float* sp = scr + (8 * c) * 33 + nl;
      float f[8];
#pragma unroll
      for (int q = 0; q < 8; ++q) f[q] = sp[q * 33];
      int row = n0 + nl;
      if (mode == 1) { const int nt = row >= DFF ? 1 : 0, jj = row - nt * DFF; row = 256 * (jj >> 7) + 128 * ((jj & 127) >> 6) + 32 * (2 * ((jj & 63) >> 5) + nt) + (jj & 31); }
      *(u32x4*)(WT + (size_t)row * K + k0 + 8 * c) = pack8(f);
    }
    asm volatile("s_waitcnt lgkmcnt(0)" ::: "memory");
  }
}
DI void conv_x(const Params& p, bf16_t* XB, int gtid, int gsz) {
  for (int id = gtid; id < NT * 128; id += gsz) {
    const int t = id >> 7, c = (id & 127) * 8;
    const float* src = xrow(p, t) + c;
    f32x4 a = *(const f32x4*)src, b = *(const f32x4*)(src + 4);
    float f[8] = {a[0], a[1], a[2], a[3], b[0], b[1], b[2], b[3]};
    *(u32x4*)(XB + (size_t)t * DM + c) = pack8(f);
  }
}
DI void phase0(const Params& p, unsigned char* lds) {
  const int tid0 = tidx(), gtid = blockIdx.x * NTHREADS + tid0, gsz = gridDim.x * NTHREADS;
  const int wave0 = __builtin_amdgcn_readfirstlane(tid0 >> 6), lane0 = tid0 & 63, gw = blockIdx.x * 8 + wave0, ngw = gridDim.x * 8;
  unsigned char* ws = p.ws;
  if (gtid < 64) ((unsigned*)(ws + O_CTR))[gtid] = 0u;
  conv_T_lds(p.in[6], 1024, NIN, (bf16_t*)(ws + O_WIN), 0, lds, gw, ngw, wave0, lane0);
  conv_T(p.in[20], 256, 768, (bf16_t*)(ws + O_WUQ), 2, gtid, gsz);
  conv_T(p.in[22], 128, 1024, (bf16_t*)(ws + O_WUKV), 2, gtid, gsz);
  conv_T_lds(p.in[18], 512, 1024, (bf16_t*)(ws + O_WPA), 0, lds, gw, ngw, wave0, lane0);
  conv_T_lds(p.in[23], 512, 1024, (bf16_t*)(ws + O_WPB), 0, lds, gw, ngw, wave0, lane0);
  conv_T_lds(p.in[25], 1024, 1024, (bf16_t*)(ws + O_WO), 0, lds, gw, ngw, wave0, lane0);
  conv_T_lds(p.in[28], 1024, 5632, (bf16_t*)(ws + O_WGU), 1, lds, gw, ngw, wave0, lane0);
  conv_T_lds(p.in[29], 2816, 1024, (bf16_t*)(ws + O_WDN), 0, lds, gw, ngw, wave0, lane0);
  conv_T(p.in[9], 64, 512, (bf16_t*)(ws + O_WW2), 2, gtid, gsz);
  conv_T(p.in[11], 64, 512, (bf16_t*)(ws + O_WA2), 2, gtid, gsz);
  conv_T(p.in[12], 128, 512, (bf16_t*)(ws + O_WG2), 2, gtid, gsz);
  conv_x(p, (bf16_t*)((unsigned char*)p.out + OO_XB), gtid, gsz);
  float* rope = (float*)(ws + O_ROPE);
  for (int id = gtid; id < NT * 16; id += gsz) {
    const int t = id >> 4, j = id & 15;
    const int pos = t < NP ? t : PAST + ((t - NP) & 31);
    const float inv = (float)exp2(-(double)j * (13.287712379549449 / 16.0));
    const float ang = (float)pos * inv;
    const double x = (double)ang;
    const double n = rint(x * 0.15915494309189535);
    const float red = (float)(x - n * 6.283185307179586);
    rope[t * 32 + j] = __cosf(red);
    rope[t * 32 + 16 + j] = __sinf(red);
  }
  bf16_t* kpeb = (bf16_t*)(ws + O_KPEB);
  for (int id = gtid; id < DB * PAST * 4; id += gsz) {
    const int row = id >> 2, ch = id & 3, b = row >> 10, j = row & 1023;
    const float* src = p.in[3] + (size_t)row * 32 + ch * 8;
    f32x4 a = *(const f32x4*)src, c = *(const f32x4*)(src + 4);
    float f[8] = {a[0], a[1], a[2], a[3], c[0], c[1], c[2], c[3]};
    *(u32x4*)(kpeb + (size_t)(NP + b * SKV + j) * 32 + ch * 8) = pack8(f);
  }
  bf16_t* knb = (bf16_t*)(ws + O_KNB);
  for (int id = gtid; id < 64 * 32; id += gsz) kpeb[(size_t)NKV * 32 + id] = 0;
  for (int id = gtid; id < 8 * 64 * 64; id += gsz) {
    const int h = id >> 12, rem = id & 4095;
    knb[((size_t)h * NKVP + NKV) * 64 + rem] = 0;
  }
}

template <int TM, int TN, bool ZERO = true, int NST = 3>
DI void gemm_mainloop(const bf16_t* __restrict__ A, int lda, const bf16_t* __restrict__ Bt, int ldb, int K, int m0, int n0, int nmax,
                      f32x16 (&acc)[TM][TN], unsigned char* lds) {
  constexpr int BM = 128 * TM, BN = 64 * TN, AG = BM / 64, BG = BN / 64, NLD = AG + BG;
  constexpr int ABYTES = BM * 128, STAGE = (BM + BN) * 128;
  static_assert(NST * STAGE <= LDS_CTRL && (NST == 2 || NST == 3), "lds");
  const int tid = tidx(), wave = __builtin_amdgcn_readfirstlane(tid >> 6), lane = tid & 63, r = lane & 31, h = lane >> 5, wm = wave & 3, wn = wave >> 2;
  const int lrow = lane >> 3, lpos = lane & 7;
  const bf16_t* ap[AG]; const bf16_t* bp[BG];
#pragma unroll
  for (int i = 0; i < AG; ++i) { const int row = (wave * AG + i) * 8 + lrow, c = lpos ^ ((row >> 1) & 7); ap[i] = A + (size_t)(m0 + row) * lda + c * 8; }
#pragma unroll
  for (int i = 0; i < BG; ++i) { const int row = (wave * BG + i) * 8 + lrow, c = lpos ^ ((row >> 1) & 7); int br = n0 + row; br = br < nmax ? br : nmax - 1; bp[i] = Bt + (size_t)br * ldb + c * 8; }
  if (ZERO) {
#pragma unroll
    for (int tm = 0; tm < TM; ++tm)
#pragma unroll
      for (int tn = 0; tn < TN; ++tn)
#pragma unroll
        for (int i = 0; i < 16; ++i) acc[tm][tn][i] = 0.f;
  }
  auto issue = [&](int kt, int stage) {
    unsigned char* sb = lds + stage * STAGE;
#pragma unroll
    for (int i = 0; i < AG; ++i) __builtin_amdgcn_global_load_lds((const unsigned*)(ap[i] + kt * 64), (unsigned*)(sb + (wave * AG + i) * 1024), 16, 0, 0);
#pragma unroll
    for (int i = 0; i < BG; ++i) __builtin_amdgcn_global_load_lds((const unsigned*)(bp[i] + kt * 64), (unsigned*)(sb + ABYTES + (wave * BG + i) * 1024), 16, 0, 0);
  };
  const int swz = (r >> 1) & 7;
  int koff[4];
#pragma unroll
  for (int ks = 0; ks < 4; ++ks) koff[ks] = ((ks * 2 + h) ^ swz) * 16;
  const int a_rd = (wm * 32 * TM + r) * 128, b_rd = ABYTES + (wn * 32 * TN + r) * 128;
  const int nk = K >> 6;
  asm volatile("s_waitcnt vmcnt(0)" ::: "memory");
  issue(0, 0);
  if (NST == 3) issue(1, 1);
  for (int kt = 0; kt < nk; ++kt) {
    if (NST == 3 && kt + 1 < nk) asm volatile("s_waitcnt vmcnt(%0)" ::"n"(NLD) : "memory");
    else asm volatile("s_waitcnt vmcnt(0)" ::: "memory");
    asm volatile("s_waitcnt lgkmcnt(0)" ::: "memory");
    __builtin_amdgcn_s_barrier();
    if (NST == 3) { if (kt + 2 < nk) issue(kt + 2, (kt + 2) % 3); }
    else { if (kt + 1 < nk) issue(kt + 1, (kt + 1) & 1); }
    const unsigned char* cur = lds + (kt % NST) * STAGE;
#pragma unroll
    for (int ks = 0; ks < 4; ++ks) {
      bf16x8 af[TM], bfr[TN];
#pragma unroll
      for (int tm = 0; tm < TM; ++tm) af[tm] = *(const bf16x8*)(cur + a_rd + tm * 4096 + koff[ks]);
#pragma unroll
      for (int tn = 0; tn < TN; ++tn) bfr[tn] = *(const bf16x8*)(cur + b_rd + tn * 4096 + koff[ks]);
#pragma unroll
      for (int tm = 0; tm < TM; ++tm)
#pragma unroll
        for (int tn = 0; tn < TN; ++tn) acc[tm][tn] = MFMA32(bfr[tn], af[tm], acc[tm][tn]);
    }
  }
  asm volatile("s_waitcnt lgkmcnt(0)" ::: "memory");
  __builtin_amdgcn_s_barrier();
}

template <int TM, int TN, int OUTC, class F>
DI void epilogue_bf16(const f32x16 (&acc)[TM][TN], unsigned char* lds, bf16_t* out, int ldo, int m0, int c0, int cmax, F f) {
  constexpr int BM = 128 * TM, STRIDE = OUTC * 2 + 16, TNO = OUTC / (32 * 2);
  const int tid = tidx(), wave = __builtin_amdgcn_readfirstlane(tid >> 6), lane = tid & 63, r = lane & 31, h = lane >> 5, wm = wave & 3, wn = wave >> 2;
#pragma unroll
  for (int tm = 0; tm < TM; ++tm)
#pragma unroll
    for (int tn = 0; tn < TNO; ++tn)
#pragma unroll
      for (int g = 0; g < 4; ++g) {
        const int rowl = wm * 32 * TM + tm * 32 + r, coll = wn * 32 * TNO + tn * 32 + 8 * g + 4 * h;
        const f32x4 o = f(tm, tn, g, rowl, coll);
        u32x2 w; w[0] = pk2(o[0], o[1]); w[1] = pk2(o[2], o[3]);
        *(u32x2*)(lds + rowl * STRIDE + coll * 2) = w;
      }
  __syncthreads();
  constexpr int CPR = OUTC / 8;
#pragma unroll
  for (int j = 0; j < BM * CPR / NTHREADS; ++j) {
    const int id = tid + NTHREADS * j, row = id / CPR, c = id % CPR;
    if (c0 + c * 8 < cmax) *(u32x4*)(out + (size_t)(m0 + row) * ldo + c0 + c * 8) = *(const u32x4*)(lds + row * STRIDE + c * 16);
  }
  __syncthreads();
}
DI f32x4 acc4(const f32x16& a, int g) { return (f32x4){a[4 * g], a[4 * g + 1], a[4 * g + 2], a[4 * g + 3]}; }

struct TileIter {
  int nM, nN, total, L, Lend, step;
  DI void init(int nM_, int nN_) {
    nM = nM_; nN = nN_; total = nM * nN;
    const int nx = (gridDim.x & 7) == 0 ? 8 : 1, x = blockIdx.x % nx, local = blockIdx.x / nx;
    step = gridDim.x / nx;
    const int per = (total + nx - 1) / nx;
    L = x * per + local; Lend = (x + 1) * per < total ? (x + 1) * per : total;
  }
  DI bool next(int& tmi, int& tni) {
    if (L >= Lend) return false;
    const int fb = nM >> 2, fullcnt = fb * 4 * nN;
    if (L < fullcnt) { const int band = L / (4 * nN), jj = L - band * 4 * nN; tni = jj >> 2; tmi = band * 4 + (jj & 3); }
    else { const int l2 = L - fullcnt, bm = nM & 3; tni = l2 / bm; tmi = fb * 4 + l2 % bm; }
    L += step; return true;
  }
};

DI void phase1(const Params& p, unsigned char* lds) {
  const bf16_t* XB = (const bf16_t*)((unsigned char*)p.out + OO_XB);
  const bf16_t* WT = (const bf16_t*)(p.ws + O_WIN);
  bf16_t* PAB = (bf16_t*)(p.ws + O_PAB);
  constexpr int NMT = NT / 256, NNT = (PABC + 127) / 128;
  const int lane = tidx() & 63, wave = __builtin_amdgcn_readfirstlane(tidx() >> 6), r = lane & 31, h = lane >> 5, wm = wave & 3, wn = wave >> 2;
  TileIter ti; ti.init(NMT, NNT);
  int tmi, tni;
  while (ti.next(tmi, tni)) {
    const int m0 = tmi * 256, n0 = tni * 128;
    f32x16 acc[2][2];
    gemm_mainloop<2, 2>(XB, DM, WT, DM, DM, m0, n0, PABC, acc, lds);
    if (m0 + 256 > NP - 1 && n0 < ACOLS) {
#pragma unroll
      for (int tm = 0; tm < 2; ++tm) {
        const int row = m0 + wm * 64 + tm * 32 + r;
        const bool lastp = row == NP - 1, lasts = row >= NP && ((row - NP) & 31) == 31;
        if (lastp || lasts) {
          float* dst = lastp ? p.out + F_SHP : p.out + F_SHS + (size_t)((row - NP) >> 5) * ACOLS;
#pragma unroll
          for (int tn = 0; tn < 2; ++tn)
#pragma unroll
            for (int g = 0; g < 4; ++g) {
              const int col = n0 + wn * 64 + tn * 32 + 8 * g + 4 * h;
              if (col < ACOLS) *(f32x4*)(dst + col) = acc4(acc[tm][tn], g);
            }
        }
      }
    }
    epilogue_bf16<2, 2, 128>(acc, lds, PAB, PABC, m0, n0, PABC, [&](int tm, int tn, int g, int, int) { return acc4(acc[tm][tn], g); });
  }
}

constexpr int L2_LORA = 0, L2_K = L2_LORA + 32 * 528, L2_R = L2_K + 32 * 1040, L2A_STG = L2_R + 32 * 1040, L2A_END = L2A_STG + 8 * 32 * 144;
constexpr int L2_CQ = 0, L2_CKV = L2_CQ + 32 * 528, L2B_STG = L2_CKV + 32 * 272, L2B_END = L2B_STG + 8 * 32 * 208;
static_assert(L2A_END <= LDS_BYTES && L2B_END <= LDS_BYTES, "lds p2");
template <int NTL, class F>
DI void stage_store16(unsigned char* stg, int lane, bf16_t* dst  , unsigned row_stride  , F f) {
  constexpr int RS = NTL * 64 + 16, CPR = NTL * 4;
  const int r = lane & 31, h = lane >> 5;
#pragma unroll
  for (int nt = 0; nt < NTL; ++nt)
#pragma unroll
    for (int i = 0; i < 16; ++i) *(unsigned short*)(stg + crow(i, h) * RS + (nt * 32 + r) * 2) = f(nt, i);
  __syncthreads();
#pragma unroll
  for (int j = 0; j < 32 * CPR / 64; ++j) {
    const int id = lane + 64 * j, row = id / CPR, ch = id % CPR;
    *(u32x4*)(dst + (size_t)row * row_stride + ch * 8) = *(const u32x4*)(stg + row * RS + ch * 16);
  }
  __syncthreads();
}

template <int NTL, int KS>
DI void mm32(const unsigned char* ldsA, int strideB, const bf16_t* Bt, int ldb, int lane, f32x16 (&acc)[NTL]) {
  constexpr int KG = (NTL * KS <= 16) ? KS : (NTL <= 2 ? 4 : 2), NG = KS / KG;
  const int r = lane & 31, h = lane >> 5;
#pragma unroll
  for (int nt = 0; nt < NTL; ++nt)
#pragma unroll
    for (int i = 0; i < 16; ++i) acc[nt][i] = 0.f;
  bf16x8 bq[2][KG][NTL];
  const bf16_t* bp = Bt + lane * 8;
#pragma unroll
  for (int k = 0; k < KG; ++k)
#pragma unroll
    for (int nt = 0; nt < NTL; ++nt) bq[0][k][nt] = *(const bf16x8*)(bp + (size_t)(nt * KS + k) * 512);
#pragma unroll
  for (int g = 0; g < NG; ++g) {
    if (g + 1 < NG) {
#pragma unroll
      for (int k = 0; k < KG; ++k)
#pragma unroll
        for (int nt = 0; nt < NTL; ++nt) bq[(g + 1) & 1][k][nt] = *(const bf16x8*)(bp + (size_t)(nt * KS + (g + 1) * KG + k) * 512);
    }
    __builtin_amdgcn_sched_barrier(0);
#pragma unroll
    for (int k = 0; k < KG; ++k) {
      const bf16x8 a = *(const bf16x8*)(ldsA + r * strideB + (g * KG + k) * 32 + h * 16);
#pragma unroll
      for (int nt = 0; nt < NTL; ++nt) acc[nt] = MFMA32(a, bq[g & 1][k][nt], acc[nt]);
    }
    __builtin_amdgcn_sched_barrier(0);
  }
}

DI void kv_expand(const Params& p, unsigned char* lds, int w, int lane, int slot0) {
  const int r = lane & 31, h = lane >> 5;
  bf16_t* knb = (bf16_t*)(p.ws + O_KNB);
  bf16_t* vT = (bf16_t*)((unsigned char*)p.out + OO_VT);
  f32x16 acc[4];
  mm32<4, 8>(lds + L2_CKV, 272, (const bf16_t*)(p.ws + O_WUKV) + (size_t)(128 * w) * 128, 128, lane, acc);
  stage_store16<2>((unsigned char*)lds + L2B_STG + w * (32 * 208), lane, knb + ((size_t)w * NKVP + slot0) * 64, 64, [&](int nt, int i) { return f2bf(acc[nt][i]); });
#pragma unroll
  for (int nt = 2; nt < 4; ++nt)
#pragma unroll
    for (int g = 0; g < 4; ++g) {
      u32x2 o; o[0] = pk2(acc[nt][4 * g], acc[nt][4 * g + 1]); o[1] = pk2(acc[nt][4 * g + 2], acc[nt][4 * g + 3]);
      *(u32x2*)(vT + ((unsigned)w * 64 + (nt - 2) * 32 + r) * (unsigned)NKVP + slot0 + 8 * g + 4 * h) = o;
    }
}

DI void p2_token_tile_a(const Params& p, unsigned char* lds, int tile) {
  const int tid = tidx(), wave = __builtin_amdgcn_readfirstlane(tid >> 6), lane = tid & 63, r = lane & 31, h = lane >> 5;
  const int t0 = tile * 32;
  unsigned char* ws = p.ws;
  const bf16_t* PAB = (const bf16_t*)(ws + O_PAB);
  bf16_t* SR = (bf16_t*)(ws + O_SIN);
  bf16_t* SK = SR + (size_t)NT * 512; bf16_t* SV = SK + (size_t)NT * 512; bf16_t* SA = SV + (size_t)NT * 512; bf16_t* SB = SA + (size_t)NT * 512;
  _Float16* SW = (_Float16*)(SB + (size_t)NT * 512);
  bf16_t* G = (bf16_t*)(ws + O_G);
  float* RK = (float*)(ws + O_RK);
  const float* rope = (const float*)(ws + O_ROPE);
#pragma unroll 1
  for (int bt = 0; bt < 2; ++bt) {
    u32x4 rawp[7], rawq[7];
#pragma unroll
    for (int it = 0; it < 7; ++it) {
      const int task = tid + NTHREADS * (bt * 7 + it);
      const int tl = task / 224, ch = task - tl * 224, c0 = ch * 8, t = t0 + tl;
      rawp[it] = *(const u32x4*)(PAB + (size_t)t * PABC + c0);
      rawq[it] = *(const u32x4*)(PAB + (size_t)(t > 0 ? t - 1 : 0) * PABC + c0);
    }
#pragma unroll
    for (int it = 0; it < 7; ++it) {
      const int task = tid + NTHREADS * (bt * 7 + it);
      const int tl = task / 224, ch = task - tl * 224, c0 = ch * 8, t = t0 + tl;
      float pv[8], pr[8];
      unpack8(rawp[it], pv);
      unpack8(rawq[it], pr);
      if (t == 0) {
#pragma unroll
        for (int j = 0; j < 8; ++j) pr[j] = 0.f;
      } else if (t >= NP && ((t - NP) & 31) == 0) {
        const float* sp = p.in[5] + (size_t)((t - NP) >> 5) * ACOLS + c0;
        const f32x4 a = *(const f32x4*)sp, b = *(const f32x4*)(sp + 4);
        pr[0] = a[0]; pr[1] = a[1]; pr[2] = a[2]; pr[3] = a[3]; pr[4] = b[0]; pr[5] = b[1]; pr[6] = b[2]; pr[7] = b[3];
      }
      const f32x4 mu0 = *(const f32x4*)(p.in[7] + c0), mu1 = *(const f32x4*)(p.in[7] + c0 + 4);
      const float mm[8] = {mu0[0], mu0[1], mu0[2], mu0[3], mu1[0], mu1[1], mu1[2], mu1[3]};
      float xs[8];
#pragma unroll
      for (int j = 0; j < 8; ++j) xs[j] = pv[j] + (pr[j] - pv[j]) * mm[j];
      if (c0 < 512) {
        const u32x4 o = pack8(xs);
        *(u32x4*)(SR + (size_t)t * 512 + c0) = o;
        *(u32x4*)(lds + L2_R + tl * 1040 + c0 * 2) = o;
      } else if (c0 < 1024) {
        *(u32x4*)(lds + L2_K + tl * 1040 + (c0 - 512) * 2) = pack8(xs);
      } else if (c0 < 1536) {
        *(u32x4*)(SV + (size_t)t * 512 + (c0 - 1024)) = pack8(xs);
      } else {
        if (c0 < 1600) {
#pragma unroll
          for (int j = 0; j < 8; ++j) { const float e = __expf(2.f * xs[j]); xs[j] = 1.f - 2.f / (e + 1.f); }
        } else if (c0 >= 1664) {
#pragma unroll
          for (int j = 0; j < 8; ++j) xs[j] = sigmoidf_(xs[j]);
        }
        *(u32x4*)(lds + L2_LORA + tl * 528 + (c0 - 1536) * 2) = pack8(xs);
      }
    }
  }
  __syncthreads();
  const int w = wave, cb = 64 * w;
  {
    int r = (tidx() & 31);
    f32x16 acc[2];
    mm32<2, 4>(lds + L2_LORA, 528, (const bf16_t*)(ws + O_WW2) + (size_t)cb * 64, 64, lane, acc);
    const float w00 = p.in[8][cb + r], w01 = p.in[8][cb + 32 + r];
    stage_store16<2>(lds + L2A_STG + w * (32 * 144), lane, (bf16_t*)SW + (size_t)t0 * 512 + cb, 512, [&](int nt, int i) {
      const float z = (nt ? w01 : w00) + acc[nt][i];
      const float sp = fmaxf(-z, 0.f) + __logf(1.f + __expf(-fabsf(z)));
      const float dec = __expf(-__expf(-sp - 0.5f));
      return __builtin_bit_cast(unsigned short, (_Float16)dec);
    });
  }
  __syncthreads();
  {
    int r = (tidx() & 31);
    f32x16 acc[2];
    mm32<2, 4>(lds + L2_LORA + 128, 528, (const bf16_t*)(ws + O_WA2) + (size_t)cb * 64, 64, lane, acc);
    float kkv[2][16];
#pragma unroll
    for (int nt = 0; nt < 2; ++nt) {
      const int c = cb + nt * 32 + r;
      const float a0 = p.in[10][c], kkc = p.in[13][c];
#pragma unroll
      for (int i = 0; i < 16; ++i) {
        acc[nt][i] = sigmoidf_(a0 + acc[nt][i]);
        kkv[nt][i] = bf2f(*(const bf16_t*)(lds + L2_K + crow(i, h) * 1040 + c * 2)) * kkc;
      }
    }
#pragma unroll
    for (int i = 0; i < 16; ++i) {
      const float nsq = sum32(kkv[0][i] * kkv[0][i] + kkv[1][i] * kkv[1][i]);
      const float inv = 1.f / fmaxf(sqrtf(nsq), 1e-12f);
      kkv[0][i] *= inv; kkv[1][i] *= inv;
      __builtin_amdgcn_sched_barrier(0);
    }
    const int c0 = cb + r, c1 = cb + 32 + r;
    const float ka0 = p.in[14][c0], ka1 = p.in[14][c1], rk0 = p.in[15][c0], rk1 = p.in[15][c1];
    unsigned char* stg = lds + L2A_STG + w * (32 * 144);
    stage_store16<2>(stg, lane, SA + (size_t)t0 * 512 + cb, 512, [&](int nt, int i) { return f2bf(-kkv[nt][i]); });
    stage_store16<2>(stg, lane, SB + (size_t)t0 * 512 + cb, 512, [&](int nt, int i) { return f2bf(kkv[nt][i] * acc[nt][i]); });
#pragma unroll
    for (int i = 0; i < 16; ++i) {
      const int tl = crow(i, h);
      const float kr0 = bf2f(*(const bf16_t*)(lds + L2_K + tl * 1040 + c0 * 2)), kr1 = bf2f(*(const bf16_t*)(lds + L2_K + tl * 1040 + c1 * 2));
      const float kh0 = kr0 * (1.f + (acc[0][i] - 1.f) * ka0), kh1 = kr1 * (1.f + (acc[1][i] - 1.f) * ka1);
      kkv[0][i] = kh0; kkv[1][i] = kh1;
      const float rr0 = bf2f(*(const bf16_t*)(lds + L2_R + tl * 1040 + c0 * 2)), rr1 = bf2f(*(const bf16_t*)(lds + L2_R + tl * 1040 + c1 * 2));
      const float sb = sum32(rr0 * kh0 * rk0 + rr1 * kh1 * rk1);
      if (r == 0) RK[(unsigned)(t0 + tl) * 8u + w] = sb;
    }
    stage_store16<2>(stg, lane, SK + (size_t)t0 * 512 + cb, 512, [&](int nt, int i) { return f2bf(kkv[nt][i]); });
  }
  __syncthreads();
  {
    int r = (tidx() & 31);
    f32x16 acc[2];
    mm32<2, 8>(lds + L2_LORA + 256, 528, (const bf16_t*)(ws + O_WG2) + (size_t)cb * 128, 128, lane, acc);
    stage_store16<2>(lds + L2A_STG + w * (32 * 144), lane, G + (size_t)t0 * 512 + cb, 512, [&](int nt, int i) { return f2bf(acc[nt][i]); });
  }
  __syncthreads();
}

DI void p2_token_tile_b(const Params& p, unsigned char* lds, int tile) {
  const int tid = tidx(), wave = __builtin_amdgcn_readfirstlane(tid >> 6), lane = tid & 63, r = lane & 31, h = lane >> 5;
  const int t0 = tile * 32;
  unsigned char* ws = p.ws;
  const bf16_t* PAB = (const bf16_t*)(ws + O_PAB);
  bf16_t* SR = (bf16_t*)(ws + O_SIN);
  bf16_t* SK = SR + (size_t)NT * 512; bf16_t* SV = SK + (size_t)NT * 512; bf16_t* SA = SV + (size_t)NT * 512; bf16_t* SB = SA + (size_t)NT * 512;
  _Float16* SW = (_Float16*)(SB + (size_t)NT * 512);
  bf16_t* G = (bf16_t*)(ws + O_G);
  float* RK = (float*)(ws + O_RK);
  const float* rope = (const float*)(ws + O_ROPE);
  {
    u32x2 vq[4]; unsigned vc[4]; float k1[4], k2[4], rc[4], rs_[4];
#pragma unroll
    for (int q = 0; q < 4; ++q) {
      const int t = t0 + wave * 4 + q;
      const bf16_t* pb = PAB + (size_t)t * PABC + ACOLS;
      vq[q] = *(const u32x2*)(pb + 4 * lane);
      vc[q] = *(const unsigned*)(pb + 256 + 2 * lane);
      k1[q] = bf2f(pb[384 + (lane & 15)]); k2[q] = bf2f(pb[400 + (lane & 15)]);
      rc[q] = rope[t * 32 + (lane & 15)]; rs_[q] = rope[t * 32 + 16 + (lane & 15)];
    }
    const f32x4 gq = *(const f32x4*)(p.in[19] + 4 * lane);
    const f32x2 gkv = *(const f32x2*)(p.in[21] + 2 * lane);
#pragma unroll
    for (int q = 0; q < 4; ++q) {
      const int tl = wave * 4 + q, t = t0 + tl;
      {
        const u32x2 v = vq[q];
        float x[4] = {__uint_as_float(v[0] << 16), __uint_as_float(v[0] & 0xffff0000u), __uint_as_float(v[1] << 16), __uint_as_float(v[1] & 0xffff0000u)};
        const float ss = wave_sum(x[0] * x[0] + x[1] * x[1] + x[2] * x[2] + x[3] * x[3]);
        const float rs = rsqrtf(ss * (1.f / 256.f) + 1e-6f);
        u32x2 o; o[0] = pk2(x[0] * rs * gq[0], x[1] * rs * gq[1]); o[1] = pk2(x[2] * rs * gq[2], x[3] * rs * gq[3]);
        *(u32x2*)(lds + L2_CQ + tl * 528 + lane * 8) = o;
      }
      {
        const unsigned v = vc[q];
        const float x0 = __uint_as_float(v << 16), x1 = __uint_as_float(v & 0xffff0000u);
        const float ss = wave_sum(x0 * x0 + x1 * x1);
        const float rs = rsqrtf(ss * (1.f / 128.f) + 1e-6f);
        const float o0 = x0 * rs * gkv[0], o1 = x1 * rs * gkv[1];
        float* dst = (t < NP) ? p.out + F_CKVP + (size_t)t * 128 : p.out + F_CKVS + (size_t)(t - NP) * 128;
        f32x2 of = {o0, o1};
        *(f32x2*)(dst + 2 * lane) = of;
        *(unsigned*)(lds + L2_CKV + tl * 272 + lane * 4) = pk2(o0, o1);
      }
      if (lane < 16) {
        const float o1 = k1[q] * rc[q] - k2[q] * rs_[q], o2 = k1[q] * rs_[q] + k2[q] * rc[q];
        float* dst = (t < NP) ? p.out + F_KPEP + (size_t)t * 32 : p.out + F_KPES + (size_t)(t - NP) * 32;
        dst[lane] = o1; dst[16 + lane] = o2;
        bf16_t* kp = (bf16_t*)(ws + O_KPEB) + (size_t)slot_of_token(t) * 32;
        kp[lane] = f2bf(o1); kp[16 + lane] = f2bf(o2);
      }
    }
  }
  __syncthreads();
  const int w = wave, cb = 64 * w;
  {
    int r = (tidx() & 31);
    f32x16 acc[3];
    mm32<3, 16>(lds + L2_CQ, 528, (const bf16_t*)(ws + O_WUQ) + (size_t)(96 * w) * 256, 256, lane, acc);
    bf16_t* Q = (bf16_t*)((unsigned char*)p.out + OO_Q);
    const int j = r & 15;
#pragma unroll
    for (int i = 0; i < 16; ++i) {
      const int t = t0 + crow(i, h);
      const float own = acc[2][i], oth = __shfl_xor(own, 16);
      const float c = rope[t * 32 + j], sn = rope[t * 32 + 16 + j];
      acc[2][i] = (r < 16) ? own * c - oth * sn : oth * sn + own * c;
    }
    stage_store16<3>(lds + L2B_STG + w * (32 * 208), lane, Q + (size_t)t0 * 768 + 96 * w, 768, [&](int nt, int i) { return f2bf(acc[nt][i] * QSCALE); });
  }
  __syncthreads();
  kv_expand(p, lds, w, lane, slot_of_token(t0));
  __syncthreads();
}

DI void p2_cache_tile(const Params& p, unsigned char* lds, int ctile) {
  const int tid = tidx(), wave = __builtin_amdgcn_readfirstlane(tid >> 6), lane = tid & 63;
  const int b = ctile >> 5, j0 = (ctile & 31) * 32;
  {
    const int row = tid >> 4, c = (tid & 15) * 8;
    const float* src = p.in[2] + ((size_t)(b * PAST + j0 + row)) * 128 + c;
    f32x4 a = *(const f32x4*)src, d = *(const f32x4*)(src + 4);
    float f[8] = {a[0], a[1], a[2], a[3], d[0], d[1], d[2], d[3]};
    *(u32x4*)(lds + L2_CKV + row * 272 + c * 2) = pack8(f);
  }
  __syncthreads();
  kv_expand(p, lds, wave, lane, NP + b * SKV + j0);
  __syncthreads();
}

DI void phase2(const Params& p, unsigned char* lds) {
  constexpr int NTT = NT / 32, NCT = DB * PAST / 32;
  {
    bf16_t* vT = (bf16_t*)((unsigned char*)p.out + OO_VT);
    for (int id = blockIdx.x * NTHREADS + tidx(); id < 8 * 64 * 64; id += gridDim.x * NTHREADS) vT[(size_t)(id >> 6) * NKVP + NKV + (id & 63)] = 0;
  }
  unsigned* ctr2 = (unsigned*)(p.ws + O_CTR) + 16;
  volatile int* s_itemp = (volatile int*)(lds + LDS_CTRL);
  for (;;) {
    if (tidx() == 0) *s_itemp = (int)atomicAdd(ctr2, 1u);
    __syncthreads();
    const int item = *s_itemp;
    __syncthreads();
    if (item >= 2 * NTT + NCT) break;
    if (item < NTT) p2_token_tile_b(p, lds, item);
    else if (item < 2 * NTT) p2_token_tile_a(p, lds, item - NTT);
    else p2_cache_tile(p, lds, item - 2 * NTT);
  }
}

constexpr int AT_KSTRIDE = 208, AT_VSTRIDE = 136, AT_KBYTES = 64 * AT_KSTRIDE, AT_STAGE = AT_KBYTES + 64 * AT_VSTRIDE;

DI void attn_item(const Params& p, unsigned char* lds, int hd, int qtok0, int nact, int slot0, int ntiles, int nvalid, bool causal) {
  const int tid = tidx(), wave = __builtin_amdgcn_readfirstlane(tid >> 6), lane = tid & 63, r = lane & 31, h = lane >> 5;
  const bf16_t* Q = (const bf16_t*)((const unsigned char*)p.out + OO_Q);
  const bf16_t* knb = (const bf16_t*)(p.ws + O_KNB) + (size_t)hd * NKVP * 64;
  const bf16_t* kpeb = (const bf16_t*)(p.ws + O_KPEB);
  const bf16_t* vT = (const bf16_t*)((const unsigned char*)p.out + OO_VT) + (size_t)hd * 64 * NKVP;
  bf16_t* YB = (bf16_t*)(p.ws + O_YB);
  const bool active = wave < nact;
  const int qtok = qtok0 + 32 * wave;
  const int wlim = !active ? 0 : (causal ? (qtok >> 6) + 1 : ntiles);
  bf16x8 qf[6];
  if (active) {
#pragma unroll
    for (int ks = 0; ks < 6; ++ks) qf[ks] = *(const bf16x8*)(Q + (size_t)(qtok + r) * 768 + 96 * hd + ks * 16 + h * 8);
  } else {
#pragma unroll
    for (int ks = 0; ks < 6; ++ks) qf[ks] = (bf16x8){0, 0, 0, 0, 0, 0, 0, 0};
  }
  f32x16 o0, o1;
#pragma unroll
  for (int i = 0; i < 16; ++i) { o0[i] = 0.f; o1[i] = 0.f; }
  float mrun = 0.f, lsum = 0.f;
  const int k_key = tid >> 3, k_ch = tid & 7;
  const int pe_key = (tid & 255) >> 2, pe_ch = tid & 3;
  const int v_dim = tid >> 3, v_ch = tid & 7;
  u32x4 rk, rpe, rv;
  auto gload = [&](int kt) {
    const int s = slot0 + kt * 64;
    rk = *(const u32x4*)(knb + (size_t)(s + k_key) * 64 + k_ch * 8);
    if (tid < 256) rpe = *(const u32x4*)(kpeb + (size_t)(s + pe_key) * 32 + pe_ch * 8);
    rv = *(const u32x4*)(vT + (size_t)v_dim * NKVP + s + v_ch * 8);
  };
  auto lstore = [&](int buf) {
    unsigned char* b = lds + buf * AT_STAGE;
    *(u32x4*)(b + k_key * AT_KSTRIDE + k_ch * 16) = rk;
    if (tid < 256) *(u32x4*)(b + pe_key * AT_KSTRIDE + 128 + pe_ch * 16) = rpe;
    u32x2 lo = {rv[0], rv[1]}, hi = {rv[2], rv[3]};
    *(u32x2*)(b + AT_KBYTES + v_dim * AT_VSTRIDE + v_ch * 16) = lo;
    *(u32x2*)(b + AT_KBYTES + v_dim * AT_VSTRIDE + v_ch * 16 + 8) = hi;
  };
  gload(0); lstore(0);
  __syncthreads();
  for (int kt = 0; kt < ntiles; ++kt) {
    const bool more = kt + 1 < ntiles;
    if (more) gload(kt + 1);
    if (kt < wlim) {
      const unsigned char* kb = lds + (kt & 1) * AT_STAGE;
      const unsigned char* vb = kb + AT_KBYTES;
      f32x16 s0, s1;
      const float nm = -mrun;
#pragma unroll
      for (int i = 0; i < 16; ++i) { s0[i] = nm; s1[i] = nm; }
#pragma unroll
      for (int ks = 0; ks < 6; ++ks) {
        const bf16x8 a0 = *(const bf16x8*)(kb + r * AT_KSTRIDE + ks * 32 + h * 16);
        const bf16x8 a1 = *(const bf16x8*)(kb + (32 + r) * AT_KSTRIDE + ks * 32 + h * 16);
        s0 = MFMA32(a0, qf[ks], s0);
        s1 = MFMA32(a1, qf[ks], s1);
      }
      if (kt * 64 + 64 > nvalid) {
#pragma unroll
        for (int i = 0; i < 16; ++i) {
          const int key = kt * 64 + crow(i, h);
          if (key >= nvalid) s0[i] = -1e30f;
          if (key + 32 >= nvalid) s1[i] = -1e30f;
        }
      }
      float mx = s0[0];
#pragma unroll
      for (int i = 1; i < 16; ++i) mx = fmaxf(mx, s0[i]);
#pragma unroll
      for (int i = 0; i < 16; ++i) mx = fmaxf(mx, s1[i]);
      mx = fmaxf(mx, __shfl_xor(mx, 32));
      const bool far = fabsf(mx) > 20.f && mx > -1e29f;
      if (__builtin_amdgcn_ballot_w64(far) != 0ull) {
        const float delta = far ? mx : 0.f;
        const float alpha = __builtin_amdgcn_exp2f(-delta);
        mrun += delta; lsum *= alpha;
#pragma unroll
        for (int i = 0; i < 16; ++i) { o0[i] *= alpha; o1[i] *= alpha; s0[i] -= delta; s1[i] -= delta; }
      }
      float rs = 0.f;
#pragma unroll
      for (int i = 0; i < 16; ++i) { s0[i] = __builtin_amdgcn_exp2f(s0[i]); rs += s0[i]; }
#pragma unroll
      for (int i = 0; i < 16; ++i) { s1[i] = __builtin_amdgcn_exp2f(s1[i]); rs += s1[i]; }
      lsum += rs;
#pragma unroll
      for (int mt = 0; mt < 2; ++mt)
#pragma unroll
        for (int s = 0; s < 2; ++s) {
          const f32x16& sv = mt ? s1 : s0;
          u32x4 pw;
          pw[0] = pk2(sv[8 * s], sv[8 * s + 1]); pw[1] = pk2(sv[8 * s + 2], sv[8 * s + 3]);
          pw[2] = pk2(sv[8 * s + 4], sv[8 * s + 5]); pw[3] = pk2(sv[8 * s + 6], sv[8 * s + 7]);
          const bf16x8 pb = __builtin_bit_cast(bf16x8, pw);
          const int kbase = mt * 32 + 16 * s + 4 * h;
          {
            const s16x4 lo = *(const s16x4*)(vb + r * AT_VSTRIDE + kbase * 2);
            const s16x4 hi = *(const s16x4*)(vb + r * AT_VSTRIDE + (kbase + 8) * 2);
            const bf16x8 av = __builtin_shufflevector(lo, hi, 0, 1, 2, 3, 4, 5, 6, 7);
            o0 = MFMA32(av, pb, o0);
          }
          {
            const s16x4 lo = *(const s16x4*)(vb + (32 + r) * AT_VSTRIDE + kbase * 2);
            const s16x4 hi = *(const s16x4*)(vb + (32 + r) * AT_VSTRIDE + (kbase + 8) * 2);
            const bf16x8 av = __builtin_shufflevector(lo, hi, 0, 1, 2, 3, 4, 5, 6, 7);
            o1 = MFMA32(av, pb, o1);
          }
        }
    }
    if (more) lstore((kt + 1) & 1);
    __syncthreads();
  }
  if (active) {
    const float lt = lsum + __shfl_xor(lsum, 32);
    const float inv = 1.f / lt;
    bf16_t* dst = YB + (size_t)(qtok + r) * 512 + hd * 64;
#pragma unroll
    for (int g = 0; g < 4; ++g) {
      u32x2 a, b;
      a[0] = pk2(o0[4 * g] * inv, o0[4 * g + 1] * inv); a[1] = pk2(o0[4 * g + 2] * inv, o0[4 * g + 3] * inv);
      b[0] = pk2(o1[4 * g] * inv, o1[4 * g + 1] * inv); b[1] = pk2(o1[4 * g + 2] * inv, o1[4 * g + 3] * inv);
      *(u32x2*)(dst + 8 * g + 4 * h) = a;
      *(u32x2*)(dst + 32 + 8 * g + 4 * h) = b;
    }
  }
}

constexpr int SC_TOK = 32, SC_ARR = SC_TOK * 64 * 4, SC_STAGE = 5 * SC_ARR + SC_TOK * 32 * 4;
static_assert(2 * SC_STAGE <= LDS_BYTES, "lds scan");
template <bool DUAL>
DI void scan_job(const Params& p, unsigned char* lds, int head, int rowgrp, int tok0, int nsteps, int init_mode  ,
                 const float* init  , bool use_v, bf16_t* Y  , float* state_out  , bf16_t* Y2 = nullptr, float* state2 = nullptr) {
  const int tid = tidx(), wave = __builtin_amdgcn_readfirstlane(tid >> 6), lane = tid & 63;
  const bf16_t* SR = (const bf16_t*)(p.ws + O_SIN);
  const bf16_t* SK = SR + (size_t)NT * 512; const bf16_t* SV = SK + (size_t)NT * 512; const bf16_t* SA = SV + (size_t)NT * 512; const bf16_t* SB = SA + (size_t)NT * 512;
  const _Float16* SW = (const _Float16*)(SB + (size_t)NT * 512);
  u32x4 rg[3];
  auto gload = [&](int c) {
    const int tb = tok0 + c * SC_TOK;
#pragma unroll
    for (int i = 0; i < 3; ++i) {
      const int L = tid + NTHREADS * i;
      if (L < 1280) {
        const int arr = L >> 8, tok = (L & 255) >> 3, ch = L & 7;
        const bf16_t* base = arr == 0 ? SA : arr == 1 ? SB : arr == 2 ? (const bf16_t*)SW : arr == 3 ? SK : SR;
        rg[i] = *(const u32x4*)(base + (size_t)(tb + tok) * 512 + head * 64 + ch * 8);
      } else if (L < 1408) {
        const int vl = L - 1280, tok = vl >> 2, hf = vl & 3;
        rg[i] = *(const u32x4*)(SV + (size_t)(tb + tok) * 512 + head * 64 + rowgrp * 32 + hf * 8);
      }
    }
  };
  auto lstore = [&](int buf) {
    unsigned char* b = lds + buf * SC_STAGE;
#pragma unroll
    for (int i = 0; i < 3; ++i) {
      const int L = tid + NTHREADS * i;
      float f[8];
      if (L < 1280) {
        const int arr = L >> 8, tok = (L & 255) >> 3, ch = L & 7;
        if (arr == 2) {
#pragma unroll
          for (int j = 0; j < 4; ++j) {
            const unsigned u = rg[i][j];
            f[2 * j] = (float)__builtin_bit_cast(_Float16, (unsigned short)(u & 0xffffu));
            f[2 * j + 1] = (float)__builtin_bit_cast(_Float16, (unsigned short)(u >> 16));
          }
        } else unpack8(rg[i], f);
        float* d = (float*)(b + arr * SC_ARR + tok * 256 + ch * 32);
        *(f32x4*)d = (f32x4){f[0], f[1], f[2], f[3]};
        *(f32x4*)(d + 4) = (f32x4){f[4], f[5], f[6], f[7]};
      } else if (L < 1408) {
        const int vl = L - 1280, tok = vl >> 2, hf = vl & 3;
        unpack8(rg[i], f);
        if (!use_v) {
#pragma unroll
          for (int j = 0; j < 8; ++j) f[j] = 0.f;
        }
        float* d = (float*)(b + 5 * SC_ARR + tok * 128 + hf * 32);
        *(f32x4*)d = (f32x4){f[0], f[1], f[2], f[3]};
        *(f32x4*)(d + 4) = (f32x4){f[4], f[5], f[6], f[7]};
      }
    }
  };
  const int rl = lane >> 4, c = lane & 15;
  const int vrow = rowgrp * 32 + 4 * wave + rl;
  f32x4 s = {0.f, 0.f, 0.f, 0.f};
  if (init_mode == 1) s = *(const f32x4*)(init + vrow * 64 + 4 * c);
  if (init_mode == 2) { s[0] = (4 * c == vrow) ? 1.f : 0.f; s[1] = (4 * c + 1 == vrow) ? 1.f : 0.f; s[2] = (4 * c + 2 == vrow) ? 1.f : 0.f; s[3] = (4 * c + 3 == vrow) ? 1.f : 0.f; }
  f32x4 s2 = {(4 * c == vrow) ? 1.f : 0.f, (4 * c + 1 == vrow) ? 1.f : 0.f, (4 * c + 2 == vrow) ? 1.f : 0.f, (4 * c + 3 == vrow) ? 1.f : 0.f};
  gload(0); lstore(0);
  __syncthreads();
  const int nch = nsteps / SC_TOK;
  for (int ci = 0; ci < nch; ++ci) {
    const bool more = ci + 1 < nch;
    if (more) gload(ci + 1);
    {
      const unsigned char* b = lds + (ci & 1) * SC_STAGE + c * 16;
      const unsigned char* bv = lds + (ci & 1) * SC_STAGE + 5 * SC_ARR + (4 * wave + rl) * 4;
      bf16_t* yp = Y + (size_t)(tok0 + ci * SC_TOK + c) * 512 + head * 64 + vrow;
      bf16_t* yp2 = DUAL ? Y2 + (size_t)(tok0 + ci * SC_TOK + c) * 512 + head * 64 + vrow : nullptr;
      f32x4 A4[3], B4[3], W4[3], K4[3], R4[3]; float V1[3];
#define SC_LOAD(slot, t)                                                                                          \
      { A4[slot] = *(const f32x4*)(b + 0 * SC_ARR + (t) * 256); B4[slot] = *(const f32x4*)(b + 1 * SC_ARR + (t) * 256);    \
        W4[slot] = *(const f32x4*)(b + 2 * SC_ARR + (t) * 256); K4[slot] = *(const f32x4*)(b + 3 * SC_ARR + (t) * 256);    \
        R4[slot] = *(const f32x4*)(b + 4 * SC_ARR + (t) * 256); V1[slot] = *(const float*)(bv + (t) * 128); }
      SC_LOAD(0, 0) SC_LOAD(1, 1)
      float ysel = 0.f, ysel2 = 0.f;
#pragma unroll
      for (int t = 0; t < SC_TOK; ++t) {
        if (t + 2 < SC_TOK) SC_LOAD((t + 2) % 3, t + 2)
        const f32x4 a4 = A4[t % 3], b4 = B4[t % 3], w4 = W4[t % 3], k4 = K4[t % 3], r4 = R4[t % 3];
        const float vv = V1[t % 3];
        const f32x4 vk = vv * k4;
        float sa = (s[0] * a4[0] + s[2] * a4[2]) + (s[1] * a4[1] + s[3] * a4[3]);
        sa = dpp_sum16(sa);
        s = s * w4 + (sa * b4 + vk);
        float y = (s[0] * r4[0] + s[2] * r4[2]) + (s[1] * r4[1] + s[3] * r4[3]);
        y = dpp_sum16(y);
        ysel = (c == (t & 15)) ? y : ysel;
        if ((t & 15) == 15) yp[(size_t)(t - 15) * 512] = f2bf(ysel);
        if (DUAL) {
          float sb = (s2[0] * a4[0] + s2[2] * a4[2]) + (s2[1] * a4[1] + s2[3] * a4[3]);
          sb = dpp_sum16(sb);
          s2 = s2 * w4 + sb * b4;
          float y2 = (s2[0] * r4[0] + s2[2] * r4[2]) + (s2[1] * r4[1] + s2[3] * r4[3]);
          y2 = dpp_sum16(y2);
          ysel2 = (c == (t & 15)) ? y2 : ysel2;
          if ((t & 15) == 15) yp2[(size_t)(t - 15) * 512] = f2bf(ysel2);
        }
      }
#undef SC_LOAD
    }
    if (more) lstore((ci + 1) & 1);
    __syncthreads();
  }
  *(f32x4*)(state_out + vrow * 64 + 4 * c) = s;
  if (DUAL) *(f32x4*)(state2 + vrow * 64 + 4 * c) = s2;
}

constexpr int Q_PSCAN = 8 * (2 + 2 * (SCC - 1)), Q_PATT = 512, Q_SATT = 128, Q_SSCAN = 256, Q_TOTAL = Q_PSCAN + Q_PATT + Q_SATT + Q_SSCAN;
DI void phase3(const Params& p, unsigned char* lds) {
  volatile int* s_itemp = (volatile int*)(lds + LDS_CTRL);
  unsigned* ctr = (unsigned*)(p.ws + O_CTR);
  float* Gb = (float*)((unsigned char*)p.out + OO_GH);
  float* Hb = Gb + (size_t)8 * SCC * 4096;
  bf16_t* Y = (bf16_t*)(p.ws + O_Y);
  bf16_t* E = (bf16_t*)(p.ws + O_E);
  for (;;) {
    if (tidx() == 0) *s_itemp = (int)atomicAdd(ctr, 1u);
    __syncthreads();
    const int item = *s_itemp;
    __syncthreads();
    if (item >= Q_TOTAL) break;
    if (item < Q_PSCAN) {
      const int hd = item / (2 + 2 * (SCC - 1)), j = item % (2 + 2 * (SCC - 1));
      if (j < 2) scan_job<false>(p, lds, hd, j, 0, SCL, 0, nullptr, true, Y, Hb + ((size_t)hd * SCC) * 4096);
      else {
        const int jj = j - 2, c = 1 + (jj >> 1), k = jj & 1;
        scan_job<true>(p, lds, hd, k, c * SCL, SCL, 0, nullptr, true, Y, Hb + ((size_t)hd * SCC + c) * 4096, E, Gb + ((size_t)hd * SCC + c) * 4096);
      }
    } else if (item < Q_PSCAN + Q_PATT) {
      const int k = item - Q_PSCAN, qb = 63 - (k >> 3), hd = k & 7;
      attn_item(p, lds, hd, qb * 256, 8, 0, qb * 4 + 4, (qb * 4 + 4) * 64, true);
    } else if (item < Q_PSCAN + Q_PATT + Q_SATT) {
      const int k = item - Q_PSCAN - Q_PATT, b = k >> 3, hd = k & 7;
      attn_item(p, lds, hd, NP + b * 32, 1, NP + b * SKV, 17, SKV, false);
    } else {
      const int k = item - Q_PSCAN - Q_PATT - Q_SATT, b = k >> 4, hd = (k & 15) >> 1, rg = k & 1;
      scan_job<false>(p, lds, hd, rg, NP + b * 32, 32, 1, p.in[4] + ((size_t)b * 8 + hd) * 4096, true, Y, p.out + F_WKVS + ((size_t)b * 8 + hd) * 4096);
    }
  }
}

DI void phase3b(const Params& p, unsigned char* lds) {
  if (blockIdx.x >= 8) return;
  const int hd = blockIdx.x, tid = tidx();
  const float* Gb = (const float*)((unsigned char*)p.out + OO_GH);
  const float* Hb = Gb + (size_t)8 * SCC * 4096;
  bf16_t* SST = (bf16_t*)((unsigned char*)p.out + OO_SST);
  float* S = (float*)lds;
  float* Gs = S + 64 * 65;
  const int v = tid >> 3, k0 = (tid & 7) * 8;
  float cur[8];
#pragma unroll
  for (int j = 0; j < 8; ++j) cur[j] = Hb[((size_t)hd * SCC) * 4096 + v * 64 + k0 + j];
  for (int c = 1; c < SCC; ++c) {
    __syncthreads();
#pragma unroll
    for (int j = 0; j < 8; ++j) { S[v * 65 + k0 + j] = cur[j]; Gs[v * 64 + k0 + j] = Gb[((size_t)hd * SCC + c) * 4096 + v * 64 + k0 + j]; }
    *(u32x4*)(SST + ((size_t)c * 8 + hd) * 4096 + v * 64 + k0) = pack8(cur);
    __syncthreads();
    float o[8];
#pragma unroll
    for (int j = 0; j < 8; ++j) o[j] = Hb[((size_t)hd * SCC + c) * 4096 + v * 64 + k0 + j];
    for (int i = 0; i < 64; ++i) {
      const float sv = S[v * 65 + i];
      const f32x4 g0 = *(const f32x4*)(Gs + i * 64 + k0), g1 = *(const f32x4*)(Gs + i * 64 + k0 + 4);
      o[0] += sv * g0[0]; o[1] += sv * g0[1]; o[2] += sv * g0[2]; o[3] += sv * g0[3];
      o[4] += sv * g1[0]; o[5] += sv * g1[1]; o[6] += sv * g1[2]; o[7] += sv * g1[3];
    }
#pragma unroll
    for (int j = 0; j < 8; ++j) cur[j] = o[j];
  }
  float* dst = p.out + F_WKVP + (size_t)hd * 4096 + v * 64 + k0;
  *(f32x4*)dst = (f32x4){cur[0], cur[1], cur[2], cur[3]};
  *(f32x4*)(dst + 4) = (f32x4){cur[4], cur[5], cur[6], cur[7]};
}

DI void phase4a(const Params& p) {
  const int tid = tidx(), lane = tid & 63, r = lane & 31, hh = lane >> 5;
  const int gw = (blockIdx.x * NTHREADS + tid) >> 6, ngw = (gridDim.x * NTHREADS) >> 6;
  const bf16_t* Y = (const bf16_t*)(p.ws + O_Y);
  const bf16_t* E = (const bf16_t*)(p.ws + O_E);
  const bf16_t* SST = (const bf16_t*)((unsigned char*)p.out + OO_SST);
  const bf16_t* SV = (const bf16_t*)(p.ws + O_SIN) + 2 * (size_t)NT * 512;
  const bf16_t* G = (const bf16_t*)(p.ws + O_G);
  const float* RK = (const float*)(p.ws + O_RK);
  bf16_t* YA = (bf16_t*)(p.ws + O_YA);
  for (int task = gw; task < (NT / 32) * 8; task += ngw) {
    const int tile = task >> 3, hd = task & 7, t0 = tile * 32, t = t0 + r;
    f32x16 acc[2];
#pragma unroll
    for (int i = 0; i < 16; ++i) { acc[0][i] = 0.f; acc[1][i] = 0.f; }
    const int c = t0 < NP ? t0 / SCL : 0;
    if (c >= 1) {
      const bf16_t* sst = SST + ((size_t)c * 8 + hd) * 4096;
#pragma unroll
      for (int ks = 0; ks < 4; ++ks) {
        const bf16x8 bv = *(const bf16x8*)(E + (size_t)t * 512 + hd * 64 + ks * 16 + hh * 8);
#pragma unroll
        for (int mt = 0; mt < 2; ++mt) {
          const bf16x8 av = *(const bf16x8*)(sst + (mt * 32 + r) * 64 + ks * 16 + hh * 8);
          acc[mt] = MFMA32(av, bv, acc[mt]);
        }
      }
    }
    float sum = 0.f;
#pragma unroll
    for (int mt = 0; mt < 2; ++mt)
#pragma unroll
      for (int g = 0; g < 4; ++g) {
        const u32x2 yv = *(const u32x2*)(Y + (size_t)t * 512 + hd * 64 + mt * 32 + 8 * g + 4 * hh);
        acc[mt][4 * g] += __uint_as_float(yv[0] << 16); acc[mt][4 * g + 1] += __uint_as_float(yv[0] & 0xffff0000u);
        acc[mt][4 * g + 2] += __uint_as_float(yv[1] << 16); acc[mt][4 * g + 3] += __uint_as_float(yv[1] & 0xffff0000u);
        sum += (acc[mt][4 * g] + acc[mt][4 * g + 1]) + (acc[mt][4 * g + 2] + acc[mt][4 * g + 3]);
      }
    sum += __shfl_xor(sum, 32);
    const float mean = sum * (1.f / 64.f);
    float sq = 0.f;
#pragma unroll
    for (int mt = 0; mt < 2; ++mt)
#pragma unroll
      for (int i = 0; i < 16; ++i) { const float d = acc[mt][i] - mean; sq += d * d; }
    sq += __shfl_xor(sq, 32);
    const float rstd = rsqrtf(sq * (1.f / 64.f) + 64e-5f);
    const float bon = RK[(size_t)t * 8 + hd];
#pragma unroll
    for (int mt = 0; mt < 2; ++mt)
#pragma unroll
      for (int g = 0; g < 4; ++g) {
        const int c0 = hd * 64 + mt * 32 + 8 * g + 4 * hh;
        const size_t o = (size_t)t * 512 + c0;
        const f32x4 lg = *(const f32x4*)(p.in[16] + c0), lb = *(const f32x4*)(p.in[17] + c0);
        const u32x2 vv = *(const u32x2*)(SV + o), gg = *(const u32x2*)(G + o);
        const float vf[4] = {__uint_as_float(vv[0] << 16), __uint_as_float(vv[0] & 0xffff0000u), __uint_as_float(vv[1] << 16), __uint_as_float(vv[1] & 0xffff0000u)};
        const float gf[4] = {__uint_as_float(gg[0] << 16), __uint_as_float(gg[0] & 0xffff0000u), __uint_as_float(gg[1] << 16), __uint_as_float(gg[1] & 0xffff0000u)};
        float ov[4];
#pragma unroll
        for (int j = 0; j < 4; ++j) ov[j] = ((acc[mt][4 * g + j] - mean) * rstd * lg[j] + lb[j] + bon * vf[j]) * gf[j];
        u32x2 w; w[0] = pk2(ov[0], ov[1]); w[1] = pk2(ov[2], ov[3]);
        *(u32x2*)(YA + o) = w;
      }
  }
  conv_x(p, (bf16_t*)((unsigned char*)p.out + OO_XB), blockIdx.x * NTHREADS + tidx(), gridDim.x * NTHREADS);
}

DI bool small_tile_of_block(int& m0, int& n0) {
  const int j = blockIdx.x >> 3;
  if (gridDim.x != 256 || (blockIdx.x & 7) != (j & 7)) return false;
  m0 = NP + (j >> 3) * 128; n0 = (j & 7) * 128; return true;
}
template <int TM>
DI void p4_tile(const Params& p, unsigned char* lds, int m0, int n0) {
  const bf16_t* XB = (const bf16_t*)((unsigned char*)p.out + OO_XB);
  const bf16_t* WIN = (const bf16_t*)(p.ws + O_WIN);
  const bf16_t* YA = (const bf16_t*)(p.ws + O_YA);
  const bf16_t* YB = (const bf16_t*)(p.ws + O_YB);
  bf16_t* M = (bf16_t*)(p.ws + O_M);
  const int tid = tidx(), lane = tid & 63, h = lane >> 5, wn = __builtin_amdgcn_readfirstlane(tid >> 6) >> 2;
  f32x16 accg[TM][2], accv[TM][2];
  gemm_mainloop<TM, 2>(YB, 512, (const bf16_t*)(p.ws + O_WPB), 512, 512, m0, n0, 1024, accv, lds);
  gemm_mainloop<TM, 2>(XB, DM, WIN + (size_t)(PABC + 1024) * DM, DM, DM, m0, n0, 1024, accg, lds);
#pragma unroll
  for (int tn = 0; tn < 2; ++tn)
#pragma unroll
    for (int g = 0; g < 4; ++g) {
      const f32x4 bg = *(const f32x4*)(p.in[24] + 1024 + n0 + wn * 64 + tn * 32 + 8 * g + 4 * h);
#pragma unroll
      for (int tm = 0; tm < TM; ++tm)
#pragma unroll
        for (int j = 0; j < 4; ++j) accv[tm][tn][4 * g + j] *= sigmoidf_(accg[tm][tn][4 * g + j] + bg[j]);
      __builtin_amdgcn_sched_barrier(0);
    }
  gemm_mainloop<TM, 2>(XB, DM, WIN + (size_t)PABC * DM, DM, DM, m0, n0, 1024, accg, lds);
#pragma unroll
  for (int tn = 0; tn < 2; ++tn)
#pragma unroll
    for (int g = 0; g < 4; ++g) {
      const f32x4 bg = *(const f32x4*)(p.in[24] + n0 + wn * 64 + tn * 32 + 8 * g + 4 * h);
#pragma unroll
      for (int tm = 0; tm < TM; ++tm)
#pragma unroll
        for (int j = 0; j < 4; ++j) {
          const float e = __expf(-(accg[tm][tn][4 * g + j] + bg[j]));
          accv[tm][tn][4 * g + j] *= (1.f + e);
          accg[tm][tn][4 * g + j] = 1.f / (1.f + e);
        }
      __builtin_amdgcn_sched_barrier(0);
    }
  gemm_mainloop<TM, 2, false>(YA, 512, (const bf16_t*)(p.ws + O_WPA), 512, 512, m0, n0, 1024, accv, lds);
  epilogue_bf16<TM, 2, 128>(accv, lds, M, DM, m0, n0, DM, [&](int tm, int tn, int g, int, int) { return acc4(accg[tm][tn], g) * acc4(accv[tm][tn], g); });
}
DI void phase4(const Params& p, unsigned char* lds) {
  if (gridDim.x == 256) {
    TileIter ti; ti.init(NP / 256, 8);
    int tmi, tni;
    while (ti.next(tmi, tni)) p4_tile<2>(p, lds, tmi * 256, tni * 128);
    int m0, n0;
    if (small_tile_of_block(m0, n0)) p4_tile<1>(p, lds, m0, n0);
  } else {
    TileIter ti; ti.init(NT / 128, 8);
    int tmi, tni;
    while (ti.next(tmi, tni)) p4_tile<1>(p, lds, tmi * 128, tni * 128);
  }
}

template <int TM, int TN, int NST>
DI void p5_tile(const Params& p, unsigned char* lds, int m0, int n0) {
  const bf16_t* M = (const bf16_t*)(p.ws + O_M);
  bf16_t* Z = (bf16_t*)(p.ws + O_Z);
  f32x16 acc[TM][TN];
  gemm_mainloop<TM, TN, true, NST>(M, DM, (const bf16_t*)(p.ws + O_WO), DM, DM, m0, n0, 1024, acc, lds);
  epilogue_bf16<TM, TN, 64 * TN>(acc, lds, Z, DM, m0, n0, DM, [&](int tm, int tn, int g, int rowl, int coll) {
    const f32x4 xv = *(const f32x4*)(xrow(p, m0 + rowl) + n0 + coll);
    return xv * DN_ALPHA + acc4(acc[tm][tn], g);
  });
}
DI void phase5(const Params& p, unsigned char* lds) {
  if (gridDim.x == 256) {
    TileIter ti; ti.init(NP / 256, 4);
    int tmi, tni;
    while (ti.next(tmi, tni)) p5_tile<2, 4, 2>(p, lds, tmi * 256, tni * 256);
    int m0, n0;
    if (small_tile_of_block(m0, n0)) p5_tile<1, 2, 3>(p, lds, m0, n0);
  } else {
    TileIter ti; ti.init(NT / 256, 8);
    int tmi, tni;
    while (ti.next(tmi, tni)) p5_tile<2, 2, 3>(p, lds, tmi * 256, tni * 128);
  }
}
template <bool OUT_BF16>
DI void ln_rows(const bf16_t* src, const float* g, const float* b, bf16_t* dst16, float* dst32) {
  const int gw = (blockIdx.x * NTHREADS + tidx()) >> 6, ngw = (gridDim.x * NTHREADS) >> 6, lane = tidx() & 63;
  for (int t = gw; t < NT; t += ngw) {
    const u32x4* xr = (const u32x4*)(src + (size_t)t * DM) + lane;
    float v[16]; float s = 0.f;
#pragma unroll
    for (int j = 0; j < 2; ++j) { unpack8(xr[64 * j], v + 8 * j); }
#pragma unroll
    for (int j = 0; j < 16; ++j) s += v[j];
    const float mean = wave_sum(s) * (1.f / DM);
    float s2 = 0.f;
#pragma unroll
    for (int j = 0; j < 16; ++j) { v[j] -= mean; s2 += v[j] * v[j]; }
    const float rstd = rsqrtf(wave_sum(s2) * (1.f / DM) + 1e-5f);
#pragma unroll
    for (int j = 0; j < 2; ++j) {
      const int c = 8 * lane + 512 * j;
      const f32x4 g0 = *(const f32x4*)(g + c), g1 = *(const f32x4*)(g + c + 4), b0 = *(const f32x4*)(b + c), b1 = *(const f32x4*)(b + c + 4);
      float o[8];
#pragma unroll
      for (int q = 0; q < 4; ++q) { o[q] = v[8 * j + q] * rstd * g0[q] + b0[q]; o[4 + q] = v[8 * j + 4 + q] * rstd * g1[q] + b1[q]; }
      if (OUT_BF16) *(u32x4*)(dst16 + (size_t)t * DM + c) = pack8(o);
      else { *(f32x4*)(dst32 + (size_t)t * DM + c) = (f32x4){o[0], o[1], o[2], o[3]}; *(f32x4*)(dst32 + (size_t)t * DM + c + 4) = (f32x4){o[4], o[5], o[6], o[7]}; }
    }
  }
}

DI void phase6(const Params& p, unsigned char* lds) {
  const bf16_t* H = (const bf16_t*)(p.ws + O_H);
  bf16_t* ACT = (bf16_t*)(p.ws + O_ACT);
  constexpr int NMT = NT / 256, NNT = 5632 / 256;
  TileIter ti; ti.init(NMT, NNT);
  int tmi, tni;
  while (ti.next(tmi, tni)) {
    const int m0 = tmi * 256, n0 = tni * 256;
    f32x16 acc[2][4];
    gemm_mainloop<2, 4, true, 2>(H, DM, (const bf16_t*)(p.ws + O_WGU), DM, DM, m0, n0, 5632, acc, lds);
    epilogue_bf16<2, 4, 128>(acc, lds, ACT, DFF, m0, tni * 128, DFF, [&](int tm, int q, int g, int, int) {
      f32x4 o;
#pragma unroll
      for (int j = 0; j < 4; ++j) { const float gte = acc[tm][2 * q][4 * g + j], up = acc[tm][2 * q + 1][4 * g + j]; o[j] = gte * sigmoidf_(gte) * up; }
      return o;
    });
  }
}
template <int TM, int TN, int NST>
DI void p7_tile(const Params& p, unsigned char* lds, int m0, int n0) {
  const bf16_t* H = (const bf16_t*)(p.ws + O_H);
  const bf16_t* ACT = (const bf16_t*)(p.ws + O_ACT);
  bf16_t* Z2 = (bf16_t*)(p.ws + O_Z2);
  f32x16 acc[TM][TN];
  gemm_mainloop<TM, TN, true, NST>(ACT, DFF, (const bf16_t*)(p.ws + O_WDN), DFF, DFF, m0, n0, 1024, acc, lds);
  epilogue_bf16<TM, TN, 64 * TN>(acc, lds, Z2, DM, m0, n0, DM, [&](int tm, int tn, int g, int rowl, int coll) {
    const u32x2 hv = *(const u32x2*)(H + (size_t)(m0 + rowl) * DM + n0 + coll);
    const f32x4 hf = {__uint_as_float(hv[0] << 16), __uint_as_float(hv[0] & 0xffff0000u), __uint_as_float(hv[1] << 16), __uint_as_float(hv[1] & 0xffff0000u)};
    return hf * DN_ALPHA + acc4(acc[tm][tn], g);
  });
}
DI void phase7(const Params& p, unsigned char* lds) {
  if (gridDim.x == 256) {
    TileIter ti; ti.init(NP / 256, 4);
    int tmi, tni;
    while (ti.next(tmi, tni)) p7_tile<2, 4, 2>(p, lds, tmi * 256, tni * 256);
    int m0, n0;
    if (small_tile_of_block(m0, n0)) p7_tile<1, 2, 3>(p, lds, m0, n0);
  } else {
    TileIter ti; ti.init(NT / 256, 8);
    int tmi, tni;
    while (ti.next(tmi, tni)) p7_tile<2, 2, 3>(p, lds, tmi * 256, tni * 128);
  }
}

DI void run_phase(const Params& p, unsigned char* lds, int ph) {
  switch (ph) {
    case 0: phase0(p, lds); break;
    case 1: phase1(p, lds); break;
    case 2: phase2(p, lds); break;
    case 3: phase3(p, lds); break;
    case 4: phase4a(p); break;
    case 5: phase4(p, lds); break;
    case 6: phase5(p, lds); break;
    case 7: ln_rows<true>((const bf16_t*)(p.ws + O_Z), p.in[26], p.in[27], (bf16_t*)(p.ws + O_H), nullptr); break;
    case 8: phase6(p, lds); break;
    case 9: phase7(p, lds); break;
    case 11: phase3b(p, lds); break;
    case 10: ln_rows<false>((const bf16_t*)(p.ws + O_Z2), p.in[30], p.in[31], nullptr, p.out + F_Y); break;
  }
}
constexpr int NPHASES = 11;

DI unsigned ctl_ld(unsigned* p) { return __hip_atomic_load(p, __ATOMIC_RELAXED, __HIP_MEMORY_SCOPE_AGENT); }
DI unsigned ctl_add(unsigned* p, unsigned v) { return __hip_atomic_fetch_add(p, v, __ATOMIC_RELAXED, __HIP_MEMORY_SCOPE_AGENT); }
DI void xbar(unsigned* ctl, unsigned x, unsigned nloc, unsigned nx, unsigned k) {
  asm volatile("s_waitcnt vmcnt(0)" ::: "memory");
  __syncthreads();
  if (threadIdx.x == 0) {
    const unsigned old = ctl_add(&ctl[(24 + x) * 64], 1u);
    if (old + 1u == k * nloc) {
      __builtin_amdgcn_fence(__ATOMIC_RELEASE, "agent");
      asm volatile("s_waitcnt vmcnt(0)" ::: "memory");
      ctl_add(&ctl[40 * 64], 1u);
    }
    while (ctl_ld(&ctl[40 * 64]) < k * nx) __builtin_amdgcn_s_sleep(1);
    __builtin_amdgcn_fence(__ATOMIC_ACQUIRE, "agent");
    asm volatile("s_waitcnt vmcnt(0)" ::: "memory");
  }
  __syncthreads();
}

__global__ void __launch_bounds__(NTHREADS) mega_kernel(Params p) {
  extern __shared__ __attribute__((aligned(16))) unsigned char lds[];
  volatile unsigned* s_bar = (volatile unsigned*)(lds + LDS_CTRL + 16);
  cg::grid_group grid = cg::this_grid();
  unsigned* ctl = (unsigned*)(p.ws + O_CTR);
  const unsigned x = (unsigned)__builtin_amdgcn_s_getreg((3 << 11) | 20) & 0xFu;
  if (threadIdx.x == 0) ctl_add(&ctl[(8 + x) * 64], 1u);
  run_phase(p, lds, 0); grid.sync();
  if (threadIdx.x == 0) {
    unsigned nx = 0;
    for (int i = 0; i < 16; ++i) nx += ctl_ld(&ctl[(8 + i) * 64]) != 0u ? 1u : 0u;
    s_bar[0] = ctl_ld(&ctl[(8 + x) * 64]); s_bar[1] = nx;
  }
  __syncthreads();
  const unsigned nloc = __builtin_amdgcn_readfirstlane(s_bar[0]), nx = __builtin_amdgcn_readfirstlane(s_bar[1]);
  run_phase(p, lds, 1); xbar(ctl, x, nloc, nx, 1);
  run_phase(p, lds, 2); xbar(ctl, x, nloc, nx, 2);
  run_phase(p, lds, 3); xbar(ctl, x, nloc, nx, 3);
  run_phase(p, lds, 11); xbar(ctl, x, nloc, nx, 4);
  run_phase(p, lds, 4); xbar(ctl, x, nloc, nx, 5);
  run_phase(p, lds, 5); xbar(ctl, x, nloc, nx, 6);
  run_phase(p, lds, 6); xbar(ctl, x, nloc, nx, 7);
  run_phase(p, lds, 7); xbar(ctl, x, nloc, nx, 8);
  run_phase(p, lds, 8); xbar(ctl, x, nloc, nx, 9);
  run_phase(p, lds, 9); xbar(ctl, x, nloc, nx, 10);
  run_phase(p, lds, 10);
}
template <int PH> __global__ void __launch_bounds__(NTHREADS) phase_kernel(Params p) {
  extern __shared__ __attribute__((aligned(16))) unsigned char lds[];
  run_phase(p, lds, PH);
}
template <int PH> static void launch_phase(const Params& p, int grid, hipStream_t stream) {
  (void)hipFuncSetAttribute((const void*)phase_kernel<PH>, hipFuncAttributeMaxDynamicSharedMemorySize, LDS_BYTES);
  hipLaunchKernelGGL(phase_kernel<PH>, dim3(grid), dim3(NTHREADS), LDS_BYTES, stream, p);
}

extern "C" void kernel_launch(void* const* d_in, const int* in_sizes, int n_in, void* d_out, int out_size, void* d_ws, size_t ws_size, hipStream_t stream) {
  static int grid_blocks = 0;
  if (grid_blocks == 0) {
    if (n_in != 32 || ws_size < WS_END) { fprintf(stderr, "kernel_launch: unexpected n_in %d or ws_size %zu (< %zu)\n", n_in, ws_size, (size_t)WS_END); grid_blocks = -1; return; }
    int dev = 0, cus = 0, per_cu = 0;
    (void)hipGetDevice(&dev);
    (void)hipDeviceGetAttribute(&cus, hipDeviceAttributeMultiprocessorCount, dev);
#if MULTI_LAUNCH
    per_cu = 1;
#else
    (void)hipFuncSetAttribute((const void*)mega_kernel, hipFuncAttributeMaxDynamicSharedMemorySize, LDS_BYTES);
    (void)hipOccupancyMaxActiveBlocksPerMultiprocessor(&per_cu, (const void*)mega_kernel, NTHREADS, LDS_BYTES);
#endif
    if (per_cu < 1) { fprintf(stderr, "kernel_launch: occupancy query gave %d\n", per_cu); grid_blocks = -1; return; }
    grid_blocks = cus;
  }
  if (grid_blocks < 0) return;
  Params p{};
  for (int i = 0; i < 32; ++i) p.in[i] = (const float*)d_in[i];
  p.out = (float*)d_out;
  p.ws = (unsigned char*)d_ws;
#if MULTI_LAUNCH
  launch_phase<0>(p, grid_blocks, stream); launch_phase<1>(p, grid_blocks, stream); launch_phase<2>(p, grid_blocks, stream); launch_phase<3>(p, grid_blocks, stream); launch_phase<11>(p, grid_blocks, stream);
  launch_phase<4>(p, grid_blocks, stream); launch_phase<5>(p, grid_blocks, stream); launch_phase<6>(p, grid_blocks, stream); launch_phase<7>(p, grid_blocks, stream);
  launch_phase<8>(p, grid_blocks, stream); launch_phase<9>(p, grid_blocks, stream); launch_phase<10>(p, grid_blocks, stream);
#else
  (void)hipMemsetAsync((unsigned char*)d_ws + O_CTR, 0, 16384, stream);
  void* args[] = {&p};
  hipError_t e = hipLaunchCooperativeKernel((void*)mega_kernel, dim3(grid_blocks), dim3(NTHREADS), args, LDS_BYTES, stream);
  if (e != hipSuccess) fprintf(stderr, "cooperative launch failed: %s (grid %d)\n", hipGetErrorString(e), grid_blocks);
#endif
}
```

```cpp
#include <hip/hip_runtime.h>
#include <hip/hip_cooperative_groups.h>
#include <cstdio>
#include <cstdint>
namespace cg = cooperative_groups;


#ifndef PROBE_DUP
#define PROBE_DUP -1
#endif
#ifndef MULTI_LAUNCH
#define MULTI_LAUNCH 0
#endif

#define DI __device__ __forceinline__
typedef unsigned short bf16_t;
typedef short bf16x8 __attribute__((ext_vector_type(8)));
typedef short s16x4 __attribute__((ext_vector_type(4)));
typedef float f32x16 __attribute__((ext_vector_type(16)));
typedef float f32x4 __attribute__((ext_vector_type(4)));
typedef float f32x2 __attribute__((ext_vector_type(2)));
typedef unsigned u32x4 __attribute__((ext_vector_type(4)));
typedef unsigned u32x2 __attribute__((ext_vector_type(2)));
typedef __bf16 bf2_t __attribute__((ext_vector_type(2)));

constexpr int NP = 16384, NS = 512, NT = NP + NS;
constexpr int DM = 1024, ACOLS = 1792, BCOLS = 416, PABC = ACOLS + BCOLS  , NIN = 4256;
constexpr int DFF = 2816;
constexpr int PAST = 1024, DSEQ = 32, DB = 16, SKV = PAST + DSEQ  ;
constexpr int NKV = NP + DB * SKV  , NKVP = NKV + 64;
constexpr float DN_ALPHA = 1.189207115002721f;
constexpr float QSCALE = 0.10206207261596575f * 1.4426950408889634f;

constexpr size_t al256(size_t x) { return (x + 255) & ~(size_t)255; }
constexpr size_t O_WIN = 0;
constexpr size_t O_WUQ = O_WIN + al256((size_t)NIN * 1024 * 2);
constexpr size_t O_WUKV = O_WUQ + al256(768 * 256 * 2);
constexpr size_t O_WPA = O_WUKV + al256(1024 * 128 * 2);
constexpr size_t O_WPB = O_WPA + al256(1024 * 512 * 2);
constexpr size_t O_WO = O_WPB + al256(1024 * 512 * 2);
constexpr size_t O_WGU = O_WO + al256(1024 * 1024 * 2);
constexpr size_t O_WDN = O_WGU + al256((size_t)5632 * 1024 * 2);
constexpr size_t O_WW2 = O_WDN + al256((size_t)1024 * 2816 * 2);
constexpr size_t O_WA2 = O_WW2 + al256(512 * 64 * 2);
constexpr size_t O_WG2 = O_WA2 + al256(512 * 64 * 2);
constexpr size_t O_ROPE = O_WG2 + al256(512 * 128 * 2);
constexpr size_t O_CTR = O_ROPE + al256((size_t)NT * 32 * 4);
constexpr size_t O_PAB = O_CTR + 16384;
constexpr size_t SZ_T512 = (size_t)NT * 512 * 2;
constexpr size_t O_SIN = O_PAB + al256((size_t)NT * PABC * 2);
constexpr size_t O_G = O_SIN + 6 * SZ_T512;
constexpr size_t O_RK = O_G + SZ_T512;
constexpr size_t O_KNB = O_RK + al256((size_t)NT * 8 * 4);
constexpr size_t O_KPEB = O_KNB + al256((size_t)8 * NKVP * 64 * 2);
constexpr int SCC = 8, SCL = NP / SCC;
constexpr size_t WS_END = O_KPEB + al256((size_t)NKVP * 32 * 2);
constexpr size_t O_Y = O_PAB;
constexpr size_t O_E = O_Y + SZ_T512;
constexpr size_t O_YB = O_Y + (size_t)NT * 512 * 4;
constexpr size_t O_YA = O_YB + SZ_T512;
constexpr size_t O_H = O_PAB;
constexpr size_t O_M = O_SIN;
constexpr size_t O_Z = O_SIN + (size_t)NT * 1024 * 2;
constexpr size_t O_Z2 = O_PAB + (size_t)NT * 1024 * 2;
constexpr size_t O_ACT = O_SIN;
constexpr size_t OO_XB = 0;
constexpr size_t OO_Q = 0;
constexpr size_t OO_VT = (size_t)NT * 768 * 2;
constexpr size_t OO_GH = OO_VT + (size_t)8 * 64 * NKVP * 2;
constexpr size_t OO_SST = OO_GH + 2 * (size_t)8 * SCC * 4096 * 4;
static_assert(OO_SST + (size_t)SCC * 8 * 4096 * 2 <= (size_t)NT * 1024 * 4, "d_out scratch");
constexpr size_t F_Y = 0, F_CKVP = (size_t)NT * 1024, F_KPEP = F_CKVP + (size_t)NP * 128, F_WKVP = F_KPEP + (size_t)NP * 32,
                 F_SHP = F_WKVP + 32768, F_CKVS = F_SHP + 1792, F_KPES = F_CKVS + (size_t)NS * 128, F_WKVS = F_KPES + (size_t)NS * 32,
                 F_SHS = F_WKVS + (size_t)DB * 32768;

constexpr int LDS_CTRL = 3 * 49152;
constexpr int LDS_BYTES = LDS_CTRL + 256;
constexpr int NTHREADS = 512;

struct Params {
  const float* in[32];
  float* out;
  unsigned char* ws;
};

DI int tidx() { int t = threadIdx.x; asm volatile("" : "+v"(t)); return t; }
DI unsigned pk2(float a, float b) { f32x2 v = {a, b}; bf2_t r = __builtin_convertvector(v, bf2_t); return __builtin_bit_cast(unsigned, r); }
DI bf16_t f2bf(float a) { return (bf16_t)(pk2(a, 0.f) & 0xffffu); }
DI float bf2f(bf16_t x) { return __uint_as_float(((unsigned)x) << 16); }
DI void unpack8(u32x4 v, float* f) {
#pragma unroll
  for (int j = 0; j < 4; ++j) { f[2 * j] = __uint_as_float(v[j] << 16); f[2 * j + 1] = __uint_as_float(v[j] & 0xffff0000u); }
}
DI u32x4 pack8(const float* f) { u32x4 o; o[0] = pk2(f[0], f[1]); o[1] = pk2(f[2], f[3]); o[2] = pk2(f[4], f[5]); o[3] = pk2(f[6], f[7]); return o; }
DI float sigmoidf_(float x) { return 1.f / (1.f + __expf(-x)); }
DI float dpp_sum16(float x) {
  x += __builtin_bit_cast(float, __builtin_amdgcn_update_dpp(0, __builtin_bit_cast(int, x), 0xB1, 0xF, 0xF, true));
  x += __builtin_bit_cast(float, __builtin_amdgcn_update_dpp(0, __builtin_bit_cast(int, x), 0x4E, 0xF, 0xF, true));
  x += __builtin_bit_cast(float, __builtin_amdgcn_update_dpp(0, __builtin_bit_cast(int, x), 0x141, 0xF, 0xF, true));
  x += __builtin_bit_cast(float, __builtin_amdgcn_update_dpp(0, __builtin_bit_cast(int, x), 0x140, 0xF, 0xF, true));
  return x;
}
DI float sum32(float x) { x = dpp_sum16(x); x += __shfl_xor(x, 16); return x; }
DI float wave_sum(float v) {
#pragma unroll
  for (int o = 1; o < 64; o <<= 1) v += __shfl_xor(v, o);
  return v;
}
DI int crow(int i, int h) { return (i & 3) + 8 * (i >> 2) + 4 * h; }
#define MFMA32(a, b, c) __builtin_amdgcn_mfma_f32_32x32x16_bf16((a), (b), (c), 0, 0, 0)
DI int slot_of_token(int t) { return t < NP ? t : NP + ((t - NP) >> 5) * SKV + PAST + ((t - NP) & 31); }
DI const float* xrow(const Params& p, int t) { return t < NP ? p.in[0] + (size_t)t * DM : p.in[1] + (size_t)(t - NP) * DM; }

DI void conv_T(const float* W, int K, int N, bf16_t* WT, int mode, int gtid, int gsz) {
  const int ntask = (K / 8) * N;
  for (int id = gtid; id < ntask; id += gsz) {
    const int kc = id / N, n = id - kc * N, k0 = kc * 8;
    float f[8];
#pragma unroll
    for (int j = 0; j < 8; ++j) f[j] = W[(size_t)(k0 + j) * N + n];
    if (mode == 2) {
      *(u32x4*)(WT + ((size_t)((n >> 5) * (K >> 4) + (k0 >> 4)) * 64 + ((k0 >> 3) & 1) * 32 + (n & 31)) * 8) = pack8(f);
      continue;
    }
    int row = n;
    if (mode == 1) { const int nt = n >= DFF ? 1 : 0, j = n - nt * DFF; row = 128 * (j >> 6) + 64 * ((j & 63) >> 5) + 32 * nt + (j & 31); }
    *(u32x4*)(WT + (size_t)row * K + k0) = pack8(f);
  }
}
DI void conv_T_lds(const float* W, int K, int N, bf16_t* WT, int mode, unsigned char* lds, int gw, int ngw, int wave, int lane) {
  float* scr = (float*)(lds + wave * (64 * 33 * 4));
  const int nblk = N >> 5, nitem = (K >> 6) * nblk;
  for (int item = gw; item < nitem; item += ngw) {
    const int kb = item / nblk, nb = item - kb * nblk, k0 = kb * 64, n0 = nb * 32;
#pragma unroll 8
    for (int i = 0; i < 32; ++i) { const int kk = 2 * i + (lane >> 5); scr[kk * 33 + (lane & 31)] = W[(size_t)(k0 + kk) * N + n0 + (lane & 31)]; }
    asm volatile("s_waitcnt lgkmcnt(0)" ::: "memory");
    const int c = lane & 7;
#pragma unroll
    for (int j = 0; j < 4; ++j) {
      const int nl = (lane >> 3) + 8 * j;
      const float* sp = scr + (8 * c) * 33 + nl;
      float f[8];
#pragma unroll
      for (int q = 0; q < 8; ++q) f[q] = sp[q * 33];
      int row = n0 + nl;
      if (mode == 1) { const int nt = row >= DFF ? 1 : 0, jj = row - nt * DFF; row = 256 * (jj >> 7) + 128 * ((jj & 127) >> 6) + 32 * (2 * ((jj & 63) >> 5) + nt) + (jj & 31); }
      *(u32x4*)(WT + (size_t)row * K + k0 + 8 * c) = pack8(f);
    }
    asm volatile("s_waitcnt lgkmcnt(0)" ::: "memory");
  }
}
DI void conv_x(const Params& p, bf16_t* XB, int gtid, int gsz) {
  for (int id = gtid; id < NT * 128; id += gsz) {
    const int t = id >> 7, c = (id & 127) * 8;
    const float* src = xrow(p, t) + c;
    f32x4 a = *(const f32x4*)src, b = *(const f32x4*)(src + 4);
    float f[8] = {a[0], a[1], a[2], a[3], b[0], b[1], b[2], b[3]};
    *(u32x4*)(XB + (size_t)t * DM + c) = pack8(f);
  }
}
DI void phase0(const Params& p, unsigned char* lds) {
  const int tid0 = tidx(), gtid = blockIdx.x * NTHREADS + tid0, gsz = gridDim.x * NTHREADS;
  const int wave0 = __builtin_amdgcn_readfirstlane(tid0 >> 6), lane0 = tid0 & 63, gw = blockIdx.x * 8 + wave0, ngw = gridDim.x * 8;
  unsigned char* ws = p.ws;
  if (gtid < 64) ((unsigned*)(ws + O_CTR))[gtid] = 0u;
  conv_T_lds(p.in[6], 1024, NIN, (bf16_t*)(ws + O_WIN), 0, lds, gw, ngw, wave0, lane0);
  conv_T(p.in[20], 256, 768, (bf16_t*)(ws + O_WUQ), 2, gtid, gsz);
  conv_T(p.in[22], 128, 1024, (bf16_t*)(ws + O_WUKV), 2, gtid, gsz);
  conv_T_lds(p.in[18], 512, 1024, (bf16_t*)(ws + O_WPA), 0, lds, gw, ngw, wave0, lane0);
  conv_T_lds(p.in[23], 512, 1024, (bf16_t*)(ws + O_WPB), 0, lds, gw, ngw, wave0, lane0);
  conv_T_lds(p.in[25], 1024, 1024, (bf16_t*)(ws + O_WO), 0, lds, gw, ngw, wave0, lane0);
  conv_T_lds(p.in[28], 1024, 5632, (bf16_t*)(ws + O_WGU), 1, lds, gw, ngw, wave0, lane0);
  conv_T_lds(p.in[29], 2816, 1024, (bf16_t*)(ws + O_WDN), 0, lds, gw, ngw, wave0, lane0);
  conv_T(p.in[9], 64, 512, (bf16_t*)(ws + O_WW2), 2, gtid, gsz);
  conv_T(p.in[11], 64, 512, (bf16_t*)(ws + O_WA2), 2, gtid, gsz);
  conv_T(p.in[12], 128, 512, (bf16_t*)(ws + O_WG2), 2, gtid, gsz);
  conv_x(p, (bf16_t*)((unsigned char*)p.out + OO_XB), gtid, gsz);
  float* rope = (float*)(ws + O_ROPE);
  for (int id = gtid; id < NT * 16; id += gsz) {
    const int t = id >> 4, j = id & 15;
    const int pos = t < NP ? t : PAST + ((t - NP) & 31);
    const float inv = (float)exp2(-(double)j * (13.287712379549449 / 16.0));
    const float ang = (float)pos * inv;
    const double x = (double)ang;
    const double n = rint(x * 0.15915494309189535);
    const float red = (float)(x - n * 6.283185307179586);
    rope[t * 32 + j] = __cosf(red);
    rope[t * 32 + 16 + j] = __sinf(red);
  }
  bf16_t* kpeb = (bf16_t*)(ws + O_KPEB);
  for (int id = gtid; id < DB * PAST * 4; id += gsz) {
    const int row = id >> 2, ch = id & 3, b = row >> 10, j = row & 1023;
    const float* src = p.in[3] + (size_t)row * 32 + ch * 8;
    f32x4 a = *(const f32x4*)src, c = *(const f32x4*)(src + 4);
    float f[8] = {a[0], a[1], a[2], a[3], c[0], c[1], c[2], c[3]};
    *(u32x4*)(kpeb + (size_t)(NP + b * SKV + j) * 32 + ch * 8) = pack8(f);
  }
  bf16_t* knb = (bf16_t*)(ws + O_KNB);
  for (int id = gtid; id < 64 * 32; id += gsz) kpeb[(size_t)NKV * 32 + id] = 0;
  for (int id = gtid; id < 8 * 64 * 64; id += gsz) {
    const int h = id >> 12, rem = id & 4095;
    knb[((size_t)h * NKVP + NKV) * 64 + rem] = 0;
  }
}

template <int TM, int TN, bool ZERO = true, int NST = 3>
DI void gemm_mainloop(const bf16_t* __restrict__ A, int lda, const bf16_t* __restrict__ Bt, int ldb, int K, int m0, int n0, int nmax,
                      f32x16 (&acc)[TM][TN], unsigned char* lds) {
  constexpr int BM = 128 * TM, BN = 64 * TN, AG = BM / 64, BG = BN / 64, NLD = AG + BG;
  constexpr int ABYTES = BM * 128, STAGE = (BM + BN) * 128;
  static_assert(NST * STAGE <= LDS_CTRL && (NST == 2 || NST == 3), "lds");
  const int tid = tidx(), wave = __builtin_amdgcn_readfirstlane(tid >> 6), lane = tid & 63, r = lane & 31, h = lane >> 5, wm = wave & 3, wn = wave >> 2;
  const int lrow = lane >> 3, lpos = lane & 7;
  const bf16_t* ap[AG]; const bf16_t* bp[BG];
#pragma unroll
  for (int i = 0; i < AG; ++i) { const int row = (wave * AG + i) * 8 + lrow, c = lpos ^ ((row >> 1) & 7); ap[i] = A + (size_t)(m0 + row) * lda + c * 8; }
#pragma unroll
  for (int i = 0; i < BG; ++i) { const int row = (wave * BG + i) * 8 + lrow, c = lpos ^ ((row >> 1) & 7); int br = n0 + row; br = br < nmax ? br : nmax - 1; bp[i] = Bt + (size_t)br * ldb + c * 8; }
  if (ZERO) {
#pragma unroll
    for (int tm = 0; tm < TM; ++tm)
#pragma unroll
      for (int tn = 0; tn < TN; ++tn)
#pragma unroll
        for (int i = 0; i < 16; ++i) acc[tm][tn][i] = 0.f;
  }
  auto issue = [&](int kt, int stage) {
    unsigned char* sb = lds + stage * STAGE;
#pragma unroll
    for (int i = 0; i < AG; ++i) __builtin_amdgcn_global_load_lds((const unsigned*)(ap[i] + kt * 64), (unsigned*)(sb + (wave * AG + i) * 1024), 16, 0, 0);
#pragma unroll
    for (int i = 0; i < BG; ++i) __builtin_amdgcn_global_load_lds((const unsigned*)(bp[i] + kt * 64), (unsigned*)(sb + ABYTES + (wave * BG + i) * 1024), 16, 0, 0);
  };
  const int swz = (r >> 1) & 7;
  int koff[4];
#pragma unroll
  for (int ks = 0; ks < 4; ++ks) koff[ks] = ((ks * 2 + h) ^ swz) * 16;
  const int a_rd = (wm * 32 * TM + r) * 128, b_rd = ABYTES + (wn * 32 * TN + r) * 128;
  const int nk = K >> 6;
  asm volatile("s_waitcnt vmcnt(0)" ::: "memory");
  issue(0, 0);
  if (NST == 3) issue(1, 1);
  for (int kt = 0; kt < nk; ++kt) {
    if (NST == 3 && kt + 1 < nk) asm volatile("s_waitcnt vmcnt(%0)" ::"n"(NLD) : "memory");
    else asm volatile("s_waitcnt vmcnt(0)" ::: "memory");
    asm volatile("s_waitcnt lgkmcnt(0)" ::: "memory");
    __builtin_amdgcn_s_barrier();
    if (NST == 3) { if (kt + 2 < nk) issue(kt + 2, (kt + 2) % 3); }
    else { if (kt + 1 < nk) issue(kt + 1, (kt + 1) & 1); }
    const unsigned char* cur = lds + (kt % NST) * STAGE;
#pragma unroll
    for (int ks = 0; ks < 4; ++ks) {
      bf16x8 af[TM], bfr[TN];
#pragma unroll
      for (int tm = 0; tm < TM; ++tm) af[tm] = *(const bf16x8*)(cur + a_rd + tm * 4096 + koff[ks]);
#pragma unroll
      for (int tn = 0; tn < TN; ++tn) bfr[tn] = *(const bf16x8*)(cur + b_rd + tn * 4096 + koff[ks]);
#pragma unroll
      for (int tm = 0; tm < TM; ++tm)
#pragma unroll
        for (int tn = 0; tn < TN; ++tn) acc[tm][tn] = MFMA32(bfr[tn], af[tm], acc[tm][tn]);
    }
  }
  asm volatile("s_waitcnt lgkmcnt(0)" ::: "memory");
  __builtin_amdgcn_s_barrier();
}

template <int TM, int TN, int OUTC, class F>
DI void epilogue_bf16(const f32x16 (&acc)[TM][TN], unsigned char* lds, bf16_t* out, int ldo, int m0, int c0, int cmax, F f) {
  constexpr int BM = 128 * TM, STRIDE = OUTC * 2 + 16, TNO = OUTC / (32 * 2);
  const int tid = tidx(), wave = __builtin_amdgcn_readfirstlane(tid >> 6), lane = tid & 63, r = lane & 31, h = lane >> 5, wm = wave & 3, wn = wave >> 2;
#pragma unroll
  for (int tm = 0; tm < TM; ++tm)
#pragma unroll
    for (int tn = 0; tn < TNO; ++tn)
#pragma unroll
      for (int g = 0; g < 4; ++g) {
        const int rowl = wm * 32 * TM + tm * 32 + r, coll = wn * 32 * TNO + tn * 32 + 8 * g + 4 * h;
        const f32x4 o = f(tm, tn, g, rowl, coll);
        u32x2 w; w[0] = pk2(o[0], o[1]); w[1] = pk2(o[2], o[3]);
        *(u32x2*)(lds + rowl * STRIDE + coll * 2) = w;
      }
  __syncthreads();
  constexpr int CPR = OUTC / 8;
#pragma unroll
  for (int j = 0; j < BM * CPR / NTHREADS; ++j) {
    const int id = tid + NTHREADS * j, row = id / CPR, c = id % CPR;
    if (c0 + c * 8 < cmax) *(u32x4*)(out + (size_t)(m0 + row) * ldo + c0 + c * 8) = *(const u32x4*)(lds + row * STRIDE + c * 16);
  }
  __syncthreads();
}
DI f32x4 acc4(const f32x16& a, int g) { return (f32x4){a[4 * g], a[4 * g + 1], a[4 * g + 2], a[4 * g + 3]}; }

struct TileIter {
  int nM, nN, total, L, Lend, step;
  DI void init(int nM_, int nN_) {
    nM = nM_; nN = nN_; total = nM * nN;
    const int nx = (gridDim.x & 7) == 0 ? 8 : 1, x = blockIdx.x % nx, local = blockIdx.x / nx;
    step = gridDim.x / nx;
    const int per = (total + nx - 1) / nx;
    L = x * per + local; Lend = (x + 1) * per < total ? (x + 1) * per : total;
  }
  DI bool next(int& tmi, int& tni) {
    if (L >= Lend) return false;
    const int fb = nM >> 2, fullcnt = fb * 4 * nN;
    if (L < fullcnt) { const int band = L / (4 * nN), jj = L - band * 4 * nN; tni = jj >> 2; tmi = band * 4 + (jj & 3); }
    else { const int l2 = L - fullcnt, bm = nM & 3; tni = l2 / bm; tmi = fb * 4 + l2 % bm; }
    L += step; return true;
  }
};

DI void phase1(const Params& p, unsigned char* lds) {
  const bf16_t* XB = (const bf16_t*)((unsigned char*)p.out + OO_XB);
  const bf16_t* WT = (const bf16_t*)(p.ws + O_WIN);
  bf16_t* PAB = (bf16_t*)(p.ws + O_PAB);
  constexpr int NMT = NT / 256, NNT = (PABC + 127) / 128;
  const int lane = tidx() & 63, wave = __builtin_amdgcn_readfirstlane(tidx() >> 6), r = lane & 31, h = lane >> 5, wm = wave & 3, wn = wave >> 2;
  TileIter ti; ti.init(NMT, NNT);
  int tmi, tni;
  while (ti.next(tmi, tni)) {
    const int m0 = tmi * 256, n0 = tni * 128;
    f32x16 acc[2][2];
    gemm_mainloop<2, 2>(XB, DM, WT, DM, DM, m0, n0, PABC, acc, lds);
    if (m0 + 256 > NP - 1 && n0 < ACOLS) {
#pragma unroll
      for (int tm = 0; tm < 2; ++tm) {
        const int row = m0 + wm * 64 + tm * 32 + r;
        const bool lastp = row == NP - 1, lasts = row >= NP && ((row - NP) & 31) == 31;
        if (lastp || lasts) {
          float* dst = lastp ? p.out + F_SHP : p.out + F_SHS + (size_t)((row - NP) >> 5) * ACOLS;
#pragma unroll
          for (int tn = 0; tn < 2; ++tn)
#pragma unroll
            for (int g = 0; g < 4; ++g) {
              const int col = n0 + wn * 64 + tn * 32 + 8 * g + 4 * h;
              if (col < ACOLS) *(f32x4*)(dst + col) = acc4(acc[tm][tn], g);
            }
        }
      }
    }
    epilogue_bf16<2, 2, 128>(acc, lds, PAB, PABC, m0, n0, PABC, [&](int tm, int tn, int g, int, int) { return acc4(acc[tm][tn], g); });
  }
}

constexpr int L2_LORA = 0, L2_K = L2_LORA + 32 * 528, L2_R = L2_K + 32 * 1040, L2A_STG = L2_R + 32 * 1040, L2A_END = L2A_STG + 8 * 32 * 144;
constexpr int L2_CQ = 0, L2_CKV = L2_CQ + 32 * 528, L2B_STG = L2_CKV + 32 * 272, L2B_END = L2B_STG + 8 * 32 * 208;
static_assert(L2A_END <= LDS_BYTES && L2B_END <= LDS_BYTES, "lds p2");
template <int NTL, class F>
DI void stage_store16(unsigned char* stg, int lane, bf16_t* dst  , unsigned row_stride  , F f) {
  constexpr int RS = NTL * 64 + 16, CPR = NTL * 4;
  const int r = lane & 31, h = lane >> 5;
#pragma unroll
  for (int nt = 0; nt < NTL; ++nt)
#pragma unroll
    for (int i = 0; i < 16; ++i) *(unsigned short*)(stg + crow(i, h) * RS + (nt * 32 + r) * 2) = f(nt, i);
  __syncthreads();
#pragma unroll
  for (int j = 0; j < 32 * CPR / 64; ++j) {
    const int id = lane + 64 * j, row = id / CPR, ch = id % CPR;
    *(u32x4*)(dst + (size_t)row * row_stride + ch * 8) = *(const u32x4*)(stg + row * RS + ch * 16);
  }
  __syncthreads();
}

template <int NTL, int KS>
DI void mm32(const unsigned char* ldsA, int strideB, const bf16_t* Bt, int ldb, int lane, f32x16 (&acc)[NTL]) {
  constexpr int KG = (NTL * KS <= 16) ? KS : (NTL <= 2 ? 4 : 2), NG = KS / KG;
  const int r = lane & 31, h = lane >> 5;
#pragma unroll
  for (int nt = 0; nt < NTL; ++nt)
#pragma unroll
    for (int i = 0; i < 16; ++i) acc[nt][i] = 0.f;
  bf16x8 bq[2][KG][NTL];
  const bf16_t* bp = Bt + lane * 8;
#pragma unroll
  for (int k = 0; k < KG; ++k)
#pragma unroll
    for (int nt = 0; nt < NTL; ++nt) bq[0][k][nt] = *(const bf16x8*)(bp + (size_t)(nt * KS + k) * 512);
#pragma unroll
  for (int g = 0; g < NG; ++g) {
    if (g + 1 < NG) {
#pragma unroll
      for (int k = 0; k < KG; ++k)
#pragma unroll
        for (int nt = 0; nt < NTL; ++nt) bq[(g + 1) & 1][k][nt] = *(const bf16x8*)(bp + (size_t)(nt * KS + (g + 1) * KG + k) * 512);
    }
    __builtin_amdgcn_sched_barrier(0);
#pragma unroll
    for (int k = 0; k < KG; ++k) {
      const bf16x8 a = *(const bf16x8*)(ldsA + r * strideB + (g * KG + k) * 32 + h * 16);
#pragma unroll
      for (int nt = 0; nt < NTL; ++nt) acc[nt] = MFMA32(a, bq[g & 1][k][nt], acc[nt]);
    }
    __builtin_amdgcn_sched_barrier(0);
  }
}

DI void kv_expand(const Params& p, unsigned char* lds, int w, int lane, int slot0) {
  const int r = lane & 31, h = lane >> 5;
  bf16_t* knb = (bf16_t*)(p.ws + O_KNB);
  bf16_t* vT = (bf16_t*)((unsigned char*)p.out + OO_VT);
  f32x16 acc[4];
  mm32<4, 8>(lds + L2_CKV, 272, (const bf16_t*)(p.ws + O_WUKV) + (size_t)(128 * w) * 128, 128, lane, acc);
  stage_store16<2>((unsigned char*)lds + L2B_STG + w * (32 * 208), lane, knb + ((size_t)w * NKVP + slot0) * 64, 64, [&](int nt, int i) { return f2bf(acc[nt][i]); });
#pragma unroll
  for (int nt = 2; nt < 4; ++nt)
#pragma unroll
    for (int g = 0; g < 4; ++g) {
      u32x2 o; o[0] = pk2(acc[nt][4 * g], acc[nt][4 * g + 1]); o[1] = pk2(acc[nt][4 * g + 2], acc[nt][4 * g + 3]);
      *(u32x2*)(vT + ((unsigned)w * 64 + (nt - 2) * 32 + r) * (unsigned)NKVP + slot0 + 8 * g + 4 * h) = o;
    }
}

DI void p2_token_tile_a(const Params& p, unsigned char* lds, int tile) {
  const int tid = tidx(), wave = __builtin_amdgcn_readfirstlane(tid >> 6), lane = tid & 63, r = lane & 31, h = lane >> 5;
  const int t0 = tile * 32;
  unsigned char* ws = p.ws;
  const bf16_t* PAB = (const bf16_t*)(ws + O_PAB);
  bf16_t* SR = (bf16_t*)(ws + O_SIN);
  bf16_t* SK = SR + (size_t)NT * 512; bf16_t* SV = SK + (size_t)NT * 512; bf16_t* SA = SV + (size_t)NT * 512; bf16_t* SB = SA + (size_t)NT * 512;
  _Float16* SW = (_Float16*)(SB + (size_t)NT * 512);
  bf16_t* G = (bf16_t*)(ws + O_G);
  float* RK = (float*)(ws + O_RK);
  const float* rope = (const float*)(ws + O_ROPE);
#pragma unroll 1
  for (int bt = 0; bt < 2; ++bt) {
    u32x4 rawp[7], rawq[7];
#pragma unroll
    for (int it = 0; it < 7; ++it) {
      const int task = tid + NTHREADS * (bt * 7 + it);
      const int tl = task / 224, ch = task - tl * 224, c0 = ch * 8, t = t0 + tl;
      rawp[it] = *(const u32x4*)(PAB + (size_t)t * PABC + c0);
      rawq[it] = *(const u32x4*)(PAB + (size_t)(t > 0 ? t - 1 : 0) * PABC + c0);
    }
#pragma unroll
    for (int it = 0; it < 7; ++it) {
      const int task = tid + NTHREADS * (bt * 7 + it);
      const int tl = task / 224, ch = task - tl * 224, c0 = ch * 8, t = t0 + tl;
      float pv[8], pr[8];
      unpack8(rawp[it], pv);
      unpack8(rawq[it], pr);
      if (t == 0) {
#pragma unroll
        for (int j = 0; j < 8; ++j) pr[j] = 0.f;
      } else if (t >= NP && ((t - NP) & 31) == 0) {
        const float* sp = p.in[5] + (size_t)((t - NP) >> 5) * ACOLS + c0;
        const f32x4 a = *(const f32x4*)sp, b = *(const f32x4*)(sp + 4);
        pr[0] = a[0]; pr[1] = a[1]; pr[2] = a[2]; pr[3] = a[3]; pr[4] = b[0]; pr[5] = b[1]; pr[6] = b[2]; pr[7] = b[3];
      }
      const f32x4 mu0 = *(const f32x4*)(p.in[7] + c0), mu1 = *(const f32x4*)(p.in[7] + c0 + 4);
      const float mm[8] = {mu0[0], mu0[1], mu0[2], mu0[3], mu1[0], mu1[1], mu1[2], mu1[3]};
      float xs[8];
#pragma unroll
      for (int j = 0; j < 8; ++j) xs[j] = pv[j] + (pr[j] - pv[j]) * mm[j];
      if (c0 < 512) {
        const u32x4 o = pack8(xs);
        *(u32x4*)(SR + (size_t)t * 512 + c0) = o;
        *(u32x4*)(lds + L2_R + tl * 1040 + c0 * 2) = o;
      } else if (c0 < 1024) {
        *(u32x4*)(lds + L2_K + tl * 1040 + (c0 - 512) * 2) = pack8(xs);
      } else if (c0 < 1536) {
        *(u32x4*)(SV + (size_t)t * 512 + (c0 - 1024)) = pack8(xs);
      } else {
        if (c0 < 1600) {
#pragma unroll
          for (int j = 0; j < 8; ++j) { const float e = __expf(2.f * xs[j]); xs[j] = 1.f - 2.f / (e + 1.f); }
        } else if (c0 >= 1664) {
#pragma unroll
          for (int j = 0; j < 8; ++j) xs[j] = sigmoidf_(xs[j]);
        }
        *(u32x4*)(lds + L2_LORA + tl * 528 + (c0 - 1536) * 2) = pack8(xs);
      }
    }
  }
  __syncthreads();
  const int w = wave, cb = 64 * w;
  {
    int r = (tidx() & 31);
    f32x16 acc[2];
    mm32<2, 4>(lds + L2_LORA, 528, (const bf16_t*)(ws + O_WW2) + (size_t)cb * 64, 64, lane, acc);
    const float w00 = p.in[8][cb + r], w01 = p.in[8][cb + 32 + r];
    stage_store16<2>(lds + L2A_STG + w * (32 * 144), lane, (bf16_t*)SW + (size_t)t0 * 512 + cb, 512, [&](int nt, int i) {
      const float z = (nt ? w01 : w00) + acc[nt][i];
      const float sp = fmaxf(-z, 0.f) + __logf(1.f + __expf(-fabsf(z)));
      const float dec = __expf(-__expf(-sp - 0.5f));
      return __builtin_bit_cast(unsigned short, (_Float16)dec);
    });
  }
  __syncthreads();
  {
    int r = (tidx() & 31);
    f32x16 acc[2];
    mm32<2, 4>(lds + L2_LORA + 128, 528, (const bf16_t*)(ws + O_WA2) + (size_t)cb * 64, 64, lane, acc);
    float kkv[2][16];
#pragma unroll
    for (int nt = 0; nt < 2; ++nt) {
      const int c = cb + nt * 32 + r;
      const float a0 = p.in[10][c], kkc = p.in[13][c];
#pragma unroll
      for (int i = 0; i < 16; ++i) {
        acc[nt][i] = sigmoidf_(a0 + acc[nt][i]);
        kkv[nt][i] = bf2f(*(const bf16_t*)(lds + L2_K + crow(i, h) * 1040 + c * 2)) * kkc;
      }
    }
#pragma unroll
    for (int i = 0; i < 16; ++i) {
      const float nsq = sum32(kkv[0][i] * kkv[0][i] + kkv[1][i] * kkv[1][i]);
      const float inv = 1.f / fmaxf(sqrtf(nsq), 1e-12f);
      kkv[0][i] *= inv; kkv[1][i] *= inv;
      __builtin_amdgcn_sched_barrier(0);
    }
    const int c0 = cb + r, c1 = cb + 32 + r;
    const float ka0 = p.in[14][c0], ka1 = p.in[14][c1], rk0 = p.in[15][c0], rk1 = p.in[15][c1];
    unsigned char* stg = lds + L2A_STG + w * (32 * 144);
    stage_store16<2>(stg, lane, SA + (size_t)t0 * 512 + cb, 512, [&](int nt, int i) { return f2bf(-kkv[nt][i]); });
    stage_store16<2>(stg, lane, SB + (size_t)t0 * 512 + cb, 512, [&](int nt, int i) { return f2bf(kkv[nt][i] * acc[nt][i]); });
#pragma unroll
    for (int i = 0; i < 16; ++i) {
      const int tl = crow(i, h);
      const float kr0 = bf2f(*(const bf16_t*)(lds + L2_K + tl * 1040 + c0 * 2)), kr1 = bf2f(*(const bf16_t*)(lds + L2_K + tl * 1040 + c1 * 2));
      const float kh0 = kr0 * (1.f + (acc[0][i] - 1.f) * ka0), kh1 = kr1 * (1.f + (acc[1][i] - 1.f) * ka1);
      kkv[0][i] = kh0; kkv[1][i] = kh1;
      const float rr0 = bf2f(*(const bf16_t*)(lds + L2_R + tl * 1040 + c0 * 2)), rr1 = bf2f(*(const bf16_t*)(lds + L2_R + tl * 1040 + c1 * 2));
      const float sb = sum32(rr0 * kh0 * rk0 + rr1 * kh1 * rk1);
      if (r == 0) RK[(unsigned)(t0 + tl) * 8u + w] = sb;
    }
    stage_store16<2>(stg, lane, SK + (size_t)t0 * 512 + cb, 512, [&](int nt, int i) { return f2bf(kkv[nt][i]); });
  }
  __syncthreads();
  {
    int r = (tidx() & 31);
    f32x16 acc[2];
    mm32<2, 8>(lds + L2_LORA + 256, 528, (const bf16_t*)(ws + O_WG2) + (size_t)cb * 128, 128, lane, acc);
    stage_store16<2>(lds + L2A_STG + w * (32 * 144), lane, G + (size_t)t0 * 512 + cb, 512, [&](int nt, int i) { return f2bf(acc[nt][i]); });
  }
  __syncthreads();
}

DI void p2_token_tile_b(const Params& p, unsigned char* lds, int tile) {
  const int tid = tidx(), wave = __builtin_amdgcn_readfirstlane(tid >> 6), lane = tid & 63, r = lane & 31, h = lane >> 5;
  const int t0 = tile * 32;
  unsigned char* ws = p.ws;
  const bf16_t* PAB = (const bf16_t*)(ws + O_PAB);
  bf16_t* SR = (bf16_t*)(ws + O_SIN);
  bf16_t* SK = SR + (size_t)NT * 512; bf16_t* SV = SK + (size_t)NT * 512; bf16_t* SA = SV + (size_t)NT * 512; bf16_t* SB = SA + (size_t)NT * 512;
  _Float16* SW = (_Float16*)(SB + (size_t)NT * 512);
  bf16_t* G = (bf16_t*)(ws + O_G);
  float* RK = (float*)(ws + O_RK);
  const float* rope = (const float*)(ws + O_ROPE);
  {
    u32x2 vq[4]; unsigned vc[4]; float k1[4], k2[4], rc[4], rs_[4];
#pragma unroll
    for (int q = 0; q < 4; ++q) {
      const int t = t0 + wave * 4 + q;
      const bf16_t* pb = PAB + (size_t)t * PABC + ACOLS;
      vq[q] = *(const u32x2*)(pb + 4 * lane);
      vc[q] = *(const unsigned*)(pb + 256 + 2 * lane);
      k1[q] = bf2f(pb[384 + (lane & 15)]); k2[q] = bf2f(pb[400 + (lane & 15)]);
      rc[q] = rope[t * 32 + (lane & 15)]; rs_[q] = rope[t * 32 + 16 + (lane & 15)];
    }
    const f32x4 gq = *(const f32x4*)(p.in[19] + 4 * lane);
    const f32x2 gkv = *(const f32x2*)(p.in[21] + 2 * lane);
#pragma unroll
    for (int q = 0; q < 4; ++q) {
      const int tl = wave * 4 + q, t = t0 + tl;
      {
        const u32x2 v = vq[q];
        float x[4] = {__uint_as_float(v[0] << 16), __uint_as_float(v[0] & 0xffff0000u), __uint_as_float(v[1] << 16), __uint_as_float(v[1] & 0xffff0000u)};
        const float ss = wave_sum(x[0] * x[0] + x[1] * x[1] + x[2] * x[2] + x[3] * x[3]);
        const float rs = rsqrtf(ss * (1.f / 256.f) + 1e-6f);
        u32x2 o; o[0] = pk2(x[0] * rs * gq[0], x[1] * rs * gq[1]); o[1] = pk2(x[2] * rs * gq[2], x[3] * rs * gq[3]);
        *(u32x2*)(lds + L2_CQ + tl * 528 + lane * 8) = o;
      }
      {
        const unsigned v = vc[q];
        const float x0 = __uint_as_float(v << 16), x1 = __uint_as_float(v & 0xffff0000u);
        const float ss = wave_sum(x0 * x0 + x1 * x1);
        const float rs = rsqrtf(ss * (1.f / 128.f) + 1e-6f);
        const float o0 = x0 * rs * gkv[0], o1 = x1 * rs * gkv[1];
        float* dst = (t < NP) ? p.out + F_CKVP + (size_t)t * 128 : p.out + F_CKVS + (size_t)(t - NP) * 128;
        f32x2 of = {o0, o1};
        *(f32x2*)(dst + 2 * lane) = of;
        *(unsigned*)(lds + L2_CKV + tl * 272 + lane * 4) = pk2(o0, o1);
      }
      if (lane < 16) {
        const float o1 = k1[q] * rc[q] - k2[q] * rs_[q], o2 = k1[q] * rs_[q] + k2[q] * rc[q];
        float* dst = (t < NP) ? p.out + F_KPEP + (size_t)t * 32 : p.out + F_KPES + (size_t)(t - NP) * 32;
        dst[lane] = o1; dst[16 + lane] = o2;
        bf16_t* kp = (bf16_t*)(ws + O_KPEB) + (size_t)slot_of_token(t) * 32;
        kp[lane] = f2bf(o1); kp[16 + lane] = f2bf(o2);
      }
    }
  }
  __syncthreads();
  const int w = wave, cb = 64 * w;
  {
    int r = (tidx() & 31);
    f32x16 acc[3];
    mm32<3, 16>(lds + L2_CQ, 528, (const bf16_t*)(ws + O_WUQ) + (size_t)(96 * w) * 256, 256, lane, acc);
    bf16_t* Q = (bf16_t*)((unsigned char*)p.out + OO_Q);
    const int j = r & 15;
#pragma unroll
    for (int i = 0; i < 16; ++i) {
      const int t = t0 + crow(i, h);
      const float own = acc[2][i], oth = __shfl_xor(own, 16);
      const float c = rope[t * 32 + j], sn = rope[t * 32 + 16 + j];
      acc[2][i] = (r < 16) ? own * c - oth * sn : oth * sn + own * c;
    }
    stage_store16<3>(lds + L2B_STG + w * (32 * 208), lane, Q + (size_t)t0 * 768 + 96 * w, 768, [&](int nt, int i) { return f2bf(acc[nt][i] * QSCALE); });
  }
  __syncthreads();
  kv_expand(p, lds, w, lane, slot_of_token(t0));
  __syncthreads();
}

DI void p2_cache_tile(const Params& p, unsigned char* lds, int ctile) {
  const int tid = tidx(), wave = __builtin_amdgcn_readfirstlane(tid >> 6), lane = tid & 63;
  const int b = ctile >> 5, j0 = (ctile & 31) * 32;
  {
    const int row = tid >> 4, c = (tid & 15) * 8;
    const float* src = p.in[2] + ((size_t)(b * PAST + j0 + row)) * 128 + c;
    f32x4 a = *(const f32x4*)src, d = *(const f32x4*)(src + 4);
    float f[8] = {a[0], a[1], a[2], a[3], d[0], d[1], d[2], d[3]};
    *(u32x4*)(lds + L2_CKV + row * 272 + c * 2) = pack8(f);
  }
  __syncthreads();
  kv_expand(p, lds, wave, lane, NP + b * SKV + j0);
  __syncthreads();
}

DI void phase2(const Params& p, unsigned char* lds) {
  constexpr int NTT = NT / 32, NCT = DB * PAST / 32;
  {
    bf16_t* vT = (bf16_t*)((unsigned char*)p.out + OO_VT);
    for (int id = blockIdx.x * NTHREADS + tidx(); id < 8 * 64 * 64; id += gridDim.x * NTHREADS) vT[(size_t)(id >> 6) * NKVP + NKV + (id & 63)] = 0;
  }
  unsigned* ctr2 = (unsigned*)(p.ws + O_CTR) + 16;
  volatile int* s_itemp = (volatile int*)(lds + LDS_CTRL);
  for (;;) {
    if (tidx() == 0) *s_itemp = (int)atomicAdd(ctr2, 1u);
    __syncthreads();
    const int item = *s_itemp;
    __syncthreads();
    if (item >= 2 * NTT + NCT) break;
    if (item < NTT) p2_token_tile_b(p, lds, item);
    else if (item < 2 * NTT) p2_token_tile_a(p, lds, item - NTT);
    else p2_cache_tile(p, lds, item - 2 * NTT);
  }
}

constexpr int AT_KSTRIDE = 208, AT_VSTRIDE = 136, AT_KBYTES = 64 * AT_KSTRIDE, AT_STAGE = AT_KBYTES + 64 * AT_VSTRIDE;

DI void attn_item(const Params& p, unsigned char* lds, int hd, int qtok0, int nact, int slot0, int ntiles, int nvalid, bool causal) {
  const int tid = tidx(), wave = __builtin_amdgcn_readfirstlane(tid >> 6), lane = tid & 63, r = lane & 31, h = lane >> 5;
  const bf16_t* Q = (const bf16_t*)((const unsigned char*)p.out + OO_Q);
  const bf16_t* knb = (const bf16_t*)(p.ws + O_KNB) + (size_t)hd * NKVP * 64;
  const bf16_t* kpeb = (const bf16_t*)(p.ws + O_KPEB);
  const bf16_t* vT = (const bf16_t*)((const unsigned char*)p.out + OO_VT) + (size_t)hd * 64 * NKVP;
  bf16_t* YB = (bf16_t*)(p.ws + O_YB);
  const bool active = wave < nact;
  const int qtok = qtok0 + 32 * wave;
  const int wlim = !active ? 0 : (causal ? (qtok >> 6) + 1 : ntiles);
  bf16x8 qf[6];
  if (active) {
#pragma unroll
    for (int ks = 0; ks < 6; ++ks) qf[ks] = *(const bf16x8*)(Q + (size_t)(qtok + r) * 768 + 96 * hd + ks * 16 + h * 8);
  } else {
#pragma unroll
    for (int ks = 0; ks < 6; ++ks) qf[ks] = (bf16x8){0, 0, 0, 0, 0, 0, 0, 0};
  }
  f32x16 o0, o1;
#pragma unroll
  for (int i = 0; i < 16; ++i) { o0[i] = 0.f; o1[i] = 0.f; }
  float mrun = 0.f, lsum = 0.f;
  const int k_key = tid >> 3, k_ch = tid & 7;
  const int pe_key = (tid & 255) >> 2, pe_ch = tid & 3;
  const int v_dim = tid >> 3, v_ch = tid & 7;
  u32x4 rk, rpe, rv;
  auto gload = [&](int kt) {
    const int s = slot0 + kt * 64;
    rk = *(const u32x4*)(knb + (size_t)(s + k_key) * 64 + k_ch * 8);
    if (tid < 256) rpe = *(const u32x4*)(kpeb + (size_t)(s + pe_key) * 32 + pe_ch * 8);
    rv = *(const u32x4*)(vT + (size_t)v_dim * NKVP + s + v_ch * 8);
  };
  auto lstore = [&](int buf) {
    unsigned char* b = lds + buf * AT_STAGE;
    *(u32x4*)(b + k_key * AT_KSTRIDE + k_ch * 16) = rk;
    if (tid < 256) *(u32x4*)(b + pe_key * AT_KSTRIDE + 128 + pe_ch * 16) = rpe;
    u32x2 lo = {rv[0], rv[1]}, hi = {rv[2], rv[3]};
    *(u32x2*)(b + AT_KBYTES + v_dim * AT_VSTRIDE + v_ch * 16) = lo;
    *(u32x2*)(b + AT_KBYTES + v_dim * AT_VSTRIDE + v_ch * 16 + 8) = hi;
  };
  gload(0); lstore(0);
  __syncthreads();
  for (int kt = 0; kt < ntiles; ++kt) {
    const bool more = kt + 1 < ntiles;
    if (more) gload(kt + 1);
    if (kt < wlim) {
      const unsigned char* kb = lds + (kt & 1) * AT_STAGE;
      const unsigned char* vb = kb + AT_KBYTES;
      f32x16 s0, s1;
      const float nm = -mrun;
#pragma unroll
      for (int i = 0; i < 16; ++i) { s0[i] = nm; s1[i] = nm; }
#pragma unroll
      for (int ks = 0; ks < 6; ++ks) {
        const bf16x8 a0 = *(const bf16x8*)(kb + r * AT_KSTRIDE + ks * 32 + h * 16);
        const bf16x8 a1 = *(const bf16x8*)(kb + (32 + r) * AT_KSTRIDE + ks * 32 + h * 16);
        s0 = MFMA32(a0, qf[ks], s0);
        s1 = MFMA32(a1, qf[ks], s1);
      }
      if (kt * 64 + 64 > nvalid) {
#pragma unroll
        for (int i = 0; i < 16; ++i) {
          const int key = kt * 64 + crow(i, h);
          if (key >= nvalid) s0[i] = -1e30f;
          if (key + 32 >= nvalid) s1[i] = -1e30f;
        }
      }
      float mx = s0[0];
#pragma unroll
      for (int i = 1; i < 16; ++i) mx = fmaxf(mx, s0[i]);
#pragma unroll
      for (int i = 0; i < 16; ++i) mx = fmaxf(mx, s1[i]);
      mx = fmaxf(mx, __shfl_xor(mx, 32));
      const bool far = fabsf(mx) > 20.f && mx > -1e29f;
      if (__builtin_amdgcn_ballot_w64(far) != 0ull) {
        const float delta = far ? mx : 0.f;
        const float alpha = __builtin_amdgcn_exp2f(-delta);
        mrun += delta; lsum *= alpha;
#pragma unroll
        for (int i = 0; i < 16; ++i) { o0[i] *= alpha; o1[i] *= alpha; s0[i] -= delta; s1[i] -= delta; }
      }
      float rs = 0.f;
#pragma unroll
      for (int i = 0; i < 16; ++i) { s0[i] = __builtin_amdgcn_exp2f(s0[i]); rs += s0[i]; }
#pragma unroll
      for (int i = 0; i < 16; ++i) { s1[i] = __builtin_amdgcn_exp2f(s1[i]); rs += s1[i]; }
      lsum += rs;
#pragma unroll
      for (int mt = 0; mt < 2; ++mt)
#pragma unroll
        for (int s = 0; s < 2; ++s) {
          const f32x16& sv = mt ? s1 : s0;
          u32x4 pw;
          pw[0] = pk2(sv[8 * s], sv[8 * s + 1]); pw[1] = pk2(sv[8 * s + 2], sv[8 * s + 3]);
          pw[2] = pk2(sv[8 * s + 4], sv[8 * s + 5]); pw[3] = pk2(sv[8 * s + 6], sv[8 * s + 7]);
          const bf16x8 pb = __builtin_bit_cast(bf16x8, pw);
          const int kbase = mt * 32 + 16 * s + 4 * h;
          {
            const s16x4 lo = *(const s16x4*)(vb + r * AT_VSTRIDE + kbase * 2);
            const s16x4 hi = *(const s16x4*)(vb + r * AT_VSTRIDE + (kbase + 8) * 2);
            const bf16x8 av = __builtin_shufflevector(lo, hi, 0, 1, 2, 3, 4, 5, 6, 7);
            o0 = MFMA32(av, pb, o0);
          }
          {
            const s16x4 lo = *(const s16x4*)(vb + (32 + r) * AT_VSTRIDE + kbase * 2);
            const s16x4 hi = *(const s16x4*)(vb + (32 + r) * AT_VSTRIDE + (kbase + 8) * 2);
            const bf16x8 av = __builtin_shufflevector(lo, hi, 0, 1, 2, 3, 4, 5, 6, 7);
            o1 = MFMA32(av, pb, o1);
          }
        }
    }
    if (more) lstore((kt + 1) & 1);
    __syncthreads();
  }
  if (active) {
    const float lt = lsum + __shfl_xor(lsum, 32);
    const float inv = 1.f / lt;
    bf16_t* dst = YB + (size_t)(qtok + r) * 512 + hd * 64;
#pragma unroll
    for (int g = 0; g < 4; ++g) {
      u32x2 a, b;
      a[0] = pk2(o0[4 * g] * inv, o0[4 * g + 1] * inv); a[1] = pk2(o0[4 * g + 2] * inv, o0[4 * g + 3] * inv);
      b[0] = pk2(o1[4 * g] * inv, o1[4 * g + 1] * inv); b[1] = pk2(o1[4 * g + 2] * inv, o1[4 * g + 3] * inv);
      *(u32x2*)(dst + 8 * g + 4 * h) = a;
      *(u32x2*)(dst + 32 + 8 * g + 4 * h) = b;
    }
  }
}

constexpr int SC_TOK = 32, SC_ARR = SC_TOK * 64 * 4, SC_STAGE = 5 * SC_ARR + SC_TOK * 32 * 4;
static_assert(2 * SC_STAGE <= LDS_BYTES, "lds scan");
template <bool DUAL>
DI void scan_job(const Params& p, unsigned char* lds, int head, int rowgrp, int tok0, int nsteps, int init_mode  ,
                 const float* init  , bool use_v, bf16_t* Y  , float* state_out  , bf16_t* Y2 = nullptr, float* state2 = nullptr) {
  const int tid = tidx(), wave = __builtin_amdgcn_readfirstlane(tid >> 6), lane = tid & 63;
  const bf16_t* SR = (const bf16_t*)(p.ws + O_SIN);
  const bf16_t* SK = SR + (size_t)NT * 512; const bf16_t* SV = SK + (size_t)NT * 512; const bf16_t* SA = SV + (size_t)NT * 512; const bf16_t* SB = SA + (size_t)NT * 512;
  const _Float16* SW = (const _Float16*)(SB + (size_t)NT * 512);
  u32x4 rg[3];
  auto gload = [&](int c) {
    const int tb = tok0 + c * SC_TOK;
#pragma unroll
    for (int i = 0; i < 3; ++i) {
      const int L = tid + NTHREADS * i;
      if (L < 1280) {
        const int arr = L >> 8, tok = (L & 255) >> 3, ch = L & 7;
        const bf16_t* base = arr == 0 ? SA : arr == 1 ? SB : arr == 2 ? (const bf16_t*)SW : arr == 3 ? SK : SR;
        rg[i] = *(const u32x4*)(base + (size_t)(tb + tok) * 512 + head * 64 + ch * 8);
      } else if (L < 1408) {
        const int vl = L - 1280, tok = vl >> 2, hf = vl & 3;
        rg[i] = *(const u32x4*)(SV + (size_t)(tb + tok) * 512 + head * 64 + rowgrp * 32 + hf * 8);
      }
    }
  };
  auto lstore = [&](int buf) {
    unsigned char* b = lds + buf * SC_STAGE;
#pragma unroll
    for (int i = 0; i < 3; ++i) {
      const int L = tid + NTHREADS * i;
      float f[8];
      if (L < 1280) {
        const int arr = L >> 8, tok = (L & 255) >> 3, ch = L & 7;
        if (arr == 2) {
#pragma unroll
          for (int j = 0; j < 4; ++j) {
            const unsigned u = rg[i][j];
            f[2 * j] = (float)__builtin_bit_cast(_Float16, (unsigned short)(u & 0xffffu));
            f[2 * j + 1] = (float)__builtin_bit_cast(_Float16, (unsigned short)(u >> 16));
          }
        } else unpack8(rg[i], f);
        float* d = (float*)(b + arr * SC_ARR + tok * 256 + ch * 32);
        *(f32x4*)d = (f32x4){f[0], f[1], f[2], f[3]};
        *(f32x4*)(d + 4) = (f32x4){f[4], f[5], f[6], f[7]};
      } else if (L < 1408) {
        const int vl = L - 1280, tok = vl >> 2, hf = vl & 3;
        unpack8(rg[i], f);
        if (!use_v) {
#pragma unroll
          for (int j = 0; j < 8; ++j) f[j] = 0.f;
        }
        float* d = (float*)(b + 5 * SC_ARR + tok * 128 + hf * 32);
        *(f32x4*)d = (f32x4){f[0], f[1], f[2], f[3]};
        *(f32x4*)(d + 4) = (f32x4){f[4], f[5], f[6], f[7]};
      }
    }
  };
  const int rl = lane >> 4, c = lane & 15;
  const int vrow = rowgrp * 32 + 4 * wave + rl;
  f32x4 s = {0.f, 0.f, 0.f, 0.f};
  if (init_mode == 1) s = *(const f32x4*)(init + vrow * 64 + 4 * c);
  if (init_mode == 2) { s[0] = (4 * c == vrow) ? 1.f : 0.f; s[1] = (4 * c + 1 == vrow) ? 1.f : 0.f; s[2] = (4 * c + 2 == vrow) ? 1.f : 0.f; s[3] = (4 * c + 3 == vrow) ? 1.f : 0.f; }
  f32x4 s2 = {(4 * c == vrow) ? 1.f : 0.f, (4 * c + 1 == vrow) ? 1.f : 0.f, (4 * c + 2 == vrow) ? 1.f : 0.f, (4 * c + 3 == vrow) ? 1.f : 0.f};
  gload(0); lstore(0);
  __syncthreads();
  const int nch = nsteps / SC_TOK;
  for (int ci = 0; ci < nch; ++ci) {
    const bool more = ci + 1 < nch;
    if (more) gload(ci + 1);
    {
      const unsigned char* b = lds + (ci & 1) * SC_STAGE + c * 16;
      const unsigned char* bv = lds + (ci & 1) * SC_STAGE + 5 * SC_ARR + (4 * wave + rl) * 4;
      bf16_t* yp = Y + (size_t)(tok0 + ci * SC_TOK + c) * 512 + head * 64 + vrow;
      bf16_t* yp2 = DUAL ? Y2 + (size_t)(tok0 + ci * SC_TOK + c) * 512 + head * 64 + vrow : nullptr;
      f32x4 A4[3], B4[3], W4[3], K4[3], R4[3]; float V1[3];
#define SC_LOAD(slot, t)                                                                                          \
      { A4[slot] = *(const f32x4*)(b + 0 * SC_ARR + (t) * 256); B4[slot] = *(const f32x4*)(b + 1 * SC_ARR + (t) * 256);    \
        W4[slot] = *(const f32x4*)(b + 2 * SC_ARR + (t) * 256); K4[slot] = *(const f32x4*)(b + 3 * SC_ARR + (t) * 256);    \
        R4[slot] = *(const f32x4*)(b + 4 * SC_ARR + (t) * 256); V1[slot] = *(const float*)(bv + (t) * 128); }
      SC_LOAD(0, 0) SC_LOAD(1, 1)
      float ysel = 0.f, ysel2 = 0.f;
#pragma unroll
      for (int t = 0; t < SC_TOK; ++t) {
        if (t + 2 < SC_TOK) SC_LOAD((t + 2) % 3, t + 2)
        const f32x4 a4 = A4[t % 3], b4 = B4[t % 3], w4 = W4[t % 3], k4 = K4[t % 3], r4 = R4[t % 3];
        const float vv = V1[t % 3];
        const f32x4 vk = vv * k4;
        float sa = (s[0] * a4[0] + s[2] * a4[2]) + (s[1] * a4[1] + s[3] * a4[3]);
        sa = dpp_sum16(sa);
        s = s * w4 + (sa * b4 + vk);
        float y = (s[0] * r4[0] + s[2] * r4[2]) + (s[1] * r4[1] + s[3] * r4[3]);
        y = dpp_sum16(y);
        ysel = (c == (t & 15)) ? y : ysel;
        if ((t & 15) == 15) yp[(size_t)(t - 15) * 512] = f2bf(ysel);
        if (DUAL) {
          float sb = (s2[0] * a4[0] + s2[2] * a4[2]) + (s2[1] * a4[1] + s2[3] * a4[3]);
          sb = dpp_sum16(sb);
          s2 = s2 * w4 + sb * b4;
          float y2 = (s2[0] * r4[0] + s2[2] * r4[2]) + (s2[1] * r4[1] + s2[3] * r4[3]);
          y2 = dpp_sum16(y2);
          ysel2 = (c == (t & 15)) ? y2 : ysel2;
          if ((t & 15) == 15) yp2[(size_t)(t - 15) * 512] = f2bf(ysel2);
        }
      }
#undef SC_LOAD
    }
    if (more) lstore((ci + 1) & 1);
    __syncthreads();
  }
  *(f32x4*)(state_out + vrow * 64 + 4 * c) = s;
  if (DUAL) *(f32x4*)(state2 + vrow * 64 + 4 * c) = s2;
}

constexpr int Q_PSCAN = 8 * (2 + 2 * (SCC - 1)), Q_PATT = 512, Q_SATT = 128, Q_SSCAN = 256, Q_TOTAL = Q_PSCAN + Q_PATT + Q_SATT + Q_SSCAN;
DI void phase3(const Params& p, unsigned char* lds) {
  volatile int* s_itemp = (volatile int*)(lds + LDS_CTRL);
  unsigned* ctr = (unsigned*)(p.ws + O_CTR);
  float* Gb = (float*)((unsigned char*)p.out + OO_GH);
  float* Hb = Gb + (size_t)8 * SCC * 4096;
  bf16_t* Y = (bf16_t*)(p.ws + O_Y);
  bf16_t* E = (bf16_t*)(p.ws + O_E);
  for (;;) {
    if (tidx() == 0) *s_itemp = (int)atomicAdd(ctr, 1u);
    __syncthreads();
    const int item = *s_itemp;
    __syncthreads();
    if (item >= Q_TOTAL) break;
    if (item < Q_PSCAN) {
      const int hd = item / (2 + 2 * (SCC - 1)), j = item % (2 + 2 * (SCC - 1));
      if (j < 2) scan_job<false>(p, lds, hd, j, 0, SCL, 0, nullptr, true, Y, Hb + ((size_t)hd * SCC) * 4096);
      else {
        const int jj = j - 2, c = 1 + (jj >> 1), k = jj & 1;
        scan_job<true>(p, lds, hd, k, c * SCL, SCL, 0, nullptr, true, Y, Hb + ((size_t)hd * SCC + c) * 4096, E, Gb + ((size_t)hd * SCC + c) * 4096);
      }
    } else if (item < Q_PSCAN + Q_PATT) {
      const int k = item - Q_PSCAN, qb = 63 - (k >> 3), hd = k & 7;
      attn_item(p, lds, hd, qb * 256, 8, 0, qb * 4 + 4, (qb * 4 + 4) * 64, true);
    } else if (item < Q_PSCAN + Q_PATT + Q_SATT) {
      const int k = item - Q_PSCAN - Q_PATT, b = k >> 3, hd = k & 7;
      attn_item(p, lds, hd, NP + b * 32, 1, NP + b * SKV, 17, SKV, false);
    } else {
      const int k = item - Q_PSCAN - Q_PATT - Q_SATT, b = k >> 4, hd = (k & 15) >> 1, rg = k & 1;
      scan_job<false>(p, lds, hd, rg, NP + b * 32, 32, 1, p.in[4] + ((size_t)b * 8 + hd) * 4096, true, Y, p.out + F_WKVS + ((size_t)b * 8 + hd) * 4096);
    }
  }
}

DI void phase3b(const Params& p, unsigned char* lds) {
  if (blockIdx.x >= 32) return;
  const int hd = blockIdx.x & 7, q = blockIdx.x >> 3, tid = tidx();
  const float* Gb = (const float*)((unsigned char*)p.out + OO_GH);
  const float* Hb = Gb + (size_t)8 * SCC * 4096;
  bf16_t* SST = (bf16_t*)((unsigned char*)p.out + OO_SST);
  float* S = (float*)lds;
  float* Gs = S + 16 * 65 + 3;
  Gs = (float*)lds + 1044;
  const int vl = tid >> 5, v = 16 * q + vl, k0 = (tid & 31) * 2;
  f32x2 cur = *(const f32x2*)(Hb + ((size_t)hd * SCC) * 4096 + v * 64 + k0);
  for (int c = 1; c < SCC; ++c) {
    const float* Gc = Gb + ((size_t)hd * SCC + c) * 4096;
    const f32x4 ga = *(const f32x4*)(Gc + tid * 8), gb2 = *(const f32x4*)(Gc + tid * 8 + 4);
    f32x2 o = *(const f32x2*)(Hb + ((size_t)hd * SCC + c) * 4096 + v * 64 + k0);
    __syncthreads();
    S[vl * 65 + k0] = cur[0]; S[vl * 65 + k0 + 1] = cur[1];
    *(f32x4*)(Gs + tid * 8) = ga; *(f32x4*)(Gs + tid * 8 + 4) = gb2;
    *(unsigned*)(SST + ((size_t)c * 8 + hd) * 4096 + v * 64 + k0) = pk2(cur[0], cur[1]);
    __syncthreads();
#pragma unroll 8
    for (int i = 0; i < 64; ++i) {
      const float sv = S[vl * 65 + i];
      const f32x2 g = *(const f32x2*)(Gs + i * 64 + k0);
      o[0] += sv * g[0]; o[1] += sv * g[1];
    }
    cur = o;
  }
  *(f32x2*)(p.out + F_WKVP + (size_t)hd * 4096 + v * 64 + k0) = cur;
}

DI void phase4a(const Params& p) {
  const int tid = tidx(), lane = tid & 63, r = lane & 31, hh = lane >> 5;
  const int gw = (blockIdx.x * NTHREADS + tid) >> 6, ngw = (gridDim.x * NTHREADS) >> 6;
  const bf16_t* Y = (const bf16_t*)(p.ws + O_Y);
  const bf16_t* E = (const bf16_t*)(p.ws + O_E);
  const bf16_t* SST = (const bf16_t*)((unsigned char*)p.out + OO_SST);
  const bf16_t* SV = (const bf16_t*)(p.ws + O_SIN) + 2 * (size_t)NT * 512;
  const bf16_t* G = (const bf16_t*)(p.ws + O_G);
  const float* RK = (const float*)(p.ws + O_RK);
  bf16_t* YA = (bf16_t*)(p.ws + O_YA);
  for (int task = gw; task < (NT / 32) * 8; task += ngw) {
    const int tile = task >> 3, hd = task & 7, t0 = tile * 32, t = t0 + r;
    f32x16 acc[2];
#pragma unroll
    for (int i = 0; i < 16; ++i) { acc[0][i] = 0.f; acc[1][i] = 0.f; }
    const int c = t0 < NP ? t0 / SCL : 0;
    if (c >= 1) {
      const bf16_t* sst = SST + ((size_t)c * 8 + hd) * 4096;
#pragma unroll
      for (int ks = 0; ks < 4; ++ks) {
        const bf16x8 bv = *(const bf16x8*)(E + (size_t)t * 512 + hd * 64 + ks * 16 + hh * 8);
#pragma unroll
        for (int mt = 0; mt < 2; ++mt) {
          const bf16x8 av = *(const bf16x8*)(sst + (mt * 32 + r) * 64 + ks * 16 + hh * 8);
          acc[mt] = MFMA32(av, bv, acc[mt]);
        }
      }
    }
    float sum = 0.f;
#pragma unroll
    for (int mt = 0; mt < 2; ++mt)
#pragma unroll
      for (int g = 0; g < 4; ++g) {
        const u32x2 yv = *(const u32x2*)(Y + (size_t)t * 512 + hd * 64 + mt * 32 + 8 * g + 4 * hh);
        acc[mt][4 * g] += __uint_as_float(yv[0] << 16); acc[mt][4 * g + 1] += __uint_as_float(yv[0] & 0xffff0000u);
        acc[mt][4 * g + 2] += __uint_as_float(yv[1] << 16); acc[mt][4 * g + 3] += __uint_as_float(yv[1] & 0xffff0000u);
        sum += (acc[mt][4 * g] + acc[mt][4 * g + 1]) + (acc[mt][4 * g + 2] + acc[mt][4 * g + 3]);
      }
    sum += __shfl_xor(sum, 32);
    const float mean = sum * (1.f / 64.f);
    float sq = 0.f;
#pragma unroll
    for (int mt = 0; mt < 2; ++mt)
#pragma unroll
      for (int i = 0; i < 16; ++i) { const float d = acc[mt][i] - mean; sq += d * d; }
    sq += __shfl_xor(sq, 32);
    const float rstd = rsqrtf(sq * (1.f / 64.f) + 64e-5f);
    const float bon = RK[(size_t)t * 8 + hd];
#pragma unroll
    for (int mt = 0; mt < 2; ++mt)
#pragma unroll
      for (int g = 0; g < 4; ++g) {
        const int c0 = hd * 64 + mt * 32 + 8 * g + 4 * hh;
        const size_t o = (size_t)t * 512 + c0;
        const f32x4 lg = *(const f32x4*)(p.in[16] + c0), lb = *(const f32x4*)(p.in[17] + c0);
        const u32x2 vv = *(const u32x2*)(SV + o), gg = *(const u32x2*)(G + o);
        const float vf[4] = {__uint_as_float(vv[0] << 16), __uint_as_float(vv[0] & 0xffff0000u), __uint_as_float(vv[1] << 16), __uint_as_float(vv[1] & 0xffff0000u)};
        const float gf[4] = {__uint_as_float(gg[0] << 16), __uint_as_float(gg[0] & 0xffff0000u), __uint_as_float(gg[1] << 16), __uint_as_float(gg[1] & 0xffff0000u)};
        float ov[4];
#pragma unroll
        for (int j = 0; j < 4; ++j) ov[j] = ((acc[mt][4 * g + j] - mean) * rstd * lg[j] + lb[j] + bon * vf[j]) * gf[j];
        u32x2 w; w[0] = pk2(ov[0], ov[1]); w[1] = pk2(ov[2], ov[3]);
        *(u32x2*)(YA + o) = w;
      }
  }
  conv_x(p, (bf16_t*)((unsigned char*)p.out + OO_XB), blockIdx.x * NTHREADS + tidx(), gridDim.x * NTHREADS);
}

DI bool small_tile_of_block(int& m0, int& n0) {
  const int j = blockIdx.x >> 3;
  if (gridDim.x != 256 || (blockIdx.x & 7) != (j & 7)) return false;
  m0 = NP + (j >> 3) * 128; n0 = (j & 7) * 128; return true;
}
template <int TM>
DI void p4_tile(const Params& p, unsigned char* lds, int m0, int n0) {
  const bf16_t* XB = (const bf16_t*)((unsigned char*)p.out + OO_XB);
  const bf16_t* WIN = (const bf16_t*)(p.ws + O_WIN);
  const bf16_t* YA = (const bf16_t*)(p.ws + O_YA);
  const bf16_t* YB = (const bf16_t*)(p.ws + O_YB);
  bf16_t* M = (bf16_t*)(p.ws + O_M);
  const int tid = tidx(), lane = tid & 63, h = lane >> 5, wn = __builtin_amdgcn_readfirstlane(tid >> 6) >> 2;
  f32x16 accg[TM][2], accv[TM][2];
  gemm_mainloop<TM, 2>(YB, 512, (const bf16_t*)(p.ws + O_WPB), 512, 512, m0, n0, 1024, accv, lds);
  gemm_mainloop<TM, 2>(XB, DM, WIN + (size_t)(PABC + 1024) * DM, DM, DM, m0, n0, 1024, accg, lds);
#pragma unroll
  for (int tn = 0; tn < 2; ++tn)
#pragma unroll
    for (int g = 0; g < 4; ++g) {
      const f32x4 bg = *(const f32x4*)(p.in[24] + 1024 + n0 + wn * 64 + tn * 32 + 8 * g + 4 * h);
#pragma unroll
      for (int tm = 0; tm < TM; ++tm)
#pragma unroll
        for (int j = 0; j < 4; ++j) accv[tm][tn][4 * g + j] *= sigmoidf_(accg[tm][tn][4 * g + j] + bg[j]);
      __builtin_amdgcn_sched_barrier(0);
    }
  gemm_mainloop<TM, 2>(XB, DM, WIN + (size_t)PABC * DM, DM, DM, m0, n0, 1024, accg, lds);
#pragma unroll
  for (int tn = 0; tn < 2; ++tn)
#pragma unroll
    for (int g = 0; g < 4; ++g) {
      const f32x4 bg = *(const f32x4*)(p.in[24] + n0 + wn * 64 + tn * 32 + 8 * g + 4 * h);
#pragma unroll
      for (int tm = 0; tm < TM; ++tm)
#pragma unroll
        for (int j = 0; j < 4; ++j) {
          const float e = __expf(-(accg[tm][tn][4 * g + j] + bg[j]));
          accv[tm][tn][4 * g + j] *= (1.f + e);
          accg[tm][tn][4 * g + j] = 1.f / (1.f + e);
        }
      __builtin_amdgcn_sched_barrier(0);
    }
  gemm_mainloop<TM, 2, false>(YA, 512, (const bf16_t*)(p.ws + O_WPA), 512, 512, m0, n0, 1024, accv, lds);
  epilogue_bf16<TM, 2, 128>(accv, lds, M, DM, m0, n0, DM, [&](int tm, int tn, int g, int, int) { return acc4(accg[tm][tn], g) * acc4(accv[tm][tn], g); });
}
DI void phase4(const Params& p, unsigned char* lds) {
  if (gridDim.x == 256) {
    TileIter ti; ti.init(NP / 256, 8);
    int tmi, tni;
    while (ti.next(tmi, tni)) p4_tile<2>(p, lds, tmi * 256, tni * 128);
    int m0, n0;
    if (small_tile_of_block(m0, n0)) p4_tile<1>(p, lds, m0, n0);
  } else {
    TileIter ti; ti.init(NT / 128, 8);
    int tmi, tni;
    while (ti.next(tmi, tni)) p4_tile<1>(p, lds, tmi * 128, tni * 128);
  }
}

template <int TM, int TN, int NST>
DI void p5_tile(const Params& p, unsigned char* lds, int m0, int n0) {
  const bf16_t* M = (const bf16_t*)(p.ws + O_M);
  bf16_t* Z = (bf16_t*)(p.ws + O_Z);
  f32x16 acc[TM][TN];
  gemm_mainloop<TM, TN, true, NST>(M, DM, (const bf16_t*)(p.ws + O_WO), DM, DM, m0, n0, 1024, acc, lds);
  epilogue_bf16<TM, TN, 64 * TN>(acc, lds, Z, DM, m0, n0, DM, [&](int tm, int tn, int g, int rowl, int coll) {
    const f32x4 xv = *(const f32x4*)(xrow(p, m0 + rowl) + n0 + coll);
    return xv * DN_ALPHA + acc4(acc[tm][tn], g);
  });
}
DI void phase5(const Params& p, unsigned char* lds) {
  if (gridDim.x == 256) {
    TileIter ti; ti.init(NP / 256, 4);
    int tmi, tni;
    while (ti.next(tmi, tni)) p5_tile<2, 4, 2>(p, lds, tmi * 256, tni * 256);
    int m0, n0;
    if (small_tile_of_block(m0, n0)) p5_tile<1, 2, 3>(p, lds, m0, n0);
  } else {
    TileIter ti; ti.init(NT / 256, 8);
    int tmi, tni;
    while (ti.next(tmi, tni)) p5_tile<2, 2, 3>(p, lds, tmi * 256, tni * 128);
  }
}
template <bool OUT_BF16>
DI void ln_rows(const bf16_t* src, const float* g, const float* b, bf16_t* dst16, float* dst32) {
  const int gw = (blockIdx.x * NTHREADS + tidx()) >> 6, ngw = (gridDim.x * NTHREADS) >> 6, lane = tidx() & 63;
  for (int t = gw; t < NT; t += ngw) {
    const u32x4* xr = (const u32x4*)(src + (size_t)t * DM) + lane;
    float v[16]; float s = 0.f;
#pragma unroll
    for (int j = 0; j < 2; ++j) { unpack8(xr[64 * j], v + 8 * j); }
#pragma unroll
    for (int j = 0; j < 16; ++j) s += v[j];
    const float mean = wave_sum(s) * (1.f / DM);
    float s2 = 0.f;
#pragma unroll
    for (int j = 0; j < 16; ++j) { v[j] -= mean; s2 += v[j] * v[j]; }
    const float rstd = rsqrtf(wave_sum(s2) * (1.f / DM) + 1e-5f);
#pragma unroll
    for (int j = 0; j < 2; ++j) {
      const int c = 8 * lane + 512 * j;
      const f32x4 g0 = *(const f32x4*)(g + c), g1 = *(const f32x4*)(g + c + 4), b0 = *(const f32x4*)(b + c), b1 = *(const f32x4*)(b + c + 4);
      float o[8];
#pragma unroll
      for (int q = 0; q < 4; ++q) { o[q] = v[8 * j + q] * rstd * g0[q] + b0[q]; o[4 + q] = v[8 * j + 4 + q] * rstd * g1[q] + b1[q]; }
      if (OUT_BF16) *(u32x4*)(dst16 + (size_t)t * DM + c) = pack8(o);
      else { *(f32x4*)(dst32 + (size_t)t * DM + c) = (f32x4){o[0], o[1], o[2], o[3]}; *(f32x4*)(dst32 + (size_t)t * DM + c + 4) = (f32x4){o[4], o[5], o[6], o[7]}; }
    }
  }
}

DI void phase6(const Params& p, unsigned char* lds) {
  const bf16_t* H = (const bf16_t*)(p.ws + O_H);
  bf16_t* ACT = (bf16_t*)(p.ws + O_ACT);
  constexpr int NMT = NT / 256, NNT = 5632 / 256;
  TileIter ti; ti.init(NMT, NNT);
  int tmi, tni;
  while (ti.next(tmi, tni)) {
    const int m0 = tmi * 256, n0 = tni * 256;
    f32x16 acc[2][4];
    gemm_mainloop<2, 4, true, 2>(H, DM, (const bf16_t*)(p.ws + O_WGU), DM, DM, m0, n0, 5632, acc, lds);
    epilogue_bf16<2, 4, 128>(acc, lds, ACT, DFF, m0, tni * 128, DFF, [&](int tm, int q, int g, int, int) {
      f32x4 o;
#pragma unroll
      for (int j = 0; j < 4; ++j) { const float gte = acc[tm][2 * q][4 * g + j], up = acc[tm][2 * q + 1][4 * g + j]; o[j] = gte * sigmoidf_(gte) * up; }
      return o;
    });
  }
}
template <int TM, int TN, int NST>
DI void p7_tile(const Params& p, unsigned char* lds, int m0, int n0) {
  const bf16_t* H = (const bf16_t*)(p.ws + O_H);
  const bf16_t* ACT = (const bf16_t*)(p.ws + O_ACT);
  bf16_t* Z2 = (bf16_t*)(p.ws + O_Z2);
  f32x16 acc[TM][TN];
  gemm_mainloop<TM, TN, true, NST>(ACT, DFF, (const bf16_t*)(p.ws + O_WDN), DFF, DFF, m0, n0, 1024, acc, lds);
  epilogue_bf16<TM, TN, 64 * TN>(acc, lds, Z2, DM, m0, n0, DM, [&](int tm, int tn, int g, int rowl, int coll) {
    const u32x2 hv = *(const u32x2*)(H + (size_t)(m0 + rowl) * DM + n0 + coll);
    const f32x4 hf = {__uint_as_float(hv[0] << 16), __uint_as_float(hv[0] & 0xffff0000u), __uint_as_float(hv[1] << 16), __uint_as_float(hv[1] & 0xffff0000u)};
    return hf * DN_ALPHA + acc4(acc[tm][tn], g);
  });
}
DI void phase7(const Params& p, unsigned char* lds) {
  if (gridDim.x == 256) {
    TileIter ti; ti.init(NP / 256, 4);
    int tmi, tni;
    while (ti.next(tmi, tni)) p7_tile<2, 4, 2>(p, lds, tmi * 256, tni * 256);
    int m0, n0;
    if (small_tile_of_block(m0, n0)) p7_tile<1, 2, 3>(p, lds, m0, n0);
  } else {
    TileIter ti; ti.init(NT / 256, 8);
    int tmi, tni;
    while (ti.next(tmi, tni)) p7_tile<2, 2, 3>(p, lds, tmi * 256, tni * 128);
  }
}

DI void run_phase(const Params& p, unsigned char* lds, int ph) {
  switch (ph) {
    case 0: phase0(p, lds); break;
    case 1: phase1(p, lds); break;
    case 2: phase2(p, lds); break;
    case 3: phase3(p, lds); break;
    case 4: phase4a(p); break;
    case 5: phase4(p, lds); break;
    case 6: phase5(p, lds); break;
    case 7: ln_rows<true>((const bf16_t*)(p.ws + O_Z), p.in[26], p.in[27], (bf16_t*)(p.ws + O_H), nullptr); break;
    case 8: phase6(p, lds); break;
    case 9: phase7(p, lds); break;
    case 11: phase3b(p, lds); break;
    case 10: ln_rows<false>((const bf16_t*)(p.ws + O_Z2), p.in[30], p.in[31], nullptr, p.out + F_Y); break;
  }
}
constexpr int NPHASES = 11;

DI unsigned ctl_ld(unsigned* p) { return __hip_atomic_load(p, __ATOMIC_RELAXED, __HIP_MEMORY_SCOPE_AGENT); }
DI unsigned ctl_add(unsigned* p, unsigned v) { return __hip_atomic_fetch_add(p, v, __ATOMIC_RELAXED, __HIP_MEMORY_SCOPE_AGENT); }
DI void xbar(unsigned* ctl, unsigned x, unsigned nloc, unsigned nx, unsigned k) {
  asm volatile("s_waitcnt vmcnt(0)" ::: "memory");
  __syncthreads();
  if (threadIdx.x == 0) {
    const unsigned old = ctl_add(&ctl[(24 + x) * 64], 1u);
    if (old + 1u == k * nloc) {
      __builtin_amdgcn_fence(__ATOMIC_RELEASE, "agent");
      asm volatile("s_waitcnt vmcnt(0)" ::: "memory");
      ctl_add(&ctl[40 * 64], 1u);
    }
    while (ctl_ld(&ctl[40 * 64]) < k * nx) __builtin_amdgcn_s_sleep(1);
    __builtin_amdgcn_fence(__ATOMIC_ACQUIRE, "agent");
    asm volatile("s_waitcnt vmcnt(0)" ::: "memory");
  }
  __syncthreads();
}

__global__ void __launch_bounds__(NTHREADS) mega_kernel(Params p) {
  extern __shared__ __attribute__((aligned(16))) unsigned char lds[];
  volatile unsigned* s_bar = (volatile unsigned*)(lds + LDS_CTRL + 16);
  cg::grid_group grid = cg::this_grid();
  unsigned* ctl = (unsigned*)(p.ws + O_CTR);
  const unsigned x = (unsigned)__builtin_amdgcn_s_getreg((3 << 11) | 20) & 0xFu;
  if (threadIdx.x == 0) ctl_add(&ctl[(8 + x) * 64], 1u);
  run_phase(p, lds, 0); grid.sync();
  if (threadIdx.x == 0) {
    unsigned nx = 0;
    for (int i = 0; i < 16; ++i) nx += ctl_ld(&ctl[(8 + i) * 64]) != 0u ? 1u : 0u;
    s_bar[0] = ctl_ld(&ctl[(8 + x) * 64]); s_bar[1] = nx;
  }
  __syncthreads();
  const unsigned nloc = __builtin_amdgcn_readfirstlane(s_bar[0]), nx = __builtin_amdgcn_readfirstlane(s_bar[1]);
  run_phase(p, lds, 1); xbar(ctl, x, nloc, nx, 1);
  run_phase(p, lds, 2); xbar(ctl, x, nloc, nx, 2);
  run_phase(p, lds, 3); xbar(ctl, x, nloc, nx, 3);
  run_phase(p, lds, 11); xbar(ctl, x, nloc, nx, 4);
  run_phase(p, lds, 4); xbar(ctl, x, nloc, nx, 5);
  run_phase(p, lds, 5); xbar(ctl, x, nloc, nx, 6);
  run_phase(p, lds, 6); xbar(ctl, x, nloc, nx, 7);
  run_phase(p, lds, 7); xbar(ctl, x, nloc, nx, 8);
  run_phase(p, lds, 8); xbar(ctl, x, nloc, nx, 9);
  run_phase(p, lds, 9); xbar(ctl, x, nloc, nx, 10);
  run_phase(p, lds, 10);
}
template <int PH> __global__ void __launch_bounds__(NTHREADS) phase_kernel(Params p) {
  extern __shared__ __attribute__((aligned(16))) unsigned char lds[];
  run_phase(p, lds, PH);
}
template <int PH> static void launch_phase(const Params& p, int grid, hipStream_t stream) {
  (void)hipFuncSetAttribute((const void*)phase_kernel<PH>, hipFuncAttributeMaxDynamicSharedMemorySize, LDS_BYTES);
  hipLaunchKernelGGL(phase_kernel<PH>, dim3(grid), dim3(NTHREADS), LDS_BYTES, stream, p);
}

extern "C" void kernel_launch(void* const* d_in, const int* in_sizes, int n_in, void* d_out, int out_size, void* d_ws, size_t ws_size, hipStream_t stream) {
  static int grid_blocks = 0;
  if (grid_blocks == 0) {
    if (n_in != 32 || ws_size < WS_END) { fprintf(stderr, "kernel_launch: unexpected n_in %d or ws_size %zu (< %zu)\n", n_in, ws_size, (size_t)WS_END); grid_blocks = -1; return; }
    int dev = 0, cus = 0, per_cu = 0;
    (void)hipGetDevice(&dev);
    (void)hipDeviceGetAttribute(&cus, hipDeviceAttributeMultiprocessorCount, dev);
#if MULTI_LAUNCH
    per_cu = 1;
#else
    (void)hipFuncSetAttribute((const void*)mega_kernel, hipFuncAttributeMaxDynamicSharedMemorySize, LDS_BYTES);
    (void)hipOccupancyMaxActiveBlocksPerMultiprocessor(&per_cu, (const void*)mega_kernel, NTHREADS, LDS_BYTES);
#endif
    if (per_cu < 1) { fprintf(stderr, "kernel_launch: occupancy query gave %d\n", per_cu); grid_blocks = -1; return; }
    grid_blocks = cus;
  }
  if (grid_blocks < 0) return;
  Params p{};
  for (int i = 0; i < 32; ++i) p.in[i] = (const float*)d_in[i];
  p.out = (float*)d_out;
  p.ws = (unsigned char*)d_ws;
#if MULTI_LAUNCH
  launch_phase<0>(p, grid_blocks, stream); launch_phase<1>(p, grid_blocks, stream); launch_phase<2>(p, grid_blocks, stream); launch_phase<3>(p, grid_blocks, stream); launch_phase<11>(p, grid_blocks, stream);
  launch_phase<4>(p, grid_blocks, stream); launch_phase<5>(p, grid_blocks, stream); launch_phase<6>(p, grid_blocks, stream); launch_phase<7>(p, grid_blocks, stream);
  launch_phase<8>(p, grid_blocks, stream); launch_phase<9>(p, grid_blocks, stream); launch_phase<10>(p, grid_blocks, stream);
#else
  (void)hipMemsetAsync((unsigned char*)d_ws + O_CTR, 0, 16384, stream);
  void* args[] = {&p};
  hipError_t e = hipLaunchCooperativeKernel((void*)mega_kernel, dim3(grid_blocks), dim3(NTHREADS), args, LDS_BYTES, stream);
  if (e != hipSuccess) fprintf(stderr, "cooperative launch failed: %s (grid %d)\n", hipGetErrorString(e), grid_blocks);
#endif
}
```

```cpp
#include <hip/hip_runtime.h>
#include <hip/hip_cooperative_groups.h>
#include <cstdio>
#include <cstdint>
namespace cg = cooperative_groups;


#ifndef PROBE_DUP
#define PROBE_DUP -1
#endif
#ifndef MULTI_LAUNCH
#define MULTI_LAUNCH 0
#endif

#define DI __device__ __forceinline__
typedef unsigned short bf16_t;
typedef short bf16x8 __attribute__((ext_vector_type(8)));
typedef short s16x4 __attribute__((ext_vector_type(4)));
typedef float f32x16 __attribute__((ext_vector_type(16)));
typedef float f32x4 __attribute__((ext_vector_type(4)));
typedef float f32x2 __attribute__((ext_vector_type(2)));
typedef unsigned u32x4 __attribute__((ext_vector_type(4)));
typedef unsigned u32x2 __attribute__((ext_vector_type(2)));
typedef __bf16 bf2_t __attribute__((ext_vector_type(2)));

constexpr int NP = 16384, NS = 512, NT = NP + NS;
constexpr int DM = 1024, ACOLS = 1792, BCOLS = 416, PABC = ACOLS + BCOLS  , NIN = 4256;
constexpr int DFF = 2816;
constexpr int PAST = 1024, DSEQ = 32, DB = 16, SKV = PAST + DSEQ  ;
constexpr int NKV = NP + DB * SKV  , NKVP = NKV + 64;
constexpr float DN_ALPHA = 1.189207115002721f;
constexpr float QSCALE = 0.10206207261596575f * 1.4426950408889634f;

constexpr size_t al256(size_t x) { return (x + 255) & ~(size_t)255; }
constexpr size_t O_WIN = 0;
constexpr size_t O_WUQ = O_WIN + al256((size_t)NIN * 1024 * 2);
constexpr size_t O_WUKV = O_WUQ + al256(768 * 256 * 2);
constexpr size_t O_WPA = O_WUKV + al256(1024 * 128 * 2);
constexpr size_t O_WPB = O_WPA + al256(1024 * 512 * 2);
constexpr size_t O_WO = O_WPB + al256(1024 * 512 * 2);
constexpr size_t O_WGU = O_WO + al256(1024 * 1024 * 2);
constexpr size_t O_WDN = O_WGU + al256((size_t)5632 * 1024 * 2);
constexpr size_t O_WW2 = O_WDN + al256((size_t)1024 * 2816 * 2);
constexpr size_t O_WA2 = O_WW2 + al256(512 * 64 * 2);
constexpr size_t O_WG2 = O_WA2 + al256(512 * 64 * 2);
constexpr size_t O_ROPE = O_WG2 + al256(512 * 128 * 2);
constexpr size_t O_CTR = O_ROPE + al256((size_t)NT * 32 * 4);
constexpr size_t O_PAB = O_CTR + 16384;
constexpr size_t SZ_T512 = (size_t)NT * 512 * 2;
constexpr size_t O_SIN = O_PAB + al256((size_t)NT * PABC * 2);
constexpr size_t O_G = O_SIN + 6 * SZ_T512;
constexpr size_t O_RK = O_G + SZ_T512;
constexpr size_t O_KNB = O_RK + al256((size_t)NT * 8 * 4);
constexpr size_t O_KPEB = O_KNB + al256((size_t)8 * NKVP * 64 * 2);
constexpr int SCC = 16, SCL = NP / SCC;
constexpr size_t WS_END = O_KPEB + al256((size_t)NKVP * 32 * 2);
constexpr size_t O_Y = O_PAB;
constexpr size_t O_E = O_Y + SZ_T512;
constexpr size_t O_YB = O_Y + (size_t)NT * 512 * 4;
constexpr size_t O_YA = O_YB + SZ_T512;
constexpr size_t O_H = O_PAB;
constexpr size_t O_M = O_SIN;
constexpr size_t O_Z = O_SIN + (size_t)NT * 1024 * 2;
constexpr size_t O_Z2 = O_PAB + (size_t)NT * 1024 * 2;
constexpr size_t O_ACT = O_SIN;
constexpr size_t OO_XB = 0;
constexpr size_t OO_Q = 0;
constexpr size_t OO_VT = (size_t)NT * 768 * 2;
constexpr size_t OO_GH = OO_VT + (size_t)8 * 64 * NKVP * 2;
constexpr size_t OO_SST = OO_GH + 2 * (size_t)8 * SCC * 4096 * 4;
static_assert(OO_SST + (size_t)SCC * 8 * 4096 * 2 <= (size_t)NT * 1024 * 4, "d_out scratch");
constexpr size_t F_Y = 0, F_CKVP = (size_t)NT * 1024, F_KPEP = F_CKVP + (size_t)NP * 128, F_WKVP = F_KPEP + (size_t)NP * 32,
                 F_SHP = F_WKVP + 32768, F_CKVS = F_SHP + 1792, F_KPES = F_CKVS + (size_t)NS * 128, F_WKVS = F_KPES + (size_t)NS * 32,
                 F_SHS = F_WKVS + (size_t)DB * 32768;

constexpr int LDS_CTRL = 3 * 49152;
constexpr int LDS_BYTES = LDS_CTRL + 256;
constexpr int NTHREADS = 512;

struct Params {
  const float* in[32];
  float* out;
  unsigned char* ws;
};

DI int tidx() { int t = threadIdx.x; asm volatile("" : "+v"(t)); return t; }
DI unsigned pk2(float a, float b) { f32x2 v = {a, b}; bf2_t r = __builtin_convertvector(v, bf2_t); return __builtin_bit_cast(unsigned, r); }
DI bf16_t f2bf(float a) { return (bf16_t)(pk2(a, 0.f) & 0xffffu); }
DI float bf2f(bf16_t x) { return __uint_as_float(((unsigned)x) << 16); }
DI void unpack8(u32x4 v, float* f) {
#pragma unroll
  for (int j = 0; j < 4; ++j) { f[2 * j] = __uint_as_float(v[j] << 16); f[2 * j + 1] = __uint_as_float(v[j] & 0xffff0000u); }
}
DI u32x4 pack8(const float* f) { u32x4 o; o[0] = pk2(f[0], f[1]); o[1] = pk2(f[2], f[3]); o[2] = pk2(f[4], f[5]); o[3] = pk2(f[6], f[7]); return o; }
DI float sigmoidf_(float x) { return 1.f / (1.f + __expf(-x)); }
DI float dpp_sum16(float x) {
  x += __builtin_bit_cast(float, __builtin_amdgcn_update_dpp(0, __builtin_bit_cast(int, x), 0xB1, 0xF, 0xF, true));
  x += __builtin_bit_cast(float, __builtin_amdgcn_update_dpp(0, __builtin_bit_cast(int, x), 0x4E, 0xF, 0xF, true));
  x += __builtin_bit_cast(float, __builtin_amdgcn_update_dpp(0, __builtin_bit_cast(int, x), 0x141, 0xF, 0xF, true));
  x += __builtin_bit_cast(float, __builtin_amdgcn_update_dpp(0, __builtin_bit_cast(int, x), 0x140, 0xF, 0xF, true));
  return x;
}
DI float sum32(float x) { x = dpp_sum16(x); x += __shfl_xor(x, 16); return x; }
DI float wave_sum(float v) {
#pragma unroll
  for (int o = 1; o < 64; o <<= 1) v += __shfl_xor(v, o);
  return v;
}
DI int crow(int i, int h) { return (i & 3) + 8 * (i >> 2) + 4 * h; }
#define MFMA32(a, b, c) __builtin_amdgcn_mfma_f32_32x32x16_bf16((a), (b), (c), 0, 0, 0)
DI int slot_of_token(int t) { return t < NP ? t : NP + ((t - NP) >> 5) * SKV + PAST + ((t - NP) & 31); }
DI const float* xrow(const Params& p, int t) { return t < NP ? p.in[0] + (size_t)t * DM : p.in[1] + (size_t)(t - NP) * DM; }

DI void conv_T(const float* W, int K, int N, bf16_t* WT, int mode, int gtid, int gsz) {
  const int ntask = (K / 8) * N;
  for (int id = gtid; id < ntask; id += gsz) {
    const int kc = id / N, n = id - kc * N, k0 = kc * 8;
    float f[8];
#pragma unroll
    for (int j = 0; j < 8; ++j) f[j] = W[(size_t)(k0 + j) * N + n];
    if (mode == 2) {
      *(u32x4*)(WT + ((size_t)((n >> 5) * (K >> 4) + (k0 >> 4)) * 64 + ((k0 >> 3) & 1) * 32 + (n & 31)) * 8) = pack8(f);
      continue;
    }
    int row = n;
    if (mode == 1) { const int nt = n >= DFF ? 1 : 0, j = n - nt * DFF; row = 128 * (j >> 6) + 64 * ((j & 63) >> 5) + 32 * nt + (j & 31); }
    *(u32x4*)(WT + (size_t)row * K + k0) = pack8(f);
  }
}
DI void conv_T_lds(const float* W, int K, int N, bf16_t* WT, int mode, unsigned char* lds, int gw, int ngw, int wave, int lane) {
  float* scr = (float*)(lds + wave * (64 * 33 * 4));
  const int nblk = N >> 5, nitem = (K >> 6) * nblk;
  for (int item = gw; item < nitem; item += ngw) {
    const int kb = item / nblk, nb = item - kb * nblk, k0 = kb * 64, n0 = nb * 32;
#pragma unroll 8
    for (int i = 0; i < 32; ++i) { const int kk = 2 * i + (lane >> 5); scr[kk * 33 + (lane & 31)] = W[(size_t)(k0 + kk) * N + n0 + (lane & 31)]; }
    asm volatile("s_waitcnt lgkmcnt(0)" ::: "memory");
    const int c = lane & 7;
#pragma unroll
    for (int j = 0; j < 4; ++j) {
      const int nl = (lane >> 3) + 8 * j;
      const float* sp = scr + (8 * c) * 33 + nl;
      float f[8];
#pragma unroll
      for (int q = 0; q < 8; ++q) f[q] = sp[q * 33];
      int row = n0 + nl;
      if (mode == 1) { const int nt = row >= DFF ? 1 : 0, jj = row - nt * DFF; row = 256 * (jj >> 7) + 128 * ((jj & 127) >> 6) + 32 * (2 * ((jj & 63) >> 5) + nt) + (jj & 31); }
      *(u32x4*)(WT + (size_t)row * K + k0 + 8 * c) = pack8(f);
    }
    asm volatile("s_waitcnt lgkmcnt(0)" ::: "memory");
  }
}
DI void conv_x(const Params& p, bf16_t* XB, int gtid, int gsz) {
  for (int id = gtid; id < NT * 128; id += gsz) {
    const int t = id >> 7, c = (id & 127) * 8;
    const float* src = xrow(p, t) + c;
    f32x4 a = *(const f32x4*)src, b = *(const f32x4*)(src + 4);
    float f[8] = {a[0], a[1], a[2], a[3], b[0], b[1], b[2], b[3]};
    *(u32x4*)(XB + (size_t)t * DM + c) = pack8(f);
  }
}
DI void phase0(const Params& p, unsigned char* lds) {
  const int tid0 = tidx(), gtid = blockIdx.x * NTHREADS + tid0, gsz = gridDim.x * NTHREADS;
  const int wave0 = __builtin_amdgcn_readfirstlane(tid0 >> 6), lane0 = tid0 & 63, gw = blockIdx.x * 8 + wave0, ngw = gridDim.x * 8;
  unsigned char* ws = p.ws;
  if (gtid < 64) ((unsigned*)(ws + O_CTR))[gtid] = 0u;
  conv_T_lds(p.in[6], 1024, NIN, (bf16_t*)(ws + O_WIN), 0, lds, gw, ngw, wave0, lane0);
  conv_T(p.in[20], 256, 768, (bf16_t*)(ws + O_WUQ), 2, gtid, gsz);
  conv_T(p.in[22], 128, 1024, (bf16_t*)(ws + O_WUKV), 2, gtid, gsz);
  conv_T_lds(p.in[18], 512, 1024, (bf16_t*)(ws + O_WPA), 0, lds, gw, ngw, wave0, lane0);
  conv_T_lds(p.in[23], 512, 1024, (bf16_t*)(ws + O_WPB), 0, lds, gw, ngw, wave0, lane0);
  conv_T_lds(p.in[25], 1024, 1024, (bf16_t*)(ws + O_WO), 0, lds, gw, ngw, wave0, lane0);
  conv_T_lds(p.in[28], 1024, 5632, (bf16_t*)(ws + O_WGU), 1, lds, gw, ngw, wave0, lane0);
  conv_T_lds(p.in[29], 2816, 1024, (bf16_t*)(ws + O_WDN), 0, lds, gw, ngw, wave0, lane0);
  conv_T(p.in[9], 64, 512, (bf16_t*)(ws + O_WW2), 2, gtid, gsz);
  conv_T(p.in[11], 64, 512, (bf16_t*)(ws + O_WA2), 2, gtid, gsz);
  conv_T(p.in[12], 128, 512, (bf16_t*)(ws + O_WG2), 2, gtid, gsz);
  conv_x(p, (bf16_t*)((unsigned char*)p.out + OO_XB), gtid, gsz);
  float* rope = (float*)(ws + O_ROPE);
  for (int id = gtid; id < NT * 16; id += gsz) {
    const int t = id >> 4, j = id & 15;
    const int pos = t < NP ? t : PAST + ((t - NP) & 31);
    const float inv = (float)exp2(-(double)j * (13.287712379549449 / 16.0));
    const float ang = (float)pos * inv;
    const double x = (double)ang;
    const double n = rint(x * 0.15915494309189535);
    const float red = (float)(x - n * 6.283185307179586);
    rope[t * 32 + j] = __cosf(red);
    rope[t * 32 + 16 + j] = __sinf(red);
  }
  bf16_t* kpeb = (bf16_t*)(ws + O_KPEB);
  for (int id = gtid; id < DB * PAST * 4; id += gsz) {
    const int row = id >> 2, ch = id & 3, b = row >> 10, j = row & 1023;
    const float* src = p.in[3] + (size_t)row * 32 + ch * 8;
    f32x4 a = *(const f32x4*)src, c = *(const f32x4*)(src + 4);
    float f[8] = {a[0], a[1], a[2], a[3], c[0], c[1], c[2], c[3]};
    *(u32x4*)(kpeb + (size_t)(NP + b * SKV + j) * 32 + ch * 8) = pack8(f);
  }
  bf16_t* knb = (bf16_t*)(ws + O_KNB);
  for (int id = gtid; id < 64 * 32; id += gsz) kpeb[(size_t)NKV * 32 + id] = 0;
  for (int id = gtid; id < 8 * 64 * 64; id += gsz) {
    const int h = id >> 12, rem = id & 4095;
    knb[((size_t)h * NKVP + NKV) * 64 + rem] = 0;
  }
}

template <int TM, int TN, bool ZERO = true, int NST = 3>
DI void gemm_mainloop(const bf16_t* __restrict__ A, int lda, const bf16_t* __restrict__ Bt, int ldb, int K, int m0, int n0, int nmax,
                      f32x16 (&acc)[TM][TN], unsigned char* lds) {
  constexpr int BM = 128 * TM, BN = 64 * TN, AG = BM / 64, BG = BN / 64, NLD = AG + BG;
  constexpr int ABYTES = BM * 128, STAGE = (BM + BN) * 128;
  static_assert(NST * STAGE <= LDS_CTRL && (NST == 2 || NST == 3), "lds");
  const int tid = tidx(), wave = __builtin_amdgcn_readfirstlane(tid >> 6), lane = tid & 63, r = lane & 31, h = lane >> 5, wm = wave & 3, wn = wave >> 2;
  const int lrow = lane >> 3, lpos = lane & 7;
  const bf16_t* ap[AG]; const bf16_t* bp[BG];
#pragma unroll
  for (int i = 0; i < AG; ++i) { const int row = (wave * AG + i) * 8 + lrow, c = lpos ^ ((row >> 1) & 7); ap[i] = A + (size_t)(m0 + row) * lda + c * 8; }
#pragma unroll
  for (int i = 0; i < BG; ++i) { const int row = (wave * BG + i) * 8 + lrow, c = lpos ^ ((row >> 1) & 7); int br = n0 + row; br = br < nmax ? br : nmax - 1; bp[i] = Bt + (size_t)br * ldb + c * 8; }
  if (ZERO) {
#pragma unroll
    for (int tm = 0; tm < TM; ++tm)
#pragma unroll
      for (int tn = 0; tn < TN; ++tn)
#pragma unroll
        for (int i = 0; i < 16; ++i) acc[tm][tn][i] = 0.f;
  }
  auto issue = [&](int kt, int stage) {
    unsigned char* sb = lds + stage * STAGE;
#pragma unroll
    for (int i = 0; i < AG; ++i) __builtin_amdgcn_global_load_lds((const unsigned*)(ap[i] + kt * 64), (unsigned*)(sb + (wave * AG + i) * 1024), 16, 0, 0);
#pragma unroll
    for (int i = 0; i < BG; ++i) __builtin_amdgcn_global_load_lds((const unsigned*)(bp[i] + kt * 64), (unsigned*)(sb + ABYTES + (wave * BG + i) * 1024), 16, 0, 0);
  };
  const int swz = (r >> 1) & 7;
  int koff[4];
#pragma unroll
  for (int ks = 0; ks < 4; ++ks) koff[ks] = ((ks * 2 + h) ^ swz) * 16;
  const int a_rd = (wm * 32 * TM + r) * 128, b_rd = ABYTES + (wn * 32 * TN + r) * 128;
  const int nk = K >> 6;
  asm volatile("s_waitcnt vmcnt(0)" ::: "memory");
  issue(0, 0);
  if (NST == 3) issue(1, 1);
  for (int kt = 0; kt < nk; ++kt) {
    if (NST == 3 && kt + 1 < nk) asm volatile("s_waitcnt vmcnt(%0)" ::"n"(NLD) : "memory");
    else asm volatile("s_waitcnt vmcnt(0)" ::: "memory");
    asm volatile("s_waitcnt lgkmcnt(0)" ::: "memory");
    __builtin_amdgcn_s_barrier();
    if (NST == 3) { if (kt + 2 < nk) issue(kt + 2, (kt + 2) % 3); }
    else { if (kt + 1 < nk) issue(kt + 1, (kt + 1) & 1); }
    const unsigned char* cur = lds + (kt % NST) * STAGE;
#pragma unroll
    for (int ks = 0; ks < 4; ++ks) {
      bf16x8 af[TM], bfr[TN];
#pragma unroll
      for (int tm = 0; tm < TM; ++tm) af[tm] = *(const bf16x8*)(cur + a_rd + tm * 4096 + koff[ks]);
#pragma unroll
      for (int tn = 0; tn < TN; ++tn) bfr[tn] = *(const bf16x8*)(cur + b_rd + tn * 4096 + koff[ks]);
#pragma unroll
      for (int tm = 0; tm < TM; ++tm)
#pragma unroll
        for (int tn = 0; tn < TN; ++tn) acc[tm][tn] = MFMA32(bfr[tn], af[tm], acc[tm][tn]);
    }
  }
  asm volatile("s_waitcnt lgkmcnt(0)" ::: "memory");
  __builtin_amdgcn_s_barrier();
}

template <int TM, int TN, int OUTC, class F>
DI void epilogue_bf16(const f32x16 (&acc)[TM][TN], unsigned char* lds, bf16_t* out, int ldo, int m0, int c0, int cmax, F f) {
  constexpr int BM = 128 * TM, STRIDE = OUTC * 2 + 16, TNO = OUTC / (32 * 2);
  const int tid = tidx(), wave = __builtin_amdgcn_readfirstlane(tid >> 6), lane = tid & 63, r = lane & 31, h = lane >> 5, wm = wave & 3, wn = wave >> 2;
#pragma unroll
  for (int tm = 0; tm < TM; ++tm)
#pragma unroll
    for (int tn = 0; tn < TNO; ++tn)
#pragma unroll
      for (int g = 0; g < 4; ++g) {
        const int rowl = wm * 32 * TM + tm * 32 + r, coll = wn * 32 * TNO + tn * 32 + 8 * g + 4 * h;
        const f32x4 o = f(tm, tn, g, rowl, coll);
        u32x2 w; w[0] = pk2(o[0], o[1]); w[1] = pk2(o[2], o[3]);
        *(u32x2*)(lds + rowl * STRIDE + coll * 2) = w;
      }
  __syncthreads();
  constexpr int CPR = OUTC / 8;
#pragma unroll
  for (int j = 0; j < BM * CPR / NTHREADS; ++j) {
    const int id = tid + NTHREADS * j, row = id / CPR, c = id % CPR;
    if (c0 + c * 8 < cmax) *(u32x4*)(out + (size_t)(m0 + row) * ldo + c0 + c * 8) = *(const u32x4*)(lds + row * STRIDE + c * 16);
  }
  __syncthreads();
}
DI f32x4 acc4(const f32x16& a, int g) { return (f32x4){a[4 * g], a[4 * g + 1], a[4 * g + 2], a[4 * g + 3]}; }

struct TileIter {
  int nM, nN, total, L, Lend, step;
  DI void init(int nM_, int nN_) {
    nM = nM_; nN = nN_; total = nM * nN;
    const int nx = (gridDim.x & 7) == 0 ? 8 : 1, x = blockIdx.x % nx, local = blockIdx.x / nx;
    step = gridDim.x / nx;
    const int per = (total + nx - 1) / nx;
    L = x * per + local; Lend = (x + 1) * per < total ? (x + 1) * per : total;
  }
  DI bool next(int& tmi, int& tni) {
    if (L >= Lend) return false;
    const int fb = nM >> 2, fullcnt = fb * 4 * nN;
    if (L < fullcnt) { const int band = L / (4 * nN), jj = L - band * 4 * nN; tni = jj >> 2; tmi = band * 4 + (jj & 3); }
    else { const int l2 = L - fullcnt, bm = nM & 3; tni = l2 / bm; tmi = fb * 4 + l2 % bm; }
    L += step; return true;
  }
};

DI void phase1(const Params& p, unsigned char* lds) {
  const bf16_t* XB = (const bf16_t*)((unsigned char*)p.out + OO_XB);
  const bf16_t* WT = (const bf16_t*)(p.ws + O_WIN);
  bf16_t* PAB = (bf16_t*)(p.ws + O_PAB);
  constexpr int NMT = NT / 256, NNT = (PABC + 127) / 128;
  const int lane = tidx() & 63, wave = __builtin_amdgcn_readfirstlane(tidx() >> 6), r = lane & 31, h = lane >> 5, wm = wave & 3, wn = wave >> 2;
  TileIter ti; ti.init(NMT, NNT);
  int tmi, tni;
  while (ti.next(tmi, tni)) {
    const int m0 = tmi * 256, n0 = tni * 128;
    f32x16 acc[2][2];
    gemm_mainloop<2, 2>(XB, DM, WT, DM, DM, m0, n0, PABC, acc, lds);
    if (m0 + 256 > NP - 1 && n0 < ACOLS) {
#pragma unroll
      for (int tm = 0; tm < 2; ++tm) {
        const int row = m0 + wm * 64 + tm * 32 + r;
        const bool lastp = row == NP - 1, lasts = row >= NP && ((row - NP) & 31) == 31;
        if (lastp || lasts) {
          float* dst = lastp ? p.out + F_SHP : p.out + F_SHS + (size_t)((row - NP) >> 5) * ACOLS;
#pragma unroll
          for (int tn = 0; tn < 2; ++tn)
#pragma unroll
            for (int g = 0; g < 4; ++g) {
              const int col = n0 + wn * 64 + tn * 32 + 8 * g + 4 * h;
              if (col < ACOLS) *(f32x4*)(dst + col) = acc4(acc[tm][tn], g);
            }
        }
      }
    }
    epilogue_bf16<2, 2, 128>(acc, lds, PAB, PABC, m0, n0, PABC, [&](int tm, int tn, int g, int, int) { return acc4(acc[tm][tn], g); });
  }
}

constexpr int L2_LORA = 0, L2_K = L2_LORA + 32 * 528, L2_R = L2_K + 32 * 1040, L2A_STG = L2_R + 32 * 1040, L2A_END = L2A_STG + 8 * 32 * 144;
constexpr int L2_CQ = 0, L2_CKV = L2_CQ + 32 * 528, L2B_STG = L2_CKV + 32 * 272, L2B_END = L2B_STG + 8 * 32 * 208;
static_assert(L2A_END <= LDS_BYTES && L2B_END <= LDS_BYTES, "lds p2");
template <int NTL, class F>
DI void stage_store16(unsigned char* stg, int lane, bf16_t* dst  , unsigned row_stride  , F f) {
  constexpr int RS = NTL * 64 + 16, CPR = NTL * 4;
  const int r = lane & 31, h = lane >> 5;
#pragma unroll
  for (int nt = 0; nt < NTL; ++nt)
#pragma unroll
    for (int i = 0; i < 16; ++i) *(unsigned short*)(stg + crow(i, h) * RS + (nt * 32 + r) * 2) = f(nt, i);
  __syncthreads();
#pragma unroll
  for (int j = 0; j < 32 * CPR / 64; ++j) {
    const int id = lane + 64 * j, row = id / CPR, ch = id % CPR;
    *(u32x4*)(dst + (size_t)row * row_stride + ch * 8) = *(const u32x4*)(stg + row * RS + ch * 16);
  }
  __syncthreads();
}

template <int NTL, int KS>
DI void mm32(const unsigned char* ldsA, int strideB, const bf16_t* Bt, int ldb, int lane, f32x16 (&acc)[NTL]) {
  constexpr int KG = (NTL * KS <= 16) ? KS : (NTL <= 2 ? 4 : 2), NG = KS / KG;
  const int r = lane & 31, h = lane >> 5;
#pragma unroll
  for (int nt = 0; nt < NTL; ++nt)
#pragma unroll
    for (int i = 0; i < 16; ++i) acc[nt][i] = 0.f;
  bf16x8 bq[2][KG][NTL];
  const bf16_t* bp = Bt + lane * 8;
#pragma unroll
  for (int k = 0; k < KG; ++k)
#pragma unroll
    for (int nt = 0; nt < NTL; ++nt) bq[0][k][nt] = *(const bf16x8*)(bp + (size_t)(nt * KS + k) * 512);
#pragma unroll
  for (int g = 0; g < NG; ++g) {
    if (g + 1 < NG) {
#pragma unroll
      for (int k = 0; k < KG; ++k)
#pragma unroll
        for (int nt = 0; nt < NTL; ++nt) bq[(g + 1) & 1][k][nt] = *(const bf16x8*)(bp + (size_t)(nt * KS + (g + 1) * KG + k) * 512);
    }
    __builtin_amdgcn_sched_barrier(0);
#pragma unroll
    for (int k = 0; k < KG; ++k) {
      const bf16x8 a = *(const bf16x8*)(ldsA + r * strideB + (g * KG + k) * 32 + h * 16);
#pragma unroll
      for (int nt = 0; nt < NTL; ++nt) acc[nt] = MFMA32(a, bq[g & 1][k][nt], acc[nt]);
    }
    __builtin_amdgcn_sched_barrier(0);
  }
}

DI void kv_expand(const Params& p, unsigned char* lds, int w, int lane, int slot0) {
  const int r = lane & 31, h = lane >> 5;
  bf16_t* knb = (bf16_t*)(p.ws + O_KNB);
  bf16_t* vT = (bf16_t*)((unsigned char*)p.out + OO_VT);
  f32x16 acc[4];
  mm32<4, 8>(lds + L2_CKV, 272, (const bf16_t*)(p.ws + O_WUKV) + (size_t)(128 * w) * 128, 128, lane, acc);
  stage_store16<2>((unsigned char*)lds + L2B_STG + w * (32 * 208), lane, knb + ((size_t)w * NKVP + slot0) * 64, 64, [&](int nt, int i) { return f2bf(acc[nt][i]); });
#pragma unroll
  for (int nt = 2; nt < 4; ++nt)
#pragma unroll
    for (int g = 0; g < 4; ++g) {
      u32x2 o; o[0] = pk2(acc[nt][4 * g], acc[nt][4 * g + 1]); o[1] = pk2(acc[nt][4 * g + 2], acc[nt][4 * g + 3]);
      *(u32x2*)(vT + ((unsigned)w * 64 + (nt - 2) * 32 + r) * (unsigned)NKVP + slot0 + 8 * g + 4 * h) = o;
    }
}

DI void p2_token_tile_a(const Params& p, unsigned char* lds, int tile) {
  const int tid = tidx(), wave = __builtin_amdgcn_readfirstlane(tid >> 6), lane = tid & 63, r = lane & 31, h = lane >> 5;
  const int t0 = tile * 32;
  unsigned char* ws = p.ws;
  const bf16_t* PAB = (const bf16_t*)(ws + O_PAB);
  bf16_t* SR = (bf16_t*)(ws + O_SIN);
  bf16_t* SK = SR + (size_t)NT * 512; bf16_t* SV = SK + (size_t)NT * 512; bf16_t* SA = SV + (size_t)NT * 512; bf16_t* SB = SA + (size_t)NT * 512;
  _Float16* SW = (_Float16*)(SB + (size_t)NT * 512);
  bf16_t* G = (bf16_t*)(ws + O_G);
  float* RK = (float*)(ws + O_RK);
  const float* rope = (const float*)(ws + O_ROPE);
#pragma unroll 1
  for (int bt = 0; bt < 2; ++bt) {
    u32x4 rawp[7], rawq[7];
#pragma unroll
    for (int it = 0; it < 7; ++it) {
      const int task = tid + NTHREADS * (bt * 7 + it);
      const int tl = task / 224, ch = task - tl * 224, c0 = ch * 8, t = t0 + tl;
      rawp[it] = *(const u32x4*)(PAB + (size_t)t * PABC + c0);
      rawq[it] = *(const u32x4*)(PAB + (size_t)(t > 0 ? t - 1 : 0) * PABC + c0);
    }
#pragma unroll
    for (int it = 0; it < 7; ++it) {
      const int task = tid + NTHREADS * (bt * 7 + it);
      const int tl = task / 224, ch = task - tl * 224, c0 = ch * 8, t = t0 + tl;
      float pv[8], pr[8];
      unpack8(rawp[it], pv);
      unpack8(rawq[it], pr);
      if (t == 0) {
#pragma unroll
        for (int j = 0; j < 8; ++j) pr[j] = 0.f;
      } else if (t >= NP && ((t - NP) & 31) == 0) {
        const float* sp = p.in[5] + (size_t)((t - NP) >> 5) * ACOLS + c0;
        const f32x4 a = *(const f32x4*)sp, b = *(const f32x4*)(sp + 4);
        pr[0] = a[0]; pr[1] = a[1]; pr[2] = a[2]; pr[3] = a[3]; pr[4] = b[0]; pr[5] = b[1]; pr[6] = b[2]; pr[7] = b[3];
      }
      const f32x4 mu0 = *(const f32x4*)(p.in[7] + c0), mu1 = *(const f32x4*)(p.in[7] + c0 + 4);
      const float mm[8] = {mu0[0], mu0[1], mu0[2], mu0[3], mu1[0], mu1[1], mu1[2], mu1[3]};
      float xs[8];
#pragma unroll
      for (int j = 0; j < 8; ++j) xs[j] = pv[j] + (pr[j] - pv[j]) * mm[j];
      if (c0 < 512) {
        const u32x4 o = pack8(xs);
        *(u32x4*)(SR + (size_t)t * 512 + c0) = o;
        *(u32x4*)(lds + L2_R + tl * 1040 + c0 * 2) = o;
      } else if (c0 < 1024) {
        *(u32x4*)(lds + L2_K + tl * 1040 + (c0 - 512) * 2) = pack8(xs);
      } else if (c0 < 1536) {
        *(u32x4*)(SV + (size_t)t * 512 + (c0 - 1024)) = pack8(xs);
      } else {
        if (c0 < 1600) {
#pragma unroll
          for (int j = 0; j < 8; ++j) { const float e = __expf(2.f * xs[j]); xs[j] = 1.f - 2.f / (e + 1.f); }
        } else if (c0 >= 1664) {
#pragma unroll
          for (int j = 0; j < 8; ++j) xs[j] = sigmoidf_(xs[j]);
        }
        *(u32x4*)(lds + L2_LORA + tl * 528 + (c0 - 1536) * 2) = pack8(xs);
      }
    }
  }
  __syncthreads();
  const int w = wave, cb = 64 * w;
  {
    int r = (tidx() & 31);
    f32x16 acc[2];
    mm32<2, 4>(lds + L2_LORA, 528, (const bf16_t*)(ws + O_WW2) + (size_t)cb * 64, 64, lane, acc);
    const float w00 = p.in[8][cb + r], w01 = p.in[8][cb + 32 + r];
    stage_store16<2>(lds + L2A_STG + w * (32 * 144), lane, (bf16_t*)SW + (size_t)t0 * 512 + cb, 512, [&](int nt, int i) {
      const float z = (nt ? w01 : w00) + acc[nt][i];
      const float sp = fmaxf(-z, 0.f) + __logf(1.f + __expf(-fabsf(z)));
      const float dec = __expf(-__expf(-sp - 0.5f));
      return __builtin_bit_cast(unsigned short, (_Float16)dec);
    });
  }
  __syncthreads();
  {
    int r = (tidx() & 31);
    f32x16 acc[2];
    mm32<2, 4>(lds + L2_LORA + 128, 528, (const bf16_t*)(ws + O_WA2) + (size_t)cb * 64, 64, lane, acc);
    float kkv[2][16];
#pragma unroll
    for (int nt = 0; nt < 2; ++nt) {
      const int c = cb + nt * 32 + r;
      const float a0 = p.in[10][c], kkc = p.in[13][c];
#pragma unroll
      for (int i = 0; i < 16; ++i) {
        acc[nt][i] = sigmoidf_(a0 + acc[nt][i]);
        kkv[nt][i] = bf2f(*(const bf16_t*)(lds + L2_K + crow(i, h) * 1040 + c * 2)) * kkc;
      }
    }
#pragma unroll
    for (int i = 0; i < 16; ++i) {
      const float nsq = sum32(kkv[0][i] * kkv[0][i] + kkv[1][i] * kkv[1][i]);
      const float inv = 1.f / fmaxf(sqrtf(nsq), 1e-12f);
      kkv[0][i] *= inv; kkv[1][i] *= inv;
      __builtin_amdgcn_sched_barrier(0);
    }
    const int c0 = cb + r, c1 = cb + 32 + r;
    const float ka0 = p.in[14][c0], ka1 = p.in[14][c1], rk0 = p.in[15][c0], rk1 = p.in[15][c1];
    unsigned char* stg = lds + L2A_STG + w * (32 * 144);
    stage_store16<2>(stg, lane, SA + (size_t)t0 * 512 + cb, 512, [&](int nt, int i) { return f2bf(-kkv[nt][i]); });
    stage_store16<2>(stg, lane, SB + (size_t)t0 * 512 + cb, 512, [&](int nt, int i) { return f2bf(kkv[nt][i] * acc[nt][i]); });
#pragma unroll
    for (int i = 0; i < 16; ++i) {
      const int tl = crow(i, h);
      const float kr0 = bf2f(*(const bf16_t*)(lds + L2_K + tl * 1040 + c0 * 2)), kr1 = bf2f(*(const bf16_t*)(lds + L2_K + tl * 1040 + c1 * 2));
      const float kh0 = kr0 * (1.f + (acc[0][i] - 1.f) * ka0), kh1 = kr1 * (1.f + (acc[1][i] - 1.f) * ka1);
      kkv[0][i] = kh0; kkv[1][i] = kh1;
      const float rr0 = bf2f(*(const bf16_t*)(lds + L2_R + tl * 1040 + c0 * 2)), rr1 = bf2f(*(const bf16_t*)(lds + L2_R + tl * 1040 + c1 * 2));
      const float sb = sum32(rr0 * kh0 * rk0 + rr1 * kh1 * rk1);
      if (r == 0) RK[(unsigned)(t0 + tl) * 8u + w] = sb;
    }
    stage_store16<2>(stg, lane, SK + (size_t)t0 * 512 + cb, 512, [&](int nt, int i) { return f2bf(kkv[nt][i]); });
  }
  __syncthreads();
  {
    int r = (tidx() & 31);
    f32x16 acc[2];
    mm32<2, 8>(lds + L2_LORA + 256, 528, (const bf16_t*)(ws + O_WG2) + (size_t)cb * 128, 128, lane, acc);
    stage_store16<2>(lds + L2A_STG + w * (32 * 144), lane, G + (size_t)t0 * 512 + cb, 512, [&](int nt, int i) { return f2bf(acc[nt][i]); });
  }
  __syncthreads();
}

DI void p2_token_tile_b(const Params& p, unsigned char* lds, int tile) {
  const int tid = tidx(), wave = __builtin_amdgcn_readfirstlane(tid >> 6), lane = tid & 63, r = lane & 31, h = lane >> 5;
  const int t0 = tile * 32;
  unsigned char* ws = p.ws;
  const bf16_t* PAB = (const bf16_t*)(ws + O_PAB);
  bf16_t* SR = (bf16_t*)(ws + O_SIN);
  bf16_t* SK = SR + (size_t)NT * 512; bf16_t* SV = SK + (size_t)NT * 512; bf16_t* SA = SV + (size_t)NT * 512; bf16_t* SB = SA + (size_t)NT * 512;
  _Float16* SW = (_Float16*)(SB + (size_t)NT * 512);
  bf16_t* G = (bf16_t*)(ws + O_G);
  float* RK = (float*)(ws + O_RK);
  const float* rope = (const float*)(ws + O_ROPE);
  {
    u32x2 vq[4]; unsigned vc[4]; float k1[4], k2[4], rc[4], rs_[4];
#pragma unroll
    for (int q = 0; q < 4; ++q) {
      const int t = t0 + wave * 4 + q;
      const bf16_t* pb = PAB + (size_t)t * PABC + ACOLS;
      vq[q] = *(const u32x2*)(pb + 4 * lane);
      vc[q] = *(const unsigned*)(pb + 256 + 2 * lane);
      k1[q] = bf2f(pb[384 + (lane & 15)]); k2[q] = bf2f(pb[400 + (lane & 15)]);
      rc[q] = rope[t * 32 + (lane & 15)]; rs_[q] = rope[t * 32 + 16 + (lane & 15)];
    }
    const f32x4 gq = *(const f32x4*)(p.in[19] + 4 * lane);
    const f32x2 gkv = *(const f32x2*)(p.in[21] + 2 * lane);
#pragma unroll
    for (int q = 0; q < 4; ++q) {
      const int tl = wave * 4 + q, t = t0 + tl;
      {
        const u32x2 v = vq[q];
        float x[4] = {__uint_as_float(v[0] << 16), __uint_as_float(v[0] & 0xffff0000u), __uint_as_float(v[1] << 16), __uint_as_float(v[1] & 0xffff0000u)};
        const float ss = wave_sum(x[0] * x[0] + x[1] * x[1] + x[2] * x[2] + x[3] * x[3]);
        const float rs = rsqrtf(ss * (1.f / 256.f) + 1e-6f);
        u32x2 o; o[0] = pk2(x[0] * rs * gq[0], x[1] * rs * gq[1]); o[1] = pk2(x[2] * rs * gq[2], x[3] * rs * gq[3]);
        *(u32x2*)(lds + L2_CQ + tl * 528 + lane * 8) = o;
      }
      {
        const unsigned v = vc[q];
        const float x0 = __uint_as_float(v << 16), x1 = __uint_as_float(v & 0xffff0000u);
        const float ss = wave_sum(x0 * x0 + x1 * x1);
        const float rs = rsqrtf(ss * (1.f / 128.f) + 1e-6f);
        const float o0 = x0 * rs * gkv[0], o1 = x1 * rs * gkv[1];
        float* dst = (t < NP) ? p.out + F_CKVP + (size_t)t * 128 : p.out + F_CKVS + (size_t)(t - NP) * 128;
        f32x2 of = {o0, o1};
        *(f32x2*)(dst + 2 * lane) = of;
        *(unsigned*)(lds + L2_CKV + tl * 272 + lane * 4) = pk2(o0, o1);
      }
      if (lane < 16) {
        const float o1 = k1[q] * rc[q] - k2[q] * rs_[q], o2 = k1[q] * rs_[q] + k2[q] * rc[q];
        float* dst = (t < NP) ? p.out + F_KPEP + (size_t)t * 32 : p.out + F_KPES + (size_t)(t - NP) * 32;
        dst[lane] = o1; dst[16 + lane] = o2;
        bf16_t* kp = (bf16_t*)(ws + O_KPEB) + (size_t)slot_of_token(t) * 32;
        kp[lane] = f2bf(o1); kp[16 + lane] = f2bf(o2);
      }
    }
  }
  __syncthreads();
  const int w = wave, cb = 64 * w;
  {
    int r = (tidx() & 31);
    f32x16 acc[3];
    mm32<3, 16>(lds + L2_CQ, 528, (const bf16_t*)(ws + O_WUQ) + (size_t)(96 * w) * 256, 256, lane, acc);
    bf16_t* Q = (bf16_t*)((unsigned char*)p.out + OO_Q);
    const int j = r & 15;
#pragma unroll
    for (int i = 0; i < 16; ++i) {
      const int t = t0 + crow(i, h);
      const float own = acc[2][i], oth = __shfl_xor(own, 16);
      const float c = rope[t * 32 + j], sn = rope[t * 32 + 16 + j];
      acc[2][i] = (r < 16) ? own * c - oth * sn : oth * sn + own * c;
    }
    stage_store16<3>(lds + L2B_STG + w * (32 * 208), lane, Q + (size_t)t0 * 768 + 96 * w, 768, [&](int nt, int i) { return f2bf(acc[nt][i] * QSCALE); });
  }
  __syncthreads();
  kv_expand(p, lds, w, lane, slot_of_token(t0));
  __syncthreads();
}

DI void p2_cache_tile(const Params& p, unsigned char* lds, int ctile) {
  const int tid = tidx(), wave = __builtin_amdgcn_readfirstlane(tid >> 6), lane = tid & 63;
  const int b = ctile >> 5, j0 = (ctile & 31) * 32;
  {
    const int row = tid >> 4, c = (tid & 15) * 8;
    const float* src = p.in[2] + ((size_t)(b * PAST + j0 + row)) * 128 + c;
    f32x4 a = *(const f32x4*)src, d = *(const f32x4*)(src + 4);
    float f[8] = {a[0], a[1], a[2], a[3], d[0], d[1], d[2], d[3]};
    *(u32x4*)(lds + L2_CKV + row * 272 + c * 2) = pack8(f);
  }
  __syncthreads();
  kv_expand(p, lds, wave, lane, NP + b * SKV + j0);
  __syncthreads();
}

DI void phase2(const Params& p, unsigned char* lds) {
  constexpr int NTT = NT / 32, NCT = DB * PAST / 32;
  {
    bf16_t* vT = (bf16_t*)((unsigned char*)p.out + OO_VT);
    for (int id = blockIdx.x * NTHREADS + tidx(); id < 8 * 64 * 64; id += gridDim.x * NTHREADS) vT[(size_t)(id >> 6) * NKVP + NKV + (id & 63)] = 0;
  }
  unsigned* ctr2 = (unsigned*)(p.ws + O_CTR) + 16;
  volatile int* s_itemp = (volatile int*)(lds + LDS_CTRL);
  for (;;) {
    if (tidx() == 0) *s_itemp = (int)atomicAdd(ctr2, 1u);
    __syncthreads();
    const int item = *s_itemp;
    __syncthreads();
    if (item >= 2 * NTT + NCT) break;
    if (item < NTT) p2_token_tile_b(p, lds, item);
    else if (item < 2 * NTT) p2_token_tile_a(p, lds, item - NTT);
    else p2_cache_tile(p, lds, item - 2 * NTT);
  }
}

constexpr int AT_KSTRIDE = 208, AT_VSTRIDE = 136, AT_KBYTES = 64 * AT_KSTRIDE, AT_STAGE = AT_KBYTES + 64 * AT_VSTRIDE;

DI void attn_item(const Params& p, unsigned char* lds, int hd, int qtok0, int nact, int slot0, int ntiles, int nvalid, bool causal) {
  const int tid = tidx(), wave = __builtin_amdgcn_readfirstlane(tid >> 6), lane = tid & 63, r = lane & 31, h = lane >> 5;
  const bf16_t* Q = (const bf16_t*)((const unsigned char*)p.out + OO_Q);
  const bf16_t* knb = (const bf16_t*)(p.ws + O_KNB) + (size_t)hd * NKVP * 64;
  const bf16_t* kpeb = (const bf16_t*)(p.ws + O_KPEB);
  const bf16_t* vT = (const bf16_t*)((const unsigned char*)p.out + OO_VT) + (size_t)hd * 64 * NKVP;
  bf16_t* YB = (bf16_t*)(p.ws + O_YB);
  const bool active = wave < nact;
  const int qtok = qtok0 + 32 * wave;
  const int wlim = !active ? 0 : (causal ? (qtok >> 6) + 1 : ntiles);
  bf16x8 qf[6];
  if (active) {
#pragma unroll
    for (int ks = 0; ks < 6; ++ks) qf[ks] = *(const bf16x8*)(Q + (size_t)(qtok + r) * 768 + 96 * hd + ks * 16 + h * 8);
  } else {
#pragma unroll
    for (int ks = 0; ks < 6; ++ks) qf[ks] = (bf16x8){0, 0, 0, 0, 0, 0, 0, 0};
  }
  f32x16 o0, o1;
#pragma unroll
  for (int i = 0; i < 16; ++i) { o0[i] = 0.f; o1[i] = 0.f; }
  float mrun = 0.f, lsum = 0.f;
  const int k_key = tid >> 3, k_ch = tid & 7;
  const int pe_key = (tid & 255) >> 2, pe_ch = tid & 3;
  const int v_dim = tid >> 3, v_ch = tid & 7;
  u32x4 rk, rpe, rv;
  auto gload = [&](int kt) {
    const int s = slot0 + kt * 64;
    rk = *(const u32x4*)(knb + (size_t)(s + k_key) * 64 + k_ch * 8);
    if (tid < 256) rpe = *(const u32x4*)(kpeb + (size_t)(s + pe_key) * 32 + pe_ch * 8);
    rv = *(const u32x4*)(vT + (size_t)v_dim * NKVP + s + v_ch * 8);
  };
  auto lstore = [&](int buf) {
    unsigned char* b = lds + buf * AT_STAGE;
    *(u32x4*)(b + k_key * AT_KSTRIDE + k_ch * 16) = rk;
    if (tid < 256) *(u32x4*)(b + pe_key * AT_KSTRIDE + 128 + pe_ch * 16) = rpe;
    u32x2 lo = {rv[0], rv[1]}, hi = {rv[2], rv[3]};
    *(u32x2*)(b + AT_KBYTES + v_dim * AT_VSTRIDE + v_ch * 16) = lo;
    *(u32x2*)(b + AT_KBYTES + v_dim * AT_VSTRIDE + v_ch * 16 + 8) = hi;
  };
  gload(0); lstore(0);
  __syncthreads();
  for (int kt = 0; kt < ntiles; ++kt) {
    const bool more = kt + 1 < ntiles;
    if (more) gload(kt + 1);
    if (kt < wlim) {
      const unsigned char* kb = lds + (kt & 1) * AT_STAGE;
      const unsigned char* vb = kb + AT_KBYTES;
      f32x16 s0, s1;
      const float nm = -mrun;
#pragma unroll
      for (int i = 0; i < 16; ++i) { s0[i] = nm; s1[i] = nm; }
#pragma unroll
      for (int ks = 0; ks < 6; ++ks) {
        const bf16x8 a0 = *(const bf16x8*)(kb + r * AT_KSTRIDE + ks * 32 + h * 16);
        const bf16x8 a1 = *(const bf16x8*)(kb + (32 + r) * AT_KSTRIDE + ks * 32 + h * 16);
        s0 = MFMA32(a0, qf[ks], s0);
        s1 = MFMA32(a1, qf[ks], s1);
      }
      if (kt * 64 + 64 > nvalid) {
#pragma unroll
        for (int i = 0; i < 16; ++i) {
          const int key = kt * 64 + crow(i, h);
          if (key >= nvalid) s0[i] = -1e30f;
          if (key + 32 >= nvalid) s1[i] = -1e30f;
        }
      }
      float mx = s0[0];
#pragma unroll
      for (int i = 1; i < 16; ++i) mx = fmaxf(mx, s0[i]);
#pragma unroll
      for (int i = 0; i < 16; ++i) mx = fmaxf(mx, s1[i]);
      mx = fmaxf(mx, __shfl_xor(mx, 32));
      const bool far = fabsf(mx) > 20.f && mx > -1e29f;
      if (__builtin_amdgcn_ballot_w64(far) != 0ull) {
        const float delta = far ? mx : 0.f;
        const float alpha = __builtin_amdgcn_exp2f(-delta);
        mrun += delta; lsum *= alpha;
#pragma unroll
        for (int i = 0; i < 16; ++i) { o0[i] *= alpha; o1[i] *= alpha; s0[i] -= delta; s1[i] -= delta; }
      }
      float rs = 0.f;
#pragma unroll
      for (int i = 0; i < 16; ++i) { s0[i] = __builtin_amdgcn_exp2f(s0[i]); rs += s0[i]; }
#pragma unroll
      for (int i = 0; i < 16; ++i) { s1[i] = __builtin_amdgcn_exp2f(s1[i]); rs += s1[i]; }
      lsum += rs;
#pragma unroll
      for (int mt = 0; mt < 2; ++mt)
#pragma unroll
        for (int s = 0; s < 2; ++s) {
          const f32x16& sv = mt ? s1 : s0;
          u32x4 pw;
          pw[0] = pk2(sv[8 * s], sv[8 * s + 1]); pw[1] = pk2(sv[8 * s + 2], sv[8 * s + 3]);
          pw[2] = pk2(sv[8 * s + 4], sv[8 * s + 5]); pw[3] = pk2(sv[8 * s + 6], sv[8 * s + 7]);
          const bf16x8 pb = __builtin_bit_cast(bf16x8, pw);
          const int kbase = mt * 32 + 16 * s + 4 * h;
          {
            const s16x4 lo = *(const s16x4*)(vb + r * AT_VSTRIDE + kbase * 2);
            const s16x4 hi = *(const s16x4*)(vb + r * AT_VSTRIDE + (kbase + 8) * 2);
            const bf16x8 av = __builtin_shufflevector(lo, hi, 0, 1, 2, 3, 4, 5, 6, 7);
            o0 = MFMA32(av, pb, o0);
          }
          {
            const s16x4 lo = *(const s16x4*)(vb + (32 + r) * AT_VSTRIDE + kbase * 2);
            const s16x4 hi = *(const s16x4*)(vb + (32 + r) * AT_VSTRIDE + (kbase + 8) * 2);
            const bf16x8 av = __builtin_shufflevector(lo, hi, 0, 1, 2, 3, 4, 5, 6, 7);
            o1 = MFMA32(av, pb, o1);
          }
        }
    }
    if (more) lstore((kt + 1) & 1);
    __syncthreads();
  }
  if (active) {
    const float lt = lsum + __shfl_xor(lsum, 32);
    const float inv = 1.f / lt;
    bf16_t* dst = YB + (size_t)(qtok + r) * 512 + hd * 64;
#pragma unroll
    for (int g = 0; g < 4; ++g) {
      u32x2 a, b;
      a[0] = pk2(o0[4 * g] * inv, o0[4 * g + 1] * inv); a[1] = pk2(o0[4 * g + 2] * inv, o0[4 * g + 3] * inv);
      b[0] = pk2(o1[4 * g] * inv, o1[4 * g + 1] * inv); b[1] = pk2(o1[4 * g + 2] * inv, o1[4 * g + 3] * inv);
      *(u32x2*)(dst + 8 * g + 4 * h) = a;
      *(u32x2*)(dst + 32 + 8 * g + 4 * h) = b;
    }
  }
}

constexpr int SC_TOK = 32, SC_ARR = SC_TOK * 64 * 4, SC_STAGE = 6 * SC_ARR;
static_assert(2 * SC_STAGE <= LDS_CTRL, "lds scan");
DI float dpp_sum8(float x) {
  x += __builtin_bit_cast(float, __builtin_amdgcn_update_dpp(0, __builtin_bit_cast(int, x), 0xB1, 0xF, 0xF, true));
  x += __builtin_bit_cast(float, __builtin_amdgcn_update_dpp(0, __builtin_bit_cast(int, x), 0x4E, 0xF, 0xF, true));
  x += __builtin_bit_cast(float, __builtin_amdgcn_update_dpp(0, __builtin_bit_cast(int, x), 0x141, 0xF, 0xF, true));
  return x;
}
DI float hsum4(f32x4 x) { return (x[0] + x[2]) + (x[1] + x[3]); }
template <bool DUAL>
DI void scan_job(const Params& p, unsigned char* lds, int head, int tok0, int nsteps, const float* init  ,
                 bf16_t* Y  , float* state_out  , bf16_t* Y2 = nullptr, float* state2 = nullptr) {
  const int tid = tidx(), wave = __builtin_amdgcn_readfirstlane(tid >> 6), lane = tid & 63;
  const bf16_t* SR = (const bf16_t*)(p.ws + O_SIN);
  const bf16_t* SK = SR + (size_t)NT * 512; const bf16_t* SV = SK + (size_t)NT * 512; const bf16_t* SA = SV + (size_t)NT * 512; const bf16_t* SB = SA + (size_t)NT * 512;
  const _Float16* SW = (const _Float16*)(SB + (size_t)NT * 512);
  u32x4 rg[3];
  auto gload = [&](int c) {
    const int tb = tok0 + c * SC_TOK;
#pragma unroll
    for (int i = 0; i < 3; ++i) {
      const int L = tid + NTHREADS * i, arr = L >> 8, tok = (L & 255) >> 3, ch = L & 7;
      const bf16_t* base = arr == 0 ? SA : arr == 1 ? SB : arr == 2 ? (const bf16_t*)SW : arr == 3 ? SK : arr == 4 ? SR : SV;
      rg[i] = *(const u32x4*)(base + (size_t)(tb + tok) * 512 + head * 64 + ch * 8);
    }
  };
  auto lstore = [&](int buf) {
    unsigned char* b = lds + buf * SC_STAGE;
#pragma unroll
    for (int i = 0; i < 3; ++i) {
      const int L = tid + NTHREADS * i, arr = L >> 8, tok = (L & 255) >> 3, ch = L & 7;
      float f[8];
      if (arr == 2) {
#pragma unroll
        for (int j = 0; j < 4; ++j) {
          const unsigned u = rg[i][j];
          f[2 * j] = (float)__builtin_bit_cast(_Float16, (unsigned short)(u & 0xffffu));
          f[2 * j + 1] = (float)__builtin_bit_cast(_Float16, (unsigned short)(u >> 16));
        }
      } else unpack8(rg[i], f);
      float* d = (float*)(b + arr * SC_ARR + tok * 256 + ch * 32);
      *(f32x4*)d = (f32x4){f[0], f[1], f[2], f[3]};
      *(f32x4*)(d + 4) = (f32x4){f[4], f[5], f[6], f[7]};
    }
  };
  const int rl = lane >> 3, c = lane & 7;
  const int vrow = 8 * wave + rl;
  f32x4 sl = {0.f, 0.f, 0.f, 0.f}, sh = {0.f, 0.f, 0.f, 0.f};
  if (init) { sl = *(const f32x4*)(init + vrow * 64 + 8 * c); sh = *(const f32x4*)(init + vrow * 64 + 8 * c + 4); }
  f32x4 tl, th;
#pragma unroll
  for (int j = 0; j < 4; ++j) { tl[j] = (8 * c + j == vrow) ? 1.f : 0.f; th[j] = (8 * c + 4 + j == vrow) ? 1.f : 0.f; }
  gload(0); lstore(0);
  __syncthreads();
  const int nch = nsteps / SC_TOK;
  for (int ci = 0; ci < nch; ++ci) {
    const bool more = ci + 1 < nch;
    if (more) gload(ci + 1);
    {
      const unsigned char* b = lds + (ci & 1) * SC_STAGE + c * 32;
      const unsigned char* bv = lds + (ci & 1) * SC_STAGE + 5 * SC_ARR + vrow * 4;
      bf16_t* yp = Y + (size_t)(tok0 + ci * SC_TOK + c) * 512 + head * 64 + vrow;
      bf16_t* yp2 = DUAL ? Y2 + (size_t)(tok0 + ci * SC_TOK + c) * 512 + head * 64 + vrow : nullptr;
      f32x4 AL[2], AH[2], BL[2], BH[2], WL[2], WH[2], KL[2], KH[2], RL[2], RH[2]; float V1[2];
#define SC_LOAD(slot, t)                                                                                                        \
      { AL[slot] = *(const f32x4*)(b + 0 * SC_ARR + (t) * 256); AH[slot] = *(const f32x4*)(b + 0 * SC_ARR + (t) * 256 + 16);    \
        BL[slot] = *(const f32x4*)(b + 1 * SC_ARR + (t) * 256); BH[slot] = *(const f32x4*)(b + 1 * SC_ARR + (t) * 256 + 16);    \
        WL[slot] = *(const f32x4*)(b + 2 * SC_ARR + (t) * 256); WH[slot] = *(const f32x4*)(b + 2 * SC_ARR + (t) * 256 + 16);    \
        KL[slot] = *(const f32x4*)(b + 3 * SC_ARR + (t) * 256); KH[slot] = *(const f32x4*)(b + 3 * SC_ARR + (t) * 256 + 16);    \
        RL[slot] = *(const f32x4*)(b + 4 * SC_ARR + (t) * 256); RH[slot] = *(const f32x4*)(b + 4 * SC_ARR + (t) * 256 + 16);    \
        V1[slot] = *(const float*)(bv + (t) * 256); }
      SC_LOAD(0, 0)
      float ysel = 0.f, ysel2 = 0.f;
#pragma unroll
      for (int t = 0; t < SC_TOK; ++t) {
        if (t + 1 < SC_TOK) SC_LOAD((t + 1) & 1, t + 1)
        const f32x4 al = AL[t & 1], ah = AH[t & 1], bl = BL[t & 1], bh = BH[t & 1], wl = WL[t & 1], wh = WH[t & 1], kl = KL[t & 1], kh = KH[t & 1], rlo = RL[t & 1], rhi = RH[t & 1];
        const float vv = V1[t & 1];
        {
          const float sa = dpp_sum8(hsum4(sl * al + sh * ah));
          sl = sl * wl + (sa * bl + vv * kl);
          sh = sh * wh + (sa * bh + vv * kh);
          const float y = dpp_sum8(hsum4(sl * rlo + sh * rhi));
          ysel = (c == (t & 7)) ? y : ysel;
          if ((t & 7) == 7) yp[(size_t)(t - 7) * 512] = f2bf(ysel);
        }
        if (DUAL) {
          const float sa = dpp_sum8(hsum4(tl * al + th * ah));
          tl = tl * wl + sa * bl;
          th = th * wh + sa * bh;
          const float y = dpp_sum8(hsum4(tl * rlo + th * rhi));
          ysel2 = (c == (t & 7)) ? y : ysel2;
          if ((t & 7) == 7) yp2[(size_t)(t - 7) * 512] = f2bf(ysel2);
        }
      }
#undef SC_LOAD
    }
    if (more) lstore((ci + 1) & 1);
    __syncthreads();
  }
  *(f32x4*)(state_out + vrow * 64 + 8 * c) = sl;
  *(f32x4*)(state_out + vrow * 64 + 8 * c + 4) = sh;
  if (DUAL) { *(f32x4*)(state2 + vrow * 64 + 8 * c) = tl; *(f32x4*)(state2 + vrow * 64 + 8 * c + 4) = th; }
}

constexpr int Q_PSCAN = 8 * SCC, Q_PATT = 512, Q_SATT = 128, Q_SSCAN = 128, Q_TOTAL = Q_PSCAN + Q_PATT + Q_SATT + Q_SSCAN;
DI void phase3(const Params& p, unsigned char* lds) {
  volatile int* s_itemp = (volatile int*)(lds + LDS_CTRL);
  unsigned* ctr = (unsigned*)(p.ws + O_CTR);
  float* Gb = (float*)((unsigned char*)p.out + OO_GH);
  float* Hb = Gb + (size_t)8 * SCC * 4096;
  bf16_t* Y = (bf16_t*)(p.ws + O_Y);
  bf16_t* E = (bf16_t*)(p.ws + O_E);
  for (;;) {
    if (tidx() == 0) *s_itemp = (int)atomicAdd(ctr, 1u);
    __syncthreads();
    const int item = *s_itemp;
    __syncthreads();
    if (item >= Q_TOTAL) break;
    if (item < Q_PSCAN) {
      const int hd = item / SCC, c = item % SCC;
      if (c == 0) scan_job<false>(p, lds, hd, 0, SCL, nullptr, Y, Hb + ((size_t)hd * SCC) * 4096);
      else scan_job<true>(p, lds, hd, c * SCL, SCL, nullptr, Y, Hb + ((size_t)hd * SCC + c) * 4096, E, Gb + ((size_t)hd * SCC + c) * 4096);
    } else if (item < Q_PSCAN + Q_PATT) {
      const int k = item - Q_PSCAN, qb = 63 - (k >> 3), hd = k & 7;
      attn_item(p, lds, hd, qb * 256, 8, 0, qb * 4 + 4, (qb * 4 + 4) * 64, true);
    } else if (item < Q_PSCAN + Q_PATT + Q_SATT) {
      const int k = item - Q_PSCAN - Q_PATT, b = k >> 3, hd = k & 7;
      attn_item(p, lds, hd, NP + b * 32, 1, NP + b * SKV, 17, SKV, false);
    } else {
      const int k = item - Q_PSCAN - Q_PATT - Q_SATT, b = k >> 3, hd = k & 7;
      scan_job<false>(p, lds, hd, NP + b * 32, 32, p.in[4] + ((size_t)b * 8 + hd) * 4096, Y, p.out + F_WKVS + ((size_t)b * 8 + hd) * 4096);
    }
  }
}

DI void phase3b(const Params& p, unsigned char* lds) {
  if (blockIdx.x >= 32) return;
  const int hd = blockIdx.x & 7, q = blockIdx.x >> 3, tid = tidx();
  const float* Gb = (const float*)((unsigned char*)p.out + OO_GH);
  const float* Hb = Gb + (size_t)8 * SCC * 4096;
  bf16_t* SST = (bf16_t*)((unsigned char*)p.out + OO_SST);
  float* S = (float*)lds;
  float* Gs = S + 16 * 65 + 3;
  Gs = (float*)lds + 1044;
  const int vl = tid >> 5, v = 16 * q + vl, k0 = (tid & 31) * 2;
  f32x2 cur = *(const f32x2*)(Hb + ((size_t)hd * SCC) * 4096 + v * 64 + k0);
  for (int c = 1; c < SCC; ++c) {
    const float* Gc = Gb + ((size_t)hd * SCC + c) * 4096;
    const f32x4 ga = *(const f32x4*)(Gc + tid * 8), gb2 = *(const f32x4*)(Gc + tid * 8 + 4);
    f32x2 o = *(const f32x2*)(Hb + ((size_t)hd * SCC + c) * 4096 + v * 64 + k0);
    __syncthreads();
    S[vl * 65 + k0] = cur[0]; S[vl * 65 + k0 + 1] = cur[1];
    *(f32x4*)(Gs + tid * 8) = ga; *(f32x4*)(Gs + tid * 8 + 4) = gb2;
    *(unsigned*)(SST + ((size_t)c * 8 + hd) * 4096 + v * 64 + k0) = pk2(cur[0], cur[1]);
    __syncthreads();
#pragma unroll 8
    for (int i = 0; i < 64; ++i) {
      const float sv = S[vl * 65 + i];
      const f32x2 g = *(const f32x2*)(Gs + i * 64 + k0);
      o[0] += sv * g[0]; o[1] += sv * g[1];
    }
    cur = o;
  }
  *(f32x2*)(p.out + F_WKVP + (size_t)hd * 4096 + v * 64 + k0) = cur;
}

DI void phase4a(const Params& p) {
  const int tid = tidx(), lane = tid & 63, r = lane & 31, hh = lane >> 5;
  const int gw = (blockIdx.x * NTHREADS + tid) >> 6, ngw = (gridDim.x * NTHREADS) >> 6;
  const bf16_t* Y = (const bf16_t*)(p.ws + O_Y);
  const bf16_t* E = (const bf16_t*)(p.ws + O_E);
  const bf16_t* SST = (const bf16_t*)((unsigned char*)p.out + OO_SST);
  const bf16_t* SV = (const bf16_t*)(p.ws + O_SIN) + 2 * (size_t)NT * 512;
  const bf16_t* G = (const bf16_t*)(p.ws + O_G);
  const float* RK = (const float*)(p.ws + O_RK);
  bf16_t* YA = (bf16_t*)(p.ws + O_YA);
  for (int task = gw; task < (NT / 32) * 8; task += ngw) {
    const int tile = task >> 3, hd = task & 7, t0 = tile * 32, t = t0 + r;
    f32x16 acc[2];
#pragma unroll
    for (int i = 0; i < 16; ++i) { acc[0][i] = 0.f; acc[1][i] = 0.f; }
    const int c = t0 < NP ? t0 / SCL : 0;
    if (c >= 1) {
      const bf16_t* sst = SST + ((size_t)c * 8 + hd) * 4096;
#pragma unroll
      for (int ks = 0; ks < 4; ++ks) {
        const bf16x8 bv = *(const bf16x8*)(E + (size_t)t * 512 + hd * 64 + ks * 16 + hh * 8);
#pragma unroll
        for (int mt = 0; mt < 2; ++mt) {
          const bf16x8 av = *(const bf16x8*)(sst + (mt * 32 + r) * 64 + ks * 16 + hh * 8);
          acc[mt] = MFMA32(av, bv, acc[mt]);
        }
      }
    }
    float sum = 0.f;
#pragma unroll
    for (int mt = 0; mt < 2; ++mt)
#pragma unroll
      for (int g = 0; g < 4; ++g) {
        const u32x2 yv = *(const u32x2*)(Y + (size_t)t * 512 + hd * 64 + mt * 32 + 8 * g + 4 * hh);
        acc[mt][4 * g] += __uint_as_float(yv[0] << 16); acc[mt][4 * g + 1] += __uint_as_float(yv[0] & 0xffff0000u);
        acc[mt][4 * g + 2] += __uint_as_float(yv[1] << 16); acc[mt][4 * g + 3] += __uint_as_float(yv[1] & 0xffff0000u);
        sum += (acc[mt][4 * g] + acc[mt][4 * g + 1]) + (acc[mt][4 * g + 2] + acc[mt][4 * g + 3]);
      }
    sum += __shfl_xor(sum, 32);
    const float mean = sum * (1.f / 64.f);
    float sq = 0.f;
#pragma unroll
    for (int mt = 0; mt < 2; ++mt)
#pragma unroll
      for (int i = 0; i < 16; ++i) { const float d = acc[mt][i] - mean; sq += d * d; }
    sq += __shfl_xor(sq, 32);
    const float rstd = rsqrtf(sq * (1.f / 64.f) + 64e-5f);
    const float bon = RK[(size_t)t * 8 + hd];
#pragma unroll
    for (int mt = 0; mt < 2; ++mt)
#pragma unroll
      for (int g = 0; g < 4; ++g) {
        const int c0 = hd * 64 + mt * 32 + 8 * g + 4 * hh;
        const size_t o = (size_t)t * 512 + c0;
        const f32x4 lg = *(const f32x4*)(p.in[16] + c0), lb = *(const f32x4*)(p.in[17] + c0);
        const u32x2 vv = *(const u32x2*)(SV + o), gg = *(const u32x2*)(G + o);
        const float vf[4] = {__uint_as_float(vv[0] << 16), __uint_as_float(vv[0] & 0xffff0000u), __uint_as_float(vv[1] << 16), __uint_as_float(vv[1] & 0xffff0000u)};
        const float gf[4] = {__uint_as_float(gg[0] << 16), __uint_as_float(gg[0] & 0xffff0000u), __uint_as_float(gg[1] << 16), __uint_as_float(gg[1] & 0xffff0000u)};
        float ov[4];
#pragma unroll
        for (int j = 0; j < 4; ++j) ov[j] = ((acc[mt][4 * g + j] - mean) * rstd * lg[j] + lb[j] + bon * vf[j]) * gf[j];
        u32x2 w; w[0] = pk2(ov[0], ov[1]); w[1] = pk2(ov[2], ov[3]);
        *(u32x2*)(YA + o) = w;
      }
  }
  conv_x(p, (bf16_t*)((unsigned char*)p.out + OO_XB), blockIdx.x * NTHREADS + tidx(), gridDim.x * NTHREADS);
}

DI bool small_tile_of_block(int& m0, int& n0) {
  const int j = blockIdx.x >> 3;
  if (gridDim.x != 256 || (blockIdx.x & 7) != (j & 7)) return false;
  m0 = NP + (j >> 3) * 128; n0 = (j & 7) * 128; return true;
}
template <int TM>
DI void p4_tile(const Params& p, unsigned char* lds, int m0, int n0) {
  const bf16_t* XB = (const bf16_t*)((unsigned char*)p.out + OO_XB);
  const bf16_t* WIN = (const bf16_t*)(p.ws + O_WIN);
  const bf16_t* YA = (const bf16_t*)(p.ws + O_YA);
  const bf16_t* YB = (const bf16_t*)(p.ws + O_YB);
  bf16_t* M = (bf16_t*)(p.ws + O_M);
  const int tid = tidx(), lane = tid & 63, h = lane >> 5, wn = __builtin_amdgcn_readfirstlane(tid >> 6) >> 2;
  f32x16 accg[TM][2], accv[TM][2];
  gemm_mainloop<TM, 2>(YB, 512, (const bf16_t*)(p.ws + O_WPB), 512, 512, m0, n0, 1024, accv, lds);
  gemm_mainloop<TM, 2>(XB, DM, WIN + (size_t)(PABC + 1024) * DM, DM, DM, m0, n0, 1024, accg, lds);
#pragma unroll
  for (int tn = 0; tn < 2; ++tn)
#pragma unroll
    for (int g = 0; g < 4; ++g) {
      const f32x4 bg = *(const f32x4*)(p.in[24] + 1024 + n0 + wn * 64 + tn * 32 + 8 * g + 4 * h);
#pragma unroll
      for (int tm = 0; tm < TM; ++tm)
#pragma unroll
        for (int j = 0; j < 4; ++j) accv[tm][tn][4 * g + j] *= sigmoidf_(accg[tm][tn][4 * g + j] + bg[j]);
      __builtin_amdgcn_sched_barrier(0);
    }
  gemm_mainloop<TM, 2>(XB, DM, WIN + (size_t)PABC * DM, DM, DM, m0, n0, 1024, accg, lds);
#pragma unroll
  for (int tn = 0; tn < 2; ++tn)
#pragma unroll
    for (int g = 0; g < 4; ++g) {
      const f32x4 bg = *(const f32x4*)(p.in[24] + n0 + wn * 64 + tn * 32 + 8 * g + 4 * h);
#pragma unroll
      for (int tm = 0; tm < TM; ++tm)
#pragma unroll
        for (int j = 0; j < 4; ++j) {
          const float e = __expf(-(accg[tm][tn][4 * g + j] + bg[j]));
          accv[tm][tn][4 * g + j] *= (1.f + e);
          accg[tm][tn][4 * g + j] = 1.f / (1.f + e);
        }
      __builtin_amdgcn_sched_barrier(0);
    }
  gemm_mainloop<TM, 2, false>(YA, 512, (const bf16_t*)(p.ws + O_WPA), 512, 512, m0, n0, 1024, accv, lds);
  epilogue_bf16<TM, 2, 128>(accv, lds, M, DM, m0, n0, DM, [&](int tm, int tn, int g, int, int) { return acc4(accg[tm][tn], g) * acc4(accv[tm][tn], g); });
}
DI void phase4(const Params& p, unsigned char* lds) {
  if (gridDim.x == 256) {
    TileIter ti; ti.init(NP / 256, 8);
    int tmi, tni;
    while (ti.next(tmi, tni)) p4_tile<2>(p, lds, tmi * 256, tni * 128);
    int m0, n0;
    if (small_tile_of_block(m0, n0)) p4_tile<1>(p, lds, m0, n0);
  } else {
    TileIter ti; ti.init(NT / 128, 8);
    int tmi, tni;
    while (ti.next(tmi, tni)) p4_tile<1>(p, lds, tmi * 128, tni * 128);
  }
}

template <int TM, int TN, int NST>
DI void p5_tile(const Params& p, unsigned char* lds, int m0, int n0) {
  const bf16_t* M = (const bf16_t*)(p.ws + O_M);
  bf16_t* Z = (bf16_t*)(p.ws + O_Z);
  f32x16 acc[TM][TN];
  gemm_mainloop<TM, TN, true, NST>(M, DM, (const bf16_t*)(p.ws + O_WO), DM, DM, m0, n0, 1024, acc, lds);
  epilogue_bf16<TM, TN, 64 * TN>(acc, lds, Z, DM, m0, n0, DM, [&](int tm, int tn, int g, int rowl, int coll) {
    const f32x4 xv = *(const f32x4*)(xrow(p, m0 + rowl) + n0 + coll);
    return xv * DN_ALPHA + acc4(acc[tm][tn], g);
  });
}
DI void phase5(const Params& p, unsigned char* lds) {
  if (gridDim.x == 256) {
    TileIter ti; ti.init(NP / 256, 4);
    int tmi, tni;
    while (ti.next(tmi, tni)) p5_tile<2, 4, 2>(p, lds, tmi * 256, tni * 256);
    int m0, n0;
    if (small_tile_of_block(m0, n0)) p5_tile<1, 2, 3>(p, lds, m0, n0);
  } else {
    TileIter ti; ti.init(NT / 256, 8);
    int tmi, tni;
    while (ti.next(tmi, tni)) p5_tile<2, 2, 3>(p, lds, tmi * 256, tni * 128);
  }
}
template <bool OUT_BF16>
DI void ln_rows(const bf16_t* src, const float* g, const float* b, bf16_t* dst16, float* dst32) {
  const int gw = (blockIdx.x * NTHREADS + tidx()) >> 6, ngw = (gridDim.x * NTHREADS) >> 6, lane = tidx() & 63;
  for (int t = gw; t < NT; t += ngw) {
    const u32x4* xr = (const u32x4*)(src + (size_t)t * DM) + lane;
    float v[16]; float s = 0.f;
#pragma unroll
    for (int j = 0; j < 2; ++j) { unpack8(xr[64 * j], v + 8 * j); }
#pragma unroll
    for (int j = 0; j < 16; ++j) s += v[j];
    const float mean = wave_sum(s) * (1.f / DM);
    float s2 = 0.f;
#pragma unroll
    for (int j = 0; j < 16; ++j) { v[j] -= mean; s2 += v[j] * v[j]; }
    const float rstd = rsqrtf(wave_sum(s2) * (1.f / DM) + 1e-5f);
#pragma unroll
    for (int j = 0; j < 2; ++j) {
      const int c = 8 * lane + 512 * j;
      const f32x4 g0 = *(const f32x4*)(g + c), g1 = *(const f32x4*)(g + c + 4), b0 = *(const f32x4*)(b + c), b1 = *(const f32x4*)(b + c + 4);
      float o[8];
#pragma unroll
      for (int q = 0; q < 4; ++q) { o[q] = v[8 * j + q] * rstd * g0[q] + b0[q]; o[4 + q] = v[8 * j + 4 + q] * rstd * g1[q] + b1[q]; }
      if (OUT_BF16) *(u32x4*)(dst16 + (size_t)t * DM + c) = pack8(o);
      else { *(f32x4*)(dst32 + (size_t)t * DM + c) = (f32x4){o[0], o[1], o[2], o[3]}; *(f32x4*)(dst32 + (size_t)t * DM + c + 4) = (f32x4){o[4], o[5], o[6], o[7]}; }
    }
  }
}

DI void phase6(const Params& p, unsigned char* lds) {
  const bf16_t* H = (const bf16_t*)(p.ws + O_H);
  bf16_t* ACT = (bf16_t*)(p.ws + O_ACT);
  constexpr int NMT = NT / 256, NNT = 5632 / 256;
  TileIter ti; ti.init(NMT, NNT);
  int tmi, tni;
  while (ti.next(tmi, tni)) {
    const int m0 = tmi * 256, n0 = tni * 256;
    f32x16 acc[2][4];
    gemm_mainloop<2, 4, true, 2>(H, DM, (const bf16_t*)(p.ws + O_WGU), DM, DM, m0, n0, 5632, acc, lds);
    epilogue_bf16<2, 4, 128>(acc, lds, ACT, DFF, m0, tni * 128, DFF, [&](int tm, int q, int g, int, int) {
      f32x4 o;
#pragma unroll
      for (int j = 0; j < 4; ++j) { const float gte = acc[tm][2 * q][4 * g + j], up = acc[tm][2 * q + 1][4 * g + j]; o[j] = gte * sigmoidf_(gte) * up; }
      return o;
    });
  }
}
template <int TM, int TN, int NST>
DI void p7_tile(const Params& p, unsigned char* lds, int m0, int n0) {
  const bf16_t* H = (const bf16_t*)(p.ws + O_H);
  const bf16_t* ACT = (const bf16_t*)(p.ws + O_ACT);
  bf16_t* Z2 = (bf16_t*)(p.ws + O_Z2);
  f32x16 acc[TM][TN];
  gemm_mainloop<TM, TN, true, NST>(ACT, DFF, (const bf16_t*)(p.ws + O_WDN), DFF, DFF, m0, n0, 1024, acc, lds);
  epilogue_bf16<TM, TN, 64 * TN>(acc, lds, Z2, DM, m0, n0, DM, [&](int tm, int tn, int g, int rowl, int coll) {
    const u32x2 hv = *(const u32x2*)(H + (size_t)(m0 + rowl) * DM + n0 + coll);
    const f32x4 hf = {__uint_as_float(hv[0] << 16), __uint_as_float(hv[0] & 0xffff0000u), __uint_as_float(hv[1] << 16), __uint_as_float(hv[1] & 0xffff0000u)};
    return hf * DN_ALPHA + acc4(acc[tm][tn], g);
  });
}
DI void phase7(const Params& p, unsigned char* lds) {
  if (gridDim.x == 256) {
    TileIter ti; ti.init(NP / 256, 4);
    int tmi, tni;
    while (ti.next(tmi, tni)) p7_tile<2, 4, 2>(p, lds, tmi * 256, tni * 256);
    int m0, n0;
    if (small_tile_of_block(m0, n0)) p7_tile<1, 2, 3>(p, lds, m0, n0);
  } else {
    TileIter ti; ti.init(NT / 256, 8);
    int tmi, tni;
    while (ti.next(tmi, tni)) p7_tile<2, 2, 3>(p, lds, tmi * 256, tni * 128);
  }
}

DI void run_phase(const Params& p, unsigned char* lds, int ph) {
  switch (ph) {
    case 0: phase0(p, lds); break;
    case 1: phase1(p, lds); break;
    case 2: phase2(p, lds); break;
    case 3: phase3(p, lds); break;
    case 4: phase4a(p); break;
    case 5: phase4(p, lds); break;
    case 6: phase5(p, lds); break;
    case 7: ln_rows<true>((const bf16_t*)(p.ws + O_Z), p.in[26], p.in[27], (bf16_t*)(p.ws + O_H), nullptr); break;
    case 8: phase6(p, lds); break;
    case 9: phase7(p, lds); break;
    case 11: phase3b(p, lds); break;
    case 10: ln_rows<false>((const bf16_t*)(p.ws + O_Z2), p.in[30], p.in[31], nullptr, p.out + F_Y); break;
  }
}
constexpr int NPHASES = 11;

DI unsigned ctl_ld(unsigned* p) { return __hip_atomic_load(p, __ATOMIC_RELAXED, __HIP_MEMORY_SCOPE_AGENT); }
DI unsigned ctl_add(unsigned* p, unsigned v) { return __hip_atomic_fetch_add(p, v, __ATOMIC_RELAXED, __HIP_MEMORY_SCOPE_AGENT); }
DI void xbar(unsigned* ctl, unsigned x, unsigned nloc, unsigned nx, unsigned k) {
  asm volatile("s_waitcnt vmcnt(0)" ::: "memory");
  __syncthreads();
  if (threadIdx.x == 0) {
    const unsigned old = ctl_add(&ctl[(24 + x) * 64], 1u);
    if (old + 1u == k * nloc) {
      __builtin_amdgcn_fence(__ATOMIC_RELEASE, "agent");
      asm volatile("s_waitcnt vmcnt(0)" ::: "memory");
      ctl_add(&ctl[40 * 64], 1u);
    }
    while (ctl_ld(&ctl[40 * 64]) < k * nx) __builtin_amdgcn_s_sleep(1);
    __builtin_amdgcn_fence(__ATOMIC_ACQUIRE, "agent");
    asm volatile("s_waitcnt vmcnt(0)" ::: "memory");
  }
  __syncthreads();
}

__global__ void __launch_bounds__(NTHREADS) mega_kernel(Params p) {
  extern __shared__ __attribute__((aligned(16))) unsigned char lds[];
  volatile unsigned* s_bar = (volatile unsigned*)(lds + LDS_CTRL + 16);
  cg::grid_group grid = cg::this_grid();
  unsigned* ctl = (unsigned*)(p.ws + O_CTR);
  const unsigned x = (unsigned)__builtin_amdgcn_s_getreg((3 << 11) | 20) & 0xFu;
  if (threadIdx.x == 0) ctl_add(&ctl[(8 + x) * 64], 1u);
  run_phase(p, lds, 0); grid.sync();
  if (threadIdx.x == 0) {
    unsigned nx = 0;
    for (int i = 0; i < 16; ++i) nx += ctl_ld(&ctl[(8 + i) * 64]) != 0u ? 1u : 0u;
    s_bar[0] = ctl_ld(&ctl[(8 + x) * 64]); s_bar[1] = nx;
  }
  __syncthreads();
  const unsigned nloc = __builtin_amdgcn_readfirstlane(s_bar[0]), nx = __builtin_amdgcn_readfirstlane(s_bar[1]);
  run_phase(p, lds, 1); xbar(ctl, x, nloc, nx, 1);
  run_phase(p, lds, 2); xbar(ctl, x, nloc, nx, 2);
  run_phase(p, lds, 3); xbar(ctl, x, nloc, nx, 3);
  run_phase(p, lds, 11); xbar(ctl, x, nloc, nx, 4);
  run_phase(p, lds, 4); xbar(ctl, x, nloc, nx, 5);
  run_phase(p, lds, 5); xbar(ctl, x, nloc, nx, 6);
  run_phase(p, lds, 6); xbar(ctl, x, nloc, nx, 7);
  run_phase(p, lds, 7); xbar(ctl, x, nloc, nx, 8);
  run_phase(p, lds, 8); xbar(ctl, x, nloc, nx, 9);
  run_phase(p, lds, 9); xbar(ctl, x, nloc, nx, 10);
  run_phase(p, lds, 10);
}
template <int PH> __global__ void __launch_bounds__(NTHREADS) phase_kernel(Params p) {
  extern __shared__ __attribute__((aligned(16))) unsigned char lds[];
  run_phase(p, lds, PH);
}
template <int PH> static void launch_phase(const Params& p, int grid, hipStream_t stream) {
  (void)hipFuncSetAttribute((const void*)phase_kernel<PH>, hipFuncAttributeMaxDynamicSharedMemorySize, LDS_BYTES);
  hipLaunchKernelGGL(phase_kernel<PH>, dim3(grid), dim3(NTHREADS), LDS_BYTES, stream, p);
}

extern "C" void kernel_launch(void* const* d_in, const int* in_sizes, int n_in, void* d_out, int out_size, void* d_ws, size_t ws_size, hipStream_t stream) {
  static int grid_blocks = 0;
  if (grid_blocks == 0) {
    if (n_in != 32 || ws_size < WS_END) { fprintf(stderr, "kernel_launch: unexpected n_in %d or ws_size %zu (< %zu)\n", n_in, ws_size, (size_t)WS_END); grid_blocks = -1; return; }
    int dev = 0, cus = 0, per_cu = 0;
    (void)hipGetDevice(&dev);
    (void)hipDeviceGetAttribute(&cus, hipDeviceAttributeMultiprocessorCount, dev);
#if MULTI_LAUNCH
    per_cu = 1;
#else
    (void)hipFuncSetAttribute((const void*)mega_kernel, hipFuncAttributeMaxDynamicSharedMemorySize, LDS_BYTES);
    (void)hipOccupancyMaxActiveBlocksPerMultiprocessor(&per_cu, (const void*)mega_kernel, NTHREADS, LDS_BYTES);
#endif
    if (per_cu < 1) { fprintf(stderr, "kernel_launch: occupancy query gave %d\n", per_cu); grid_blocks = -1; return; }
    grid_blocks = cus;
  }
  if (grid_blocks < 0) return;
  Params p{};
  for (int i = 0; i < 32; ++i) p.in[i] = (const float*)d_in[i];
  p.out = (float*)d_out;
  p.ws = (unsigned char*)d_ws;
#if MULTI_LAUNCH
  launch_phase<0>(p, grid_blocks, stream); launch_phase<1>(p, grid_blocks, stream); launch_phase<2>(p, grid_blocks, stream); launch_phase<3>(p, grid_blocks, stream); launch_phase<11>(p, grid_blocks, stream);
  launch_phase<4>(p, grid_blocks, stream); launch_phase<5>(p, grid_blocks, stream); launch_phase<6>(p, grid_blocks, stream); launch_phase<7>(p, grid_blocks, stream);
  launch_phase<8>(p, grid_blocks, stream); launch_phase<9>(p, grid_blocks, stream); launch_phase<10>(p, grid_blocks, stream);
#else
  (void)hipMemsetAsync((unsigned char*)d_ws + O_CTR, 0, 16384, stream);
  void* args[] = {&p};
  hipError_t e = hipLaunchCooperativeKernel((void*)mega_kernel, dim3(grid_blocks), dim3(NTHREADS), args, LDS_BYTES, stream);
  if (e != hipSuccess) fprintf(stderr, "cooperative launch failed: %s (grid %d)\n", hipGetErrorString(e), grid_blocks);
#endif
}
```

```cpp
#include <hip/hip_runtime.h>
#include <hip/hip_cooperative_groups.h>
#include <cstdio>
#include <cstdint>
namespace cg = cooperative_groups;


#ifndef PROBE_DUP
#define PROBE_DUP -1
#endif
#ifndef MULTI_LAUNCH
#define MULTI_LAUNCH 0
#endif

#define DI __device__ __forceinline__
typedef unsigned short bf16_t;
typedef short bf16x8 __attribute__((ext_vector_type(8)));
typedef short s16x4 __attribute__((ext_vector_type(4)));
typedef float f32x16 __attribute__((ext_vector_type(16)));
typedef float f32x4 __attribute__((ext_vector_type(4)));
typedef float f32x2 __attribute__((ext_vector_type(2)));
typedef unsigned u32x4 __attribute__((ext_vector_type(4)));
typedef unsigned u32x2 __attribute__((ext_vector_type(2)));
typedef __bf16 bf2_t __attribute__((ext_vector_type(2)));

constexpr int NP = 16384, NS = 512, NT = NP + NS;
constexpr int DM = 1024, ACOLS = 1792, BCOLS = 416, PABC = ACOLS + BCOLS  , NIN = 4256;
constexpr int DFF = 2816;
constexpr int PAST = 1024, DSEQ = 32, DB = 16, SKV = PAST + DSEQ  ;
constexpr int NKV = NP + DB * SKV  , NKVP = NKV + 64;
constexpr float DN_ALPHA = 1.189207115002721f;
constexpr float QSCALE = 0.10206207261596575f * 1.4426950408889634f;

constexpr size_t al256(size_t x) { return (x + 255) & ~(size_t)255; }
constexpr size_t O_WIN = 0;
constexpr size_t O_WUQ = O_WIN + al256((size_t)NIN * 1024 * 2);
constexpr size_t O_WUKV = O_WUQ + al256(768 * 256 * 2);
constexpr size_t O_WPA = O_WUKV + al256(1024 * 128 * 2);
constexpr size_t O_WPB = O_WPA + al256(1024 * 512 * 2);
constexpr size_t O_WO = O_WPB + al256(1024 * 512 * 2);
constexpr size_t O_WGU = O_WO + al256(1024 * 1024 * 2);
constexpr size_t O_WDN = O_WGU + al256((size_t)5632 * 1024 * 2);
constexpr size_t O_WW2 = O_WDN + al256((size_t)1024 * 2816 * 2);
constexpr size_t O_WA2 = O_WW2 + al256(512 * 64 * 2);
constexpr size_t O_WG2 = O_WA2 + al256(512 * 64 * 2);
constexpr size_t O_ROPE = O_WG2 + al256(512 * 128 * 2);
constexpr size_t O_CTR = O_ROPE + al256((size_t)NT * 32 * 4);
constexpr size_t O_PAB = O_CTR + 16384;
constexpr size_t SZ_T512 = (size_t)NT * 512 * 2;
constexpr size_t O_SIN = O_PAB + al256((size_t)NT * PABC * 2);
constexpr size_t O_G = O_SIN + 6 * SZ_T512;
constexpr size_t O_RK = O_G + SZ_T512;
constexpr size_t O_KNB = O_RK + al256((size_t)NT * 8 * 4);
constexpr size_t O_KPEB = O_KNB + al256((size_t)8 * NKVP * 64 * 2);
constexpr int SCC = 16, SCL = NP / SCC;
constexpr size_t WS_END = O_KPEB + al256((size_t)NKVP * 32 * 2);
constexpr size_t O_Y = O_PAB;
constexpr size_t O_E = O_Y + SZ_T512;
constexpr size_t O_YB = O_Y + (size_t)NT * 512 * 4;
constexpr size_t O_YA = O_YB + SZ_T512;
constexpr size_t O_H = O_PAB;
constexpr size_t O_M = O_SIN;
constexpr size_t O_Z = O_SIN + (size_t)NT * 1024 * 2;
constexpr size_t O_Z2 = O_PAB + (size_t)NT * 1024 * 2;
constexpr size_t O_ACT = O_SIN;
constexpr size_t OO_XB = 0;
constexpr size_t OO_Q = 0;
constexpr size_t OO_VT = (size_t)NT * 768 * 2;
constexpr size_t OO_GH = OO_VT + (size_t)8 * 64 * NKVP * 2;
constexpr size_t OO_SST = OO_GH + 2 * (size_t)8 * SCC * 4096 * 4;
static_assert(OO_SST + (size_t)SCC * 8 * 4096 * 2 <= (size_t)NT * 1024 * 4, "d_out scratch");
constexpr size_t F_Y = 0, F_CKVP = (size_t)NT * 1024, F_KPEP = F_CKVP + (size_t)NP * 128, F_WKVP = F_KPEP + (size_t)NP * 32,
                 F_SHP = F_WKVP + 32768, F_CKVS = F_SHP + 1792, F_KPES = F_CKVS + (size_t)NS * 128, F_WKVS = F_KPES + (size_t)NS * 32,
                 F_SHS = F_WKVS + (size_t)DB * 32768;

constexpr int LDS_CTRL = 3 * 49152;
constexpr int LDS_BYTES = LDS_CTRL + 256;
constexpr int NTHREADS = 512;

struct Params {
  const float* in[32];
  float* out;
  unsigned char* ws;
};

DI int tidx() { int t = threadIdx.x; asm volatile("" : "+v"(t)); return t; }
DI unsigned pk2(float a, float b) { f32x2 v = {a, b}; bf2_t r = __builtin_convertvector(v, bf2_t); return __builtin_bit_cast(unsigned, r); }
DI bf16_t f2bf(float a) { return (bf16_t)(pk2(a, 0.f) & 0xffffu); }
DI float bf2f(bf16_t x) { return __uint_as_float(((unsigned)x) << 16); }
DI void unpack8(u32x4 v, float* f) {
#pragma unroll
  for (int j = 0; j < 4; ++j) { f[2 * j] = __uint_as_float(v[j] << 16); f[2 * j + 1] = __uint_as_float(v[j] & 0xffff0000u); }
}
DI u32x4 pack8(const float* f) { u32x4 o; o[0] = pk2(f[0], f[1]); o[1] = pk2(f[2], f[3]); o[2] = pk2(f[4], f[5]); o[3] = pk2(f[6], f[7]); return o; }
DI float sigmoidf_(float x) { return 1.f / (1.f + __expf(-x)); }
DI float dpp_sum16(float x) {
  x += __builtin_bit_cast(float, __builtin_amdgcn_update_dpp(0, __builtin_bit_cast(int, x), 0xB1, 0xF, 0xF, true));
  x += __builtin_bit_cast(float, __builtin_amdgcn_update_dpp(0, __builtin_bit_cast(int, x), 0x4E, 0xF, 0xF, true));
  x += __builtin_bit_cast(float, __builtin_amdgcn_update_dpp(0, __builtin_bit_cast(int, x), 0x141, 0xF, 0xF, true));
  x += __builtin_bit_cast(float, __builtin_amdgcn_update_dpp(0, __builtin_bit_cast(int, x), 0x140, 0xF, 0xF, true));
  return x;
}
DI float sum32(float x) { x = dpp_sum16(x); x += __shfl_xor(x, 16); return x; }
DI float wave_sum(float v) {
#pragma unroll
  for (int o = 1; o < 64; o <<= 1) v += __shfl_xor(v, o);
  return v;
}
DI int crow(int i, int h) { return (i & 3) + 8 * (i >> 2) + 4 * h; }
#define MFMA32(a, b, c) __builtin_amdgcn_mfma_f32_32x32x16_bf16((a), (b), (c), 0, 0, 0)
DI int slot_of_token(int t) { return t < NP ? t : NP + ((t - NP) >> 5) * SKV + PAST + ((t - NP) & 31); }
DI const float* xrow(const Params& p, int t) { return t < NP ? p.in[0] + (size_t)t * DM : p.in[1] + (size_t)(t - NP) * DM; }

DI void conv_T(const float* W, int K, int N, bf16_t* WT, int mode, int gtid, int gsz) {
  const int ntask = (K / 8) * N;
  for (int id = gtid; id < ntask; id += gsz) {
    const int kc = id / N, n = id - kc * N, k0 = kc * 8;
    float f[8];
#pragma unroll
    for (int j = 0; j < 8; ++j) f[j] = W[(size_t)(k0 + j) * N + n];
    if (mode == 2) {
      *(u32x4*)(WT + ((size_t)((n >> 5) * (K >> 4) + (k0 >> 4)) * 64 + ((k0 >> 3) & 1) * 32 + (n & 31)) * 8) = pack8(f);
      continue;
    }
    int row = n;
    if (mode == 1) { const int nt = n >= DFF ? 1 : 0, j = n - nt * DFF; row = 128 * (j >> 6) + 64 * ((j & 63) >> 5) + 32 * nt + (j & 31); }
    *(u32x4*)(WT + (size_t)row * K + k0) = pack8(f);
  }
}
DI void conv_T_lds(const float* W, int K, int N, bf16_t* WT, int mode, unsigned char* lds, int gw, int ngw, int wave, int lane) {
  float* scr = (float*)(lds + wave * (64 * 33 * 4));
  const int nblk = N >> 5, nitem = (K >> 6) * nblk;
  for (int item = gw; item < nitem; item += ngw) {
    const int kb = item / nblk, nb = item - kb * nblk, k0 = kb * 64, n0 = nb * 32;
#pragma unroll 8
    for (int i = 0; i < 32; ++i) { const int kk = 2 * i + (lane >> 5); scr[kk * 33 + (lane & 31)] = W[(size_t)(k0 + kk) * N + n0 + (lane & 31)]; }
    asm volatile("s_waitcnt lgkmcnt(0)" ::: "memory");
    const int c = lane & 7;
#pragma unroll
    for (int j = 0; j < 4; ++j) {
      const int nl = (lane >> 3) + 8 * j;
      const float* sp = scr + (8 * c) * 33 + nl;
      float f[8];
#pragma unroll
      for (int q = 0; q < 8; ++q) f[q] = sp[q * 33];
      int row = n0 + nl;
      if (mode == 1) { const int nt = row >= DFF ? 1 : 0, jj = row - nt * DFF; row = 256 * (jj >> 7) + 128 * ((jj & 127) >> 6) + 32 * (2 * ((jj & 63) >> 5) + nt) + (jj & 31); }
      *(u32x4*)(WT + (size_t)row * K + k0 + 8 * c) = pack8(f);
    }
    asm volatile("s_waitcnt lgkmcnt(0)" ::: "memory");
  }
}
DI void conv_x(const Params& p, bf16_t* XB, int gtid, int gsz) {
  for (int id = gtid; id < NT * 128; id += gsz) {
    const int t = id >> 7, c = (id & 127) * 8;
    const float* src = xrow(p, t) + c;
    f32x4 a = *(const f32x4*)src, b = *(const f32x4*)(src + 4);
    float f[8] = {a[0], a[1], a[2], a[3], b[0], b[1], b[2], b[3]};
    *(u32x4*)(XB + (size_t)t * DM + c) = pack8(f);
  }
}
DI void phase0(const Params& p, unsigned char* lds) {
  const int tid0 = tidx(), gtid = blockIdx.x * NTHREADS + tid0, gsz = gridDim.x * NTHREADS;
  const int wave0 = __builtin_amdgcn_readfirstlane(tid0 >> 6), lane0 = tid0 & 63, gw = blockIdx.x * 8 + wave0, ngw = gridDim.x * 8;
  unsigned char* ws = p.ws;
  if (gtid < 64) ((unsigned*)(ws + O_CTR))[gtid] = 0u;
  conv_T_lds(p.in[6], 1024, NIN, (bf16_t*)(ws + O_WIN), 0, lds, gw, ngw, wave0, lane0);
  conv_T(p.in[20], 256, 768, (bf16_t*)(ws + O_WUQ), 2, gtid, gsz);
  conv_T(p.in[22], 128, 1024, (bf16_t*)(ws + O_WUKV), 2, gtid, gsz);
  conv_T_lds(p.in[18], 512, 1024, (bf16_t*)(ws + O_WPA), 0, lds, gw, ngw, wave0, lane0);
  conv_T_lds(p.in[23], 512, 1024, (bf16_t*)(ws + O_WPB), 0, lds, gw, ngw, wave0, lane0);
  conv_T_lds(p.in[25], 1024, 1024, (bf16_t*)(ws + O_WO), 0, lds, gw, ngw, wave0, lane0);
  conv_T_lds(p.in[28], 1024, 5632, (bf16_t*)(ws + O_WGU), 1, lds, gw, ngw, wave0, lane0);
  conv_T_lds(p.in[29], 2816, 1024, (bf16_t*)(ws + O_WDN), 0, lds, gw, ngw, wave0, lane0);
  conv_T(p.in[9], 64, 512, (bf16_t*)(ws + O_WW2), 2, gtid, gsz);
  conv_T(p.in[11], 64, 512, (bf16_t*)(ws + O_WA2), 2, gtid, gsz);
  conv_T(p.in[12], 128, 512, (bf16_t*)(ws + O_WG2), 2, gtid, gsz);
  conv_x(p, (bf16_t*)((unsigned char*)p.out + OO_XB), gtid, gsz);
  float* rope = (float*)(ws + O_ROPE);
  for (int id = gtid; id < NT * 16; id += gsz) {
    const int t = id >> 4, j = id & 15;
    const int pos = t < NP ? t : PAST + ((t - NP) & 31);
    const float inv = (float)exp2(-(double)j * (13.287712379549449 / 16.0));
    const float ang = (float)pos * inv;
    const double x = (double)ang;
    const double n = rint(x * 0.15915494309189535);
    const float red = (float)(x - n * 6.283185307179586);
    rope[t * 32 + j] = __cosf(red);
    rope[t * 32 + 16 + j] = __sinf(red);
  }
  bf16_t* kpeb = (bf16_t*)(ws + O_KPEB);
  for (int id = gtid; id < DB * PAST * 4; id += gsz) {
    const int row = id >> 2, ch = id & 3, b = row >> 10, j = row & 1023;
    const float* src = p.in[3] + (size_t)row * 32 + ch * 8;
    f32x4 a = *(const f32x4*)src, c = *(const f32x4*)(src + 4);
    float f[8] = {a[0], a[1], a[2], a[3], c[0], c[1], c[2], c[3]};
    *(u32x4*)(kpeb + (size_t)(NP + b * SKV + j) * 32 + ch * 8) = pack8(f);
  }
  bf16_t* knb = (bf16_t*)(ws + O_KNB);
  for (int id = gtid; id < 64 * 32; id += gsz) kpeb[(size_t)NKV * 32 + id] = 0;
  for (int id = gtid; id < 8 * 64 * 64; id += gsz) {
    const int h = id >> 12, rem = id & 4095;
    knb[((size_t)h * NKVP + NKV) * 64 + rem] = 0;
  }
}

template <int TM, int TN, bool ZERO = true, int NST = 3>
DI void gemm_mainloop(const bf16_t* __restrict__ A, int lda, const bf16_t* __restrict__ Bt, int ldb, int K, int m0, int n0, int nmax,
                      f32x16 (&acc)[TM][TN], unsigned char* lds) {
  constexpr int BM = 128 * TM, BN = 64 * TN, AG = BM / 64, BG = BN / 64, NLD = AG + BG;
  constexpr int ABYTES = BM * 128, STAGE = (BM + BN) * 128;
  static_assert(NST * STAGE <= LDS_CTRL && (NST == 2 || NST == 3), "lds");
  const int tid = tidx(), wave = __builtin_amdgcn_readfirstlane(tid >> 6), lane = tid & 63, r = lane & 31, h = lane >> 5, wm = wave & 3, wn = wave >> 2;
  const int lrow = lane >> 3, lpos = lane & 7;
  const bf16_t* ap[AG]; const bf16_t* bp[BG];
#pragma unroll
  for (int i = 0; i < AG; ++i) { const int row = (wave * AG + i) * 8 + lrow, c = lpos ^ ((row >> 1) & 7); ap[i] = A + (size_t)(m0 + row) * lda + c * 8; }
#pragma unroll
  for (int i = 0; i < BG; ++i) { const int row = (wave * BG + i) * 8 + lrow, c = lpos ^ ((row >> 1) & 7); int br = n0 + row; br = br < nmax ? br : nmax - 1; bp[i] = Bt + (size_t)br * ldb + c * 8; }
  if (ZERO) {
#pragma unroll
    for (int tm = 0; tm < TM; ++tm)
#pragma unroll
      for (int tn = 0; tn < TN; ++tn)
#pragma unroll
        for (int i = 0; i < 16; ++i) acc[tm][tn][i] = 0.f;
  }
  auto issue = [&](int kt, int stage) {
    unsigned char* sb = lds + stage * STAGE;
#pragma unroll
    for (int i = 0; i < AG; ++i) __builtin_amdgcn_global_load_lds((const unsigned*)(ap[i] + kt * 64), (unsigned*)(sb + (wave * AG + i) * 1024), 16, 0, 0);
#pragma unroll
    for (int i = 0; i < BG; ++i) __builtin_amdgcn_global_load_lds((const unsigned*)(bp[i] + kt * 64), (unsigned*)(sb + ABYTES + (wave * BG + i) * 1024), 16, 0, 0);
  };
  const int swz = (r >> 1) & 7;
  int koff[4];
#pragma unroll
  for (int ks = 0; ks < 4; ++ks) koff[ks] = ((ks * 2 + h) ^ swz) * 16;
  const int a_rd = (wm * 32 * TM + r) * 128, b_rd = ABYTES + (wn * 32 * TN + r) * 128;
  const int nk = K >> 6;
  asm volatile("s_waitcnt vmcnt(0)" ::: "memory");
  issue(0, 0);
  if (NST == 3) issue(1, 1);
  for (int kt = 0; kt < nk; ++kt) {
    if (NST == 3 && kt + 1 < nk) asm volatile("s_waitcnt vmcnt(%0)" ::"n"(NLD) : "memory");
    else asm volatile("s_waitcnt vmcnt(0)" ::: "memory");
    asm volatile("s_waitcnt lgkmcnt(0)" ::: "memory");
    __builtin_amdgcn_s_barrier();
    if (NST == 3) { if (kt + 2 < nk) issue(kt + 2, (kt + 2) % 3); }
    else { if (kt + 1 < nk) issue(kt + 1, (kt + 1) & 1); }
    const unsigned char* cur = lds + (kt % NST) * STAGE;
#pragma unroll
    for (int ks = 0; ks < 4; ++ks) {
      bf16x8 af[TM], bfr[TN];
#pragma unroll
      for (int tm = 0; tm < TM; ++tm) af[tm] = *(const bf16x8*)(cur + a_rd + tm * 4096 + koff[ks]);
#pragma unroll
      for (int tn = 0; tn < TN; ++tn) bfr[tn] = *(const bf16x8*)(cur + b_rd + tn * 4096 + koff[ks]);
#pragma unroll
      for (int tm = 0; tm < TM; ++tm)
#pragma unroll
        for (int tn = 0; tn < TN; ++tn) acc[tm][tn] = MFMA32(bfr[tn], af[tm], acc[tm][tn]);
    }
  }
  asm volatile("s_waitcnt lgkmcnt(0)" ::: "memory");
  __builtin_amdgcn_s_barrier();
}

template <int TM, int TN, int OUTC, class F>
DI void epilogue_bf16(const f32x16 (&acc)[TM][TN], unsigned char* lds, bf16_t* out, int ldo, int m0, int c0, int cmax, F f) {
  constexpr int BM = 128 * TM, STRIDE = OUTC * 2 + 16, TNO = OUTC / (32 * 2);
  const int tid = tidx(), wave = __builtin_amdgcn_readfirstlane(tid >> 6), lane = tid & 63, r = lane & 31, h = lane >> 5, wm = wave & 3, wn = wave >> 2;
#pragma unroll
  for (int tm = 0; tm < TM; ++tm)
#pragma unroll
    for (int tn = 0; tn < TNO; ++tn)
#pragma unroll
      for (int g = 0; g < 4; ++g) {
        const int rowl = wm * 32 * TM + tm * 32 + r, coll = wn * 32 * TNO + tn * 32 + 8 * g + 4 * h;
        const f32x4 o = f(tm, tn, g, rowl, coll);
        u32x2 w; w[0] = pk2(o[0], o[1]); w[1] = pk2(o[2], o[3]);
        *(u32x2*)(lds + rowl * STRIDE + coll * 2) = w;
      }
  __syncthreads();
  constexpr int CPR = OUTC / 8;
#pragma unroll
  for (int j = 0; j < BM * CPR / NTHREADS; ++j) {
    const int id = tid + NTHREADS * j, row = id / CPR, c = id % CPR;
    if (c0 + c * 8 < cmax) *(u32x4*)(out + (size_t)(m0 + row) * ldo + c0 + c * 8) = *(const u32x4*)(lds + row * STRIDE + c * 16);
  }
  __syncthreads();
}
DI f32x4 acc4(const f32x16& a, int g) { return (f32x4){a[4 * g], a[4 * g + 1], a[4 * g + 2], a[4 * g + 3]}; }

struct TileIter {
  int nM, nN, total, L, Lend, step;
  DI void init(int nM_, int nN_) {
    nM = nM_; nN = nN_; total = nM * nN;
    const int nx = (gridDim.x & 7) == 0 ? 8 : 1, x = blockIdx.x % nx, local = blockIdx.x / nx;
    step = gridDim.x / nx;
    const int per = (total + nx - 1) / nx;
    L = x * per + local; Lend = (x + 1) * per < total ? (x + 1) * per : total;
  }
  DI bool next(int& tmi, int& tni) {
    if (L >= Lend) return false;
    const int fb = nM >> 2, fullcnt = fb * 4 * nN;
    if (L < fullcnt) { const int band = L / (4 * nN), jj = L - band * 4 * nN; tni = jj >> 2; tmi = band * 4 + (jj & 3); }
    else { const int l2 = L - fullcnt, bm = nM & 3; tni = l2 / bm; tmi = fb * 4 + l2 % bm; }
    L += step; return true;
  }
};

DI void phase1(const Params& p, unsigned char* lds) {
  const bf16_t* XB = (const bf16_t*)((unsigned char*)p.out + OO_XB);
  const bf16_t* WT = (const bf16_t*)(p.ws + O_WIN);
  bf16_t* PAB = (bf16_t*)(p.ws + O_PAB);
  constexpr int NMT = NT / 256, NNT = (PABC + 127) / 128;
  const int lane = tidx() & 63, wave = __builtin_amdgcn_readfirstlane(tidx() >> 6), r = lane & 31, h = lane >> 5, wm = wave & 3, wn = wave >> 2;
  TileIter ti; ti.init(NMT, NNT);
  int tmi, tni;
  while (ti.next(tmi, tni)) {
    const int m0 = tmi * 256, n0 = tni * 128;
    f32x16 acc[2][2];
    gemm_mainloop<2, 2>(XB, DM, WT, DM, DM, m0, n0, PABC, acc, lds);
    if (m0 + 256 > NP - 1 && n0 < ACOLS) {
#pragma unroll
      for (int tm = 0; tm < 2; ++tm) {
        const int row = m0 + wm * 64 + tm * 32 + r;
        const bool lastp = row == NP - 1, lasts = row >= NP && ((row - NP) & 31) == 31;
        if (lastp || lasts) {
          float* dst = lastp ? p.out + F_SHP : p.out + F_SHS + (size_t)((row - NP) >> 5) * ACOLS;
#pragma unroll
          for (int tn = 0; tn < 2; ++tn)
#pragma unroll
            for (int g = 0; g < 4; ++g) {
              const int col = n0 + wn * 64 + tn * 32 + 8 * g + 4 * h;
              if (col < ACOLS) *(f32x4*)(dst + col) = acc4(acc[tm][tn], g);
            }
        }
      }
    }
    epilogue_bf16<2, 2, 128>(acc, lds, PAB, PABC, m0, n0, PABC, [&](int tm, int tn, int g, int, int) { return acc4(acc[tm][tn], g); });
  }
}

constexpr int L2_LORA = 0, L2_K = L2_LORA + 32 * 528, L2_R = L2_K + 32 * 1040, L2A_STG = L2_R + 32 * 1040, L2A_END = L2A_STG + 8 * 32 * 144;
constexpr int L2_CQ = 0, L2_CKV = L2_CQ + 32 * 528, L2B_STG = L2_CKV + 32 * 272, L2B_END = L2B_STG + 8 * 32 * 208;
static_assert(L2A_END <= LDS_BYTES && L2B_END <= LDS_BYTES, "lds p2");
template <int NTL, class F>
DI void stage_store16(unsigned char* stg, int lane, bf16_t* dst  , unsigned row_stride  , F f) {
  constexpr int RS = NTL * 64 + 16, CPR = NTL * 4;
  const int r = lane & 31, h = lane >> 5;
#pragma unroll
  for (int nt = 0; nt < NTL; ++nt)
#pragma unroll
    for (int i = 0; i < 16; ++i) *(unsigned short*)(stg + crow(i, h) * RS + (nt * 32 + r) * 2) = f(nt, i);
  __syncthreads();
#pragma unroll
  for (int j = 0; j < 32 * CPR / 64; ++j) {
    const int id = lane + 64 * j, row = id / CPR, ch = id % CPR;
    *(u32x4*)(dst + (size_t)row * row_stride + ch * 8) = *(const u32x4*)(stg + row * RS + ch * 16);
  }
  __syncthreads();
}

template <int NTL, int KS>
DI void mm32(const unsigned char* ldsA, int strideB, const bf16_t* Bt, int ldb, int lane, f32x16 (&acc)[NTL]) {
  constexpr int KG = (NTL * KS <= 16) ? KS : (NTL <= 2 ? 4 : 2), NG = KS / KG;
  const int r = lane & 31, h = lane >> 5;
#pragma unroll
  for (int nt = 0; nt < NTL; ++nt)
#pragma unroll
    for (int i = 0; i < 16; ++i) acc[nt][i] = 0.f;
  bf16x8 bq[2][KG][NTL];
  const bf16_t* bp = Bt + lane * 8;
#pragma unroll
  for (int k = 0; k < KG; ++k)
#pragma unroll
    for (int nt = 0; nt < NTL; ++nt) bq[0][k][nt] = *(const bf16x8*)(bp + (size_t)(nt * KS + k) * 512);
#pragma unroll
  for (int g = 0; g < NG; ++g) {
    if (g + 1 < NG) {
#pragma unroll
      for (int k = 0; k < KG; ++k)
#pragma unroll
        for (int nt = 0; nt < NTL; ++nt) bq[(g + 1) & 1][k][nt] = *(const bf16x8*)(bp + (size_t)(nt * KS + (g + 1) * KG + k) * 512);
    }
    __builtin_amdgcn_sched_barrier(0);
#pragma unroll
    for (int k = 0; k < KG; ++k) {
      const bf16x8 a = *(const bf16x8*)(ldsA + r * strideB + (g * KG + k) * 32 + h * 16);
#pragma unroll
      for (int nt = 0; nt < NTL; ++nt) acc[nt] = MFMA32(a, bq[g & 1][k][nt], acc[nt]);
    }
    __builtin_amdgcn_sched_barrier(0);
  }
}

DI void kv_expand(const Params& p, unsigned char* lds, int w, int lane, int slot0) {
  const int r = lane & 31, h = lane >> 5;
  bf16_t* knb = (bf16_t*)(p.ws + O_KNB);
  bf16_t* vT = (bf16_t*)((unsigned char*)p.out + OO_VT);
  f32x16 acc[4];
  mm32<4, 8>(lds + L2_CKV, 272, (const bf16_t*)(p.ws + O_WUKV) + (size_t)(128 * w) * 128, 128, lane, acc);
  stage_store16<2>((unsigned char*)lds + L2B_STG + w * (32 * 208), lane, knb + ((size_t)w * NKVP + slot0) * 64, 64, [&](int nt, int i) { return f2bf(acc[nt][i]); });
#pragma unroll
  for (int nt = 2; nt < 4; ++nt)
#pragma unroll
    for (int g = 0; g < 4; ++g) {
      u32x2 o; o[0] = pk2(acc[nt][4 * g], acc[nt][4 * g + 1]); o[1] = pk2(acc[nt][4 * g + 2], acc[nt][4 * g + 3]);
      *(u32x2*)(vT + ((unsigned)w * 64 + (nt - 2) * 32 + r) * (unsigned)NKVP + slot0 + 8 * g + 4 * h) = o;
    }
}

DI void p2_token_tile_a(const Params& p, unsigned char* lds, int tile) {
  const int tid = tidx(), wave = __builtin_amdgcn_readfirstlane(tid >> 6), lane = tid & 63, r = lane & 31, h = lane >> 5;
  const int t0 = tile * 32;
  unsigned char* ws = p.ws;
  const bf16_t* PAB = (const bf16_t*)(ws + O_PAB);
  bf16_t* SR = (bf16_t*)(ws + O_SIN);
  bf16_t* SK = SR + (size_t)NT * 512; bf16_t* SV = SK + (size_t)NT * 512; bf16_t* SA = SV + (size_t)NT * 512; bf16_t* SB = SA + (size_t)NT * 512;
  _Float16* SW = (_Float16*)(SB + (size_t)NT * 512);
  bf16_t* G = (bf16_t*)(ws + O_G);
  float* RK = (float*)(ws + O_RK);
  const float* rope = (const float*)(ws + O_ROPE);
#pragma unroll 1
  for (int bt = 0; bt < 2; ++bt) {
    u32x4 rawp[7], rawq[7];
#pragma unroll
    for (int it = 0; it < 7; ++it) {
      const int task = tid + NTHREADS * (bt * 7 + it);
      const int tl = task / 224, ch = task - tl * 224, c0 = ch * 8, t = t0 + tl;
      rawp[it] = *(const u32x4*)(PAB + (size_t)t * PABC + c0);
      rawq[it] = *(const u32x4*)(PAB + (size_t)(t > 0 ? t - 1 : 0) * PABC + c0);
    }
#pragma unroll
    for (int it = 0; it < 7; ++it) {
      const int task = tid + NTHREADS * (bt * 7 + it);
      const int tl = task / 224, ch = task - tl * 224, c0 = ch * 8, t = t0 + tl;
      float pv[8], pr[8];
      unpack8(rawp[it], pv);
      unpack8(rawq[it], pr);
      if (t == 0) {
#pragma unroll
        for (int j = 0; j < 8; ++j) pr[j] = 0.f;
      } else if (t >= NP && ((t - NP) & 31) == 0) {
        const float* sp = p.in[5] + (size_t)((t - NP) >> 5) * ACOLS + c0;
        const f32x4 a = *(const f32x4*)sp, b = *(const f32x4*)(sp + 4);
        pr[0] = a[0]; pr[1] = a[1]; pr[2] = a[2]; pr[3] = a[3]; pr[4] = b[0]; pr[5] = b[1]; pr[6] = b[2]; pr[7] = b[3];
      }
      const f32x4 mu0 = *(const f32x4*)(p.in[7] + c0), mu1 = *(const f32x4*)(p.in[7] + c0 + 4);
      const float mm[8] = {mu0[0], mu0[1], mu0[2], mu0[3], mu1[0], mu1[1], mu1[2], mu1[3]};
      float xs[8];
#pragma unroll
      for (int j = 0; j < 8; ++j) xs[j] = pv[j] + (pr[j] - pv[j]) * mm[j];
      if (c0 < 512) {
        const u32x4 o = pack8(xs);
        *(u32x4*)(SR + (size_t)t * 512 + c0) = o;
        *(u32x4*)(lds + L2_R + tl * 1040 + c0 * 2) = o;
      } else if (c0 < 1024) {
        *(u32x4*)(lds + L2_K + tl * 1040 + (c0 - 512) * 2) = pack8(xs);
      } else if (c0 < 1536) {
        *(u32x4*)(SV + (size_t)t * 512 + (c0 - 1024)) = pack8(xs);
      } else {
        if (c0 < 1600) {
#pragma unroll
          for (int j = 0; j < 8; ++j) { const float e = __expf(2.f * xs[j]); xs[j] = 1.f - 2.f / (e + 1.f); }
        } else if (c0 >= 1664) {
#pragma unroll
          for (int j = 0; j < 8; ++j) xs[j] = sigmoidf_(xs[j]);
        }
        *(u32x4*)(lds + L2_LORA + tl * 528 + (c0 - 1536) * 2) = pack8(xs);
      }
    }
  }
  __syncthreads();
  const int w = wave, cb = 64 * w;
  {
    int r = (tidx() & 31);
    f32x16 acc[2];
    mm32<2, 4>(lds + L2_LORA, 528, (const bf16_t*)(ws + O_WW2) + (size_t)cb * 64, 64, lane, acc);
    const float w00 = p.in[8][cb + r], w01 = p.in[8][cb + 32 + r];
    stage_store16<2>(lds + L2A_STG + w * (32 * 144), lane, (bf16_t*)SW + (size_t)t0 * 512 + cb, 512, [&](int nt, int i) {
      const float z = (nt ? w01 : w00) + acc[nt][i];
      const float sp = fmaxf(-z, 0.f) + __logf(1.f + __expf(-fabsf(z)));
      const float dec = __expf(-__expf(-sp - 0.5f));
      return __builtin_bit_cast(unsigned short, (_Float16)dec);
    });
  }
  __syncthreads();
  {
    int r = (tidx() & 31);
    f32x16 acc[2];
    mm32<2, 4>(lds + L2_LORA + 128, 528, (const bf16_t*)(ws + O_WA2) + (size_t)cb * 64, 64, lane, acc);
    float kkv[2][16];
#pragma unroll
    for (int nt = 0; nt < 2; ++nt) {
      const int c = cb + nt * 32 + r;
      const float a0 = p.in[10][c], kkc = p.in[13][c];
#pragma unroll
      for (int i = 0; i < 16; ++i) {
        acc[nt][i] = sigmoidf_(a0 + acc[nt][i]);
        kkv[nt][i] = bf2f(*(const bf16_t*)(lds + L2_K + crow(i, h) * 1040 + c * 2)) * kkc;
      }
    }
#pragma unroll
    for (int i = 0; i < 16; ++i) {
      const float nsq = sum32(kkv[0][i] * kkv[0][i] + kkv[1][i] * kkv[1][i]);
      const float inv = 1.f / fmaxf(sqrtf(nsq), 1e-12f);
      kkv[0][i] *= inv; kkv[1][i] *= inv;
      __builtin_amdgcn_sched_barrier(0);
    }
    const int c0 = cb + r, c1 = cb + 32 + r;
    const float ka0 = p.in[14][c0], ka1 = p.in[14][c1], rk0 = p.in[15][c0], rk1 = p.in[15][c1];
    unsigned char* stg = lds + L2A_STG + w * (32 * 144);
    stage_store16<2>(stg, lane, SA + (size_t)t0 * 512 + cb, 512, [&](int nt, int i) { return f2bf(-kkv[nt][i]); });
    stage_store16<2>(stg, lane, SB + (size_t)t0 * 512 + cb, 512, [&](int nt, int i) { return f2bf(kkv[nt][i] * acc[nt][i]); });
#pragma unroll
    for (int i = 0; i < 16; ++i) {
      const int tl = crow(i, h);
      const float kr0 = bf2f(*(const bf16_t*)(lds + L2_K + tl * 1040 + c0 * 2)), kr1 = bf2f(*(const bf16_t*)(lds + L2_K + tl * 1040 + c1 * 2));
      const float kh0 = kr0 * (1.f + (acc[0][i] - 1.f) * ka0), kh1 = kr1 * (1.f + (acc[1][i] - 1.f) * ka1);
      kkv[0][i] = kh0; kkv[1][i] = kh1;
      const float rr0 = bf2f(*(const bf16_t*)(lds + L2_R + tl * 1040 + c0 * 2)), rr1 = bf2f(*(const bf16_t*)(lds + L2_R + tl * 1040 + c1 * 2));
      const float sb = sum32(rr0 * kh0 * rk0 + rr1 * kh1 * rk1);
      if (r == 0) RK[(unsigned)(t0 + tl) * 8u + w] = sb;
    }
    stage_store16<2>(stg, lane, SK + (size_t)t0 * 512 + cb, 512, [&](int nt, int i) { return f2bf(kkv[nt][i]); });
  }
  __syncthreads();
  {
    int r = (tidx() & 31);
    f32x16 acc[2];
    mm32<2, 8>(lds + L2_LORA + 256, 528, (const bf16_t*)(ws + O_WG2) + (size_t)cb * 128, 128, lane, acc);
    stage_store16<2>(lds + L2A_STG + w * (32 * 144), lane, G + (size_t)t0 * 512 + cb, 512, [&](int nt, int i) { return f2bf(acc[nt][i]); });
  }
  __syncthreads();
}

DI void p2_token_tile_b(const Params& p, unsigned char* lds, int tile) {
  const int tid = tidx(), wave = __builtin_amdgcn_readfirstlane(tid >> 6), lane = tid & 63, r = lane & 31, h = lane >> 5;
  const int t0 = tile * 32;
  unsigned char* ws = p.ws;
  const bf16_t* PAB = (const bf16_t*)(ws + O_PAB);
  bf16_t* SR = (bf16_t*)(ws + O_SIN);
  bf16_t* SK = SR + (size_t)NT * 512; bf16_t* SV = SK + (size_t)NT * 512; bf16_t* SA = SV + (size_t)NT * 512; bf16_t* SB = SA + (size_t)NT * 512;
  _Float16* SW = (_Float16*)(SB + (size_t)NT * 512);
  bf16_t* G = (bf16_t*)(ws + O_G);
  float* RK = (float*)(ws + O_RK);
  const float* rope = (const float*)(ws + O_ROPE);
  {
    u32x2 vq[4]; unsigned vc[4]; float k1[4], k2[4], rc[4], rs_[4];
#pragma unroll
    for (int q = 0; q < 4; ++q) {
      const int t = t0 + wave * 4 + q;
      const bf16_t* pb = PAB + (size_t)t * PABC + ACOLS;
      vq[q] = *(const u32x2*)(pb + 4 * lane);
      vc[q] = *(const unsigned*)(pb + 256 + 2 * lane);
      k1[q] = bf2f(pb[384 + (lane & 15)]); k2[q] = bf2f(pb[400 + (lane & 15)]);
      rc[q] = rope[t * 32 + (lane & 15)]; rs_[q] = rope[t * 32 + 16 + (lane & 15)];
    }
    const f32x4 gq = *(const f32x4*)(p.in[19] + 4 * lane);
    const f32x2 gkv = *(const f32x2*)(p.in[21] + 2 * lane);
#pragma unroll
    for (int q = 0; q < 4; ++q) {
      const int tl = wave * 4 + q, t = t0 + tl;
      {
        const u32x2 v = vq[q];
        float x[4] = {__uint_as_float(v[0] << 16), __uint_as_float(v[0] & 0xffff0000u), __uint_as_float(v[1] << 16), __uint_as_float(v[1] & 0xffff0000u)};
        const float ss = wave_sum(x[0] * x[0] + x[1] * x[1] + x[2] * x[2] + x[3] * x[3]);
        const float rs = rsqrtf(ss * (1.f / 256.f) + 1e-6f);
        u32x2 o; o[0] = pk2(x[0] * rs * gq[0], x[1] * rs * gq[1]); o[1] = pk2(x[2] * rs * gq[2], x[3] * rs * gq[3]);
        *(u32x2*)(lds + L2_CQ + tl * 528 + lane * 8) = o;
      }
      {
        const unsigned v = vc[q];
        const float x0 = __uint_as_float(v << 16), x1 = __uint_as_float(v & 0xffff0000u);
        const float ss = wave_sum(x0 * x0 + x1 * x1);
        const float rs = rsqrtf(ss * (1.f / 128.f) + 1e-6f);
        const float o0 = x0 * rs * gkv[0], o1 = x1 * rs * gkv[1];
        float* dst = (t < NP) ? p.out + F_CKVP + (size_t)t * 128 : p.out + F_CKVS + (size_t)(t - NP) * 128;
        f32x2 of = {o0, o1};
        *(f32x2*)(dst + 2 * lane) = of;
        *(unsigned*)(lds + L2_CKV + tl * 272 + lane * 4) = pk2(o0, o1);
      }
      if (lane < 16) {
        const float o1 = k1[q] * rc[q] - k2[q] * rs_[q], o2 = k1[q] * rs_[q] + k2[q] * rc[q];
        float* dst = (t < NP) ? p.out + F_KPEP + (size_t)t * 32 : p.out + F_KPES + (size_t)(t - NP) * 32;
        dst[lane] = o1; dst[16 + lane] = o2;
        bf16_t* kp = (bf16_t*)(ws + O_KPEB) + (size_t)slot_of_token(t) * 32;
        kp[lane] = f2bf(o1); kp[16 + lane] = f2bf(o2);
      }
    }
  }
  __syncthreads();
  const int w = wave, cb = 64 * w;
  {
    int r = (tidx() & 31);
    f32x16 acc[3];
    mm32<3, 16>(lds + L2_CQ, 528, (const bf16_t*)(ws + O_WUQ) + (size_t)(96 * w) * 256, 256, lane, acc);
    bf16_t* Q = (bf16_t*)((unsigned char*)p.out + OO_Q);
    const int j = r & 15;
#pragma unroll
    for (int i = 0; i < 16; ++i) {
      const int t = t0 + crow(i, h);
      const float own = acc[2][i], oth = __shfl_xor(own, 16);
      const float c = rope[t * 32 + j], sn = rope[t * 32 + 16 + j];
      acc[2][i] = (r < 16) ? own * c - oth * sn : oth * sn + own * c;
    }
    stage_store16<3>(lds + L2B_STG + w * (32 * 208), lane, Q + (size_t)t0 * 768 + 96 * w, 768, [&](int nt, int i) { return f2bf(acc[nt][i] * QSCALE); });
  }
  __syncthreads();
  kv_expand(p, lds, w, lane, slot_of_token(t0));
  __syncthreads();
}

DI void p2_cache_tile(const Params& p, unsigned char* lds, int ctile) {
  const int tid = tidx(), wave = __builtin_amdgcn_readfirstlane(tid >> 6), lane = tid & 63;
  const int b = ctile >> 5, j0 = (ctile & 31) * 32;
  {
    const int row = tid >> 4, c = (tid & 15) * 8;
    const float* src = p.in[2] + ((size_t)(b * PAST + j0 + row)) * 128 + c;
    f32x4 a = *(const f32x4*)src, d = *(const f32x4*)(src + 4);
    float f[8] = {a[0], a[1], a[2], a[3], d[0], d[1], d[2], d[3]};
    *(u32x4*)(lds + L2_CKV + row * 272 + c * 2) = pack8(f);
  }
  __syncthreads();
  kv_expand(p, lds, wave, lane, NP + b * SKV + j0);
  __syncthreads();
}

DI void phase2(const Params& p, unsigned char* lds) {
  constexpr int NTT = NT / 32, NCT = DB * PAST / 32;
  {
    bf16_t* vT = (bf16_t*)((unsigned char*)p.out + OO_VT);
    for (int id = blockIdx.x * NTHREADS + tidx(); id < 8 * 64 * 64; id += gridDim.x * NTHREADS) vT[(size_t)(id >> 6) * NKVP + NKV + (id & 63)] = 0;
  }
  unsigned* ctr2 = (unsigned*)(p.ws + O_CTR) + 16;
  volatile int* s_itemp = (volatile int*)(lds + LDS_CTRL);
  for (;;) {
    if (tidx() == 0) *s_itemp = (int)atomicAdd(ctr2, 1u);
    __syncthreads();
    const int item = *s_itemp;
    __syncthreads();
    if (item >= 2 * NTT + NCT) break;
    if (item < NTT) p2_token_tile_b(p, lds, item);
    else if (item < 2 * NTT) p2_token_tile_a(p, lds, item - NTT);
    else p2_cache_tile(p, lds, item - 2 * NTT);
  }
}

constexpr int AT_KSTRIDE = 208, AT_VSTRIDE = 136, AT_KBYTES = 64 * AT_KSTRIDE, AT_STAGE = AT_KBYTES + 64 * AT_VSTRIDE;

DI void attn_item(const Params& p, unsigned char* lds, int hd, int qtok0, int nact, int slot0, int ntiles, int nvalid, bool causal) {
  const int tid = tidx(), wave = __builtin_amdgcn_readfirstlane(tid >> 6), lane = tid & 63, r = lane & 31, h = lane >> 5;
  const bf16_t* Q = (const bf16_t*)((const unsigned char*)p.out + OO_Q);
  const bf16_t* knb = (const bf16_t*)(p.ws + O_KNB) + (size_t)hd * NKVP * 64;
  const bf16_t* kpeb = (const bf16_t*)(p.ws + O_KPEB);
  const bf16_t* vT = (const bf16_t*)((const unsigned char*)p.out + OO_VT) + (size_t)hd * 64 * NKVP;
  bf16_t* YB = (bf16_t*)(p.ws + O_YB);
  const bool active = wave < nact;
  const int qtok = qtok0 + 32 * wave;
  const int wlim = !active ? 0 : (causal ? (qtok >> 6) + 1 : ntiles);
  bf16x8 qf[6];
  if (active) {
#pragma unroll
    for (int ks = 0; ks < 6; ++ks) qf[ks] = *(const bf16x8*)(Q + (size_t)(qtok + r) * 768 + 96 * hd + ks * 16 + h * 8);
  } else {
#pragma unroll
    for (int ks = 0; ks < 6; ++ks) qf[ks] = (bf16x8){0, 0, 0, 0, 0, 0, 0, 0};
  }
  f32x16 o0, o1;
#pragma unroll
  for (int i = 0; i < 16; ++i) { o0[i] = 0.f; o1[i] = 0.f; }
  float mrun = 0.f, lsum = 0.f;
  const int k_key = tid >> 3, k_ch = tid & 7;
  const int pe_key = (tid & 255) >> 2, pe_ch = tid & 3;
  const int v_dim = tid >> 3, v_ch = tid & 7;
  u32x4 rk, rpe, rv;
  auto gload = [&](int kt) {
    const int s = slot0 + kt * 64;
    rk = *(const u32x4*)(knb + (size_t)(s + k_key) * 64 + k_ch * 8);
    if (tid < 256) rpe = *(const u32x4*)(kpeb + (size_t)(s + pe_key) * 32 + pe_ch * 8);
    rv = *(const u32x4*)(vT + (size_t)v_dim * NKVP + s + v_ch * 8);
  };
  auto lstore = [&](int buf) {
    unsigned char* b = lds + buf * AT_STAGE;
    *(u32x4*)(b + k_key * AT_KSTRIDE + k_ch * 16) = rk;
    if (tid < 256) *(u32x4*)(b + pe_key * AT_KSTRIDE + 128 + pe_ch * 16) = rpe;
    u32x2 lo = {rv[0], rv[1]}, hi = {rv[2], rv[3]};
    *(u32x2*)(b + AT_KBYTES + v_dim * AT_VSTRIDE + v_ch * 16) = lo;
    *(u32x2*)(b + AT_KBYTES + v_dim * AT_VSTRIDE + v_ch * 16 + 8) = hi;
  };
  gload(0); lstore(0);
  __syncthreads();
  for (int kt = 0; kt < ntiles; ++kt) {
    const bool more = kt + 1 < ntiles;
    if (more) gload(kt + 1);
    if (kt < wlim) {
      const unsigned char* kb = lds + (kt & 1) * AT_STAGE;
      const unsigned char* vb = kb + AT_KBYTES;
      f32x16 s0, s1;
      const float nm = -mrun;
#pragma unroll
      for (int i = 0; i < 16; ++i) { s0[i] = nm; s1[i] = nm; }
#pragma unroll
      for (int ks = 0; ks < 6; ++ks) {
        const bf16x8 a0 = *(const bf16x8*)(kb + r * AT_KSTRIDE + ks * 32 + h * 16);
        const bf16x8 a1 = *(const bf16x8*)(kb + (32 + r) * AT_KSTRIDE + ks * 32 + h * 16);
        s0 = MFMA32(a0, qf[ks], s0);
        s1 = MFMA32(a1, qf[ks], s1);
      }
      if (kt * 64 + 64 > nvalid) {
#pragma unroll
        for (int i = 0; i < 16; ++i) {
          const int key = kt * 64 + crow(i, h);
          if (key >= nvalid) s0[i] = -1e30f;
          if (key + 32 >= nvalid) s1[i] = -1e30f;
        }
      }
      float mx = s0[0];
#pragma unroll
      for (int i = 1; i < 16; ++i) mx = fmaxf(mx, s0[i]);
#pragma unroll
      for (int i = 0; i < 16; ++i) mx = fmaxf(mx, s1[i]);
      mx = fmaxf(mx, __shfl_xor(mx, 32));
      const bool far = fabsf(mx) > 20.f && mx > -1e29f;
      if (__builtin_amdgcn_ballot_w64(far) != 0ull) {
        const float delta = far ? mx : 0.f;
        const float alpha = __builtin_amdgcn_exp2f(-delta);
        mrun += delta; lsum *= alpha;
#pragma unroll
        for (int i = 0; i < 16; ++i) { o0[i] *= alpha; o1[i] *= alpha; s0[i] -= delta; s1[i] -= delta; }
      }
      float rs = 0.f;
#pragma unroll
      for (int i = 0; i < 16; ++i) { s0[i] = __builtin_amdgcn_exp2f(s0[i]); rs += s0[i]; }
#pragma unroll
      for (int i = 0; i < 16; ++i) { s1[i] = __builtin_amdgcn_exp2f(s1[i]); rs += s1[i]; }
      lsum += rs;
#pragma unroll
      for (int mt = 0; mt < 2; ++mt)
#pragma unroll
        for (int s = 0; s < 2; ++s) {
          const f32x16& sv = mt ? s1 : s0;
          u32x4 pw;
          pw[0] = pk2(sv[8 * s], sv[8 * s + 1]); pw[1] = pk2(sv[8 * s + 2], sv[8 * s + 3]);
          pw[2] = pk2(sv[8 * s + 4], sv[8 * s + 5]); pw[3] = pk2(sv[8 * s + 6], sv[8 * s + 7]);
          const bf16x8 pb = __builtin_bit_cast(bf16x8, pw);
          const int kbase = mt * 32 + 16 * s + 4 * h;
          {
            const s16x4 lo = *(const s16x4*)(vb + r * AT_VSTRIDE + kbase * 2);
            const s16x4 hi = *(const s16x4*)(vb + r * AT_VSTRIDE + (kbase + 8) * 2);
            const bf16x8 av = __builtin_shufflevector(lo, hi, 0, 1, 2, 3, 4, 5, 6, 7);
            o0 = MFMA32(av, pb, o0);
          }
          {
            const s16x4 lo = *(const s16x4*)(vb + (32 + r) * AT_VSTRIDE + kbase * 2);
            const s16x4 hi = *(const s16x4*)(vb + (32 + r) * AT_VSTRIDE + (kbase + 8) * 2);
            const bf16x8 av = __builtin_shufflevector(lo, hi, 0, 1, 2, 3, 4, 5, 6, 7);
            o1 = MFMA32(av, pb, o1);
          }
        }
    }
    if (more) lstore((kt + 1) & 1);
    __syncthreads();
  }
  if (active) {
    const float lt = lsum + __shfl_xor(lsum, 32);
    const float inv = 1.f / lt;
    bf16_t* dst = YB + (size_t)(qtok + r) * 512 + hd * 64;
#pragma unroll
    for (int g = 0; g < 4; ++g) {
      u32x2 a, b;
      a[0] = pk2(o0[4 * g] * inv, o0[4 * g + 1] * inv); a[1] = pk2(o0[4 * g + 2] * inv, o0[4 * g + 3] * inv);
      b[0] = pk2(o1[4 * g] * inv, o1[4 * g + 1] * inv); b[1] = pk2(o1[4 * g + 2] * inv, o1[4 * g + 3] * inv);
      *(u32x2*)(dst + 8 * g + 4 * h) = a;
      *(u32x2*)(dst + 32 + 8 * g + 4 * h) = b;
    }
  }
}

constexpr int SC_TOK = 32, SC_ARR = SC_TOK * 64 * 4, SC_STAGE = 6 * SC_ARR;
static_assert(2 * SC_STAGE <= LDS_CTRL, "lds scan");
DI float dpp_sum8(float x) {
  x += __builtin_bit_cast(float, __builtin_amdgcn_update_dpp(0, __builtin_bit_cast(int, x), 0xB1, 0xF, 0xF, true));
  x += __builtin_bit_cast(float, __builtin_amdgcn_update_dpp(0, __builtin_bit_cast(int, x), 0x4E, 0xF, 0xF, true));
  x += __builtin_bit_cast(float, __builtin_amdgcn_update_dpp(0, __builtin_bit_cast(int, x), 0x141, 0xF, 0xF, true));
  return x;
}
DI float hsum4(f32x4 x) { return (x[0] + x[2]) + (x[1] + x[3]); }
template <bool DUAL>
DI void scan_job(const Params& p, unsigned char* lds, int head, int tok0, int nsteps, const float* init  ,
                 bf16_t* Y  , float* state_out  , bf16_t* Y2 = nullptr, float* state2 = nullptr) {
  const int tid = tidx(), wave = __builtin_amdgcn_readfirstlane(tid >> 6), lane = tid & 63;
  const bf16_t* SR = (const bf16_t*)(p.ws + O_SIN);
  const bf16_t* SK = SR + (size_t)NT * 512; const bf16_t* SV = SK + (size_t)NT * 512; const bf16_t* SA = SV + (size_t)NT * 512; const bf16_t* SB = SA + (size_t)NT * 512;
  const _Float16* SW = (const _Float16*)(SB + (size_t)NT * 512);
  u32x4 rg[3];
  auto gload = [&](int c) {
    const int tb = tok0 + c * SC_TOK;
#pragma unroll
    for (int i = 0; i < 3; ++i) {
      const int L = tid + NTHREADS * i, arr = L >> 8, tok = (L & 255) >> 3, ch = L & 7;
      const bf16_t* base = arr == 0 ? SA : arr == 1 ? SB : arr == 2 ? (const bf16_t*)SW : arr == 3 ? SK : arr == 4 ? SR : SV;
      rg[i] = *(const u32x4*)(base + (size_t)(tb + tok) * 512 + head * 64 + ch * 8);
    }
  };
  auto lstore = [&](int buf) {
    unsigned char* b = lds + buf * SC_STAGE;
#pragma unroll
    for (int i = 0; i < 3; ++i) {
      const int L = tid + NTHREADS * i, arr = L >> 8, tok = (L & 255) >> 3, ch = L & 7;
      float f[8];
      if (arr == 2) {
#pragma unroll
        for (int j = 0; j < 4; ++j) {
          const unsigned u = rg[i][j];
          f[2 * j] = (float)__builtin_bit_cast(_Float16, (unsigned short)(u & 0xffffu));
          f[2 * j + 1] = (float)__builtin_bit_cast(_Float16, (unsigned short)(u >> 16));
        }
      } else unpack8(rg[i], f);
      float* d = (float*)(b + arr * SC_ARR + tok * 256 + ch * 32);
      *(f32x4*)d = (f32x4){f[0], f[1], f[2], f[3]};
      *(f32x4*)(d + 4) = (f32x4){f[4], f[5], f[6], f[7]};
    }
  };
  const int rl = lane >> 3, c = lane & 7;
  const int vrow = 8 * wave + rl;
  f32x4 sl = {0.f, 0.f, 0.f, 0.f}, sh = {0.f, 0.f, 0.f, 0.f};
  if (init) { sl = *(const f32x4*)(init + vrow * 64 + 8 * c); sh = *(const f32x4*)(init + vrow * 64 + 8 * c + 4); }
  f32x4 tl, th;
#pragma unroll
  for (int j = 0; j < 4; ++j) { tl[j] = (8 * c + j == vrow) ? 1.f : 0.f; th[j] = (8 * c + 4 + j == vrow) ? 1.f : 0.f; }
  gload(0); lstore(0);
  __syncthreads();
  const int nch = nsteps / SC_TOK;
  for (int ci = 0; ci < nch; ++ci) {
    const bool more = ci + 1 < nch;
    if (more) gload(ci + 1);
    {
      const unsigned char* b = lds + (ci & 1) * SC_STAGE + c * 32;
      const unsigned char* bv = lds + (ci & 1) * SC_STAGE + 5 * SC_ARR + vrow * 4;
      bf16_t* yp = Y + (size_t)(tok0 + ci * SC_TOK + c) * 512 + head * 64 + vrow;
      bf16_t* yp2 = DUAL ? Y2 + (size_t)(tok0 + ci * SC_TOK + c) * 512 + head * 64 + vrow : nullptr;
      f32x4 AL[2], AH[2], BL[2], BH[2], WL[2], WH[2], KL[2], KH[2], RL[2], RH[2]; float V1[2];
#define SC_LOAD(slot, t)                                                                                                        \
      { AL[slot] = *(const f32x4*)(b + 0 * SC_ARR + (t) * 256); AH[slot] = *(const f32x4*)(b + 0 * SC_ARR + (t) * 256 + 16);    \
        BL[slot] = *(const f32x4*)(b + 1 * SC_ARR + (t) * 256); BH[slot] = *(const f32x4*)(b + 1 * SC_ARR + (t) * 256 + 16);    \
        WL[slot] = *(const f32x4*)(b + 2 * SC_ARR + (t) * 256); WH[slot] = *(const f32x4*)(b + 2 * SC_ARR + (t) * 256 + 16);    \
        KL[slot] = *(const f32x4*)(b + 3 * SC_ARR + (t) * 256); KH[slot] = *(const f32x4*)(b + 3 * SC_ARR + (t) * 256 + 16);    \
        RL[slot] = *(const f32x4*)(b + 4 * SC_ARR + (t) * 256); RH[slot] = *(const f32x4*)(b + 4 * SC_ARR + (t) * 256 + 16);    \
        V1[slot] = *(const float*)(bv + (t) * 256); }
      SC_LOAD(0, 0)
      float ysel = 0.f, ysel2 = 0.f;
#pragma unroll
      for (int t = 0; t < SC_TOK; ++t) {
        if (t + 1 < SC_TOK) SC_LOAD((t + 1) & 1, t + 1)
        const f32x4 al = AL[t & 1], ah = AH[t & 1], bl = BL[t & 1], bh = BH[t & 1], wl = WL[t & 1], wh = WH[t & 1], kl = KL[t & 1], kh = KH[t & 1], rlo = RL[t & 1], rhi = RH[t & 1];
        const float vv = V1[t & 1];
        {
          const float sa = dpp_sum8(hsum4(sl * al + sh * ah));
          sl = sl * wl + (sa * bl + vv * kl);
          sh = sh * wh + (sa * bh + vv * kh);
          const float y = dpp_sum8(hsum4(sl * rlo + sh * rhi));
          ysel = (c == (t & 7)) ? y : ysel;
          if ((t & 7) == 7) yp[(size_t)(t - 7) * 512] = f2bf(ysel);
        }
        if (DUAL) {
          const float sa = dpp_sum8(hsum4(tl * al + th * ah));
          tl = tl * wl + sa * bl;
          th = th * wh + sa * bh;
          const float y = dpp_sum8(hsum4(tl * rlo + th * rhi));
          ysel2 = (c == (t & 7)) ? y : ysel2;
          if ((t & 7) == 7) yp2[(size_t)(t - 7) * 512] = f2bf(ysel2);
        }
      }
#undef SC_LOAD
    }
    if (more) lstore((ci + 1) & 1);
    __syncthreads();
  }
  *(f32x4*)(state_out + vrow * 64 + 8 * c) = sl;
  *(f32x4*)(state_out + vrow * 64 + 8 * c + 4) = sh;
  if (DUAL) { *(f32x4*)(state2 + vrow * 64 + 8 * c) = tl; *(f32x4*)(state2 + vrow * 64 + 8 * c + 4) = th; }
}

DI void chain_item(const Params& p, unsigned char* lds, int hd, int q) {
  const int tid = tidx();
  const float* Gb = (const float*)((unsigned char*)p.out + OO_GH);
  const float* Hb = Gb + (size_t)8 * SCC * 4096;
  bf16_t* SST = (bf16_t*)((unsigned char*)p.out + OO_SST);
  float* S = (float*)lds;
  float* Gs = S + 16 * 65 + 3;
  Gs = (float*)lds + 1044;
  const int vl = tid >> 5, v = 16 * q + vl, k0 = (tid & 31) * 2;
  f32x2 cur = *(const f32x2*)(Hb + ((size_t)hd * SCC) * 4096 + v * 64 + k0);
  for (int c = 1; c < SCC; ++c) {
    const float* Gc = Gb + ((size_t)hd * SCC + c) * 4096;
    const f32x4 ga = *(const f32x4*)(Gc + tid * 8), gb2 = *(const f32x4*)(Gc + tid * 8 + 4);
    f32x2 o = *(const f32x2*)(Hb + ((size_t)hd * SCC + c) * 4096 + v * 64 + k0);
    __syncthreads();
    S[vl * 65 + k0] = cur[0]; S[vl * 65 + k0 + 1] = cur[1];
    *(f32x4*)(Gs + tid * 8) = ga; *(f32x4*)(Gs + tid * 8 + 4) = gb2;
    *(unsigned*)(SST + ((size_t)c * 8 + hd) * 4096 + v * 64 + k0) = pk2(cur[0], cur[1]);
    __syncthreads();
#pragma unroll 8
    for (int i = 0; i < 64; ++i) {
      const float sv = S[vl * 65 + i];
      const f32x2 g = *(const f32x2*)(Gs + i * 64 + k0);
      o[0] += sv * g[0]; o[1] += sv * g[1];
    }
    cur = o;
  }
  *(f32x2*)(p.out + F_WKVP + (size_t)hd * 4096 + v * 64 + k0) = cur;
}

constexpr int Q_PSCAN = 8 * SCC, Q_PATT = 512, Q_CHAIN = 32, Q_SATT = 128, Q_SSCAN = 128, Q_TOTAL = Q_PSCAN + Q_PATT + Q_CHAIN + Q_SATT + Q_SSCAN;
DI void phase3(const Params& p, unsigned char* lds) {
  volatile int* s_itemp = (volatile int*)(lds + LDS_CTRL);
  unsigned* ctr = (unsigned*)(p.ws + O_CTR);
  unsigned* sdone = ctr + 32;
  float* Gb = (float*)((unsigned char*)p.out + OO_GH);
  float* Hb = Gb + (size_t)8 * SCC * 4096;
  bf16_t* Y = (bf16_t*)(p.ws + O_Y);
  bf16_t* E = (bf16_t*)(p.ws + O_E);
  for (;;) {
    if (tidx() == 0) *s_itemp = (int)atomicAdd(ctr, 1u);
    __syncthreads();
    const int item = *s_itemp;
    __syncthreads();
    if (item >= Q_TOTAL) break;
    if (item < Q_PSCAN) {
      const int hd = item / SCC, c = item % SCC;
      if (c == 0) scan_job<false>(p, lds, hd, 0, SCL, nullptr, Y, Hb + ((size_t)hd * SCC) * 4096);
      else scan_job<true>(p, lds, hd, c * SCL, SCL, nullptr, Y, Hb + ((size_t)hd * SCC + c) * 4096, E, Gb + ((size_t)hd * SCC + c) * 4096);
      asm volatile("s_waitcnt vmcnt(0)" ::: "memory");
      __syncthreads();
      if (threadIdx.x == 0) {
        __builtin_amdgcn_fence(__ATOMIC_RELEASE, "agent");
        asm volatile("s_waitcnt vmcnt(0)" ::: "memory");
        __hip_atomic_fetch_add(sdone, 1u, __ATOMIC_RELAXED, __HIP_MEMORY_SCOPE_AGENT);
      }
    } else if (item < Q_PSCAN + Q_PATT) {
      const int k = item - Q_PSCAN, qb = 63 - (k >> 3), hd = k & 7;
      attn_item(p, lds, hd, qb * 256, 8, 0, qb * 4 + 4, (qb * 4 + 4) * 64, true);
    } else if (item < Q_PSCAN + Q_PATT + Q_CHAIN) {
      const int k = item - Q_PSCAN - Q_PATT;
      if (threadIdx.x == 0) {
        while (__hip_atomic_load(sdone, __ATOMIC_RELAXED, __HIP_MEMORY_SCOPE_AGENT) < (unsigned)Q_PSCAN) __builtin_amdgcn_s_sleep(4);
        __builtin_amdgcn_fence(__ATOMIC_ACQUIRE, "agent");
        asm volatile("s_waitcnt vmcnt(0)" ::: "memory");
      }
      __syncthreads();
      chain_item(p, lds, k & 7, k >> 3);
    } else if (item < Q_PSCAN + Q_PATT + Q_CHAIN + Q_SATT) {
      const int k = item - Q_PSCAN - Q_PATT - Q_CHAIN, b = k >> 3, hd = k & 7;
      attn_item(p, lds, hd, NP + b * 32, 1, NP + b * SKV, 17, SKV, false);
    } else {
      const int k = item - Q_PSCAN - Q_PATT - Q_CHAIN - Q_SATT, b = k >> 3, hd = k & 7;
      scan_job<false>(p, lds, hd, NP + b * 32, 32, p.in[4] + ((size_t)b * 8 + hd) * 4096, Y, p.out + F_WKVS + ((size_t)b * 8 + hd) * 4096);
    }
  }
}

DI void phase4a(const Params& p) {
  const int tid = tidx(), lane = tid & 63, r = lane & 31, hh = lane >> 5;
  const int gw = (blockIdx.x * NTHREADS + tid) >> 6, ngw = (gridDim.x * NTHREADS) >> 6;
  const bf16_t* Y = (const bf16_t*)(p.ws + O_Y);
  const bf16_t* E = (const bf16_t*)(p.ws + O_E);
  const bf16_t* SST = (const bf16_t*)((unsigned char*)p.out + OO_SST);
  const bf16_t* SV = (const bf16_t*)(p.ws + O_SIN) + 2 * (size_t)NT * 512;
  const bf16_t* G = (const bf16_t*)(p.ws + O_G);
  const float* RK = (const float*)(p.ws + O_RK);
  bf16_t* YA = (bf16_t*)(p.ws + O_YA);
  for (int task = gw; task < (NT / 32) * 8; task += ngw) {
    const int tile = task >> 3, hd = task & 7, t0 = tile * 32, t = t0 + r;
    f32x16 acc[2];
#pragma unroll
    for (int i = 0; i < 16; ++i) { acc[0][i] = 0.f; acc[1][i] = 0.f; }
    const int c = t0 < NP ? t0 / SCL : 0;
    if (c >= 1) {
      const bf16_t* sst = SST + ((size_t)c * 8 + hd) * 4096;
#pragma unroll
      for (int ks = 0; ks < 4; ++ks) {
        const bf16x8 bv = *(const bf16x8*)(E + (size_t)t * 512 + hd * 64 + ks * 16 + hh * 8);
#pragma unroll
        for (int mt = 0; mt < 2; ++mt) {
          const bf16x8 av = *(const bf16x8*)(sst + (mt * 32 + r) * 64 + ks * 16 + hh * 8);
          acc[mt] = MFMA32(av, bv, acc[mt]);
        }
      }
    }
    float sum = 0.f;
#pragma unroll
    for (int mt = 0; mt < 2; ++mt)
#pragma unroll
      for (int g = 0; g < 4; ++g) {
        const u32x2 yv = *(const u32x2*)(Y + (size_t)t * 512 + hd * 64 + mt * 32 + 8 * g + 4 * hh);
        acc[mt][4 * g] += __uint_as_float(yv[0] << 16); acc[mt][4 * g + 1] += __uint_as_float(yv[0] & 0xffff0000u);
        acc[mt][4 * g + 2] += __uint_as_float(yv[1] << 16); acc[mt][4 * g + 3] += __uint_as_float(yv[1] & 0xffff0000u);
        sum += (acc[mt][4 * g] + acc[mt][4 * g + 1]) + (acc[mt][4 * g + 2] + acc[mt][4 * g + 3]);
      }
    sum += __shfl_xor(sum, 32);
    const float mean = sum * (1.f / 64.f);
    float sq = 0.f;
#pragma unroll
    for (int mt = 0; mt < 2; ++mt)
#pragma unroll
      for (int i = 0; i < 16; ++i) { const float d = acc[mt][i] - mean; sq += d * d; }
    sq += __shfl_xor(sq, 32);
    const float rstd = rsqrtf(sq * (1.f / 64.f) + 64e-5f);
    const float bon = RK[(size_t)t * 8 + hd];
#pragma unroll
    for (int mt = 0; mt < 2; ++mt)
#pragma unroll
      for (int g = 0; g < 4; ++g) {
        const int c0 = hd * 64 + mt * 32 + 8 * g + 4 * hh;
        const size_t o = (size_t)t * 512 + c0;
        const f32x4 lg = *(const f32x4*)(p.in[16] + c0), lb = *(const f32x4*)(p.in[17] + c0);
        const u32x2 vv = *(const u32x2*)(SV + o), gg = *(const u32x2*)(G + o);
        const float vf[4] = {__uint_as_float(vv[0] << 16), __uint_as_float(vv[0] & 0xffff0000u), __uint_as_float(vv[1] << 16), __uint_as_float(vv[1] & 0xffff0000u)};
        const float gf[4] = {__uint_as_float(gg[0] << 16), __uint_as_float(gg[0] & 0xffff0000u), __uint_as_float(gg[1] << 16), __uint_as_float(gg[1] & 0xffff0000u)};
        float ov[4];
#pragma unroll
        for (int j = 0; j < 4; ++j) ov[j] = ((acc[mt][4 * g + j] - mean) * rstd * lg[j] + lb[j] + bon * vf[j]) * gf[j];
        u32x2 w; w[0] = pk2(ov[0], ov[1]); w[1] = pk2(ov[2], ov[3]);
        *(u32x2*)(YA + o) = w;
      }
  }
  conv_x(p, (bf16_t*)((unsigned char*)p.out + OO_XB), blockIdx.x * NTHREADS + tidx(), gridDim.x * NTHREADS);
}

DI bool small_tile_of_block(int& m0, int& n0) {
  const int j = blockIdx.x >> 3;
  if (gridDim.x != 256 || (blockIdx.x & 7) != (j & 7)) return false;
  m0 = NP + (j >> 3) * 128; n0 = (j & 7) * 128; return true;
}
template <int TM>
DI void p4_tile(const Params& p, unsigned char* lds, int m0, int n0) {
  const bf16_t* XB = (const bf16_t*)((unsigned char*)p.out + OO_XB);
  const bf16_t* WIN = (const bf16_t*)(p.ws + O_WIN);
  const bf16_t* YA = (const bf16_t*)(p.ws + O_YA);
  const bf16_t* YB = (const bf16_t*)(p.ws + O_YB);
  bf16_t* M = (bf16_t*)(p.ws + O_M);
  const int tid = tidx(), lane = tid & 63, h = lane >> 5, wn = __builtin_amdgcn_readfirstlane(tid >> 6) >> 2;
  f32x16 accg[TM][2], accv[TM][2];
  gemm_mainloop<TM, 2>(YB, 512, (const bf16_t*)(p.ws + O_WPB), 512, 512, m0, n0, 1024, accv, lds);
  gemm_mainloop<TM, 2>(XB, DM, WIN + (size_t)(PABC + 1024) * DM, DM, DM, m0, n0, 1024, accg, lds);
#pragma unroll
  for (int tn = 0; tn < 2; ++tn)
#pragma unroll
    for (int g = 0; g < 4; ++g) {
      const f32x4 bg = *(const f32x4*)(p.in[24] + 1024 + n0 + wn * 64 + tn * 32 + 8 * g + 4 * h);
#pragma unroll
      for (int tm = 0; tm < TM; ++tm)
#pragma unroll
        for (int j = 0; j < 4; ++j) accv[tm][tn][4 * g + j] *= sigmoidf_(accg[tm][tn][4 * g + j] + bg[j]);
      __builtin_amdgcn_sched_barrier(0);
    }
  gemm_mainloop<TM, 2>(XB, DM, WIN + (size_t)PABC * DM, DM, DM, m0, n0, 1024, accg, lds);
#pragma unroll
  for (int tn = 0; tn < 2; ++tn)
#pragma unroll
    for (int g = 0; g < 4; ++g) {
      const f32x4 bg = *(const f32x4*)(p.in[24] + n0 + wn * 64 + tn * 32 + 8 * g + 4 * h);
#pragma unroll
      for (int tm = 0; tm < TM; ++tm)
#pragma unroll
        for (int j = 0; j < 4; ++j) {
          const float e = __expf(-(accg[tm][tn][4 * g + j] + bg[j]));
          accv[tm][tn][4 * g + j] *= (1.f + e);
          accg[tm][tn][4 * g + j] = 1.f / (1.f + e);
        }
      __builtin_amdgcn_sched_barrier(0);
    }
  gemm_mainloop<TM, 2, false>(YA, 512, (const bf16_t*)(p.ws + O_WPA), 512, 512, m0, n0, 1024, accv, lds);
  epilogue_bf16<TM, 2, 128>(accv, lds, M, DM, m0, n0, DM, [&](int tm, int tn, int g, int, int) { return acc4(accg[tm][tn], g) * acc4(accv[tm][tn], g); });
}
DI void phase4(const Params& p, unsigned char* lds) {
  if (gridDim.x == 256) {
    TileIter ti; ti.init(NP / 256, 8);
    int tmi, tni;
    while (ti.next(tmi, tni)) p4_tile<2>(p, lds, tmi * 256, tni * 128);
    int m0, n0;
    if (small_tile_of_block(m0, n0)) p4_tile<1>(p, lds, m0, n0);
  } else {
    TileIter ti; ti.init(NT / 128, 8);
    int tmi, tni;
    while (ti.next(tmi, tni)) p4_tile<1>(p, lds, tmi * 128, tni * 128);
  }
}

template <int TM, int TN, int NST>
DI void p5_tile(const Params& p, unsigned char* lds, int m0, int n0) {
  const bf16_t* M = (const bf16_t*)(p.ws + O_M);
  bf16_t* Z = (bf16_t*)(p.ws + O_Z);
  f32x16 acc[TM][TN];
  gemm_mainloop<TM, TN, true, NST>(M, DM, (const bf16_t*)(p.ws + O_WO), DM, DM, m0, n0, 1024, acc, lds);
  epilogue_bf16<TM, TN, 64 * TN>(acc, lds, Z, DM, m0, n0, DM, [&](int tm, int tn, int g, int rowl, int coll) {
    const f32x4 xv = *(const f32x4*)(xrow(p, m0 + rowl) + n0 + coll);
    return xv * DN_ALPHA + acc4(acc[tm][tn], g);
  });
}
DI void phase5(const Params& p, unsigned char* lds) {
  if (gridDim.x == 256) {
    TileIter ti; ti.init(NP / 256, 4);
    int tmi, tni;
    while (ti.next(tmi, tni)) p5_tile<2, 4, 2>(p, lds, tmi * 256, tni * 256);
    int m0, n0;
    if (small_tile_of_block(m0, n0)) p5_tile<1, 2, 3>(p, lds, m0, n0);
  } else {
    TileIter ti; ti.init(NT / 256, 8);
    int tmi, tni;
    while (ti.next(tmi, tni)) p5_tile<2, 2, 3>(p, lds, tmi * 256, tni * 128);
  }
}
template <bool OUT_BF16>
DI void ln_rows(const bf16_t* src, const float* g, const float* b, bf16_t* dst16, float* dst32) {
  const int gw = (blockIdx.x * NTHREADS + tidx()) >> 6, ngw = (gridDim.x * NTHREADS) >> 6, lane = tidx() & 63;
  for (int t = gw; t < NT; t += ngw) {
    const u32x4* xr = (const u32x4*)(src + (size_t)t * DM) + lane;
    float v[16]; float s = 0.f;
#pragma unroll
    for (int j = 0; j < 2; ++j) { unpack8(xr[64 * j], v + 8 * j); }
#pragma unroll
    for (int j = 0; j < 16; ++j) s += v[j];
    const float mean = wave_sum(s) * (1.f / DM);
    float s2 = 0.f;
#pragma unroll
    for (int j = 0; j < 16; ++j) { v[j] -= mean; s2 += v[j] * v[j]; }
    const float rstd = rsqrtf(wave_sum(s2) * (1.f / DM) + 1e-5f);
#pragma unroll
    for (int j = 0; j < 2; ++j) {
      const int c = 8 * lane + 512 * j;
      const f32x4 g0 = *(const f32x4*)(g + c), g1 = *(const f32x4*)(g + c + 4), b0 = *(const f32x4*)(b + c), b1 = *(const f32x4*)(b + c + 4);
      float o[8];
#pragma unroll
      for (int q = 0; q < 4; ++q) { o[q] = v[8 * j + q] * rstd * g0[q] + b0[q]; o[4 + q] = v[8 * j + 4 + q] * rstd * g1[q] + b1[q]; }
      if (OUT_BF16) *(u32x4*)(dst16 + (size_t)t * DM + c) = pack8(o);
      else { *(f32x4*)(dst32 + (size_t)t * DM + c) = (f32x4){o[0], o[1], o[2], o[3]}; *(f32x4*)(dst32 + (size_t)t * DM + c + 4) = (f32x4){o[4], o[5], o[6], o[7]}; }
    }
  }
}

DI void phase6(const Params& p, unsigned char* lds) {
  const bf16_t* H = (const bf16_t*)(p.ws + O_H);
  bf16_t* ACT = (bf16_t*)(p.ws + O_ACT);
  constexpr int NMT = NT / 256, NNT = 5632 / 256;
  TileIter ti; ti.init(NMT, NNT);
  int tmi, tni;
  while (ti.next(tmi, tni)) {
    const int m0 = tmi * 256, n0 = tni * 256;
    f32x16 acc[2][4];
    gemm_mainloop<2, 4, true, 2>(H, DM, (const bf16_t*)(p.ws + O_WGU), DM, DM, m0, n0, 5632, acc, lds);
    epilogue_bf16<2, 4, 128>(acc, lds, ACT, DFF, m0, tni * 128, DFF, [&](int tm, int q, int g, int, int) {
      f32x4 o;
#pragma unroll
      for (int j = 0; j < 4; ++j) { const float gte = acc[tm][2 * q][4 * g + j], up = acc[tm][2 * q + 1][4 * g + j]; o[j] = gte * sigmoidf_(gte) * up; }
      return o;
    });
  }
}
template <int TM, int TN, int NST>
DI void p7_tile(const Params& p, unsigned char* lds, int m0, int n0) {
  const bf16_t* H = (const bf16_t*)(p.ws + O_H);
  const bf16_t* ACT = (const bf16_t*)(p.ws + O_ACT);
  bf16_t* Z2 = (bf16_t*)(p.ws + O_Z2);
  f32x16 acc[TM][TN];
  gemm_mainloop<TM, TN, true, NST>(ACT, DFF, (const bf16_t*)(p.ws + O_WDN), DFF, DFF, m0, n0, 1024, acc, lds);
  epilogue_bf16<TM, TN, 64 * TN>(acc, lds, Z2, DM, m0, n0, DM, [&](int tm, int tn, int g, int rowl, int coll) {
    const u32x2 hv = *(const u32x2*)(H + (size_t)(m0 + rowl) * DM + n0 + coll);
    const f32x4 hf = {__uint_as_float(hv[0] << 16), __uint_as_float(hv[0] & 0xffff0000u), __uint_as_float(hv[1] << 16), __uint_as_float(hv[1] & 0xffff0000u)};
    return hf * DN_ALPHA + acc4(acc[tm][tn], g);
  });
}
DI void phase7(const Params& p, unsigned char* lds) {
  if (gridDim.x == 256) {
    TileIter ti; ti.init(NP / 256, 4);
    int tmi, tni;
    while (ti.next(tmi, tni)) p7_tile<2, 4, 2>(p, lds, tmi * 256, tni * 256);
    int m0, n0;
    if (small_tile_of_block(m0, n0)) p7_tile<1, 2, 3>(p, lds, m0, n0);
  } else {
    TileIter ti; ti.init(NT / 256, 8);
    int tmi, tni;
    while (ti.next(tmi, tni)) p7_tile<2, 2, 3>(p, lds, tmi * 256, tni * 128);
  }
}

DI void run_phase(const Params& p, unsigned char* lds, int ph) {
  switch (ph) {
    case 0: phase0(p, lds); break;
    case 1: phase1(p, lds); break;
    case 2: phase2(p, lds); break;
    case 3: phase3(p, lds); break;
    case 4: phase4a(p); break;
    case 5: phase4(p, lds); break;
    case 6: phase5(p, lds); break;
    case 7: ln_rows<true>((const bf16_t*)(p.ws + O_Z), p.in[26], p.in[27], (bf16_t*)(p.ws + O_H), nullptr); break;
    case 8: phase6(p, lds); break;
    case 9: phase7(p, lds); break;
    case 10: ln_rows<false>((const bf16_t*)(p.ws + O_Z2), p.in[30], p.in[31], nullptr, p.out + F_Y); break;
  }
}
constexpr int NPHASES = 11;

DI unsigned ctl_ld(unsigned* p) { return __hip_atomic_load(p, __ATOMIC_RELAXED, __HIP_MEMORY_SCOPE_AGENT); }
DI unsigned ctl_add(unsigned* p, unsigned v) { return __hip_atomic_fetch_add(p, v, __ATOMIC_RELAXED, __HIP_MEMORY_SCOPE_AGENT); }
DI void xbar(unsigned* ctl, unsigned x, unsigned nloc, unsigned nx, unsigned k) {
  asm volatile("s_waitcnt vmcnt(0)" ::: "memory");
  __syncthreads();
  if (threadIdx.x == 0) {
    const unsigned old = ctl_add(&ctl[(24 + x) * 64], 1u);
    if (old + 1u == k * nloc) {
      __builtin_amdgcn_fence(__ATOMIC_RELEASE, "agent");
      asm volatile("s_waitcnt vmcnt(0)" ::: "memory");
      ctl_add(&ctl[40 * 64], 1u);
    }
    while (ctl_ld(&ctl[40 * 64]) < k * nx) __builtin_amdgcn_s_sleep(1);
    __builtin_amdgcn_fence(__ATOMIC_ACQUIRE, "agent");
    asm volatile("s_waitcnt vmcnt(0)" ::: "memory");
  }
  __syncthreads();
}

__global__ void __launch_bounds__(NTHREADS) mega_kernel(Params p) {
  extern __shared__ __attribute__((aligned(16))) unsigned char lds[];
  volatile unsigned* s_bar = (volatile unsigned*)(lds + LDS_CTRL + 16);
  cg::grid_group grid = cg::this_grid();
  unsigned* ctl = (unsigned*)(p.ws + O_CTR);
  const unsigned x = (unsigned)__builtin_amdgcn_s_getreg((3 << 11) | 20) & 0xFu;
  if (threadIdx.x == 0) ctl_add(&ctl[(8 + x) * 64], 1u);
  run_phase(p, lds, 0); grid.sync();
  if (threadIdx.x == 0) {
    unsigned nx = 0;
    for (int i = 0; i < 16; ++i) nx += ctl_ld(&ctl[(8 + i) * 64]) != 0u ? 1u : 0u;
    s_bar[0] = ctl_ld(&ctl[(8 + x) * 64]); s_bar[1] = nx;
  }
  __syncthreads();
  const unsigned nloc = __builtin_amdgcn_readfirstlane(s_bar[0]), nx = __builtin_amdgcn_readfirstlane(s_bar[1]);
  run_phase(p, lds, 1); xbar(ctl, x, nloc, nx, 1);
  run_phase(p, lds, 2); xbar(ctl, x, nloc, nx, 2);
  run_phase(p, lds, 3); xbar(ctl, x, nloc, nx, 3);
  run_phase(p, lds, 4); xbar(ctl, x, nloc, nx, 4);
  run_phase(p, lds, 5); xbar(ctl, x, nloc, nx, 5);
  run_phase(p, lds, 6); xbar(ctl, x, nloc, nx, 6);
  run_phase(p, lds, 7); xbar(ctl, x, nloc, nx, 7);
  run_phase(p, lds, 8); xbar(ctl, x, nloc, nx, 8);
  run_phase(p, lds, 9); xbar(ctl, x, nloc, nx, 9);
  run_phase(p, lds, 10);
}
template <int PH> __global__ void __launch_bounds__(NTHREADS) phase_kernel(Params p) {
  extern __shared__ __attribute__((aligned(16))) unsigned char lds[];
  run_phase(p, lds, PH);
}
template <int PH> static void launch_phase(const Params& p, int grid, hipStream_t stream) {
  (void)hipFuncSetAttribute((const void*)phase_kernel<PH>, hipFuncAttributeMaxDynamicSharedMemorySize, LDS_BYTES);
  hipLaunchKernelGGL(phase_kernel<PH>, dim3(grid), dim3(NTHREADS), LDS_BYTES, stream, p);
}

extern "C" void kernel_launch(void* const* d_in, const int* in_sizes, int n_in, void* d_out, int out_size, void* d_ws, size_t ws_size, hipStream_t stream) {
  static int grid_blocks = 0;
  if (grid_blocks == 0) {
    if (n_in != 32 || ws_size < WS_END) { fprintf(stderr, "kernel_launch: unexpected n_in %d or ws_size %zu (< %zu)\n", n_in, ws_size, (size_t)WS_END); grid_blocks = -1; return; }
    int dev = 0, cus = 0, per_cu = 0;
    (void)hipGetDevice(&dev);
    (void)hipDeviceGetAttribute(&cus, hipDeviceAttributeMultiprocessorCount, dev);
#if MULTI_LAUNCH
    per_cu = 1;
#else
    (void)hipFuncSetAttribute((const void*)mega_kernel, hipFuncAttributeMaxDynamicSharedMemorySize, LDS_BYTES);
    (void)hipOccupancyMaxActiveBlocksPerMultiprocessor(&per_cu, (const void*)mega_kernel, NTHREADS, LDS_BYTES);
#endif
    if (per_cu < 1) { fprintf(stderr, "kernel_launch: occupancy query gave %d\n", per_cu); grid_blocks = -1; return; }
    grid_blocks = cus;
  }
  if (grid_blocks < 0) return;
  Params p{};
  for (int i = 0; i < 32; ++i) p.in[i] = (const float*)d_in[i];
  p.out = (float*)d_out;
  p.ws = (unsigned char*)d_ws;
#if MULTI_LAUNCH
  launch_phase<0>(p, grid_blocks, stream); launch_phase<1>(p, grid_blocks, stream); launch_phase<2>(p, grid_blocks, stream); launch_phase<3>(p, grid_blocks, stream);
  launch_phase<4>(p, grid_blocks, stream); launch_phase<5>(p, grid_blocks, stream); launch_phase<6>(p, grid_blocks, stream); launch_phase<7>(p, grid_blocks, stream);
  launch_phase<8>(p, grid_blocks, stream); launch_phase<9>(p, grid_blocks, stream); launch_phase<10>(p, grid_blocks, stream);
#else
  (void)hipMemsetAsync((unsigned char*)d_ws + O_CTR, 0, 16384, stream);
  void* args[] = {&p};
  hipError_t e = hipLaunchCooperativeKernel((void*)mega_kernel, dim3(grid_blocks), dim3(NTHREADS), args, LDS_BYTES, stream);
  if (e != hipSuccess) fprintf(stderr, "cooperative launch failed: %s (grid %d)\n", hipGetErrorString(e), grid_blocks);
#endif
}
```

```cpp
#include <hip/hip_runtime.h>
#include <hip/hip_cooperative_groups.h>
#include <cstdio>
#include <cstdint>
namespace cg = cooperative_groups;


#ifndef PROBE_DUP
#define PROBE_DUP -1
#endif
#ifndef MULTI_LAUNCH
#define MULTI_LAUNCH 0
#endif

#define DI __device__ __forceinline__
typedef unsigned short bf16_t;
typedef short bf16x8 __attribute__((ext_vector_type(8)));
typedef short s16x4 __attribute__((ext_vector_type(4)));
typedef float f32x16 __attribute__((ext_vector_type(16)));
typedef float f32x4 __attribute__((ext_vector_type(4)));
typedef float f32x2 __attribute__((ext_vector_type(2)));
typedef unsigned u32x4 __attribute__((ext_vector_type(4)));
typedef unsigned u32x2 __attribute__((ext_vector_type(2)));
typedef __bf16 bf2_t __attribute__((ext_vector_type(2)));

constexpr int NP = 16384, NS = 512, NT = NP + NS;
constexpr int DM = 1024, ACOLS = 1792, BCOLS = 416, PABC = ACOLS + BCOLS  , NIN = 4256;
constexpr int DFF = 2816;
constexpr int PAST = 1024, DSEQ = 32, DB = 16, SKV = PAST + DSEQ  ;
constexpr int NKV = NP + DB * SKV  , NKVP = NKV + 64;
constexpr float DN_ALPHA = 1.189207115002721f;
constexpr float QSCALE = 0.10206207261596575f * 1.4426950408889634f;

constexpr size_t al256(size_t x) { return (x + 255) & ~(size_t)255; }
constexpr size_t O_WIN = 0;
constexpr size_t O_WUQ = O_WIN + al256((size_t)NIN * 1024 * 2);
constexpr size_t O_WUKV = O_WUQ + al256(768 * 256 * 2);
constexpr size_t O_WPA = O_WUKV + al256(1024 * 128 * 2);
constexpr size_t O_WPB = O_WPA + al256(1024 * 512 * 2);
constexpr size_t O_WO = O_WPB + al256(1024 * 512 * 2);
constexpr size_t O_WGU = O_WO + al256(1024 * 1024 * 2);
constexpr size_t O_WDN = O_WGU + al256((size_t)5632 * 1024 * 2);
constexpr size_t O_WW2 = O_WDN + al256((size_t)1024 * 2816 * 2);
constexpr size_t O_WA2 = O_WW2 + al256(512 * 64 * 2);
constexpr size_t O_WG2 = O_WA2 + al256(512 * 64 * 2);
constexpr size_t O_ROPE = O_WG2 + al256(512 * 128 * 2);
constexpr size_t O_CTR = O_ROPE + al256((size_t)NT * 32 * 4);
constexpr size_t O_PAB = O_CTR + 16384;
constexpr size_t SZ_T512 = (size_t)NT * 512 * 2;
constexpr size_t O_SIN = O_PAB + al256((size_t)NT * PABC * 2);
constexpr size_t O_G = O_SIN + 6 * SZ_T512;
constexpr size_t O_RK = O_G + SZ_T512;
constexpr size_t O_KNB = O_RK + al256((size_t)NT * 8 * 4);
constexpr size_t O_KPEB = O_KNB + al256((size_t)8 * NKVP * 64 * 2);
constexpr int SCC = 16, SCL = NP / SCC;
constexpr size_t WS_END = O_KPEB + al256((size_t)NKVP * 32 * 2);
constexpr size_t O_Y = O_PAB;
constexpr size_t O_E = O_Y + SZ_T512;
constexpr size_t O_YB = O_Y + (size_t)NT * 512 * 4;
constexpr size_t O_YA = O_YB + SZ_T512;
constexpr size_t O_H = O_PAB;
constexpr size_t O_M = O_SIN;
constexpr size_t O_Z = O_SIN + (size_t)NT * 1024 * 2;
constexpr size_t O_Z2 = O_PAB + (size_t)NT * 1024 * 2;
constexpr size_t O_ACT = O_SIN;
constexpr size_t OO_XB = 0;
constexpr size_t OO_Q = 0;
constexpr size_t OO_VT = (size_t)NT * 768 * 2;
constexpr size_t OO_GH = OO_VT + (size_t)8 * 64 * NKVP * 2;
constexpr size_t OO_SST = OO_GH + 2 * (size_t)8 * SCC * 4096 * 4;
static_assert(OO_SST + (size_t)SCC * 8 * 4096 * 2 <= (size_t)NT * 1024 * 4, "d_out scratch");
constexpr size_t F_Y = 0, F_CKVP = (size_t)NT * 1024, F_KPEP = F_CKVP + (size_t)NP * 128, F_WKVP = F_KPEP + (size_t)NP * 32,
                 F_SHP = F_WKVP + 32768, F_CKVS = F_SHP + 1792, F_KPES = F_CKVS + (size_t)NS * 128, F_WKVS = F_KPES + (size_t)NS * 32,
                 F_SHS = F_WKVS + (size_t)DB * 32768;

constexpr int LDS_CTRL = 3 * 49152;
constexpr int LDS_BYTES = LDS_CTRL + 256;
constexpr int NTHREADS = 512;

struct Params {
  const float* in[32];
  float* out;
  unsigned char* ws;
};

DI int tidx() { int t = threadIdx.x; asm volatile("" : "+v"(t)); return t; }
DI unsigned pk2(float a, float b) { f32x2 v = {a, b}; bf2_t r = __builtin_convertvector(v, bf2_t); return __builtin_bit_cast(unsigned, r); }
DI bf16_t f2bf(float a) { return (bf16_t)(pk2(a, 0.f) & 0xffffu); }
DI float bf2f(bf16_t x) { return __uint_as_float(((unsigned)x) << 16); }
DI void unpack8(u32x4 v, float* f) {
#pragma unroll
  for (int j = 0; j < 4; ++j) { f[2 * j] = __uint_as_float(v[j] << 16); f[2 * j + 1] = __uint_as_float(v[j] & 0xffff0000u); }
}
DI u32x4 pack8(const float* f) { u32x4 o; o[0] = pk2(f[0], f[1]); o[1] = pk2(f[2], f[3]); o[2] = pk2(f[4], f[5]); o[3] = pk2(f[6], f[7]); return o; }
DI float sigmoidf_(float x) { return __builtin_amdgcn_rcpf(1.f + __expf(-x)); }
DI float dpp_sum16(float x) {
  x += __builtin_bit_cast(float, __builtin_amdgcn_update_dpp(0, __builtin_bit_cast(int, x), 0xB1, 0xF, 0xF, true));
  x += __builtin_bit_cast(float, __builtin_amdgcn_update_dpp(0, __builtin_bit_cast(int, x), 0x4E, 0xF, 0xF, true));
  x += __builtin_bit_cast(float, __builtin_amdgcn_update_dpp(0, __builtin_bit_cast(int, x), 0x141, 0xF, 0xF, true));
  x += __builtin_bit_cast(float, __builtin_amdgcn_update_dpp(0, __builtin_bit_cast(int, x), 0x140, 0xF, 0xF, true));
  return x;
}
DI float sum32(float x) { x = dpp_sum16(x); x += __shfl_xor(x, 16); return x; }
DI float wave_sum(float v) {
#pragma unroll
  for (int o = 1; o < 64; o <<= 1) v += __shfl_xor(v, o);
  return v;
}
DI int crow(int i, int h) { return (i & 3) + 8 * (i >> 2) + 4 * h; }
#define MFMA32(a, b, c) __builtin_amdgcn_mfma_f32_32x32x16_bf16((a), (b), (c), 0, 0, 0)
DI int slot_of_token(int t) { return t < NP ? t : NP + ((t - NP) >> 5) * SKV + PAST + ((t - NP) & 31); }
DI const float* xrow(const Params& p, int t) { return t < NP ? p.in[0] + (size_t)t * DM : p.in[1] + (size_t)(t - NP) * DM; }

DI void conv_T(const float* W, int K, int N, bf16_t* WT, int mode, int gtid, int gsz) {
  const int ntask = (K / 8) * N;
  for (int id = gtid; id < ntask; id += gsz) {
    const int kc = id / N, n = id - kc * N, k0 = kc * 8;
    float f[8];
#pragma unroll
    for (int j = 0; j < 8; ++j) f[j] = W[(size_t)(k0 + j) * N + n];
    if (mode == 2) {
      *(u32x4*)(WT + ((size_t)((n >> 5) * (K >> 4) + (k0 >> 4)) * 64 + ((k0 >> 3) & 1) * 32 + (n & 31)) * 8) = pack8(f);
      continue;
    }
    int row = n;
    if (mode == 1) { const int nt = n >= DFF ? 1 : 0, j = n - nt * DFF; row = 128 * (j >> 6) + 64 * ((j & 63) >> 5) + 32 * nt + (j & 31); }
    *(u32x4*)(WT + (size_t)row * K + k0) = pack8(f);
  }
}
DI void conv_T_lds(const float* W, int K, int N, bf16_t* WT, int mode, unsigned char* lds, int gw, int ngw, int wave, int lane) {
  float* scr = (float*)(lds + wave * (64 * 33 * 4));
  const int nblk = N >> 5, nitem = (K >> 6) * nblk;
  for (int item = gw; item < nitem; item += ngw) {
    const int kb = item / nblk, nb = item - kb * nblk, k0 = kb * 64, n0 = nb * 32;
#pragma unroll 8
    for (int i = 0; i < 32; ++i) { const int kk = 2 * i + (lane >> 5); scr[kk * 33 + (lane & 31)] = W[(size_t)(k0 + kk) * N + n0 + (lane & 31)]; }
    asm volatile("s_waitcnt lgkmcnt(0)" ::: "memory");
    const int c = lane & 7;
#pragma unroll
    for (int j = 0; j < 4; ++j) {
      const int nl = (lane >> 3) + 8 * j;
      const float* sp = scr + (8 * c) * 33 + nl;
      float f[8];
#pragma unroll
      for (int q = 0; q < 8; ++q) f[q] = sp[q * 33];
      int row = n0 + nl;
      if (mode == 1) { const int nt = row >= DFF ? 1 : 0, jj = row - nt * DFF; row = 256 * (jj >> 7) + 128 * ((jj & 127) >> 6) + 32 * (2 * ((jj & 63) >> 5) + nt) + (jj & 31); }
      *(u32x4*)(WT + (size_t)row * K + k0 + 8 * c) = pack8(f);
    }
    asm volatile("s_waitcnt lgkmcnt(0)" ::: "memory");
  }
}
DI void conv_x(const Params& p, bf16_t* XB, int gtid, int gsz) {
  for (int id = gtid; id < NT * 128; id += gsz) {
    const int t = id >> 7, c = (id & 127) * 8;
    const float* src = xrow(p, t) + c;
    f32x4 a = *(const f32x4*)src, b = *(const f32x4*)(src + 4);
    float f[8] = {a[0], a[1], a[2], a[3], b[0], b[1], b[2], b[3]};
    *(u32x4*)(XB + (size_t)t * DM + c) = pack8(f);
  }
}
DI void phase0(const Params& p, unsigned char* lds) {
  const int tid0 = tidx(), gtid = blockIdx.x * NTHREADS + tid0, gsz = gridDim.x * NTHREADS;
  const int wave0 = __builtin_amdgcn_readfirstlane(tid0 >> 6), lane0 = tid0 & 63, gw = blockIdx.x * 8 + wave0, ngw = gridDim.x * 8;
  unsigned char* ws = p.ws;
  if (gtid < 64) ((unsigned*)(ws + O_CTR))[gtid] = 0u;
  conv_T_lds(p.in[6], 1024, NIN, (bf16_t*)(ws + O_WIN), 0, lds, gw, ngw, wave0, lane0);
  conv_T(p.in[20], 256, 768, (bf16_t*)(ws + O_WUQ), 2, gtid, gsz);
  conv_T(p.in[22], 128, 1024, (bf16_t*)(ws + O_WUKV), 2, gtid, gsz);
  conv_T_lds(p.in[18], 512, 1024, (bf16_t*)(ws + O_WPA), 0, lds, gw, ngw, wave0, lane0);
  conv_T_lds(p.in[23], 512, 1024, (bf16_t*)(ws + O_WPB), 0, lds, gw, ngw, wave0, lane0);
  conv_T_lds(p.in[25], 1024, 1024, (bf16_t*)(ws + O_WO), 0, lds, gw, ngw, wave0, lane0);
  conv_T_lds(p.in[28], 1024, 5632, (bf16_t*)(ws + O_WGU), 1, lds, gw, ngw, wave0, lane0);
  conv_T_lds(p.in[29], 2816, 1024, (bf16_t*)(ws + O_WDN), 0, lds, gw, ngw, wave0, lane0);
  conv_T(p.in[9], 64, 512, (bf16_t*)(ws + O_WW2), 2, gtid, gsz);
  conv_T(p.in[11], 64, 512, (bf16_t*)(ws + O_WA2), 2, gtid, gsz);
  conv_T(p.in[12], 128, 512, (bf16_t*)(ws + O_WG2), 2, gtid, gsz);
  conv_x(p, (bf16_t*)((unsigned char*)p.out + OO_XB), gtid, gsz);
  float* rope = (float*)(ws + O_ROPE);
  for (int id = gtid; id < NT * 16; id += gsz) {
    const int t = id >> 4, j = id & 15;
    const int pos = t < NP ? t : PAST + ((t - NP) & 31);
    const float inv = (float)exp2(-(double)j * (13.287712379549449 / 16.0));
    const float ang = (float)pos * inv;
    const double x = (double)ang;
    const double n = rint(x * 0.15915494309189535);
    const float red = (float)(x - n * 6.283185307179586);
    rope[t * 32 + j] = __cosf(red);
    rope[t * 32 + 16 + j] = __sinf(red);
  }
  bf16_t* kpeb = (bf16_t*)(ws + O_KPEB);
  for (int id = gtid; id < DB * PAST * 4; id += gsz) {
    const int row = id >> 2, ch = id & 3, b = row >> 10, j = row & 1023;
    const float* src = p.in[3] + (size_t)row * 32 + ch * 8;
    f32x4 a = *(const f32x4*)src, c = *(const f32x4*)(src + 4);
    float f[8] = {a[0], a[1], a[2], a[3], c[0], c[1], c[2], c[3]};
    *(u32x4*)(kpeb + (size_t)(NP + b * SKV + j) * 32 + ch * 8) = pack8(f);
  }
  bf16_t* knb = (bf16_t*)(ws + O_KNB);
  for (int id = gtid; id < 64 * 32; id += gsz) kpeb[(size_t)NKV * 32 + id] = 0;
  for (int id = gtid; id < 8 * 64 * 64; id += gsz) {
    const int h = id >> 12, rem = id & 4095;
    knb[((size_t)h * NKVP + NKV) * 64 + rem] = 0;
  }
}

template <int TM, int TN, bool ZERO = true, int NST = 3>
DI void gemm_mainloop(const bf16_t* __restrict__ A, int lda, const bf16_t* __restrict__ Bt, int ldb, int K, int m0, int n0, int nmax,
                      f32x16 (&acc)[TM][TN], unsigned char* lds) {
  constexpr int BM = 128 * TM, BN = 64 * TN, AG = BM / 64, BG = BN / 64, NLD = AG + BG;
  constexpr int ABYTES = BM * 128, STAGE = (BM + BN) * 128;
  static_assert(NST * STAGE <= LDS_CTRL && (NST == 2 || NST == 3), "lds");
  const int tid = tidx(), wave = __builtin_amdgcn_readfirstlane(tid >> 6), lane = tid & 63, r = lane & 31, h = lane >> 5, wm = wave & 3, wn = wave >> 2;
  const int lrow = lane >> 3, lpos = lane & 7;
  const bf16_t* ap[AG]; const bf16_t* bp[BG];
#pragma unroll
  for (int i = 0; i < AG; ++i) { const int row = (wave * AG + i) * 8 + lrow, c = lpos ^ ((row >> 1) & 7); ap[i] = A + (size_t)(m0 + row) * lda + c * 8; }
#pragma unroll
  for (int i = 0; i < BG; ++i) { const int row = (wave * BG + i) * 8 + lrow, c = lpos ^ ((row >> 1) & 7); int br = n0 + row; br = br < nmax ? br : nmax - 1; bp[i] = Bt + (size_t)br * ldb + c * 8; }
  if (ZERO) {
#pragma unroll
    for (int tm = 0; tm < TM; ++tm)
#pragma unroll
      for (int tn = 0; tn < TN; ++tn)
#pragma unroll
        for (int i = 0; i < 16; ++i) acc[tm][tn][i] = 0.f;
  }
  auto issue = [&](int kt, int stage) {
    unsigned char* sb = lds + stage * STAGE;
#pragma unroll
    for (int i = 0; i < AG; ++i) __builtin_amdgcn_global_load_lds((const unsigned*)(ap[i] + kt * 64), (unsigned*)(sb + (wave * AG + i) * 1024), 16, 0, 0);
#pragma unroll
    for (int i = 0; i < BG; ++i) __builtin_amdgcn_global_load_lds((const unsigned*)(bp[i] + kt * 64), (unsigned*)(sb + ABYTES + (wave * BG + i) * 1024), 16, 0, 0);
  };
  const int swz = (r >> 1) & 7;
  int koff[4];
#pragma unroll
  for (int ks = 0; ks < 4; ++ks) koff[ks] = ((ks * 2 + h) ^ swz) * 16;
  const int a_rd = (wm * 32 * TM + r) * 128, b_rd = ABYTES + (wn * 32 * TN + r) * 128;
  const int nk = K >> 6;
  asm volatile("s_waitcnt vmcnt(0)" ::: "memory");
  issue(0, 0);
  if (NST == 3) issue(1, 1);
  for (int kt = 0; kt < nk; ++kt) {
    if (NST == 3 && kt + 1 < nk) asm volatile("s_waitcnt vmcnt(%0)" ::"n"(NLD) : "memory");
    else asm volatile("s_waitcnt vmcnt(0)" ::: "memory");
    asm volatile("s_waitcnt lgkmcnt(0)" ::: "memory");
    __builtin_amdgcn_s_barrier();
    if (NST == 3) { if (kt + 2 < nk) issue(kt + 2, (kt + 2) % 3); }
    else { if (kt + 1 < nk) issue(kt + 1, (kt + 1) & 1); }
    const unsigned char* cur = lds + (kt % NST) * STAGE;
#pragma unroll
    for (int ks = 0; ks < 4; ++ks) {
      bf16x8 af[TM], bfr[TN];
#pragma unroll
      for (int tm = 0; tm < TM; ++tm) af[tm] = *(const bf16x8*)(cur + a_rd + tm * 4096 + koff[ks]);
#pragma unroll
      for (int tn = 0; tn < TN; ++tn) bfr[tn] = *(const bf16x8*)(cur + b_rd + tn * 4096 + koff[ks]);
#pragma unroll
      for (int tm = 0; tm < TM; ++tm)
#pragma unroll
        for (int tn = 0; tn < TN; ++tn) acc[tm][tn] = MFMA32(bfr[tn], af[tm], acc[tm][tn]);
    }
  }
  asm volatile("s_waitcnt lgkmcnt(0)" ::: "memory");
  __builtin_amdgcn_s_barrier();
}

template <int TM, int TN, int OUTC, class F>
DI void epilogue_bf16(const f32x16 (&acc)[TM][TN], unsigned char* lds, bf16_t* out, int ldo, int m0, int c0, int cmax, F f) {
  constexpr int BM = 128 * TM, STRIDE = OUTC * 2 + 16, TNO = OUTC / (32 * 2);
  const int tid = tidx(), wave = __builtin_amdgcn_readfirstlane(tid >> 6), lane = tid & 63, r = lane & 31, h = lane >> 5, wm = wave & 3, wn = wave >> 2;
#pragma unroll
  for (int tm = 0; tm < TM; ++tm)
#pragma unroll
    for (int tn = 0; tn < TNO; ++tn)
#pragma unroll
      for (int g = 0; g < 4; ++g) {
        const int rowl = wm * 32 * TM + tm * 32 + r, coll = wn * 32 * TNO + tn * 32 + 8 * g + 4 * h;
        const f32x4 o = f(tm, tn, g, rowl, coll);
        u32x2 w; w[0] = pk2(o[0], o[1]); w[1] = pk2(o[2], o[3]);
        *(u32x2*)(lds + rowl * STRIDE + coll * 2) = w;
      }
  __syncthreads();
  constexpr int CPR = OUTC / 8;
#pragma unroll
  for (int j = 0; j < BM * CPR / NTHREADS; ++j) {
    const int id = tid + NTHREADS * j, row = id / CPR, c = id % CPR;
    if (c0 + c * 8 < cmax) *(u32x4*)(out + (size_t)(m0 + row) * ldo + c0 + c * 8) = *(const u32x4*)(lds + row * STRIDE + c * 16);
  }
  __syncthreads();
}
DI f32x4 acc4(const f32x16& a, int g) { return (f32x4){a[4 * g], a[4 * g + 1], a[4 * g + 2], a[4 * g + 3]}; }

struct TileIter {
  int nM, nN, total, L, Lend, step;
  DI void init(int nM_, int nN_) {
    nM = nM_; nN = nN_; total = nM * nN;
    const int nx = (gridDim.x & 7) == 0 ? 8 : 1, x = blockIdx.x % nx, local = blockIdx.x / nx;
    step = gridDim.x / nx;
    const int per = (total + nx - 1) / nx;
    L = x * per + local; Lend = (x + 1) * per < total ? (x + 1) * per : total;
  }
  DI bool next(int& tmi, int& tni) {
    if (L >= Lend) return false;
    const int fb = nM >> 2, fullcnt = fb * 4 * nN;
    if (L < fullcnt) { const int band = L / (4 * nN), jj = L - band * 4 * nN; tni = jj >> 2; tmi = band * 4 + (jj & 3); }
    else { const int l2 = L - fullcnt, bm = nM & 3; tni = l2 / bm; tmi = fb * 4 + l2 % bm; }
    L += step; return true;
  }
};

DI void phase1(const Params& p, unsigned char* lds) {
  const bf16_t* XB = (const bf16_t*)((unsigned char*)p.out + OO_XB);
  const bf16_t* WT = (const bf16_t*)(p.ws + O_WIN);
  bf16_t* PAB = (bf16_t*)(p.ws + O_PAB);
  constexpr int NMT = NT / 256, NNT = (PABC + 127) / 128;
  const int lane = tidx() & 63, wave = __builtin_amdgcn_readfirstlane(tidx() >> 6), r = lane & 31, h = lane >> 5, wm = wave & 3, wn = wave >> 2;
  TileIter ti; ti.init(NMT, NNT);
  int tmi, tni;
  while (ti.next(tmi, tni)) {
    const int m0 = tmi * 256, n0 = tni * 128;
    f32x16 acc[2][2];
    gemm_mainloop<2, 2>(XB, DM, WT, DM, DM, m0, n0, PABC, acc, lds);
    if (m0 + 256 > NP - 1 && n0 < ACOLS) {
#pragma unroll
      for (int tm = 0; tm < 2; ++tm) {
        const int row = m0 + wm * 64 + tm * 32 + r;
        const bool lastp = row == NP - 1, lasts = row >= NP && ((row - NP) & 31) == 31;
        if (lastp || lasts) {
          float* dst = lastp ? p.out + F_SHP : p.out + F_SHS + (size_t)((row - NP) >> 5) * ACOLS;
#pragma unroll
          for (int tn = 0; tn < 2; ++tn)
#pragma unroll
            for (int g = 0; g < 4; ++g) {
              const int col = n0 + wn * 64 + tn * 32 + 8 * g + 4 * h;
              if (col < ACOLS) *(f32x4*)(dst + col) = acc4(acc[tm][tn], g);
            }
        }
      }
    }
    epilogue_bf16<2, 2, 128>(acc, lds, PAB, PABC, m0, n0, PABC, [&](int tm, int tn, int g, int, int) { return acc4(acc[tm][tn], g); });
  }
}

constexpr int L2_LORA = 0, L2_K = L2_LORA + 32 * 528, L2_R = L2_K + 32 * 1040, L2A_STG = L2_R + 32 * 1040, L2A_END = L2A_STG + 8 * 32 * 144;
constexpr int L2_CQ = 0, L2_CKV = L2_CQ + 32 * 528, L2B_STG = L2_CKV + 32 * 272, L2B_END = L2B_STG + 8 * 32 * 208;
static_assert(L2A_END <= LDS_BYTES && L2B_END <= LDS_BYTES, "lds p2");
template <int NTL, class F>
DI void stage_store16(unsigned char* stg, int lane, bf16_t* dst  , unsigned row_stride  , F f) {
  constexpr int RS = NTL * 64 + 16, CPR = NTL * 4;
  const int r = lane & 31, h = lane >> 5;
#pragma unroll
  for (int nt = 0; nt < NTL; ++nt)
#pragma unroll
    for (int i = 0; i < 16; ++i) *(unsigned short*)(stg + crow(i, h) * RS + (nt * 32 + r) * 2) = f(nt, i);
  __syncthreads();
#pragma unroll
  for (int j = 0; j < 32 * CPR / 64; ++j) {
    const int id = lane + 64 * j, row = id / CPR, ch = id % CPR;
    *(u32x4*)(dst + (size_t)row * row_stride + ch * 8) = *(const u32x4*)(stg + row * RS + ch * 16);
  }
  __syncthreads();
}

template <int NTL, int KS>
DI void mm32(const unsigned char* ldsA, int strideB, const bf16_t* Bt, int ldb, int lane, f32x16 (&acc)[NTL]) {
  constexpr int KG = (NTL * KS <= 16) ? KS : (NTL <= 2 ? 4 : 2), NG = KS / KG;
  const int r = lane & 31, h = lane >> 5;
#pragma unroll
  for (int nt = 0; nt < NTL; ++nt)
#pragma unroll
    for (int i = 0; i < 16; ++i) acc[nt][i] = 0.f;
  bf16x8 bq[2][KG][NTL];
  const bf16_t* bp = Bt + lane * 8;
#pragma unroll
  for (int k = 0; k < KG; ++k)
#pragma unroll
    for (int nt = 0; nt < NTL; ++nt) bq[0][k][nt] = *(const bf16x8*)(bp + (size_t)(nt * KS + k) * 512);
#pragma unroll
  for (int g = 0; g < NG; ++g) {
    if (g + 1 < NG) {
#pragma unroll
      for (int k = 0; k < KG; ++k)
#pragma unroll
        for (int nt = 0; nt < NTL; ++nt) bq[(g + 1) & 1][k][nt] = *(const bf16x8*)(bp + (size_t)(nt * KS + (g + 1) * KG + k) * 512);
    }
    __builtin_amdgcn_sched_barrier(0);
#pragma unroll
    for (int k = 0; k < KG; ++k) {
      const bf16x8 a = *(const bf16x8*)(ldsA + r * strideB + (g * KG + k) * 32 + h * 16);
#pragma unroll
      for (int nt = 0; nt < NTL; ++nt) acc[nt] = MFMA32(a, bq[g & 1][k][nt], acc[nt]);
    }
    __builtin_amdgcn_sched_barrier(0);
  }
}

DI void kv_expand(const Params& p, unsigned char* lds, int w, int lane, int slot0) {
  const int r = lane & 31, h = lane >> 5;
  bf16_t* knb = (bf16_t*)(p.ws + O_KNB);
  bf16_t* vT = (bf16_t*)((unsigned char*)p.out + OO_VT);
  f32x16 acc[4];
  mm32<4, 8>(lds + L2_CKV, 272, (const bf16_t*)(p.ws + O_WUKV) + (size_t)(128 * w) * 128, 128, lane, acc);
  stage_store16<2>((unsigned char*)lds + L2B_STG + w * (32 * 208), lane, knb + ((size_t)w * NKVP + slot0) * 64, 64, [&](int nt, int i) { return f2bf(acc[nt][i]); });
#pragma unroll
  for (int nt = 2; nt < 4; ++nt)
#pragma unroll
    for (int g = 0; g < 4; ++g) {
      u32x2 o; o[0] = pk2(acc[nt][4 * g], acc[nt][4 * g + 1]); o[1] = pk2(acc[nt][4 * g + 2], acc[nt][4 * g + 3]);
      *(u32x2*)(vT + ((unsigned)w * 64 + (nt - 2) * 32 + r) * (unsigned)NKVP + slot0 + 8 * g + 4 * h) = o;
    }
}

DI void p2_token_tile_a(const Params& p, unsigned char* lds, int tile) {
  const int tid = tidx(), wave = __builtin_amdgcn_readfirstlane(tid >> 6), lane = tid & 63, r = lane & 31, h = lane >> 5;
  const int t0 = tile * 32;
  unsigned char* ws = p.ws;
  const bf16_t* PAB = (const bf16_t*)(ws + O_PAB);
  bf16_t* SR = (bf16_t*)(ws + O_SIN);
  bf16_t* SK = SR + (size_t)NT * 512; bf16_t* SV = SK + (size_t)NT * 512; bf16_t* SA = SV + (size_t)NT * 512; bf16_t* SB = SA + (size_t)NT * 512;
  _Float16* SW = (_Float16*)(SB + (size_t)NT * 512);
  bf16_t* G = (bf16_t*)(ws + O_G);
  float* RK = (float*)(ws + O_RK);
  const float* rope = (const float*)(ws + O_ROPE);
#pragma unroll 1
  for (int bt = 0; bt < 2; ++bt) {
    u32x4 rawp[7], rawq[7];
#pragma unroll
    for (int it = 0; it < 7; ++it) {
      const int task = tid + NTHREADS * (bt * 7 + it);
      const int tl = task / 224, ch = task - tl * 224, c0 = ch * 8, t = t0 + tl;
      rawp[it] = *(const u32x4*)(PAB + (size_t)t * PABC + c0);
      rawq[it] = *(const u32x4*)(PAB + (size_t)(t > 0 ? t - 1 : 0) * PABC + c0);
    }
#pragma unroll
    for (int it = 0; it < 7; ++it) {
      const int task = tid + NTHREADS * (bt * 7 + it);
      const int tl = task / 224, ch = task - tl * 224, c0 = ch * 8, t = t0 + tl;
      float pv[8], pr[8];
      unpack8(rawp[it], pv);
      unpack8(rawq[it], pr);
      if (t == 0) {
#pragma unroll
        for (int j = 0; j < 8; ++j) pr[j] = 0.f;
      } else if (t >= NP && ((t - NP) & 31) == 0) {
        const float* sp = p.in[5] + (size_t)((t - NP) >> 5) * ACOLS + c0;
        const f32x4 a = *(const f32x4*)sp, b = *(const f32x4*)(sp + 4);
        pr[0] = a[0]; pr[1] = a[1]; pr[2] = a[2]; pr[3] = a[3]; pr[4] = b[0]; pr[5] = b[1]; pr[6] = b[2]; pr[7] = b[3];
      }
      const f32x4 mu0 = *(const f32x4*)(p.in[7] + c0), mu1 = *(const f32x4*)(p.in[7] + c0 + 4);
      const float mm[8] = {mu0[0], mu0[1], mu0[2], mu0[3], mu1[0], mu1[1], mu1[2], mu1[3]};
      float xs[8];
#pragma unroll
      for (int j = 0; j < 8; ++j) xs[j] = pv[j] + (pr[j] - pv[j]) * mm[j];
      if (c0 < 512) {
        const u32x4 o = pack8(xs);
        *(u32x4*)(SR + (size_t)t * 512 + c0) = o;
        *(u32x4*)(lds + L2_R + tl * 1040 + c0 * 2) = o;
      } else if (c0 < 1024) {
        *(u32x4*)(lds + L2_K + tl * 1040 + (c0 - 512) * 2) = pack8(xs);
      } else if (c0 < 1536) {
        *(u32x4*)(SV + (size_t)t * 512 + (c0 - 1024)) = pack8(xs);
      } else {
        *(u32x4*)(lds + L2_LORA + tl * 528 + (c0 - 1536) * 2) = pack8(xs);
      }
    }
  }
  __syncthreads();
  if (tid < 256) {
    unsigned char* q = lds + L2_LORA + (tid >> 3) * 528 + (tid & 7) * 16;
    float f[8]; unpack8(*(const u32x4*)q, f);
#pragma unroll
    for (int j = 0; j < 8; ++j) { const float e = __expf(2.f * f[j]); f[j] = 1.f - 2.f * __builtin_amdgcn_rcpf(e + 1.f); }
    *(u32x4*)q = pack8(f);
  }
  {
    unsigned char* q = lds + L2_LORA + (tid >> 4) * 528 + 256 + (tid & 15) * 16;
    float f[8]; unpack8(*(const u32x4*)q, f);
#pragma unroll
    for (int j = 0; j < 8; ++j) f[j] = sigmoidf_(f[j]);
    *(u32x4*)q = pack8(f);
  }
  __syncthreads();
  const int w = wave, cb = 64 * w;
  {
    int r = (tidx() & 31);
    f32x16 acc[2];
    mm32<2, 4>(lds + L2_LORA, 528, (const bf16_t*)(ws + O_WW2) + (size_t)cb * 64, 64, lane, acc);
    const float w00 = p.in[8][cb + r], w01 = p.in[8][cb + 32 + r];
    stage_store16<2>(lds + L2A_STG + w * (32 * 144), lane, (bf16_t*)SW + (size_t)t0 * 512 + cb, 512, [&](int nt, int i) {
      const float z = (nt ? w01 : w00) + acc[nt][i];
      const float sp = fmaxf(-z, 0.f) + __logf(1.f + __expf(-fabsf(z)));
      const float dec = __expf(-__expf(-sp - 0.5f));
      return __builtin_bit_cast(unsigned short, (_Float16)dec);
    });
  }
  __syncthreads();
  {
    int r = (tidx() & 31);
    f32x16 acc[2];
    mm32<2, 4>(lds + L2_LORA + 128, 528, (const bf16_t*)(ws + O_WA2) + (size_t)cb * 64, 64, lane, acc);
    float kkv[2][16];
#pragma unroll
    for (int nt = 0; nt < 2; ++nt) {
      const int c = cb + nt * 32 + r;
      const float a0 = p.in[10][c], kkc = p.in[13][c];
#pragma unroll
      for (int i = 0; i < 16; ++i) {
        acc[nt][i] = sigmoidf_(a0 + acc[nt][i]);
        kkv[nt][i] = bf2f(*(const bf16_t*)(lds + L2_K + crow(i, h) * 1040 + c * 2)) * kkc;
      }
    }
#pragma unroll
    for (int i = 0; i < 16; ++i) {
      const float nsq = sum32(kkv[0][i] * kkv[0][i] + kkv[1][i] * kkv[1][i]);
      const float inv = 1.f / fmaxf(sqrtf(nsq), 1e-12f);
      kkv[0][i] *= inv; kkv[1][i] *= inv;
      __builtin_amdgcn_sched_barrier(0);
    }
    const int c0 = cb + r, c1 = cb + 32 + r;
    const float ka0 = p.in[14][c0], ka1 = p.in[14][c1], rk0 = p.in[15][c0], rk1 = p.in[15][c1];
    unsigned char* stg = lds + L2A_STG + w * (32 * 144);
    stage_store16<2>(stg, lane, SA + (size_t)t0 * 512 + cb, 512, [&](int nt, int i) { return f2bf(-kkv[nt][i]); });
    stage_store16<2>(stg, lane, SB + (size_t)t0 * 512 + cb, 512, [&](int nt, int i) { return f2bf(kkv[nt][i] * acc[nt][i]); });
#pragma unroll
    for (int i = 0; i < 16; ++i) {
      const int tl = crow(i, h);
      const float kr0 = bf2f(*(const bf16_t*)(lds + L2_K + tl * 1040 + c0 * 2)), kr1 = bf2f(*(const bf16_t*)(lds + L2_K + tl * 1040 + c1 * 2));
      const float kh0 = kr0 * (1.f + (acc[0][i] - 1.f) * ka0), kh1 = kr1 * (1.f + (acc[1][i] - 1.f) * ka1);
      kkv[0][i] = kh0; kkv[1][i] = kh1;
      const float rr0 = bf2f(*(const bf16_t*)(lds + L2_R + tl * 1040 + c0 * 2)), rr1 = bf2f(*(const bf16_t*)(lds + L2_R + tl * 1040 + c1 * 2));
      const float sb = sum32(rr0 * kh0 * rk0 + rr1 * kh1 * rk1);
      if (r == 0) RK[(unsigned)(t0 + tl) * 8u + w] = sb;
    }
    stage_store16<2>(stg, lane, SK + (size_t)t0 * 512 + cb, 512, [&](int nt, int i) { return f2bf(kkv[nt][i]); });
  }
  __syncthreads();
  {
    int r = (tidx() & 31);
    f32x16 acc[2];
    mm32<2, 8>(lds + L2_LORA + 256, 528, (const bf16_t*)(ws + O_WG2) + (size_t)cb * 128, 128, lane, acc);
    stage_store16<2>(lds + L2A_STG + w * (32 * 144), lane, G + (size_t)t0 * 512 + cb, 512, [&](int nt, int i) { return f2bf(acc[nt][i]); });
  }
  __syncthreads();
}

DI void p2_token_tile_b(const Params& p, unsigned char* lds, int tile) {
  const int tid = tidx(), wave = __builtin_amdgcn_readfirstlane(tid >> 6), lane = tid & 63, r = lane & 31, h = lane >> 5;
  const int t0 = tile * 32;
  unsigned char* ws = p.ws;
  const bf16_t* PAB = (const bf16_t*)(ws + O_PAB);
  bf16_t* SR = (bf16_t*)(ws + O_SIN);
  bf16_t* SK = SR + (size_t)NT * 512; bf16_t* SV = SK + (size_t)NT * 512; bf16_t* SA = SV + (size_t)NT * 512; bf16_t* SB = SA + (size_t)NT * 512;
  _Float16* SW = (_Float16*)(SB + (size_t)NT * 512);
  bf16_t* G = (bf16_t*)(ws + O_G);
  float* RK = (float*)(ws + O_RK);
  const float* rope = (const float*)(ws + O_ROPE);
  {
    u32x2 vq[4]; unsigned vc[4]; float k1[4], k2[4], rc[4], rs_[4];
#pragma unroll
    for (int q = 0; q < 4; ++q) {
      const int t = t0 + wave * 4 + q;
      const bf16_t* pb = PAB + (size_t)t * PABC + ACOLS;
      vq[q] = *(const u32x2*)(pb + 4 * lane);
      vc[q] = *(const unsigned*)(pb + 256 + 2 * lane);
      k1[q] = bf2f(pb[384 + (lane & 15)]); k2[q] = bf2f(pb[400 + (lane & 15)]);
      rc[q] = rope[t * 32 + (lane & 15)]; rs_[q] = rope[t * 32 + 16 + (lane & 15)];
    }
    const f32x4 gq = *(const f32x4*)(p.in[19] + 4 * lane);
    const f32x2 gkv = *(const f32x2*)(p.in[21] + 2 * lane);
#pragma unroll
    for (int q = 0; q < 4; ++q) {
      const int tl = wave * 4 + q, t = t0 + tl;
      {
        const u32x2 v = vq[q];
        float x[4] = {__uint_as_float(v[0] << 16), __uint_as_float(v[0] & 0xffff0000u), __uint_as_float(v[1] << 16), __uint_as_float(v[1] & 0xffff0000u)};
        const float ss = wave_sum(x[0] * x[0] + x[1] * x[1] + x[2] * x[2] + x[3] * x[3]);
        const float rs = rsqrtf(ss * (1.f / 256.f) + 1e-6f);
        u32x2 o; o[0] = pk2(x[0] * rs * gq[0], x[1] * rs * gq[1]); o[1] = pk2(x[2] * rs * gq[2], x[3] * rs * gq[3]);
        *(u32x2*)(lds + L2_CQ + tl * 528 + lane * 8) = o;
      }
      {
        const unsigned v = vc[q];
        const float x0 = __uint_as_float(v << 16), x1 = __uint_as_float(v & 0xffff0000u);
        const float ss = wave_sum(x0 * x0 + x1 * x1);
        const float rs = rsqrtf(ss * (1.f / 128.f) + 1e-6f);
        const float o0 = x0 * rs * gkv[0], o1 = x1 * rs * gkv[1];
        float* dst = (t < NP) ? p.out + F_CKVP + (size_t)t * 128 : p.out + F_CKVS + (size_t)(t - NP) * 128;
        f32x2 of = {o0, o1};
        *(f32x2*)(dst + 2 * lane) = of;
        *(unsigned*)(lds + L2_CKV + tl * 272 + lane * 4) = pk2(o0, o1);
      }
      if (lane < 16) {
        const float o1 = k1[q] * rc[q] - k2[q] * rs_[q], o2 = k1[q] * rs_[q] + k2[q] * rc[q];
        float* dst = (t < NP) ? p.out + F_KPEP + (size_t)t * 32 : p.out + F_KPES + (size_t)(t - NP) * 32;
        dst[lane] = o1; dst[16 + lane] = o2;
        bf16_t* kp = (bf16_t*)(ws + O_KPEB) + (size_t)slot_of_token(t) * 32;
        kp[lane] = f2bf(o1); kp[16 + lane] = f2bf(o2);
      }
    }
  }
  __syncthreads();
  const int w = wave, cb = 64 * w;
  {
    int r = (tidx() & 31);
    f32x16 acc[3];
    mm32<3, 16>(lds + L2_CQ, 528, (const bf16_t*)(ws + O_WUQ) + (size_t)(96 * w) * 256, 256, lane, acc);
    bf16_t* Q = (bf16_t*)((unsigned char*)p.out + OO_Q);
    const int j = r & 15;
#pragma unroll
    for (int i = 0; i < 16; ++i) {
      const int t = t0 + crow(i, h);
      const float own = acc[2][i], oth = __shfl_xor(own, 16);
      const float c = rope[t * 32 + j], sn = rope[t * 32 + 16 + j];
      acc[2][i] = (r < 16) ? own * c - oth * sn : oth * sn + own * c;
    }
    stage_store16<3>(lds + L2B_STG + w * (32 * 208), lane, Q + (size_t)t0 * 768 + 96 * w, 768, [&](int nt, int i) { return f2bf(acc[nt][i] * QSCALE); });
  }
  __syncthreads();
  kv_expand(p, lds, w, lane, slot_of_token(t0));
  __syncthreads();
}

DI void p2_cache_tile(const Params& p, unsigned char* lds, int ctile) {
  const int tid = tidx(), wave = __builtin_amdgcn_readfirstlane(tid >> 6), lane = tid & 63;
  const int b = ctile >> 5, j0 = (ctile & 31) * 32;
  {
    const int row = tid >> 4, c = (tid & 15) * 8;
    const float* src = p.in[2] + ((size_t)(b * PAST + j0 + row)) * 128 + c;
    f32x4 a = *(const f32x4*)src, d = *(const f32x4*)(src + 4);
    float f[8] = {a[0], a[1], a[2], a[3], d[0], d[1], d[2], d[3]};
    *(u32x4*)(lds + L2_CKV + row * 272 + c * 2) = pack8(f);
  }
  __syncthreads();
  kv_expand(p, lds, wave, lane, NP + b * SKV + j0);
  __syncthreads();
}

DI void phase2(const Params& p, unsigned char* lds) {
  constexpr int NTT = NT / 32, NCT = DB * PAST / 32;
  {
    bf16_t* vT = (bf16_t*)((unsigned char*)p.out + OO_VT);
    for (int id = blockIdx.x * NTHREADS + tidx(); id < 8 * 64 * 64; id += gridDim.x * NTHREADS) vT[(size_t)(id >> 6) * NKVP + NKV + (id & 63)] = 0;
  }
  unsigned* ctr2 = (unsigned*)(p.ws + O_CTR) + 16;
  volatile int* s_itemp = (volatile int*)(lds + LDS_CTRL);
  for (;;) {
    if (tidx() == 0) *s_itemp = (int)atomicAdd(ctr2, 1u);
    __syncthreads();
    const int item = *s_itemp;
    __syncthreads();
    if (item >= 2 * NTT + NCT) break;
    if (item < NTT) p2_token_tile_b(p, lds, item);
    else if (item < 2 * NTT) p2_token_tile_a(p, lds, item - NTT);
    else p2_cache_tile(p, lds, item - 2 * NTT);
  }
}

constexpr int AT_KSTRIDE = 208, AT_VSTRIDE = 136, AT_KBYTES = 64 * AT_KSTRIDE, AT_STAGE = AT_KBYTES + 64 * AT_VSTRIDE;

DI void attn_item(const Params& p, unsigned char* lds, int hd, int qtok0, int nact, int slot0, int ntiles, int nvalid, bool causal) {
  const int tid = tidx(), wave = __builtin_amdgcn_readfirstlane(tid >> 6), lane = tid & 63, r = lane & 31, h = lane >> 5;
  const bf16_t* Q = (const bf16_t*)((const unsigned char*)p.out + OO_Q);
  const bf16_t* knb = (const bf16_t*)(p.ws + O_KNB) + (size_t)hd * NKVP * 64;
  const bf16_t* kpeb = (const bf16_t*)(p.ws + O_KPEB);
  const bf16_t* vT = (const bf16_t*)((const unsigned char*)p.out + OO_VT) + (size_t)hd * 64 * NKVP;
  bf16_t* YB = (bf16_t*)(p.ws + O_YB);
  const bool active = wave < nact;
  const int qtok = qtok0 + 32 * wave;
  const int wlim = !active ? 0 : (causal ? (qtok >> 6) + 1 : ntiles);
  bf16x8 qf[6];
  if (active) {
#pragma unroll
    for (int ks = 0; ks < 6; ++ks) qf[ks] = *(const bf16x8*)(Q + (size_t)(qtok + r) * 768 + 96 * hd + ks * 16 + h * 8);
  } else {
#pragma unroll
    for (int ks = 0; ks < 6; ++ks) qf[ks] = (bf16x8){0, 0, 0, 0, 0, 0, 0, 0};
  }
  f32x16 o0, o1;
#pragma unroll
  for (int i = 0; i < 16; ++i) { o0[i] = 0.f; o1[i] = 0.f; }
  float mrun = 0.f, lsum = 0.f;
  const int k_key = tid >> 3, k_ch = tid & 7;
  const int pe_key = (tid & 255) >> 2, pe_ch = tid & 3;
  const int v_dim = tid >> 3, v_ch = tid & 7;
  u32x4 rk, rpe, rv;
  auto gload = [&](int kt) {
    const int s = slot0 + kt * 64;
    rk = *(const u32x4*)(knb + (size_t)(s + k_key) * 64 + k_ch * 8);
    if (tid < 256) rpe = *(const u32x4*)(kpeb + (size_t)(s + pe_key) * 32 + pe_ch * 8);
    rv = *(const u32x4*)(vT + (size_t)v_dim * NKVP + s + v_ch * 8);
  };
  auto lstore = [&](int buf) {
    unsigned char* b = lds + buf * AT_STAGE;
    *(u32x4*)(b + k_key * AT_KSTRIDE + k_ch * 16) = rk;
    if (tid < 256) *(u32x4*)(b + pe_key * AT_KSTRIDE + 128 + pe_ch * 16) = rpe;
    u32x2 lo = {rv[0], rv[1]}, hi = {rv[2], rv[3]};
    *(u32x2*)(b + AT_KBYTES + v_dim * AT_VSTRIDE + v_ch * 16) = lo;
    *(u32x2*)(b + AT_KBYTES + v_dim * AT_VSTRIDE + v_ch * 16 + 8) = hi;
  };
  gload(0); lstore(0);
  __syncthreads();
  for (int kt = 0; kt < ntiles; ++kt) {
    const bool more = kt + 1 < ntiles;
    if (more) gload(kt + 1);
    if (kt < wlim) {
      const unsigned char* kb = lds + (kt & 1) * AT_STAGE;
      const unsigned char* vb = kb + AT_KBYTES;
      f32x16 s0, s1;
      const float nm = -mrun;
#pragma unroll
      for (int i = 0; i < 16; ++i) { s0[i] = nm; s1[i] = nm; }
#pragma unroll
      for (int ks = 0; ks < 6; ++ks) {
        const bf16x8 a0 = *(const bf16x8*)(kb + r * AT_KSTRIDE + ks * 32 + h * 16);
        const bf16x8 a1 = *(const bf16x8*)(kb + (32 + r) * AT_KSTRIDE + ks * 32 + h * 16);
        s0 = MFMA32(a0, qf[ks], s0);
        s1 = MFMA32(a1, qf[ks], s1);
      }
      if (kt * 64 + 64 > nvalid) {
#pragma unroll
        for (int i = 0; i < 16; ++i) {
          const int key = kt * 64 + crow(i, h);
          if (key >= nvalid) s0[i] = -1e30f;
          if (key + 32 >= nvalid) s1[i] = -1e30f;
        }
      }
      float mx = s0[0];
#pragma unroll
      for (int i = 1; i < 16; ++i) mx = fmaxf(mx, s0[i]);
#pragma unroll
      for (int i = 0; i < 16; ++i) mx = fmaxf(mx, s1[i]);
      mx = fmaxf(mx, __shfl_xor(mx, 32));
      const bool far = fabsf(mx) > 20.f && mx > -1e29f;
      if (__builtin_amdgcn_ballot_w64(far) != 0ull) {
        const float delta = far ? mx : 0.f;
        const float alpha = __builtin_amdgcn_exp2f(-delta);
        mrun += delta; lsum *= alpha;
#pragma unroll
        for (int i = 0; i < 16; ++i) { o0[i] *= alpha; o1[i] *= alpha; s0[i] -= delta; s1[i] -= delta; }
      }
      float rs = 0.f;
#pragma unroll
      for (int i = 0; i < 16; ++i) { s0[i] = __builtin_amdgcn_exp2f(s0[i]); rs += s0[i]; }
#pragma unroll
      for (int i = 0; i < 16; ++i) { s1[i] = __builtin_amdgcn_exp2f(s1[i]); rs += s1[i]; }
      lsum += rs;
#pragma unroll
      for (int mt = 0; mt < 2; ++mt)
#pragma unroll
        for (int s = 0; s < 2; ++s) {
          const f32x16& sv = mt ? s1 : s0;
          u32x4 pw;
          pw[0] = pk2(sv[8 * s], sv[8 * s + 1]); pw[1] = pk2(sv[8 * s + 2], sv[8 * s + 3]);
          pw[2] = pk2(sv[8 * s + 4], sv[8 * s + 5]); pw[3] = pk2(sv[8 * s + 6], sv[8 * s + 7]);
          const bf16x8 pb = __builtin_bit_cast(bf16x8, pw);
          const int kbase = mt * 32 + 16 * s + 4 * h;
          {
            const s16x4 lo = *(const s16x4*)(vb + r * AT_VSTRIDE + kbase * 2);
            const s16x4 hi = *(const s16x4*)(vb + r * AT_VSTRIDE + (kbase + 8) * 2);
            const bf16x8 av = __builtin_shufflevector(lo, hi, 0, 1, 2, 3, 4, 5, 6, 7);
            o0 = MFMA32(av, pb, o0);
          }
          {
            const s16x4 lo = *(const s16x4*)(vb + (32 + r) * AT_VSTRIDE + kbase * 2);
            const s16x4 hi = *(const s16x4*)(vb + (32 + r) * AT_VSTRIDE + (kbase + 8) * 2);
            const bf16x8 av = __builtin_shufflevector(lo, hi, 0, 1, 2, 3, 4, 5, 6, 7);
            o1 = MFMA32(av, pb, o1);
          }
        }
    }
    if (more) lstore((kt + 1) & 1);
    __syncthreads();
  }
  if (active) {
    const float lt = lsum + __shfl_xor(lsum, 32);
    const float inv = 1.f / lt;
    bf16_t* dst = YB + (size_t)(qtok + r) * 512 + hd * 64;
#pragma unroll
    for (int g = 0; g < 4; ++g) {
      u32x2 a, b;
      a[0] = pk2(o0[4 * g] * inv, o0[4 * g + 1] * inv); a[1] = pk2(o0[4 * g + 2] * inv, o0[4 * g + 3] * inv);
      b[0] = pk2(o1[4 * g] * inv, o1[4 * g + 1] * inv); b[1] = pk2(o1[4 * g + 2] * inv, o1[4 * g + 3] * inv);
      *(u32x2*)(dst + 8 * g + 4 * h) = a;
      *(u32x2*)(dst + 32 + 8 * g + 4 * h) = b;
    }
  }
}

constexpr int SC_TOK = 32, SC_ARR = SC_TOK * 64 * 4, SC_STAGE = 6 * SC_ARR;
static_assert(2 * SC_STAGE <= LDS_CTRL, "lds scan");
DI float dpp_sum8(float x) {
  x += __builtin_bit_cast(float, __builtin_amdgcn_update_dpp(0, __builtin_bit_cast(int, x), 0xB1, 0xF, 0xF, true));
  x += __builtin_bit_cast(float, __builtin_amdgcn_update_dpp(0, __builtin_bit_cast(int, x), 0x4E, 0xF, 0xF, true));
  x += __builtin_bit_cast(float, __builtin_amdgcn_update_dpp(0, __builtin_bit_cast(int, x), 0x141, 0xF, 0xF, true));
  return x;
}
DI float hsum4(f32x4 x) { return (x[0] + x[2]) + (x[1] + x[3]); }
template <bool DUAL>
DI void scan_job(const Params& p, unsigned char* lds, int head, int tok0, int nsteps, const float* init  ,
                 bf16_t* Y  , float* state_out  , bf16_t* Y2 = nullptr, float* state2 = nullptr) {
  const int tid = tidx(), wave = __builtin_amdgcn_readfirstlane(tid >> 6), lane = tid & 63;
  const bf16_t* SR = (const bf16_t*)(p.ws + O_SIN);
  const bf16_t* SK = SR + (size_t)NT * 512; const bf16_t* SV = SK + (size_t)NT * 512; const bf16_t* SA = SV + (size_t)NT * 512; const bf16_t* SB = SA + (size_t)NT * 512;
  const _Float16* SW = (const _Float16*)(SB + (size_t)NT * 512);
  u32x4 rg[3];
  auto gload = [&](int c) {
    const int tb = tok0 + c * SC_TOK;
#pragma unroll
    for (int i = 0; i < 3; ++i) {
      const int L = tid + NTHREADS * i, arr = L >> 8, tok = (L & 255) >> 3, ch = L & 7;
      const bf16_t* base = arr == 0 ? SA : arr == 1 ? SB : arr == 2 ? (const bf16_t*)SW : arr == 3 ? SK : arr == 4 ? SR : SV;
      rg[i] = *(const u32x4*)(base + (size_t)(tb + tok) * 512 + head * 64 + ch * 8);
    }
  };
  auto lstore = [&](int buf) {
    unsigned char* b = lds + buf * SC_STAGE;
#pragma unroll
    for (int i = 0; i < 3; ++i) {
      const int L = tid + NTHREADS * i, arr = L >> 8, tok = (L & 255) >> 3, ch = L & 7;
      float f[8];
      if (arr == 2) {
#pragma unroll
        for (int j = 0; j < 4; ++j) {
          const unsigned u = rg[i][j];
          f[2 * j] = (float)__builtin_bit_cast(_Float16, (unsigned short)(u & 0xffffu));
          f[2 * j + 1] = (float)__builtin_bit_cast(_Float16, (unsigned short)(u >> 16));
        }
      } else unpack8(rg[i], f);
      float* d = (float*)(b + arr * SC_ARR + tok * 256 + ch * 32);
      *(f32x4*)d = (f32x4){f[0], f[1], f[2], f[3]};
      *(f32x4*)(d + 4) = (f32x4){f[4], f[5], f[6], f[7]};
    }
  };
  const int rl = lane >> 3, c = lane & 7;
  const int vrow = 8 * wave + rl;
  f32x4 sl = {0.f, 0.f, 0.f, 0.f}, sh = {0.f, 0.f, 0.f, 0.f};
  if (init) { sl = *(const f32x4*)(init + vrow * 64 + 8 * c); sh = *(const f32x4*)(init + vrow * 64 + 8 * c + 4); }
  f32x4 tl, th;
#pragma unroll
  for (int j = 0; j < 4; ++j) { tl[j] = (8 * c + j == vrow) ? 1.f : 0.f; th[j] = (8 * c + 4 + j == vrow) ? 1.f : 0.f; }
  gload(0); lstore(0);
  __syncthreads();
  const int nch = nsteps / SC_TOK;
  for (int ci = 0; ci < nch; ++ci) {
    const bool more = ci + 1 < nch;
    if (more) gload(ci + 1);
    {
      const unsigned char* b = lds + (ci & 1) * SC_STAGE + c * 32;
      const unsigned char* bv = lds + (ci & 1) * SC_STAGE + 5 * SC_ARR + vrow * 4;
      bf16_t* yp = Y + (size_t)(tok0 + ci * SC_TOK + c) * 512 + head * 64 + vrow;
      bf16_t* yp2 = DUAL ? Y2 + (size_t)(tok0 + ci * SC_TOK + c) * 512 + head * 64 + vrow : nullptr;
      f32x4 AL[2], AH[2], BL[2], BH[2], WL[2], WH[2], KL[2], KH[2], RL[2], RH[2]; float V1[2];
#define SC_LOAD(slot, t)                                                                                                        \
      { AL[slot] = *(const f32x4*)(b + 0 * SC_ARR + (t) * 256); AH[slot] = *(const f32x4*)(b + 0 * SC_ARR + (t) * 256 + 16);    \
        BL[slot] = *(const f32x4*)(b + 1 * SC_ARR + (t) * 256); BH[slot] = *(const f32x4*)(b + 1 * SC_ARR + (t) * 256 + 16);    \
        WL[slot] = *(const f32x4*)(b + 2 * SC_ARR + (t) * 256); WH[slot] = *(const f32x4*)(b + 2 * SC_ARR + (t) * 256 + 16);    \
        KL[slot] = *(const f32x4*)(b + 3 * SC_ARR + (t) * 256); KH[slot] = *(const f32x4*)(b + 3 * SC_ARR + (t) * 256 + 16);    \
        RL[slot] = *(const f32x4*)(b + 4 * SC_ARR + (t) * 256); RH[slot] = *(const f32x4*)(b + 4 * SC_ARR + (t) * 256 + 16);    \
        V1[slot] = *(const float*)(bv + (t) * 256); }
      SC_LOAD(0, 0)
      float ysel = 0.f, ysel2 = 0.f;
#pragma unroll
      for (int t = 0; t < SC_TOK; ++t) {
        if (t + 1 < SC_TOK) SC_LOAD((t + 1) & 1, t + 1)
        const f32x4 al = AL[t & 1], ah = AH[t & 1], bl = BL[t & 1], bh = BH[t & 1], wl = WL[t & 1], wh = WH[t & 1], kl = KL[t & 1], kh = KH[t & 1], rlo = RL[t & 1], rhi = RH[t & 1];
        const float vv = V1[t & 1];
        {
          const float sa = dpp_sum8(hsum4(sl * al + sh * ah));
          sl = sl * wl + (sa * bl + vv * kl);
          sh = sh * wh + (sa * bh + vv * kh);
          const float y = dpp_sum8(hsum4(sl * rlo + sh * rhi));
          ysel = (c == (t & 7)) ? y : ysel;
          if ((t & 7) == 7) yp[(size_t)(t - 7) * 512] = f2bf(ysel);
        }
        if (DUAL) {
          const float sa = dpp_sum8(hsum4(tl * al + th * ah));
          tl = tl * wl + sa * bl;
          th = th * wh + sa * bh;
          const float y = dpp_sum8(hsum4(tl * rlo + th * rhi));
          ysel2 = (c == (t & 7)) ? y : ysel2;
          if ((t & 7) == 7) yp2[(size_t)(t - 7) * 512] = f2bf(ysel2);
        }
      }
#undef SC_LOAD
    }
    if (more) lstore((ci + 1) & 1);
    __syncthreads();
  }
  *(f32x4*)(state_out + vrow * 64 + 8 * c) = sl;
  *(f32x4*)(state_out + vrow * 64 + 8 * c + 4) = sh;
  if (DUAL) { *(f32x4*)(state2 + vrow * 64 + 8 * c) = tl; *(f32x4*)(state2 + vrow * 64 + 8 * c + 4) = th; }
}

DI void chain_item(const Params& p, unsigned char* lds, int hd, int q) {
  const int tid = tidx();
  const float* Gb = (const float*)((unsigned char*)p.out + OO_GH);
  const float* Hb = Gb + (size_t)8 * SCC * 4096;
  bf16_t* SST = (bf16_t*)((unsigned char*)p.out + OO_SST);
  float* S = (float*)lds;
  float* Gs = S + 16 * 65 + 3;
  Gs = (float*)lds + 1044;
  const int vl = tid >> 5, v = 16 * q + vl, k0 = (tid & 31) * 2;
  f32x2 cur = *(const f32x2*)(Hb + ((size_t)hd * SCC) * 4096 + v * 64 + k0);
  for (int c = 1; c < SCC; ++c) {
    const float* Gc = Gb + ((size_t)hd * SCC + c) * 4096;
    const f32x4 ga = *(const f32x4*)(Gc + tid * 8), gb2 = *(const f32x4*)(Gc + tid * 8 + 4);
    f32x2 o = *(const f32x2*)(Hb + ((size_t)hd * SCC + c) * 4096 + v * 64 + k0);
    __syncthreads();
    S[vl * 65 + k0] = cur[0]; S[vl * 65 + k0 + 1] = cur[1];
    *(f32x4*)(Gs + tid * 8) = ga; *(f32x4*)(Gs + tid * 8 + 4) = gb2;
    *(unsigned*)(SST + ((size_t)c * 8 + hd) * 4096 + v * 64 + k0) = pk2(cur[0], cur[1]);
    __syncthreads();
#pragma unroll 8
    for (int i = 0; i < 64; ++i) {
      const float sv = S[vl * 65 + i];
      const f32x2 g = *(const f32x2*)(Gs + i * 64 + k0);
      o[0] += sv * g[0]; o[1] += sv * g[1];
    }
    cur = o;
  }
  *(f32x2*)(p.out + F_WKVP + (size_t)hd * 4096 + v * 64 + k0) = cur;
}

constexpr int Q_PSCAN = 8 * SCC, Q_PATT = 512, Q_CHAIN = 32, Q_SATT = 128, Q_SSCAN = 128, Q_TOTAL = Q_PSCAN + Q_PATT + Q_CHAIN + Q_SATT + Q_SSCAN;
DI void phase3(const Params& p, unsigned char* lds) {
  volatile int* s_itemp = (volatile int*)(lds + LDS_CTRL);
  unsigned* ctr = (unsigned*)(p.ws + O_CTR);
  unsigned* sdone = ctr + 32;
  float* Gb = (float*)((unsigned char*)p.out + OO_GH);
  float* Hb = Gb + (size_t)8 * SCC * 4096;
  bf16_t* Y = (bf16_t*)(p.ws + O_Y);
  bf16_t* E = (bf16_t*)(p.ws + O_E);
  for (;;) {
    if (tidx() == 0) *s_itemp = (int)atomicAdd(ctr, 1u);
    __syncthreads();
    const int item = *s_itemp;
    __syncthreads();
    if (item >= Q_TOTAL) break;
    if (item < Q_PSCAN) {
      const int hd = item / SCC, c = item % SCC;
      if (c == 0) scan_job<false>(p, lds, hd, 0, SCL, nullptr, Y, Hb + ((size_t)hd * SCC) * 4096);
      else scan_job<true>(p, lds, hd, c * SCL, SCL, nullptr, Y, Hb + ((size_t)hd * SCC + c) * 4096, E, Gb + ((size_t)hd * SCC + c) * 4096);
      asm volatile("s_waitcnt vmcnt(0)" ::: "memory");
      __syncthreads();
      if (threadIdx.x == 0) {
        __builtin_amdgcn_fence(__ATOMIC_RELEASE, "agent");
        asm volatile("s_waitcnt vmcnt(0)" ::: "memory");
        __hip_atomic_fetch_add(sdone, 1u, __ATOMIC_RELAXED, __HIP_MEMORY_SCOPE_AGENT);
      }
    } else if (item < Q_PSCAN + Q_PATT) {
      const int k = item - Q_PSCAN, qb = 63 - (k >> 3), hd = k & 7;
      attn_item(p, lds, hd, qb * 256, 8, 0, qb * 4 + 4, (qb * 4 + 4) * 64, true);
    } else if (item < Q_PSCAN + Q_PATT + Q_CHAIN) {
      const int k = item - Q_PSCAN - Q_PATT;
      if (threadIdx.x == 0) {
        while (__hip_atomic_load(sdone, __ATOMIC_RELAXED, __HIP_MEMORY_SCOPE_AGENT) < (unsigned)Q_PSCAN) __builtin_amdgcn_s_sleep(4);
        __builtin_amdgcn_fence(__ATOMIC_ACQUIRE, "agent");
        asm volatile("s_waitcnt vmcnt(0)" ::: "memory");
      }
      __syncthreads();
      chain_item(p, lds, k & 7, k >> 3);
    } else if (item < Q_PSCAN + Q_PATT + Q_CHAIN + Q_SATT) {
      const int k = item - Q_PSCAN - Q_PATT - Q_CHAIN, b = k >> 3, hd = k & 7;
      attn_item(p, lds, hd, NP + b * 32, 1, NP + b * SKV, 17, SKV, false);
    } else {
      const int k = item - Q_PSCAN - Q_PATT - Q_CHAIN - Q_SATT, b = k >> 3, hd = k & 7;
      scan_job<false>(p, lds, hd, NP + b * 32, 32, p.in[4] + ((size_t)b * 8 + hd) * 4096, Y, p.out + F_WKVS + ((size_t)b * 8 + hd) * 4096);
    }
  }
}

DI void phase4a(const Params& p) {
  const int tid = tidx(), lane = tid & 63, r = lane & 31, hh = lane >> 5;
  const int gw = (blockIdx.x * NTHREADS + tid) >> 6, ngw = (gridDim.x * NTHREADS) >> 6;
  const bf16_t* Y = (const bf16_t*)(p.ws + O_Y);
  const bf16_t* E = (const bf16_t*)(p.ws + O_E);
  const bf16_t* SST = (const bf16_t*)((unsigned char*)p.out + OO_SST);
  const bf16_t* SV = (const bf16_t*)(p.ws + O_SIN) + 2 * (size_t)NT * 512;
  const bf16_t* G = (const bf16_t*)(p.ws + O_G);
  const float* RK = (const float*)(p.ws + O_RK);
  bf16_t* YA = (bf16_t*)(p.ws + O_YA);
  for (int task = gw; task < (NT / 32) * 8; task += ngw) {
    const int tile = task >> 3, hd = task & 7, t0 = tile * 32, t = t0 + r;
    f32x16 acc[2];
#pragma unroll
    for (int i = 0; i < 16; ++i) { acc[0][i] = 0.f; acc[1][i] = 0.f; }
    const int c = t0 < NP ? t0 / SCL : 0;
    if (c >= 1) {
      const bf16_t* sst = SST + ((size_t)c * 8 + hd) * 4096;
#pragma unroll
      for (int ks = 0; ks < 4; ++ks) {
        const bf16x8 bv = *(const bf16x8*)(E + (size_t)t * 512 + hd * 64 + ks * 16 + hh * 8);
#pragma unroll
        for (int mt = 0; mt < 2; ++mt) {
          const bf16x8 av = *(const bf16x8*)(sst + (mt * 32 + r) * 64 + ks * 16 + hh * 8);
          acc[mt] = MFMA32(av, bv, acc[mt]);
        }
      }
    }
    float sum = 0.f;
#pragma unroll
    for (int mt = 0; mt < 2; ++mt)
#pragma unroll
      for (int g = 0; g < 4; ++g) {
        const u32x2 yv = *(const u32x2*)(Y + (size_t)t * 512 + hd * 64 + mt * 32 + 8 * g + 4 * hh);
        acc[mt][4 * g] += __uint_as_float(yv[0] << 16); acc[mt][4 * g + 1] += __uint_as_float(yv[0] & 0xffff0000u);
        acc[mt][4 * g + 2] += __uint_as_float(yv[1] << 16); acc[mt][4 * g + 3] += __uint_as_float(yv[1] & 0xffff0000u);
        sum += (acc[mt][4 * g] + acc[mt][4 * g + 1]) + (acc[mt][4 * g + 2] + acc[mt][4 * g + 3]);
      }
    sum += __shfl_xor(sum, 32);
    const float mean = sum * (1.f / 64.f);
    float sq = 0.f;
#pragma unroll
    for (int mt = 0; mt < 2; ++mt)
#pragma unroll
      for (int i = 0; i < 16; ++i) { const float d = acc[mt][i] - mean; sq += d * d; }
    sq += __shfl_xor(sq, 32);
    const float rstd = rsqrtf(sq * (1.f / 64.f) + 64e-5f);
    const float bon = RK[(size_t)t * 8 + hd];
#pragma unroll
    for (int mt = 0; mt < 2; ++mt)
#pragma unroll
      for (int g = 0; g < 4; ++g) {
        const int c0 = hd * 64 + mt * 32 + 8 * g + 4 * hh;
        const size_t o = (size_t)t * 512 + c0;
        const f32x4 lg = *(const f32x4*)(p.in[16] + c0), lb = *(const f32x4*)(p.in[17] + c0);
        const u32x2 vv = *(const u32x2*)(SV + o), gg = *(const u32x2*)(G + o);
        const float vf[4] = {__uint_as_float(vv[0] << 16), __uint_as_float(vv[0] & 0xffff0000u), __uint_as_float(vv[1] << 16), __uint_as_float(vv[1] & 0xffff0000u)};
        const float gf[4] = {__uint_as_float(gg[0] << 16), __uint_as_float(gg[0] & 0xffff0000u), __uint_as_float(gg[1] << 16), __uint_as_float(gg[1] & 0xffff0000u)};
        float ov[4];
#pragma unroll
        for (int j = 0; j < 4; ++j) ov[j] = ((acc[mt][4 * g + j] - mean) * rstd * lg[j] + lb[j] + bon * vf[j]) * gf[j];
        u32x2 w; w[0] = pk2(ov[0], ov[1]); w[1] = pk2(ov[2], ov[3]);
        *(u32x2*)(YA + o) = w;
      }
  }
  conv_x(p, (bf16_t*)((unsigned char*)p.out + OO_XB), blockIdx.x * NTHREADS + tidx(), gridDim.x * NTHREADS);
}

DI bool small_tile_of_block(int& m0, int& n0) {
  const int j = blockIdx.x >> 3;
  if (gridDim.x != 256 || (blockIdx.x & 7) != (j & 7)) return false;
  m0 = NP + (j >> 3) * 128; n0 = (j & 7) * 128; return true;
}
template <int TM>
DI void p4_tile(const Params& p, unsigned char* lds, int m0, int n0) {
  const bf16_t* XB = (const bf16_t*)((unsigned char*)p.out + OO_XB);
  const bf16_t* WIN = (const bf16_t*)(p.ws + O_WIN);
  const bf16_t* YA = (const bf16_t*)(p.ws + O_YA);
  const bf16_t* YB = (const bf16_t*)(p.ws + O_YB);
  bf16_t* M = (bf16_t*)(p.ws + O_M);
  const int tid = tidx(), lane = tid & 63, h = lane >> 5, wn = __builtin_amdgcn_readfirstlane(tid >> 6) >> 2;
  f32x16 accg[TM][2], accv[TM][2];
  gemm_mainloop<TM, 2>(YB, 512, (const bf16_t*)(p.ws + O_WPB), 512, 512, m0, n0, 1024, accv, lds);
  gemm_mainloop<TM, 2>(XB, DM, WIN + (size_t)(PABC + 1024) * DM, DM, DM, m0, n0, 1024, accg, lds);
#pragma unroll
  for (int tn = 0; tn < 2; ++tn)
#pragma unroll
    for (int g = 0; g < 4; ++g) {
      const f32x4 bg = *(const f32x4*)(p.in[24] + 1024 + n0 + wn * 64 + tn * 32 + 8 * g + 4 * h);
#pragma unroll
      for (int tm = 0; tm < TM; ++tm)
#pragma unroll
        for (int j = 0; j < 4; ++j) accv[tm][tn][4 * g + j] *= sigmoidf_(accg[tm][tn][4 * g + j] + bg[j]);
      __builtin_amdgcn_sched_barrier(0);
    }
  gemm_mainloop<TM, 2>(XB, DM, WIN + (size_t)PABC * DM, DM, DM, m0, n0, 1024, accg, lds);
#pragma unroll
  for (int tn = 0; tn < 2; ++tn)
#pragma unroll
    for (int g = 0; g < 4; ++g) {
      const f32x4 bg = *(const f32x4*)(p.in[24] + n0 + wn * 64 + tn * 32 + 8 * g + 4 * h);
#pragma unroll
      for (int tm = 0; tm < TM; ++tm)
#pragma unroll
        for (int j = 0; j < 4; ++j) {
          const float e = __expf(-(accg[tm][tn][4 * g + j] + bg[j]));
          accv[tm][tn][4 * g + j] *= (1.f + e);
          accg[tm][tn][4 * g + j] = 1.f / (1.f + e);
        }
      __builtin_amdgcn_sched_barrier(0);
    }
  gemm_mainloop<TM, 2, false>(YA, 512, (const bf16_t*)(p.ws + O_WPA), 512, 512, m0, n0, 1024, accv, lds);
  epilogue_bf16<TM, 2, 128>(accv, lds, M, DM, m0, n0, DM, [&](int tm, int tn, int g, int, int) { return acc4(accg[tm][tn], g) * acc4(accv[tm][tn], g); });
}
DI void phase4(const Params& p, unsigned char* lds) {
  if (gridDim.x == 256) {
    TileIter ti; ti.init(NP / 256, 8);
    int tmi, tni;
    while (ti.next(tmi, tni)) p4_tile<2>(p, lds, tmi * 256, tni * 128);
    int m0, n0;
    if (small_tile_of_block(m0, n0)) p4_tile<1>(p, lds, m0, n0);
  } else {
    TileIter ti; ti.init(NT / 128, 8);
    int tmi, tni;
    while (ti.next(tmi, tni)) p4_tile<1>(p, lds, tmi * 128, tni * 128);
  }
}

template <int TM, int TN, int NST>
DI void p5_tile(const Params& p, unsigned char* lds, int m0, int n0) {
  const bf16_t* M = (const bf16_t*)(p.ws + O_M);
  bf16_t* Z = (bf16_t*)(p.ws + O_Z);
  f32x16 acc[TM][TN];
  gemm_mainloop<TM, TN, true, NST>(M, DM, (const bf16_t*)(p.ws + O_WO), DM, DM, m0, n0, 1024, acc, lds);
  epilogue_bf16<TM, TN, 64 * TN>(acc, lds, Z, DM, m0, n0, DM, [&](int tm, int tn, int g, int rowl, int coll) {
    const f32x4 xv = *(const f32x4*)(xrow(p, m0 + rowl) + n0 + coll);
    return xv * DN_ALPHA + acc4(acc[tm][tn], g);
  });
}
DI void phase5(const Params& p, unsigned char* lds) {
  if (gridDim.x == 256) {
    TileIter ti; ti.init(NP / 256, 4);
    int tmi, tni;
    while (ti.next(tmi, tni)) p5_tile<2, 4, 2>(p, lds, tmi * 256, tni * 256);
    int m0, n0;
    if (small_tile_of_block(m0, n0)) p5_tile<1, 2, 3>(p, lds, m0, n0);
  } else {
    TileIter ti; ti.init(NT / 256, 8);
    int tmi, tni;
    while (ti.next(tmi, tni)) p5_tile<2, 2, 3>(p, lds, tmi * 256, tni * 128);
  }
}
template <bool OUT_BF16>
DI void ln_rows(const bf16_t* src, const float* g, const float* b, bf16_t* dst16, float* dst32) {
  const int gw = (blockIdx.x * NTHREADS + tidx()) >> 6, ngw = (gridDim.x * NTHREADS) >> 6, lane = tidx() & 63;
  for (int t = gw; t < NT; t += ngw) {
    const u32x4* xr = (const u32x4*)(src + (size_t)t * DM) + lane;
    float v[16]; float s = 0.f;
#pragma unroll
    for (int j = 0; j < 2; ++j) { unpack8(xr[64 * j], v + 8 * j); }
#pragma unroll
    for (int j = 0; j < 16; ++j) s += v[j];
    const float mean = wave_sum(s) * (1.f / DM);
    float s2 = 0.f;
#pragma unroll
    for (int j = 0; j < 16; ++j) { v[j] -= mean; s2 += v[j] * v[j]; }
    const float rstd = rsqrtf(wave_sum(s2) * (1.f / DM) + 1e-5f);
#pragma unroll
    for (int j = 0; j < 2; ++j) {
      const int c = 8 * lane + 512 * j;
      const f32x4 g0 = *(const f32x4*)(g + c), g1 = *(const f32x4*)(g + c + 4), b0 = *(const f32x4*)(b + c), b1 = *(const f32x4*)(b + c + 4);
      float o[8];
#pragma unroll
      for (int q = 0; q < 4; ++q) { o[q] = v[8 * j + q] * rstd * g0[q] + b0[q]; o[4 + q] = v[8 * j + 4 + q] * rstd * g1[q] + b1[q]; }
      if (OUT_BF16) *(u32x4*)(dst16 + (size_t)t * DM + c) = pack8(o);
      else { *(f32x4*)(dst32 + (size_t)t * DM + c) = (f32x4){o[0], o[1], o[2], o[3]}; *(f32x4*)(dst32 + (size_t)t * DM + c + 4) = (f32x4){o[4], o[5], o[6], o[7]}; }
    }
  }
}

DI void phase6(const Params& p, unsigned char* lds) {
  const bf16_t* H = (const bf16_t*)(p.ws + O_H);
  bf16_t* ACT = (bf16_t*)(p.ws + O_ACT);
  constexpr int NMT = NT / 256, NNT = 5632 / 256;
  TileIter ti; ti.init(NMT, NNT);
  int tmi, tni;
  while (ti.next(tmi, tni)) {
    const int m0 = tmi * 256, n0 = tni * 256;
    f32x16 acc[2][4];
    gemm_mainloop<2, 4, true, 2>(H, DM, (const bf16_t*)(p.ws + O_WGU), DM, DM, m0, n0, 5632, acc, lds);
    epilogue_bf16<2, 4, 128>(acc, lds, ACT, DFF, m0, tni * 128, DFF, [&](int tm, int q, int g, int, int) {
      f32x4 o;
#pragma unroll
      for (int j = 0; j < 4; ++j) { const float gte = acc[tm][2 * q][4 * g + j], up = acc[tm][2 * q + 1][4 * g + j]; o[j] = gte * sigmoidf_(gte) * up; }
      return o;
    });
  }
}
template <int TM, int TN, int NST>
DI void p7_tile(const Params& p, unsigned char* lds, int m0, int n0) {
  const bf16_t* H = (const bf16_t*)(p.ws + O_H);
  const bf16_t* ACT = (const bf16_t*)(p.ws + O_ACT);
  bf16_t* Z2 = (bf16_t*)(p.ws + O_Z2);
  f32x16 acc[TM][TN];
  gemm_mainloop<TM, TN, true, NST>(ACT, DFF, (const bf16_t*)(p.ws + O_WDN), DFF, DFF, m0, n0, 1024, acc, lds);
  epilogue_bf16<TM, TN, 64 * TN>(acc, lds, Z2, DM, m0, n0, DM, [&](int tm, int tn, int g, int rowl, int coll) {
    const u32x2 hv = *(const u32x2*)(H + (size_t)(m0 + rowl) * DM + n0 + coll);
    const f32x4 hf = {__uint_as_float(hv[0] << 16), __uint_as_float(hv[0] & 0xffff0000u), __uint_as_float(hv[1] << 16), __uint_as_float(hv[1] & 0xffff0000u)};
    return hf * DN_ALPHA + acc4(acc[tm][tn], g);
  });
}
DI void phase7(const Params& p, unsigned char* lds) {
  if (gridDim.x == 256) {
    TileIter ti; ti.init(NP / 256, 4);
    int tmi, tni;
    while (ti.next(tmi, tni)) p7_tile<2, 4, 2>(p, lds, tmi * 256, tni * 256);
    int m0, n0;
    if (small_tile_of_block(m0, n0)) p7_tile<1, 2, 3>(p, lds, m0, n0);
  } else {
    TileIter ti; ti.init(NT / 256, 8);
    int tmi, tni;
    while (ti.next(tmi, tni)) p7_tile<2, 2, 3>(p, lds, tmi * 256, tni * 128);
  }
}

DI void run_phase(const Params& p, unsigned char* lds, int ph) {
  switch (ph) {
    case 0: phase0(p, lds); break;
    case 1: phase1(p, lds); break;
    case 2: phase2(p, lds); break;
    case 3: phase3(p, lds); break;
    case 4: phase4a(p); break;
    case 5: phase4(p, lds); break;
    case 6: phase5(p, lds); break;
    case 7: ln_rows<true>((const bf16_t*)(p.ws + O_Z), p.in[26], p.in[27], (bf16_t*)(p.ws + O_H), nullptr); break;
    case 8: phase6(p, lds); break;
    case 9: phase7(p, lds); break;
    case 10: ln_rows<false>((const bf16_t*)(p.ws + O_Z2), p.in[30], p.in[31], nullptr, p.out + F_Y); break;
  }
}
constexpr int NPHASES = 11;

DI unsigned ctl_ld(unsigned* p) { return __hip_atomic_load(p, __ATOMIC_RELAXED, __HIP_MEMORY_SCOPE_AGENT); }
DI unsigned ctl_add(unsigned* p, unsigned v) { return __hip_atomic_fetch_add(p, v, __ATOMIC_RELAXED, __HIP_MEMORY_SCOPE_AGENT); }
DI void xbar(unsigned* ctl, unsigned x, unsigned nloc, unsigned nx, unsigned k) {
  asm volatile("s_waitcnt vmcnt(0)" ::: "memory");
  __syncthreads();
  if (threadIdx.x == 0) {
    const unsigned old = ctl_add(&ctl[(24 + x) * 64], 1u);
    if (old + 1u == k * nloc) {
      __builtin_amdgcn_fence(__ATOMIC_RELEASE, "agent");
      asm volatile("s_waitcnt vmcnt(0)" ::: "memory");
      ctl_add(&ctl[40 * 64], 1u);
    }
    while (ctl_ld(&ctl[40 * 64]) < k * nx) __builtin_amdgcn_s_sleep(1);
    __builtin_amdgcn_fence(__ATOMIC_ACQUIRE, "agent");
    asm volatile("s_waitcnt vmcnt(0)" ::: "memory");
  }
  __syncthreads();
}

__global__ void __launch_bounds__(NTHREADS) mega_kernel(Params p) {
  extern __shared__ __attribute__((aligned(16))) unsigned char lds[];
  volatile unsigned* s_bar = (volatile unsigned*)(lds + LDS_CTRL + 16);
  cg::grid_group grid = cg::this_grid();
  unsigned* ctl = (unsigned*)(p.ws + O_CTR);
  const unsigned x = (unsigned)__builtin_amdgcn_s_getreg((3 << 11) | 20) & 0xFu;
  if (threadIdx.x == 0) ctl_add(&ctl[(8 + x) * 64], 1u);
  run_phase(p, lds, 0); grid.sync();
  if (threadIdx.x == 0) {
    unsigned nx = 0;
    for (int i = 0; i < 16; ++i) nx += ctl_ld(&ctl[(8 + i) * 64]) != 0u ? 1u : 0u;
    s_bar[0] = ctl_ld(&ctl[(8 + x) * 64]); s_bar[1] = nx;
  }
  __syncthreads();
  const unsigned nloc = __builtin_amdgcn_readfirstlane(s_bar[0]), nx = __builtin_amdgcn_readfirstlane(s_bar[1]);
  run_phase(p, lds, 1); xbar(ctl, x, nloc, nx, 1);
  run_phase(p, lds, 2); xbar(ctl, x, nloc, nx, 2);
  run_phase(p, lds, 3); xbar(ctl, x, nloc, nx, 3);
  run_phase(p, lds, 4); xbar(ctl, x, nloc, nx, 4);
  run_phase(p, lds, 5); xbar(ctl, x, nloc, nx, 5);
  run_phase(p, lds, 6); xbar(ctl, x, nloc, nx, 6);
  run_phase(p, lds, 7); xbar(ctl, x, nloc, nx, 7);
  run_phase(p, lds, 8); xbar(ctl, x, nloc, nx, 8);
  run_phase(p, lds, 9); xbar(ctl, x, nloc, nx, 9);
  run_phase(p, lds, 10);
}
template <int PH> __global__ void __launch_bounds__(NTHREADS) phase_kernel(Params p) {
  extern __shared__ __attribute__((aligned(16))) unsigned char lds[];
  run_phase(p, lds, PH);
}
template <int PH> static void launch_phase(const Params& p, int grid, hipStream_t stream) {
  (void)hipFuncSetAttribute((const void*)phase_kernel<PH>, hipFuncAttributeMaxDynamicSharedMemorySize, LDS_BYTES);
  hipLaunchKernelGGL(phase_kernel<PH>, dim3(grid), dim3(NTHREADS), LDS_BYTES, stream, p);
}

extern "C" void kernel_launch(void* const* d_in, const int* in_sizes, int n_in, void* d_out, int out_size, void* d_ws, size_t ws_size, hipStream_t stream) {
  static int grid_blocks = 0;
  if (grid_blocks == 0) {
    if (n_in != 32 || ws_size < WS_END) { fprintf(stderr, "kernel_launch: unexpected n_in %d or ws_size %zu (< %zu)\n", n_in, ws_size, (size_t)WS_END); grid_blocks = -1; return; }
    int dev = 0, cus = 0, per_cu = 0;
    (void)hipGetDevice(&dev);
    (void)hipDeviceGetAttribute(&cus, hipDeviceAttributeMultiprocessorCount, dev);
#if MULTI_LAUNCH
    per_cu = 1;
#else
    (void)hipFuncSetAttribute((const void*)mega_kernel, hipFuncAttributeMaxDynamicSharedMemorySize, LDS_BYTES);
    (void)hipOccupancyMaxActiveBlocksPerMultiprocessor(&per_cu, (const void*)mega_kernel, NTHREADS, LDS_BYTES);
#endif
    if (per_cu < 1) { fprintf(stderr, "kernel_launch: occupancy query gave %d\n", per_cu); grid_blocks = -1; return; }
    grid_blocks = cus;
  }
  if (grid_blocks < 0) return;
  Params p{};
  for (int i = 0; i < 32; ++i) p.in[i] = (const float*)d_in[i];
  p.out = (float*)d_out;
  p.ws = (unsigned char*)d_ws;
#if MULTI_LAUNCH
  launch_phase<0>(p, grid_blocks, stream); launch_phase<1>(p, grid_blocks, stream); launch_phase<2>(p, grid_blocks, stream); launch_phase<3>(p, grid_blocks, stream);
  launch_phase<4>(p, grid_blocks, stream); launch_phase<5>(p, grid_blocks, stream); launch_phase<6>(p, grid_blocks, stream); launch_phase<7>(p, grid_blocks, stream);
  launch_phase<8>(p, grid_blocks, stream); launch_phase<9>(p, grid_blocks, stream); launch_phase<10>(p, grid_blocks, stream);
#else
  (void)hipMemsetAsync((unsigned char*)d_ws + O_CTR, 0, 16384, stream);
  void* args[] = {&p};
  hipError_t e = hipLaunchCooperativeKernel((void*)mega_kernel, dim3(grid_blocks), dim3(NTHREADS), args, LDS_BYTES, stream);
  if (e != hipSuccess) fprintf(stderr, "cooperative launch failed: %s (grid %d)\n", hipGetErrorString(e), grid_blocks);
#endif
}
```

```cpp
#include <hip/hip_runtime.h>
#include <hip/hip_cooperative_groups.h>
#include <cstdio>
#include <cstdint>
namespace cg = cooperative_groups;


#ifndef PROBE_DUP
#define PROBE_DUP -1
#endif
#ifndef MULTI_LAUNCH
#define MULTI_LAUNCH 0
#endif

#define DI __device__ __forceinline__
typedef unsigned short bf16_t;
typedef short bf16x8 __attribute__((ext_vector_type(8)));
typedef short s16x4 __attribute__((ext_vector_type(4)));
typedef float f32x16 __attribute__((ext_vector_type(16)));
typedef float f32x4 __attribute__((ext_vector_type(4)));
typedef float f32x2 __attribute__((ext_vector_type(2)));
typedef unsigned u32x4 __attribute__((ext_vector_type(4)));
typedef unsigned u32x2 __attribute__((ext_vector_type(2)));
typedef __bf16 bf2_t __attribute__((ext_vector_type(2)));

constexpr int NP = 16384, NS = 512, NT = NP + NS;
constexpr int DM = 1024, ACOLS = 1792, BCOLS = 416, PABC = ACOLS + BCOLS  , NIN = 4256;
constexpr int DFF = 2816;
constexpr int PAST = 1024, DSEQ = 32, DB = 16, SKV = PAST + DSEQ  ;
constexpr int NKV = NP + DB * SKV  , NKVP = NKV + 64;
constexpr float DN_ALPHA = 1.189207115002721f;
constexpr float QSCALE = 0.10206207261596575f * 1.4426950408889634f;

constexpr size_t al256(size_t x) { return (x + 255) & ~(size_t)255; }
constexpr size_t O_WIN = 0;
constexpr size_t O_WUQ = O_WIN + al256((size_t)NIN * 1024 * 2);
constexpr size_t O_WUKV = O_WUQ + al256(768 * 256 * 2);
constexpr size_t O_WPA = O_WUKV + al256(1024 * 128 * 2);
constexpr size_t O_WPB = O_WPA + al256(1024 * 512 * 2);
constexpr size_t O_WO = O_WPB + al256(1024 * 512 * 2);
constexpr size_t O_WGU = O_WO + al256(1024 * 1024 * 2);
constexpr size_t O_WDN = O_WGU + al256((size_t)5632 * 1024 * 2);
constexpr size_t O_WW2 = O_WDN + al256((size_t)1024 * 2816 * 2);
constexpr size_t O_WA2 = O_WW2 + al256(512 * 64 * 2);
constexpr size_t O_WG2 = O_WA2 + al256(512 * 64 * 2);
constexpr size_t O_ROPE = O_WG2 + al256(512 * 128 * 2);
constexpr size_t O_CTR = O_ROPE + al256((size_t)NT * 32 * 4);
constexpr size_t O_PAB = O_CTR + 16384;
constexpr size_t SZ_T512 = (size_t)NT * 512 * 2;
constexpr size_t O_SIN = O_PAB + al256((size_t)NT * PABC * 2);
constexpr size_t O_G = O_SIN + 6 * SZ_T512;
constexpr size_t O_RK = O_G + SZ_T512;
constexpr size_t O_KNB = O_RK + al256((size_t)NT * 8 * 4);
constexpr size_t O_KPEB = O_KNB + al256((size_t)8 * NKVP * 64 * 2);
constexpr int SCC = 16, SCL = NP / SCC;
constexpr size_t WS_END = O_KPEB + al256((size_t)NKVP * 32 * 2);
constexpr size_t O_Y = O_PAB;
constexpr size_t O_E = O_Y + SZ_T512;
constexpr size_t O_YB = O_Y + (size_t)NT * 512 * 4;
constexpr size_t O_YA = O_YB + SZ_T512;
constexpr size_t O_H = O_PAB;
constexpr size_t O_M = O_SIN;
constexpr size_t O_Z = O_SIN + (size_t)NT * 1024 * 2;
constexpr size_t O_Z2 = O_PAB + (size_t)NT * 1024 * 2;
constexpr size_t O_ACT = O_SIN;
constexpr size_t OO_XB = 0;
constexpr size_t OO_Q = 0;
constexpr size_t OO_VT = (size_t)NT * 768 * 2;
constexpr size_t OO_GH = OO_VT + (size_t)8 * 64 * NKVP * 2;
constexpr size_t OO_SST = OO_GH + 2 * (size_t)8 * SCC * 4096 * 4;
static_assert(OO_SST + (size_t)SCC * 8 * 4096 * 2 <= (size_t)NT * 1024 * 4, "d_out scratch");
constexpr size_t F_Y = 0, F_CKVP = (size_t)NT * 1024, F_KPEP = F_CKVP + (size_t)NP * 128, F_WKVP = F_KPEP + (size_t)NP * 32,
                 F_SHP = F_WKVP + 32768, F_CKVS = F_SHP + 1792, F_KPES = F_CKVS + (size_t)NS * 128, F_WKVS = F_KPES + (size_t)NS * 32,
                 F_SHS = F_WKVS + (size_t)DB * 32768;

constexpr int LDS_CTRL = 3 * 49152;
constexpr int LDS_BYTES = LDS_CTRL + 256;
constexpr int NTHREADS = 512;

struct Params {
  const float* in[32];
  float* out;
  unsigned char* ws;
};

DI int tidx() { int t = threadIdx.x; asm volatile("" : "+v"(t)); return t; }
DI unsigned pk2(float a, float b) { f32x2 v = {a, b}; bf2_t r = __builtin_convertvector(v, bf2_t); return __builtin_bit_cast(unsigned, r); }
DI bf16_t f2bf(float a) { return (bf16_t)(pk2(a, 0.f) & 0xffffu); }
DI float bf2f(bf16_t x) { return __uint_as_float(((unsigned)x) << 16); }
DI void unpack8(u32x4 v, float* f) {
#pragma unroll
  for (int j = 0; j < 4; ++j) { f[2 * j] = __uint_as_float(v[j] << 16); f[2 * j + 1] = __uint_as_float(v[j] & 0xffff0000u); }
}
DI u32x4 pack8(const float* f) { u32x4 o; o[0] = pk2(f[0], f[1]); o[1] = pk2(f[2], f[3]); o[2] = pk2(f[4], f[5]); o[3] = pk2(f[6], f[7]); return o; }
DI float sigmoidf_(float x) { return __builtin_amdgcn_rcpf(1.f + __expf(-x)); }
DI float dpp_sum16(float x) {
  x += __builtin_bit_cast(float, __builtin_amdgcn_update_dpp(0, __builtin_bit_cast(int, x), 0xB1, 0xF, 0xF, true));
  x += __builtin_bit_cast(float, __builtin_amdgcn_update_dpp(0, __builtin_bit_cast(int, x), 0x4E, 0xF, 0xF, true));
  x += __builtin_bit_cast(float, __builtin_amdgcn_update_dpp(0, __builtin_bit_cast(int, x), 0x141, 0xF, 0xF, true));
  x += __builtin_bit_cast(float, __builtin_amdgcn_update_dpp(0, __builtin_bit_cast(int, x), 0x140, 0xF, 0xF, true));
  return x;
}
DI float sum32(float x) { x = dpp_sum16(x); x += __shfl_xor(x, 16); return x; }
DI float wave_sum(float v) {
#pragma unroll
  for (int o = 1; o < 64; o <<= 1) v += __shfl_xor(v, o);
  return v;
}
DI int crow(int i, int h) { return (i & 3) + 8 * (i >> 2) + 4 * h; }
#define MFMA32(a, b, c) __builtin_amdgcn_mfma_f32_32x32x16_bf16((a), (b), (c), 0, 0, 0)
DI int slot_of_token(int t) { return t < NP ? t : NP + ((t - NP) >> 5) * SKV + PAST + ((t - NP) & 31); }
DI const float* xrow(const Params& p, int t) { return t < NP ? p.in[0] + (size_t)t * DM : p.in[1] + (size_t)(t - NP) * DM; }

DI void conv_T(const float* W, int K, int N, bf16_t* WT, int mode, int gtid, int gsz) {
  const int ntask = (K / 8) * N;
  for (int id = gtid; id < ntask; id += gsz) {
    const int kc = id / N, n = id - kc * N, k0 = kc * 8;
    float f[8];
#pragma unroll
    for (int j = 0; j < 8; ++j) f[j] = W[(size_t)(k0 + j) * N + n];
    if (mode == 2) {
      *(u32x4*)(WT + ((size_t)((n >> 5) * (K >> 4) + (k0 >> 4)) * 64 + ((k0 >> 3) & 1) * 32 + (n & 31)) * 8) = pack8(f);
      continue;
    }
    int row = n;
    if (mode == 1) { const int nt = n >= DFF ? 1 : 0, j = n - nt * DFF; row = 128 * (j >> 6) + 64 * ((j & 63) >> 5) + 32 * nt + (j & 31); }
    *(u32x4*)(WT + (size_t)row * K + k0) = pack8(f);
  }
}
DI void conv_T_lds(const float* W, int K, int N, bf16_t* WT, int mode, unsigned char* lds, int gw, int ngw, int wave, int lane) {
  float* scr = (float*)(lds + wave * (64 * 33 * 4));
  const int nblk = N >> 5, nitem = (K >> 6) * nblk;
  for (int item = gw; item < nitem; item += ngw) {
    const int kb = item / nblk, nb = item - kb * nblk, k0 = kb * 64, n0 = nb * 32;
#pragma unroll 8
    for (int i = 0; i < 32; ++i) { const int kk = 2 * i + (lane >> 5); scr[kk * 33 + (lane & 31)] = W[(size_t)(k0 + kk) * N + n0 + (lane & 31)]; }
    asm volatile("s_waitcnt lgkmcnt(0)" ::: "memory");
    const int c = lane & 7;
#pragma unroll
    for (int j = 0; j < 4; ++j) {
      const int nl = (lane >> 3) + 8 * j;
      const float* sp = scr + (8 * c) * 33 + nl;
      float f[8];
#pragma unroll
      for (int q = 0; q < 8; ++q) f[q] = sp[q * 33];
      int row = n0 + nl;
      if (mode == 1) { const int nt = row >= DFF ? 1 : 0, jj = row - nt * DFF; row = 256 * (jj >> 7) + 128 * ((jj & 127) >> 6) + 32 * (2 * ((jj & 63) >> 5) + nt) + (jj & 31); }
      *(u32x4*)(WT + (size_t)row * K + k0 + 8 * c) = pack8(f);
    }
    asm volatile("s_waitcnt lgkmcnt(0)" ::: "memory");
  }
}
DI void conv_x(const Params& p, bf16_t* XB, int gtid, int gsz) {
  for (int id = gtid; id < NT * 128; id += gsz) {
    const int t = id >> 7, c = (id & 127) * 8;
    const float* src = xrow(p, t) + c;
    f32x4 a = *(const f32x4*)src, b = *(const f32x4*)(src + 4);
    float f[8] = {a[0], a[1], a[2], a[3], b[0], b[1], b[2], b[3]};
    *(u32x4*)(XB + (size_t)t * DM + c) = pack8(f);
  }
}
DI void phase0(const Params& p, unsigned char* lds) {
  const int tid0 = tidx(), gtid = blockIdx.x * NTHREADS + tid0, gsz = gridDim.x * NTHREADS;
  const int wave0 = __builtin_amdgcn_readfirstlane(tid0 >> 6), lane0 = tid0 & 63, gw = blockIdx.x * 8 + wave0, ngw = gridDim.x * 8;
  unsigned char* ws = p.ws;
  if (gtid < 64) ((unsigned*)(ws + O_CTR))[gtid] = 0u;
  conv_T_lds(p.in[6], 1024, NIN, (bf16_t*)(ws + O_WIN), 0, lds, gw, ngw, wave0, lane0);
  conv_T(p.in[20], 256, 768, (bf16_t*)(ws + O_WUQ), 2, gtid, gsz);
  conv_T(p.in[22], 128, 1024, (bf16_t*)(ws + O_WUKV), 2, gtid, gsz);
  conv_T_lds(p.in[18], 512, 1024, (bf16_t*)(ws + O_WPA), 0, lds, gw, ngw, wave0, lane0);
  conv_T_lds(p.in[23], 512, 1024, (bf16_t*)(ws + O_WPB), 0, lds, gw, ngw, wave0, lane0);
  conv_T_lds(p.in[25], 1024, 1024, (bf16_t*)(ws + O_WO), 0, lds, gw, ngw, wave0, lane0);
  conv_T_lds(p.in[28], 1024, 5632, (bf16_t*)(ws + O_WGU), 1, lds, gw, ngw, wave0, lane0);
  conv_T_lds(p.in[29], 2816, 1024, (bf16_t*)(ws + O_WDN), 0, lds, gw, ngw, wave0, lane0);
  conv_T(p.in[9], 64, 512, (bf16_t*)(ws + O_WW2), 2, gtid, gsz);
  conv_T(p.in[11], 64, 512, (bf16_t*)(ws + O_WA2), 2, gtid, gsz);
  conv_T(p.in[12], 128, 512, (bf16_t*)(ws + O_WG2), 2, gtid, gsz);
  conv_x(p, (bf16_t*)((unsigned char*)p.out + OO_XB), gtid, gsz);
  float* rope = (float*)(ws + O_ROPE);
  for (int id = gtid; id < NT * 16; id += gsz) {
    const int t = id >> 4, j = id & 15;
    const int pos = t < NP ? t : PAST + ((t - NP) & 31);
    const float inv = (float)exp2(-(double)j * (13.287712379549449 / 16.0));
    const float ang = (float)pos * inv;
    const double x = (double)ang;
    const double n = rint(x * 0.15915494309189535);
    const float red = (float)(x - n * 6.283185307179586);
    rope[t * 32 + j] = __cosf(red);
    rope[t * 32 + 16 + j] = __sinf(red);
  }
  bf16_t* kpeb = (bf16_t*)(ws + O_KPEB);
  for (int id = gtid; id < DB * PAST * 4; id += gsz) {
    const int row = id >> 2, ch = id & 3, b = row >> 10, j = row & 1023;
    const float* src = p.in[3] + (size_t)row * 32 + ch * 8;
    f32x4 a = *(const f32x4*)src, c = *(const f32x4*)(src + 4);
    float f[8] = {a[0], a[1], a[2], a[3], c[0], c[1], c[2], c[3]};
    *(u32x4*)(kpeb + (size_t)(NP + b * SKV + j) * 32 + ch * 8) = pack8(f);
  }
  bf16_t* knb = (bf16_t*)(ws + O_KNB);
  for (int id = gtid; id < 64 * 32; id += gsz) kpeb[(size_t)NKV * 32 + id] = 0;
  for (int id = gtid; id < 8 * 64 * 64; id += gsz) {
    const int h = id >> 12, rem = id & 4095;
    knb[((size_t)h * NKVP + NKV) * 64 + rem] = 0;
  }
}

template <int TM, int TN, bool ZERO = true, int NST = 3>
DI void gemm_mainloop(const bf16_t* __restrict__ A, int lda, const bf16_t* __restrict__ Bt, int ldb, int K, int m0, int n0, int nmax,
                      f32x16 (&acc)[TM][TN], unsigned char* lds) {
  constexpr int BM = 128 * TM, BN = 64 * TN, AG = BM / 64, BG = BN / 64, NLD = AG + BG;
  constexpr int ABYTES = BM * 128, STAGE = (BM + BN) * 128;
  static_assert(NST * STAGE <= LDS_CTRL && (NST == 2 || NST == 3), "lds");
  const int tid = tidx(), wave = __builtin_amdgcn_readfirstlane(tid >> 6), lane = tid & 63, r = lane & 31, h = lane >> 5, wm = wave & 3, wn = wave >> 2;
  const int lrow = lane >> 3, lpos = lane & 7;
  const bf16_t* ap[AG]; const bf16_t* bp[BG];
#pragma unroll
  for (int i = 0; i < AG; ++i) { const int row = (wave * AG + i) * 8 + lrow, c = lpos ^ ((row >> 1) & 7); ap[i] = A + (size_t)(m0 + row) * lda + c * 8; }
#pragma unroll
  for (int i = 0; i < BG; ++i) { const int row = (wave * BG + i) * 8 + lrow, c = lpos ^ ((row >> 1) & 7); int br = n0 + row; br = br < nmax ? br : nmax - 1; bp[i] = Bt + (size_t)br * ldb + c * 8; }
  if (ZERO) {
#pragma unroll
    for (int tm = 0; tm < TM; ++tm)
#pragma unroll
      for (int tn = 0; tn < TN; ++tn)
#pragma unroll
        for (int i = 0; i < 16; ++i) acc[tm][tn][i] = 0.f;
  }
  auto issue = [&](int kt, int stage) {
    unsigned char* sb = lds + stage * STAGE;
#pragma unroll
    for (int i = 0; i < AG; ++i) __builtin_amdgcn_global_load_lds((const unsigned*)(ap[i] + kt * 64), (unsigned*)(sb + (wave * AG + i) * 1024), 16, 0, 0);
#pragma unroll
    for (int i = 0; i < BG; ++i) __builtin_amdgcn_global_load_lds((const unsigned*)(bp[i] + kt * 64), (unsigned*)(sb + ABYTES + (wave * BG + i) * 1024), 16, 0, 0);
  };
  const int swz = (r >> 1) & 7;
  int koff[4];
#pragma unroll
  for (int ks = 0; ks < 4; ++ks) koff[ks] = ((ks * 2 + h) ^ swz) * 16;
  const int a_rd = (wm * 32 * TM + r) * 128, b_rd = ABYTES + (wn * 32 * TN + r) * 128;
  const int nk = K >> 6;
  asm volatile("s_waitcnt vmcnt(0)" ::: "memory");
  issue(0, 0);
  if (NST == 3) issue(1, 1);
  for (int kt = 0; kt < nk; ++kt) {
    if (NST == 3 && kt + 1 < nk) asm volatile("s_waitcnt vmcnt(%0)" ::"n"(NLD) : "memory");
    else asm volatile("s_waitcnt vmcnt(0)" ::: "memory");
    asm volatile("s_waitcnt lgkmcnt(0)" ::: "memory");
    __builtin_amdgcn_s_barrier();
    if (NST == 3) { if (kt + 2 < nk) issue(kt + 2, (kt + 2) % 3); }
    else { if (kt + 1 < nk) issue(kt + 1, (kt + 1) & 1); }
    const unsigned char* cur = lds + (kt % NST) * STAGE;
#pragma unroll
    for (int ks = 0; ks < 4; ++ks) {
      bf16x8 af[TM], bfr[TN];
#pragma unroll
      for (int tm = 0; tm < TM; ++tm) af[tm] = *(const bf16x8*)(cur + a_rd + tm * 4096 + koff[ks]);
#pragma unroll
      for (int tn = 0; tn < TN; ++tn) bfr[tn] = *(const bf16x8*)(cur + b_rd + tn * 4096 + koff[ks]);
#pragma unroll
      for (int tm = 0; tm < TM; ++tm)
#pragma unroll
        for (int tn = 0; tn < TN; ++tn) acc[tm][tn] = MFMA32(bfr[tn], af[tm], acc[tm][tn]);
    }
  }
  asm volatile("s_waitcnt lgkmcnt(0)" ::: "memory");
  __builtin_amdgcn_s_barrier();
}

template <int TM, int TN, int OUTC, class F>
DI void epilogue_bf16(const f32x16 (&acc)[TM][TN], unsigned char* lds, bf16_t* out, int ldo, int m0, int c0, int cmax, F f) {
  constexpr int BM = 128 * TM, STRIDE = OUTC * 2 + 16, TNO = OUTC / (32 * 2);
  const int tid = tidx(), wave = __builtin_amdgcn_readfirstlane(tid >> 6), lane = tid & 63, r = lane & 31, h = lane >> 5, wm = wave & 3, wn = wave >> 2;
#pragma unroll
  for (int tm = 0; tm < TM; ++tm)
#pragma unroll
    for (int tn = 0; tn < TNO; ++tn)
#pragma unroll
      for (int g = 0; g < 4; ++g) {
        const int rowl = wm * 32 * TM + tm * 32 + r, coll = wn * 32 * TNO + tn * 32 + 8 * g + 4 * h;
        const f32x4 o = f(tm, tn, g, rowl, coll);
        u32x2 w; w[0] = pk2(o[0], o[1]); w[1] = pk2(o[2], o[3]);
        *(u32x2*)(lds + rowl * STRIDE + coll * 2) = w;
      }
  __syncthreads();
  constexpr int CPR = OUTC / 8;
#pragma unroll
  for (int j = 0; j < BM * CPR / NTHREADS; ++j) {
    const int id = tid + NTHREADS * j, row = id / CPR, c = id % CPR;
    if (c0 + c * 8 < cmax) *(u32x4*)(out + (size_t)(m0 + row) * ldo + c0 + c * 8) = *(const u32x4*)(lds + row * STRIDE + c * 16);
  }
  __syncthreads();
}
DI f32x4 acc4(const f32x16& a, int g) { return (f32x4){a[4 * g], a[4 * g + 1], a[4 * g + 2], a[4 * g + 3]}; }

struct TileIter {
  int nM, nN, total, L, Lend, step;
  DI void init(int nM_, int nN_) {
    nM = nM_; nN = nN_; total = nM * nN;
    const int nx = (gridDim.x & 7) == 0 ? 8 : 1, x = blockIdx.x % nx, local = blockIdx.x / nx;
    step = gridDim.x / nx;
    const int per = (total + nx - 1) / nx;
    L = x * per + local; Lend = (x + 1) * per < total ? (x + 1) * per : total;
  }
  DI bool next(int& tmi, int& tni) {
    if (L >= Lend) return false;
    const int fb = nM >> 2, fullcnt = fb * 4 * nN;
    if (L < fullcnt) { const int band = L / (4 * nN), jj = L - band * 4 * nN; tni = jj >> 2; tmi = band * 4 + (jj & 3); }
    else { const int l2 = L - fullcnt, bm = nM & 3; tni = l2 / bm; tmi = fb * 4 + l2 % bm; }
    L += step; return true;
  }
};

DI void phase1(const Params& p, unsigned char* lds) {
  const bf16_t* XB = (const bf16_t*)((unsigned char*)p.out + OO_XB);
  const bf16_t* WT = (const bf16_t*)(p.ws + O_WIN);
  bf16_t* PAB = (bf16_t*)(p.ws + O_PAB);
  constexpr int NMT = NT / 256, NNT = (PABC + 127) / 128;
  const int lane = tidx() & 63, wave = __builtin_amdgcn_readfirstlane(tidx() >> 6), r = lane & 31, h = lane >> 5, wm = wave & 3, wn = wave >> 2;
  TileIter ti; ti.init(NMT, NNT);
  int tmi, tni;
  while (ti.next(tmi, tni)) {
    const int m0 = tmi * 256, n0 = tni * 128;
    f32x16 acc[2][2];
    gemm_mainloop<2, 2>(XB, DM, WT, DM, DM, m0, n0, PABC, acc, lds);
    if (m0 + 256 > NP - 1 && n0 < ACOLS) {
#pragma unroll
      for (int tm = 0; tm < 2; ++tm) {
        const int row = m0 + wm * 64 + tm * 32 + r;
        const bool lastp = row == NP - 1, lasts = row >= NP && ((row - NP) & 31) == 31;
        if (lastp || lasts) {
          float* dst = lastp ? p.out + F_SHP : p.out + F_SHS + (size_t)((row - NP) >> 5) * ACOLS;
#pragma unroll
          for (int tn = 0; tn < 2; ++tn)
#pragma unroll
            for (int g = 0; g < 4; ++g) {
              const int col = n0 + wn * 64 + tn * 32 + 8 * g + 4 * h;
              if (col < ACOLS) *(f32x4*)(dst + col) = acc4(acc[tm][tn], g);
            }
        }
      }
    }
    epilogue_bf16<2, 2, 128>(acc, lds, PAB, PABC, m0, n0, PABC, [&](int tm, int tn, int g, int, int) { return acc4(acc[tm][tn], g); });
  }
}

constexpr int L2_LORA = 0, L2_K = L2_LORA + 32 * 528, L2_R = L2_K + 32 * 1040, L2A_STG = L2_R + 32 * 1040, L2A_END = L2A_STG + 8 * 32 * 144;
constexpr int L2_CQ = 0, L2_CKV = L2_CQ + 32 * 528, L2B_STG = L2_CKV + 32 * 272, L2B_END = L2B_STG + 8 * 32 * 208;
static_assert(L2A_END <= LDS_BYTES && L2B_END <= LDS_BYTES, "lds p2");
template <int NTL, class F>
DI void stage_store16(unsigned char* stg, int lane, bf16_t* dst  , unsigned row_stride  , F f) {
  constexpr int RS = NTL * 64 + 16, CPR = NTL * 4;
  const int r = lane & 31, h = lane >> 5;
#pragma unroll
  for (int nt = 0; nt < NTL; ++nt)
#pragma unroll
    for (int i = 0; i < 16; ++i) *(unsigned short*)(stg + crow(i, h) * RS + (nt * 32 + r) * 2) = f(nt, i);
  __syncthreads();
#pragma unroll
  for (int j = 0; j < 32 * CPR / 64; ++j) {
    const int id = lane + 64 * j, row = id / CPR, ch = id % CPR;
    *(u32x4*)(dst + (size_t)row * row_stride + ch * 8) = *(const u32x4*)(stg + row * RS + ch * 16);
  }
  __syncthreads();
}

template <int NTL, int KS>
DI void mm32(const unsigned char* ldsA, int strideB, const bf16_t* Bt, int ldb, int lane, f32x16 (&acc)[NTL]) {
  constexpr int KG = (NTL * KS <= 16) ? KS : (NTL <= 2 ? 4 : 2), NG = KS / KG;
  const int r = lane & 31, h = lane >> 5;
#pragma unroll
  for (int nt = 0; nt < NTL; ++nt)
#pragma unroll
    for (int i = 0; i < 16; ++i) acc[nt][i] = 0.f;
  bf16x8 bq[2][KG][NTL];
  const bf16_t* bp = Bt + lane * 8;
#pragma unroll
  for (int k = 0; k < KG; ++k)
#pragma unroll
    for (int nt = 0; nt < NTL; ++nt) bq[0][k][nt] = *(const bf16x8*)(bp + (size_t)(nt * KS + k) * 512);
#pragma unroll
  for (int g = 0; g < NG; ++g) {
    if (g + 1 < NG) {
#pragma unroll
      for (int k = 0; k < KG; ++k)
#pragma unroll
        for (int nt = 0; nt < NTL; ++nt) bq[(g + 1) & 1][k][nt] = *(const bf16x8*)(bp + (size_t)(nt * KS + (g + 1) * KG + k) * 512);
    }
    __builtin_amdgcn_sched_barrier(0);
#pragma unroll
    for (int k = 0; k < KG; ++k) {
      const bf16x8 a = *(const bf16x8*)(ldsA + r * strideB + (g * KG + k) * 32 + h * 16);
#pragma unroll
      for (int nt = 0; nt < NTL; ++nt) acc[nt] = MFMA32(a, bq[g & 1][k][nt], acc[nt]);
    }
    __builtin_amdgcn_sched_barrier(0);
  }
}

DI void kv_expand(const Params& p, unsigned char* lds, int w, int lane, int slot0) {
  const int r = lane & 31, h = lane >> 5;
  bf16_t* knb = (bf16_t*)(p.ws + O_KNB);
  bf16_t* vT = (bf16_t*)((unsigned char*)p.out + OO_VT);
  f32x16 acc[4];
  mm32<4, 8>(lds + L2_CKV, 272, (const bf16_t*)(p.ws + O_WUKV) + (size_t)(128 * w) * 128, 128, lane, acc);
  stage_store16<2>((unsigned char*)lds + L2B_STG + w * (32 * 208), lane, knb + ((size_t)w * NKVP + slot0) * 64, 64, [&](int nt, int i) { return f2bf(acc[nt][i]); });
#pragma unroll
  for (int nt = 2; nt < 4; ++nt)
#pragma unroll
    for (int g = 0; g < 4; ++g) {
      u32x2 o; o[0] = pk2(acc[nt][4 * g], acc[nt][4 * g + 1]); o[1] = pk2(acc[nt][4 * g + 2], acc[nt][4 * g + 3]);
      *(u32x2*)(vT + ((unsigned)w * 64 + (nt - 2) * 32 + r) * (unsigned)NKVP + slot0 + 8 * g + 4 * h) = o;
    }
}

DI void p2_token_tile_a(const Params& p, unsigned char* lds, int tile) {
  const int tid = tidx(), wave = __builtin_amdgcn_readfirstlane(tid >> 6), lane = tid & 63, r = lane & 31, h = lane >> 5;
  const int t0 = tile * 32;
  unsigned char* ws = p.ws;
  const bf16_t* PAB = (const bf16_t*)(ws + O_PAB);
  bf16_t* SR = (bf16_t*)(ws + O_SIN);
  bf16_t* SK = SR + (size_t)NT * 512; bf16_t* SV = SK + (size_t)NT * 512; bf16_t* SA = SV + (size_t)NT * 512; bf16_t* SB = SA + (size_t)NT * 512;
  _Float16* SW = (_Float16*)(SB + (size_t)NT * 512);
  bf16_t* G = (bf16_t*)(ws + O_G);
  float* RK = (float*)(ws + O_RK);
  const float* rope = (const float*)(ws + O_ROPE);
#pragma unroll 1
  for (int bt = 0; bt < 2; ++bt) {
    u32x4 rawp[7], rawq[7];
#pragma unroll
    for (int it = 0; it < 7; ++it) {
      const int task = tid + NTHREADS * (bt * 7 + it);
      const int tl = task / 224, ch = task - tl * 224, c0 = ch * 8, t = t0 + tl;
      rawp[it] = *(const u32x4*)(PAB + (size_t)t * PABC + c0);
      rawq[it] = *(const u32x4*)(PAB + (size_t)(t > 0 ? t - 1 : 0) * PABC + c0);
    }
#pragma unroll
    for (int it = 0; it < 7; ++it) {
      const int task = tid + NTHREADS * (bt * 7 + it);
      const int tl = task / 224, ch = task - tl * 224, c0 = ch * 8, t = t0 + tl;
      float pv[8], pr[8];
      unpack8(rawp[it], pv);
      unpack8(rawq[it], pr);
      if (t == 0) {
#pragma unroll
        for (int j = 0; j < 8; ++j) pr[j] = 0.f;
      } else if (t >= NP && ((t - NP) & 31) == 0) {
        const float* sp = p.in[5] + (size_t)((t - NP) >> 5) * ACOLS + c0;
        const f32x4 a = *(const f32x4*)sp, b = *(const f32x4*)(sp + 4);
        pr[0] = a[0]; pr[1] = a[1]; pr[2] = a[2]; pr[3] = a[3]; pr[4] = b[0]; pr[5] = b[1]; pr[6] = b[2]; pr[7] = b[3];
      }
      const f32x4 mu0 = *(const f32x4*)(p.in[7] + c0), mu1 = *(const f32x4*)(p.in[7] + c0 + 4);
      const float mm[8] = {mu0[0], mu0[1], mu0[2], mu0[3], mu1[0], mu1[1], mu1[2], mu1[3]};
      float xs[8];
#pragma unroll
      for (int j = 0; j < 8; ++j) xs[j] = pv[j] + (pr[j] - pv[j]) * mm[j];
      if (c0 < 512) {
        const u32x4 o = pack8(xs);
        *(u32x4*)(SR + (size_t)t * 512 + c0) = o;
        *(u32x4*)(lds + L2_R + tl * 1040 + c0 * 2) = o;
      } else if (c0 < 1024) {
        *(u32x4*)(lds + L2_K + tl * 1040 + (c0 - 512) * 2) = pack8(xs);
      } else if (c0 < 1536) {
        *(u32x4*)(SV + (size_t)t * 512 + (c0 - 1024)) = pack8(xs);
      } else {
        *(u32x4*)(lds + L2_LORA + tl * 528 + (c0 - 1536) * 2) = pack8(xs);
      }
    }
  }
  __syncthreads();
  if (tid < 256) {
    unsigned char* q = lds + L2_LORA + (tid >> 3) * 528 + (tid & 7) * 16;
    float f[8]; unpack8(*(const u32x4*)q, f);
#pragma unroll
    for (int j = 0; j < 8; ++j) { const float e = __expf(2.f * f[j]); f[j] = 1.f - 2.f * __builtin_amdgcn_rcpf(e + 1.f); }
    *(u32x4*)q = pack8(f);
  }
  {
    unsigned char* q = lds + L2_LORA + (tid >> 4) * 528 + 256 + (tid & 15) * 16;
    float f[8]; unpack8(*(const u32x4*)q, f);
#pragma unroll
    for (int j = 0; j < 8; ++j) f[j] = sigmoidf_(f[j]);
    *(u32x4*)q = pack8(f);
  }
  __syncthreads();
  const int w = wave, cb = 64 * w;
  {
    int r = (tidx() & 31);
    f32x16 acc[2];
    mm32<2, 4>(lds + L2_LORA, 528, (const bf16_t*)(ws + O_WW2) + (size_t)cb * 64, 64, lane, acc);
    const float w00 = p.in[8][cb + r], w01 = p.in[8][cb + 32 + r];
    stage_store16<2>(lds + L2A_STG + w * (32 * 144), lane, (bf16_t*)SW + (size_t)t0 * 512 + cb, 512, [&](int nt, int i) {
      const float z = (nt ? w01 : w00) + acc[nt][i];
      const float sp = fmaxf(-z, 0.f) + __logf(1.f + __expf(-fabsf(z)));
      const float dec = __expf(-__expf(-sp - 0.5f));
      return __builtin_bit_cast(unsigned short, (_Float16)dec);
    });
  }
  __syncthreads();
  {
    int r = (tidx() & 31);
    f32x16 acc[2];
    mm32<2, 4>(lds + L2_LORA + 128, 528, (const bf16_t*)(ws + O_WA2) + (size_t)cb * 64, 64, lane, acc);
    float kkv[2][16];
#pragma unroll
    for (int nt = 0; nt < 2; ++nt) {
      const int c = cb + nt * 32 + r;
      const float a0 = p.in[10][c], kkc = p.in[13][c];
#pragma unroll
      for (int i = 0; i < 16; ++i) {
        acc[nt][i] = sigmoidf_(a0 + acc[nt][i]);
        kkv[nt][i] = bf2f(*(const bf16_t*)(lds + L2_K + crow(i, h) * 1040 + c * 2)) * kkc;
      }
    }
#pragma unroll
    for (int i = 0; i < 16; ++i) {
      const float nsq = sum32(kkv[0][i] * kkv[0][i] + kkv[1][i] * kkv[1][i]);
      const float inv = __builtin_amdgcn_rsqf(fmaxf(nsq, 1e-24f));
      kkv[0][i] *= inv; kkv[1][i] *= inv;
    }
    const int c0 = cb + r, c1 = cb + 32 + r;
    const float ka0 = p.in[14][c0], ka1 = p.in[14][c1], rk0 = p.in[15][c0], rk1 = p.in[15][c1];
    unsigned char* stg = lds + L2A_STG + w * (32 * 144);
    stage_store16<2>(stg, lane, SA + (size_t)t0 * 512 + cb, 512, [&](int nt, int i) { return f2bf(-kkv[nt][i]); });
    stage_store16<2>(stg, lane, SB + (size_t)t0 * 512 + cb, 512, [&](int nt, int i) { return f2bf(kkv[nt][i] * acc[nt][i]); });
#pragma unroll
    for (int i = 0; i < 16; ++i) {
      const int tl = crow(i, h);
      const float kr0 = bf2f(*(const bf16_t*)(lds + L2_K + tl * 1040 + c0 * 2)), kr1 = bf2f(*(const bf16_t*)(lds + L2_K + tl * 1040 + c1 * 2));
      const float kh0 = kr0 * (1.f + (acc[0][i] - 1.f) * ka0), kh1 = kr1 * (1.f + (acc[1][i] - 1.f) * ka1);
      kkv[0][i] = kh0; kkv[1][i] = kh1;
      const float rr0 = bf2f(*(const bf16_t*)(lds + L2_R + tl * 1040 + c0 * 2)), rr1 = bf2f(*(const bf16_t*)(lds + L2_R + tl * 1040 + c1 * 2));
      const float sb = sum32(rr0 * kh0 * rk0 + rr1 * kh1 * rk1);
      if (r == 0) RK[(unsigned)(t0 + tl) * 8u + w] = sb;
    }
    stage_store16<2>(stg, lane, SK + (size_t)t0 * 512 + cb, 512, [&](int nt, int i) { return f2bf(kkv[nt][i]); });
  }
  __syncthreads();
  {
    int r = (tidx() & 31);
    f32x16 acc[2];
    mm32<2, 8>(lds + L2_LORA + 256, 528, (const bf16_t*)(ws + O_WG2) + (size_t)cb * 128, 128, lane, acc);
    stage_store16<2>(lds + L2A_STG + w * (32 * 144), lane, G + (size_t)t0 * 512 + cb, 512, [&](int nt, int i) { return f2bf(acc[nt][i]); });
  }
  __syncthreads();
}

DI void p2_token_tile_b(const Params& p, unsigned char* lds, int tile) {
  const int tid = tidx(), wave = __builtin_amdgcn_readfirstlane(tid >> 6), lane = tid & 63, r = lane & 31, h = lane >> 5;
  const int t0 = tile * 32;
  unsigned char* ws = p.ws;
  const bf16_t* PAB = (const bf16_t*)(ws + O_PAB);
  bf16_t* SR = (bf16_t*)(ws + O_SIN);
  bf16_t* SK = SR + (size_t)NT * 512; bf16_t* SV = SK + (size_t)NT * 512; bf16_t* SA = SV + (size_t)NT * 512; bf16_t* SB = SA + (size_t)NT * 512;
  _Float16* SW = (_Float16*)(SB + (size_t)NT * 512);
  bf16_t* G = (bf16_t*)(ws + O_G);
  float* RK = (float*)(ws + O_RK);
  const float* rope = (const float*)(ws + O_ROPE);
  {
    u32x2 vq[4]; unsigned vc[4]; float k1[4], k2[4], rc[4], rs_[4];
#pragma unroll
    for (int q = 0; q < 4; ++q) {
      const int t = t0 + wave * 4 + q;
      const bf16_t* pb = PAB + (size_t)t * PABC + ACOLS;
      vq[q] = *(const u32x2*)(pb + 4 * lane);
      vc[q] = *(const unsigned*)(pb + 256 + 2 * lane);
      k1[q] = bf2f(pb[384 + (lane & 15)]); k2[q] = bf2f(pb[400 + (lane & 15)]);
      rc[q] = rope[t * 32 + (lane & 15)]; rs_[q] = rope[t * 32 + 16 + (lane & 15)];
    }
    const f32x4 gq = *(const f32x4*)(p.in[19] + 4 * lane);
    const f32x2 gkv = *(const f32x2*)(p.in[21] + 2 * lane);
#pragma unroll
    for (int q = 0; q < 4; ++q) {
      const int tl = wave * 4 + q, t = t0 + tl;
      {
        const u32x2 v = vq[q];
        float x[4] = {__uint_as_float(v[0] << 16), __uint_as_float(v[0] & 0xffff0000u), __uint_as_float(v[1] << 16), __uint_as_float(v[1] & 0xffff0000u)};
        const float ss = wave_sum(x[0] * x[0] + x[1] * x[1] + x[2] * x[2] + x[3] * x[3]);
        const float rs = rsqrtf(ss * (1.f / 256.f) + 1e-6f);
        u32x2 o; o[0] = pk2(x[0] * rs * gq[0], x[1] * rs * gq[1]); o[1] = pk2(x[2] * rs * gq[2], x[3] * rs * gq[3]);
        *(u32x2*)(lds + L2_CQ + tl * 528 + lane * 8) = o;
      }
      {
        const unsigned v = vc[q];
        const float x0 = __uint_as_float(v << 16), x1 = __uint_as_float(v & 0xffff0000u);
        const float ss = wave_sum(x0 * x0 + x1 * x1);
        const float rs = rsqrtf(ss * (1.f / 128.f) + 1e-6f);
        const float o0 = x0 * rs * gkv[0], o1 = x1 * rs * gkv[1];
        float* dst = (t < NP) ? p.out + F_CKVP + (size_t)t * 128 : p.out + F_CKVS + (size_t)(t - NP) * 128;
        f32x2 of = {o0, o1};
        *(f32x2*)(dst + 2 * lane) = of;
        *(unsigned*)(lds + L2_CKV + tl * 272 + lane * 4) = pk2(o0, o1);
      }
      if (lane < 16) {
        const float o1 = k1[q] * rc[q] - k2[q] * rs_[q], o2 = k1[q] * rs_[q] + k2[q] * rc[q];
        float* dst = (t < NP) ? p.out + F_KPEP + (size_t)t * 32 : p.out + F_KPES + (size_t)(t - NP) * 32;
        dst[lane] = o1; dst[16 + lane] = o2;
        bf16_t* kp = (bf16_t*)(ws + O_KPEB) + (size_t)slot_of_token(t) * 32;
        kp[lane] = f2bf(o1); kp[16 + lane] = f2bf(o2);
      }
    }
  }
  __syncthreads();
  const int w = wave, cb = 64 * w;
  {
    int r = (tidx() & 31);
    f32x16 acc[3];
    mm32<3, 16>(lds + L2_CQ, 528, (const bf16_t*)(ws + O_WUQ) + (size_t)(96 * w) * 256, 256, lane, acc);
    bf16_t* Q = (bf16_t*)((unsigned char*)p.out + OO_Q);
    const int j = r & 15;
#pragma unroll
    for (int i = 0; i < 16; ++i) {
      const int t = t0 + crow(i, h);
      const float own = acc[2][i], oth = __shfl_xor(own, 16);
      const float c = rope[t * 32 + j], sn = rope[t * 32 + 16 + j];
      acc[2][i] = (r < 16) ? own * c - oth * sn : oth * sn + own * c;
    }
    stage_store16<3>(lds + L2B_STG + w * (32 * 208), lane, Q + (size_t)t0 * 768 + 96 * w, 768, [&](int nt, int i) { return f2bf(acc[nt][i] * QSCALE); });
  }
  __syncthreads();
  kv_expand(p, lds, w, lane, slot_of_token(t0));
  __syncthreads();
}

DI void p2_cache_tile(const Params& p, unsigned char* lds, int ctile) {
  const int tid = tidx(), wave = __builtin_amdgcn_readfirstlane(tid >> 6), lane = tid & 63;
  const int b = ctile >> 5, j0 = (ctile & 31) * 32;
  {
    const int row = tid >> 4, c = (tid & 15) * 8;
    const float* src = p.in[2] + ((size_t)(b * PAST + j0 + row)) * 128 + c;
    f32x4 a = *(const f32x4*)src, d = *(const f32x4*)(src + 4);
    float f[8] = {a[0], a[1], a[2], a[3], d[0], d[1], d[2], d[3]};
    *(u32x4*)(lds + L2_CKV + row * 272 + c * 2) = pack8(f);
  }
  __syncthreads();
  kv_expand(p, lds, wave, lane, NP + b * SKV + j0);
  __syncthreads();
}

DI void phase2(const Params& p, unsigned char* lds) {
  constexpr int NTT = NT / 32, NCT = DB * PAST / 32;
  {
    bf16_t* vT = (bf16_t*)((unsigned char*)p.out + OO_VT);
    for (int id = blockIdx.x * NTHREADS + tidx(); id < 8 * 64 * 64; id += gridDim.x * NTHREADS) vT[(size_t)(id >> 6) * NKVP + NKV + (id & 63)] = 0;
  }
  unsigned* ctr2 = (unsigned*)(p.ws + O_CTR) + 16;
  volatile int* s_itemp = (volatile int*)(lds + LDS_CTRL);
  for (;;) {
    if (tidx() == 0) *s_itemp = (int)atomicAdd(ctr2, 1u);
    __syncthreads();
    const int item = *s_itemp;
    __syncthreads();
    if (item >= 2 * NTT + NCT) break;
    if (item < NTT) p2_token_tile_b(p, lds, item);
    else if (item < 2 * NTT) p2_token_tile_a(p, lds, item - NTT);
    else p2_cache_tile(p, lds, item - 2 * NTT);
  }
}

constexpr int AT_KSTRIDE = 208, AT_VSTRIDE = 136, AT_KBYTES = 64 * AT_KSTRIDE, AT_STAGE = AT_KBYTES + 64 * AT_VSTRIDE;

DI void attn_item(const Params& p, unsigned char* lds, int hd, int qtok0, int nact, int slot0, int ntiles, int nvalid, bool causal) {
  const int tid = tidx(), wave = __builtin_amdgcn_readfirstlane(tid >> 6), lane = tid & 63, r = lane & 31, h = lane >> 5;
  const bf16_t* Q = (const bf16_t*)((const unsigned char*)p.out + OO_Q);
  const bf16_t* knb = (const bf16_t*)(p.ws + O_KNB) + (size_t)hd * NKVP * 64;
  const bf16_t* kpeb = (const bf16_t*)(p.ws + O_KPEB);
  const bf16_t* vT = (const bf16_t*)((const unsigned char*)p.out + OO_VT) + (size_t)hd * 64 * NKVP;
  bf16_t* YB = (bf16_t*)(p.ws + O_YB);
  const bool active = wave < nact;
  const int qtok = qtok0 + 32 * wave;
  const int wlim = !active ? 0 : (causal ? (qtok >> 6) + 1 : ntiles);
  bf16x8 qf[6];
  if (active) {
#pragma unroll
    for (int ks = 0; ks < 6; ++ks) qf[ks] = *(const bf16x8*)(Q + (size_t)(qtok + r) * 768 + 96 * hd + ks * 16 + h * 8);
  } else {
#pragma unroll
    for (int ks = 0; ks < 6; ++ks) qf[ks] = (bf16x8){0, 0, 0, 0, 0, 0, 0, 0};
  }
  f32x16 o0, o1;
#pragma unroll
  for (int i = 0; i < 16; ++i) { o0[i] = 0.f; o1[i] = 0.f; }
  float mrun = 0.f, lsum = 0.f;
  const int k_key = tid >> 3, k_ch = tid & 7;
  const int pe_key = (tid & 255) >> 2, pe_ch = tid & 3;
  const int v_dim = tid >> 3, v_ch = tid & 7;
  u32x4 rk, rpe, rv;
  auto gload = [&](int kt) {
    const int s = slot0 + kt * 64;
    rk = *(const u32x4*)(knb + (size_t)(s + k_key) * 64 + k_ch * 8);
    if (tid < 256) rpe = *(const u32x4*)(kpeb + (size_t)(s + pe_key) * 32 + pe_ch * 8);
    rv = *(const u32x4*)(vT + (size_t)v_dim * NKVP + s + v_ch * 8);
  };
  auto lstore = [&](int buf) {
    unsigned char* b = lds + buf * AT_STAGE;
    *(u32x4*)(b + k_key * AT_KSTRIDE + k_ch * 16) = rk;
    if (tid < 256) *(u32x4*)(b + pe_key * AT_KSTRIDE + 128 + pe_ch * 16) = rpe;
    u32x2 lo = {rv[0], rv[1]}, hi = {rv[2], rv[3]};
    *(u32x2*)(b + AT_KBYTES + v_dim * AT_VSTRIDE + v_ch * 16) = lo;
    *(u32x2*)(b + AT_KBYTES + v_dim * AT_VSTRIDE + v_ch * 16 + 8) = hi;
  };
  gload(0); lstore(0);
  __syncthreads();
  for (int kt = 0; kt < ntiles; ++kt) {
    const bool more = kt + 1 < ntiles;
    if (more) gload(kt + 1);
    if (kt < wlim) {
      const unsigned char* kb = lds + (kt & 1) * AT_STAGE;
      const unsigned char* vb = kb + AT_KBYTES;
      f32x16 s0, s1;
      const float nm = -mrun;
#pragma unroll
      for (int i = 0; i < 16; ++i) { s0[i] = nm; s1[i] = nm; }
#pragma unroll
      for (int ks = 0; ks < 6; ++ks) {
        const bf16x8 a0 = *(const bf16x8*)(kb + r * AT_KSTRIDE + ks * 32 + h * 16);
        const bf16x8 a1 = *(const bf16x8*)(kb + (32 + r) * AT_KSTRIDE + ks * 32 + h * 16);
        s0 = MFMA32(a0, qf[ks], s0);
        s1 = MFMA32(a1, qf[ks], s1);
      }
      if (kt * 64 + 64 > nvalid) {
#pragma unroll
        for (int i = 0; i < 16; ++i) {
          const int key = kt * 64 + crow(i, h);
          if (key >= nvalid) s0[i] = -1e30f;
          if (key + 32 >= nvalid) s1[i] = -1e30f;
        }
      }
      float mx = s0[0];
#pragma unroll
      for (int i = 1; i < 16; ++i) mx = fmaxf(mx, s0[i]);
#pragma unroll
      for (int i = 0; i < 16; ++i) mx = fmaxf(mx, s1[i]);
      mx = fmaxf(mx, __shfl_xor(mx, 32));
      const bool far = fabsf(mx) > 20.f && mx > -1e29f;
      if (__builtin_amdgcn_ballot_w64(far) != 0ull) {
        const float delta = far ? mx : 0.f;
        const float alpha = __builtin_amdgcn_exp2f(-delta);
        mrun += delta; lsum *= alpha;
#pragma unroll
        for (int i = 0; i < 16; ++i) { o0[i] *= alpha; o1[i] *= alpha; s0[i] -= delta; s1[i] -= delta; }
      }
      float rs = 0.f;
#pragma unroll
      for (int i = 0; i < 16; ++i) { s0[i] = __builtin_amdgcn_exp2f(s0[i]); rs += s0[i]; }
#pragma unroll
      for (int i = 0; i < 16; ++i) { s1[i] = __builtin_amdgcn_exp2f(s1[i]); rs += s1[i]; }
      lsum += rs;
#pragma unroll
      for (int mt = 0; mt < 2; ++mt)
#pragma unroll
        for (int s = 0; s < 2; ++s) {
          const f32x16& sv = mt ? s1 : s0;
          u32x4 pw;
          pw[0] = pk2(sv[8 * s], sv[8 * s + 1]); pw[1] = pk2(sv[8 * s + 2], sv[8 * s + 3]);
          pw[2] = pk2(sv[8 * s + 4], sv[8 * s + 5]); pw[3] = pk2(sv[8 * s + 6], sv[8 * s + 7]);
          const bf16x8 pb = __builtin_bit_cast(bf16x8, pw);
          const int kbase = mt * 32 + 16 * s + 4 * h;
          {
            const s16x4 lo = *(const s16x4*)(vb + r * AT_VSTRIDE + kbase * 2);
            const s16x4 hi = *(const s16x4*)(vb + r * AT_VSTRIDE + (kbase + 8) * 2);
            const bf16x8 av = __builtin_shufflevector(lo, hi, 0, 1, 2, 3, 4, 5, 6, 7);
            o0 = MFMA32(av, pb, o0);
          }
          {
            const s16x4 lo = *(const s16x4*)(vb + (32 + r) * AT_VSTRIDE + kbase * 2);
            const s16x4 hi = *(const s16x4*)(vb + (32 + r) * AT_VSTRIDE + (kbase + 8) * 2);
            const bf16x8 av = __builtin_shufflevector(lo, hi, 0, 1, 2, 3, 4, 5, 6, 7);
            o1 = MFMA32(av, pb, o1);
          }
        }
    }
    if (more) lstore((kt + 1) & 1);
    __syncthreads();
  }
  if (active) {
    const float lt = lsum + __shfl_xor(lsum, 32);
    const float inv = 1.f / lt;
    bf16_t* dst = YB + (size_t)(qtok + r) * 512 + hd * 64;
#pragma unroll
    for (int g = 0; g < 4; ++g) {
      u32x2 a, b;
      a[0] = pk2(o0[4 * g] * inv, o0[4 * g + 1] * inv); a[1] = pk2(o0[4 * g + 2] * inv, o0[4 * g + 3] * inv);
      b[0] = pk2(o1[4 * g] * inv, o1[4 * g + 1] * inv); b[1] = pk2(o1[4 * g + 2] * inv, o1[4 * g + 3] * inv);
      *(u32x2*)(dst + 8 * g + 4 * h) = a;
      *(u32x2*)(dst + 32 + 8 * g + 4 * h) = b;
    }
  }
}

constexpr int SC_TOK = 32, SC_ARR = SC_TOK * 64 * 4, SC_STAGE = 6 * SC_ARR;
static_assert(2 * SC_STAGE <= LDS_CTRL, "lds scan");
DI float dpp_sum8(float x) {
  x += __builtin_bit_cast(float, __builtin_amdgcn_update_dpp(0, __builtin_bit_cast(int, x), 0xB1, 0xF, 0xF, true));
  x += __builtin_bit_cast(float, __builtin_amdgcn_update_dpp(0, __builtin_bit_cast(int, x), 0x4E, 0xF, 0xF, true));
  x += __builtin_bit_cast(float, __builtin_amdgcn_update_dpp(0, __builtin_bit_cast(int, x), 0x141, 0xF, 0xF, true));
  return x;
}
DI float hsum4(f32x4 x) { return (x[0] + x[2]) + (x[1] + x[3]); }
template <bool DUAL>
DI void scan_job(const Params& p, unsigned char* lds, int head, int tok0, int nsteps, const float* init  ,
                 bf16_t* Y  , float* state_out  , bf16_t* Y2 = nullptr, float* state2 = nullptr) {
  const int tid = tidx(), wave = __builtin_amdgcn_readfirstlane(tid >> 6), lane = tid & 63;
  const bf16_t* SR = (const bf16_t*)(p.ws + O_SIN);
  const bf16_t* SK = SR + (size_t)NT * 512; const bf16_t* SV = SK + (size_t)NT * 512; const bf16_t* SA = SV + (size_t)NT * 512; const bf16_t* SB = SA + (size_t)NT * 512;
  const _Float16* SW = (const _Float16*)(SB + (size_t)NT * 512);
  u32x4 rg[3];
  auto gload = [&](int c) {
    const int tb = tok0 + c * SC_TOK;
#pragma unroll
    for (int i = 0; i < 3; ++i) {
      const int L = tid + NTHREADS * i, arr = L >> 8, tok = (L & 255) >> 3, ch = L & 7;
      const bf16_t* base = arr == 0 ? SA : arr == 1 ? SB : arr == 2 ? (const bf16_t*)SW : arr == 3 ? SK : arr == 4 ? SR : SV;
      rg[i] = *(const u32x4*)(base + (size_t)(tb + tok) * 512 + head * 64 + ch * 8);
    }
  };
  auto lstore = [&](int buf) {
    unsigned char* b = lds + buf * SC_STAGE;
#pragma unroll
    for (int i = 0; i < 3; ++i) {
      const int L = tid + NTHREADS * i, arr = L >> 8, tok = (L & 255) >> 3, ch = L & 7;
      float f[8];
      if (arr == 2) {
#pragma unroll
        for (int j = 0; j < 4; ++j) {
          const unsigned u = rg[i][j];
          f[2 * j] = (float)__builtin_bit_cast(_Float16, (unsigned short)(u & 0xffffu));
          f[2 * j + 1] = (float)__builtin_bit_cast(_Float16, (unsigned short)(u >> 16));
        }
      } else unpack8(rg[i], f);
      float* d = (float*)(b + arr * SC_ARR + tok * 256 + ch * 32);
      *(f32x4*)d = (f32x4){f[0], f[1], f[2], f[3]};
      *(f32x4*)(d + 4) = (f32x4){f[4], f[5], f[6], f[7]};
    }
  };
  const int rl = lane >> 3, c = lane & 7;
  const int vrow = 8 * wave + rl;
  f32x4 sl = {0.f, 0.f, 0.f, 0.f}, sh = {0.f, 0.f, 0.f, 0.f};
  if (init) { sl = *(const f32x4*)(init + vrow * 64 + 8 * c); sh = *(const f32x4*)(init + vrow * 64 + 8 * c + 4); }
  f32x4 tl, th;
#pragma unroll
  for (int j = 0; j < 4; ++j) { tl[j] = (8 * c + j == vrow) ? 1.f : 0.f; th[j] = (8 * c + 4 + j == vrow) ? 1.f : 0.f; }
  gload(0); lstore(0);
  __syncthreads();
  const int nch = nsteps / SC_TOK;
  for (int ci = 0; ci < nch; ++ci) {
    const bool more = ci + 1 < nch;
    if (more) gload(ci + 1);
    {
      const unsigned char* b = lds + (ci & 1) * SC_STAGE + c * 32;
      const unsigned char* bv = lds + (ci & 1) * SC_STAGE + 5 * SC_ARR + vrow * 4;
      bf16_t* yp = Y + (size_t)(tok0 + ci * SC_TOK + c) * 512 + head * 64 + vrow;
      bf16_t* yp2 = DUAL ? Y2 + (size_t)(tok0 + ci * SC_TOK + c) * 512 + head * 64 + vrow : nullptr;
      f32x4 AL[2], AH[2], BL[2], BH[2], WL[2], WH[2], KL[2], KH[2], RL[2], RH[2]; float V1[2];
#define SC_LOAD(slot, t)                                                                                                        \
      { AL[slot] = *(const f32x4*)(b + 0 * SC_ARR + (t) * 256); AH[slot] = *(const f32x4*)(b + 0 * SC_ARR + (t) * 256 + 16);    \
        BL[slot] = *(const f32x4*)(b + 1 * SC_ARR + (t) * 256); BH[slot] = *(const f32x4*)(b + 1 * SC_ARR + (t) * 256 + 16);    \
        WL[slot] = *(const f32x4*)(b + 2 * SC_ARR + (t) * 256); WH[slot] = *(const f32x4*)(b + 2 * SC_ARR + (t) * 256 + 16);    \
        KL[slot] = *(const f32x4*)(b + 3 * SC_ARR + (t) * 256); KH[slot] = *(const f32x4*)(b + 3 * SC_ARR + (t) * 256 + 16);    \
        RL[slot] = *(const f32x4*)(b + 4 * SC_ARR + (t) * 256); RH[slot] = *(const f32x4*)(b + 4 * SC_ARR + (t) * 256 + 16);    \
        V1[slot] = *(const float*)(bv + (t) * 256); }
      SC_LOAD(0, 0)
      float ysel = 0.f, ysel2 = 0.f;
#pragma unroll
      for (int t = 0; t < SC_TOK; ++t) {
        if (t + 1 < SC_TOK) SC_LOAD((t + 1) & 1, t + 1)
        const f32x4 al = AL[t & 1], ah = AH[t & 1], bl = BL[t & 1], bh = BH[t & 1], wl = WL[t & 1], wh = WH[t & 1], kl = KL[t & 1], kh = KH[t & 1], rlo = RL[t & 1], rhi = RH[t & 1];
        const float vv = V1[t & 1];
        {
          const float sa = dpp_sum8(hsum4(sl * al + sh * ah));
          sl = sl * wl + (sa * bl + vv * kl);
          sh = sh * wh + (sa * bh + vv * kh);
          const float y = dpp_sum8(hsum4(sl * rlo + sh * rhi));
          ysel = (c == (t & 7)) ? y : ysel;
          if ((t & 7) == 7) yp[(size_t)(t - 7) * 512] = f2bf(ysel);
        }
        if (DUAL) {
          const float sa = dpp_sum8(hsum4(tl * al + th * ah));
          tl = tl * wl + sa * bl;
          th = th * wh + sa * bh;
          const float y = dpp_sum8(hsum4(tl * rlo + th * rhi));
          ysel2 = (c == (t & 7)) ? y : ysel2;
          if ((t & 7) == 7) yp2[(size_t)(t - 7) * 512] = f2bf(ysel2);
        }
      }
#undef SC_LOAD
    }
    if (more) lstore((ci + 1) & 1);
    __syncthreads();
  }
  *(f32x4*)(state_out + vrow * 64 + 8 * c) = sl;
  *(f32x4*)(state_out + vrow * 64 + 8 * c + 4) = sh;
  if (DUAL) { *(f32x4*)(state2 + vrow * 64 + 8 * c) = tl; *(f32x4*)(state2 + vrow * 64 + 8 * c + 4) = th; }
}

DI void chain_item(const Params& p, unsigned char* lds, int hd, int q) {
  const int tid = tidx();
  const float* Gb = (const float*)((unsigned char*)p.out + OO_GH);
  const float* Hb = Gb + (size_t)8 * SCC * 4096;
  bf16_t* SST = (bf16_t*)((unsigned char*)p.out + OO_SST);
  float* S = (float*)lds;
  float* Gs = S + 16 * 65 + 3;
  Gs = (float*)lds + 1044;
  const int vl = tid >> 5, v = 16 * q + vl, k0 = (tid & 31) * 2;
  f32x2 cur = *(const f32x2*)(Hb + ((size_t)hd * SCC) * 4096 + v * 64 + k0);
  for (int c = 1; c < SCC; ++c) {
    const float* Gc = Gb + ((size_t)hd * SCC + c) * 4096;
    const f32x4 ga = *(const f32x4*)(Gc + tid * 8), gb2 = *(const f32x4*)(Gc + tid * 8 + 4);
    f32x2 o = *(const f32x2*)(Hb + ((size_t)hd * SCC + c) * 4096 + v * 64 + k0);
    __syncthreads();
    S[vl * 65 + k0] = cur[0]; S[vl * 65 + k0 + 1] = cur[1];
    *(f32x4*)(Gs + tid * 8) = ga; *(f32x4*)(Gs + tid * 8 + 4) = gb2;
    *(unsigned*)(SST + ((size_t)c * 8 + hd) * 4096 + v * 64 + k0) = pk2(cur[0], cur[1]);
    __syncthreads();
#pragma unroll 8
    for (int i = 0; i < 64; ++i) {
      const float sv = S[vl * 65 + i];
      const f32x2 g = *(const f32x2*)(Gs + i * 64 + k0);
      o[0] += sv * g[0]; o[1] += sv * g[1];
    }
    cur = o;
  }
  *(f32x2*)(p.out + F_WKVP + (size_t)hd * 4096 + v * 64 + k0) = cur;
}

constexpr int Q_PSCAN = 8 * SCC, Q_PATT = 512, Q_CHAIN = 32, Q_SATT = 128, Q_SSCAN = 128, Q_TOTAL = Q_PSCAN + Q_PATT + Q_CHAIN + Q_SATT + Q_SSCAN;
DI void phase3(const Params& p, unsigned char* lds) {
  volatile int* s_itemp = (volatile int*)(lds + LDS_CTRL);
  unsigned* ctr = (unsigned*)(p.ws + O_CTR);
  unsigned* sdone = ctr + 32;
  float* Gb = (float*)((unsigned char*)p.out + OO_GH);
  float* Hb = Gb + (size_t)8 * SCC * 4096;
  bf16_t* Y = (bf16_t*)(p.ws + O_Y);
  bf16_t* E = (bf16_t*)(p.ws + O_E);
  for (;;) {
    if (tidx() == 0) *s_itemp = (int)atomicAdd(ctr, 1u);
    __syncthreads();
    const int item = *s_itemp;
    __syncthreads();
    if (item >= Q_TOTAL) break;
    if (item < Q_PSCAN) {
      const int hd = item / SCC, c = item % SCC;
      if (c == 0) scan_job<false>(p, lds, hd, 0, SCL, nullptr, Y, Hb + ((size_t)hd * SCC) * 4096);
      else scan_job<true>(p, lds, hd, c * SCL, SCL, nullptr, Y, Hb + ((size_t)hd * SCC + c) * 4096, E, Gb + ((size_t)hd * SCC + c) * 4096);
      asm volatile("s_waitcnt vmcnt(0)" ::: "memory");
      __syncthreads();
      if (threadIdx.x == 0) {
        __builtin_amdgcn_fence(__ATOMIC_RELEASE, "agent");
        asm volatile("s_waitcnt vmcnt(0)" ::: "memory");
        __hip_atomic_fetch_add(sdone, 1u, __ATOMIC_RELAXED, __HIP_MEMORY_SCOPE_AGENT);
      }
    } else if (item < Q_PSCAN + Q_PATT) {
      const int k = item - Q_PSCAN, qb = 63 - (k >> 3), hd = k & 7;
      attn_item(p, lds, hd, qb * 256, 8, 0, qb * 4 + 4, (qb * 4 + 4) * 64, true);
    } else if (item < Q_PSCAN + Q_PATT + Q_CHAIN) {
      const int k = item - Q_PSCAN - Q_PATT;
      if (threadIdx.x == 0) {
        while (__hip_atomic_load(sdone, __ATOMIC_RELAXED, __HIP_MEMORY_SCOPE_AGENT) < (unsigned)Q_PSCAN) __builtin_amdgcn_s_sleep(4);
        __builtin_amdgcn_fence(__ATOMIC_ACQUIRE, "agent");
        asm volatile("s_waitcnt vmcnt(0)" ::: "memory");
      }
      __syncthreads();
      chain_item(p, lds, k & 7, k >> 3);
    } else if (item < Q_PSCAN + Q_PATT + Q_CHAIN + Q_SATT) {
      const int k = item - Q_PSCAN - Q_PATT - Q_CHAIN, b = k >> 3, hd = k & 7;
      attn_item(p, lds, hd, NP + b * 32, 1, NP + b * SKV, 17, SKV, false);
    } else {
      const int k = item - Q_PSCAN - Q_PATT - Q_CHAIN - Q_SATT, b = k >> 3, hd = k & 7;
      scan_job<false>(p, lds, hd, NP + b * 32, 32, p.in[4] + ((size_t)b * 8 + hd) * 4096, Y, p.out + F_WKVS + ((size_t)b * 8 + hd) * 4096);
    }
  }
}

DI void phase4a(const Params& p) {
  const int tid = tidx(), lane = tid & 63, r = lane & 31, hh = lane >> 5;
  const int gw = (blockIdx.x * NTHREADS + tid) >> 6, ngw = (gridDim.x * NTHREADS) >> 6;
  const bf16_t* Y = (const bf16_t*)(p.ws + O_Y);
  const bf16_t* E = (const bf16_t*)(p.ws + O_E);
  const bf16_t* SST = (const bf16_t*)((unsigned char*)p.out + OO_SST);
  const bf16_t* SV = (const bf16_t*)(p.ws + O_SIN) + 2 * (size_t)NT * 512;
  const bf16_t* G = (const bf16_t*)(p.ws + O_G);
  const float* RK = (const float*)(p.ws + O_RK);
  bf16_t* YA = (bf16_t*)(p.ws + O_YA);
  for (int task = gw; task < (NT / 32) * 8; task += ngw) {
    const int tile = task >> 3, hd = task & 7, t0 = tile * 32, t = t0 + r;
    f32x16 acc[2];
#pragma unroll
    for (int i = 0; i < 16; ++i) { acc[0][i] = 0.f; acc[1][i] = 0.f; }
    const int c = t0 < NP ? t0 / SCL : 0;
    if (c >= 1) {
      const bf16_t* sst = SST + ((size_t)c * 8 + hd) * 4096;
#pragma unroll
      for (int ks = 0; ks < 4; ++ks) {
        const bf16x8 bv = *(const bf16x8*)(E + (size_t)t * 512 + hd * 64 + ks * 16 + hh * 8);
#pragma unroll
        for (int mt = 0; mt < 2; ++mt) {
          const bf16x8 av = *(const bf16x8*)(sst + (mt * 32 + r) * 64 + ks * 16 + hh * 8);
          acc[mt] = MFMA32(av, bv, acc[mt]);
        }
      }
    }
    float sum = 0.f;
#pragma unroll
    for (int mt = 0; mt < 2; ++mt)
#pragma unroll
      for (int g = 0; g < 4; ++g) {
        const u32x2 yv = *(const u32x2*)(Y + (size_t)t * 512 + hd * 64 + mt * 32 + 8 * g + 4 * hh);
        acc[mt][4 * g] += __uint_as_float(yv[0] << 16); acc[mt][4 * g + 1] += __uint_as_float(yv[0] & 0xffff0000u);
        acc[mt][4 * g + 2] += __uint_as_float(yv[1] << 16); acc[mt][4 * g + 3] += __uint_as_float(yv[1] & 0xffff0000u);
        sum += (acc[mt][4 * g] + acc[mt][4 * g + 1]) + (acc[mt][4 * g + 2] + acc[mt][4 * g + 3]);
      }
    sum += __shfl_xor(sum, 32);
    const float mean = sum * (1.f / 64.f);
    float sq = 0.f;
#pragma unroll
    for (int mt = 0; mt < 2; ++mt)
#pragma unroll
      for (int i = 0; i < 16; ++i) { const float d = acc[mt][i] - mean; sq += d * d; }
    sq += __shfl_xor(sq, 32);
    const float rstd = rsqrtf(sq * (1.f / 64.f) + 64e-5f);
    const float bon = RK[(size_t)t * 8 + hd];
#pragma unroll
    for (int mt = 0; mt < 2; ++mt)
#pragma unroll
      for (int g = 0; g < 4; ++g) {
        const int c0 = hd * 64 + mt * 32 + 8 * g + 4 * hh;
        const size_t o = (size_t)t * 512 + c0;
        const f32x4 lg = *(const f32x4*)(p.in[16] + c0), lb = *(const f32x4*)(p.in[17] + c0);
        const u32x2 vv = *(const u32x2*)(SV + o), gg = *(const u32x2*)(G + o);
        const float vf[4] = {__uint_as_float(vv[0] << 16), __uint_as_float(vv[0] & 0xffff0000u), __uint_as_float(vv[1] << 16), __uint_as_float(vv[1] & 0xffff0000u)};
        const float gf[4] = {__uint_as_float(gg[0] << 16), __uint_as_float(gg[0] & 0xffff0000u), __uint_as_float(gg[1] << 16), __uint_as_float(gg[1] & 0xffff0000u)};
        float ov[4];
#pragma unroll
        for (int j = 0; j < 4; ++j) ov[j] = ((acc[mt][4 * g + j] - mean) * rstd * lg[j] + lb[j] + bon * vf[j]) * gf[j];
        u32x2 w; w[0] = pk2(ov[0], ov[1]); w[1] = pk2(ov[2], ov[3]);
        *(u32x2*)(YA + o) = w;
      }
  }
  conv_x(p, (bf16_t*)((unsigned char*)p.out + OO_XB), blockIdx.x * NTHREADS + tidx(), gridDim.x * NTHREADS);
}

DI bool small_tile_of_block(int& m0, int& n0) {
  const int j = blockIdx.x >> 3;
  if (gridDim.x != 256 || (blockIdx.x & 7) != (j & 7)) return false;
  m0 = NP + (j >> 3) * 128; n0 = (j & 7) * 128; return true;
}
template <int TM>
DI void p4_tile(const Params& p, unsigned char* lds, int m0, int n0) {
  const bf16_t* XB = (const bf16_t*)((unsigned char*)p.out + OO_XB);
  const bf16_t* WIN = (const bf16_t*)(p.ws + O_WIN);
  const bf16_t* YA = (const bf16_t*)(p.ws + O_YA);
  const bf16_t* YB = (const bf16_t*)(p.ws + O_YB);
  bf16_t* M = (bf16_t*)(p.ws + O_M);
  const int tid = tidx(), lane = tid & 63, h = lane >> 5, wn = __builtin_amdgcn_readfirstlane(tid >> 6) >> 2;
  f32x16 accg[TM][2], accv[TM][2];
  gemm_mainloop<TM, 2>(YB, 512, (const bf16_t*)(p.ws + O_WPB), 512, 512, m0, n0, 1024, accv, lds);
  gemm_mainloop<TM, 2>(XB, DM, WIN + (size_t)(PABC + 1024) * DM, DM, DM, m0, n0, 1024, accg, lds);
#pragma unroll
  for (int tn = 0; tn < 2; ++tn)
#pragma unroll
    for (int g = 0; g < 4; ++g) {
      const f32x4 bg = *(const f32x4*)(p.in[24] + 1024 + n0 + wn * 64 + tn * 32 + 8 * g + 4 * h);
#pragma unroll
      for (int tm = 0; tm < TM; ++tm)
#pragma unroll
        for (int j = 0; j < 4; ++j) accv[tm][tn][4 * g + j] *= sigmoidf_(accg[tm][tn][4 * g + j] + bg[j]);
      __builtin_amdgcn_sched_barrier(0);
    }
  gemm_mainloop<TM, 2>(XB, DM, WIN + (size_t)PABC * DM, DM, DM, m0, n0, 1024, accg, lds);
#pragma unroll
  for (int tn = 0; tn < 2; ++tn)
#pragma unroll
    for (int g = 0; g < 4; ++g) {
      const f32x4 bg = *(const f32x4*)(p.in[24] + n0 + wn * 64 + tn * 32 + 8 * g + 4 * h);
#pragma unroll
      for (int tm = 0; tm < TM; ++tm)
#pragma unroll
        for (int j = 0; j < 4; ++j) {
          const float e = __expf(-(accg[tm][tn][4 * g + j] + bg[j]));
          accv[tm][tn][4 * g + j] *= (1.f + e);
          accg[tm][tn][4 * g + j] = __builtin_amdgcn_rcpf(1.f + e);
        }
      __builtin_amdgcn_sched_barrier(0);
    }
  gemm_mainloop<TM, 2, false>(YA, 512, (const bf16_t*)(p.ws + O_WPA), 512, 512, m0, n0, 1024, accv, lds);
  epilogue_bf16<TM, 2, 128>(accv, lds, M, DM, m0, n0, DM, [&](int tm, int tn, int g, int, int) { return acc4(accg[tm][tn], g) * acc4(accv[tm][tn], g); });
}
DI void phase4(const Params& p, unsigned char* lds) {
  if (gridDim.x == 256) {
    TileIter ti; ti.init(NP / 256, 8);
    int tmi, tni;
    while (ti.next(tmi, tni)) p4_tile<2>(p, lds, tmi * 256, tni * 128);
    int m0, n0;
    if (small_tile_of_block(m0, n0)) p4_tile<1>(p, lds, m0, n0);
  } else {
    TileIter ti; ti.init(NT / 128, 8);
    int tmi, tni;
    while (ti.next(tmi, tni)) p4_tile<1>(p, lds, tmi * 128, tni * 128);
  }
}

template <int TM, int TN, int NST>
DI void p5_tile(const Params& p, unsigned char* lds, int m0, int n0) {
  const bf16_t* M = (const bf16_t*)(p.ws + O_M);
  bf16_t* Z = (bf16_t*)(p.ws + O_Z);
  f32x16 acc[TM][TN];
  gemm_mainloop<TM, TN, true, NST>(M, DM, (const bf16_t*)(p.ws + O_WO), DM, DM, m0, n0, 1024, acc, lds);
  epilogue_bf16<TM, TN, 64 * TN>(acc, lds, Z, DM, m0, n0, DM, [&](int tm, int tn, int g, int rowl, int coll) {
    const f32x4 xv = *(const f32x4*)(xrow(p, m0 + rowl) + n0 + coll);
    return xv * DN_ALPHA + acc4(acc[tm][tn], g);
  });
}
DI void phase5(const Params& p, unsigned char* lds) {
  if (gridDim.x == 256) {
    TileIter ti; ti.init(NP / 256, 4);
    int tmi, tni;
    while (ti.next(tmi, tni)) p5_tile<2, 4, 2>(p, lds, tmi * 256, tni * 256);
    int m0, n0;
    if (small_tile_of_block(m0, n0)) p5_tile<1, 2, 3>(p, lds, m0, n0);
  } else {
    TileIter ti; ti.init(NT / 256, 8);
    int tmi, tni;
    while (ti.next(tmi, tni)) p5_tile<2, 2, 3>(p, lds, tmi * 256, tni * 128);
  }
}
template <bool OUT_BF16>
DI void ln_rows(const bf16_t* src, const float* g, const float* b, bf16_t* dst16, float* dst32) {
  const int gw = (blockIdx.x * NTHREADS + tidx()) >> 6, ngw = (gridDim.x * NTHREADS) >> 6, lane = tidx() & 63;
  for (int t = gw; t < NT; t += ngw) {
    const u32x4* xr = (const u32x4*)(src + (size_t)t * DM) + lane;
    float v[16]; float s = 0.f;
#pragma unroll
    for (int j = 0; j < 2; ++j) { unpack8(xr[64 * j], v + 8 * j); }
#pragma unroll
    for (int j = 0; j < 16; ++j) s += v[j];
    const float mean = wave_sum(s) * (1.f / DM);
    float s2 = 0.f;
#pragma unroll
    for (int j = 0; j < 16; ++j) { v[j] -= mean; s2 += v[j] * v[j]; }
    const float rstd = rsqrtf(wave_sum(s2) * (1.f / DM) + 1e-5f);
#pragma unroll
    for (int j = 0; j < 2; ++j) {
      const int c = 8 * lane + 512 * j;
      const f32x4 g0 = *(const f32x4*)(g + c), g1 = *(const f32x4*)(g + c + 4), b0 = *(const f32x4*)(b + c), b1 = *(const f32x4*)(b + c + 4);
      float o[8];
#pragma unroll
      for (int q = 0; q < 4; ++q) { o[q] = v[8 * j + q] * rstd * g0[q] + b0[q]; o[4 + q] = v[8 * j + 4 + q] * rstd * g1[q] + b1[q]; }
      if (OUT_BF16) *(u32x4*)(dst16 + (size_t)t * DM + c) = pack8(o);
      else { *(f32x4*)(dst32 + (size_t)t * DM + c) = (f32x4){o[0], o[1], o[2], o[3]}; *(f32x4*)(dst32 + (size_t)t * DM + c + 4) = (f32x4){o[4], o[5], o[6], o[7]}; }
    }
  }
}

DI void phase6(const Params& p, unsigned char* lds) {
  const bf16_t* H = (const bf16_t*)(p.ws + O_H);
  bf16_t* ACT = (bf16_t*)(p.ws + O_ACT);
  constexpr int NMT = NT / 256, NNT = 5632 / 256;
  TileIter ti; ti.init(NMT, NNT);
  int tmi, tni;
  while (ti.next(tmi, tni)) {
    const int m0 = tmi * 256, n0 = tni * 256;
    f32x16 acc[2][4];
    gemm_mainloop<2, 4, true, 2>(H, DM, (const bf16_t*)(p.ws + O_WGU), DM, DM, m0, n0, 5632, acc, lds);
    epilogue_bf16<2, 4, 128>(acc, lds, ACT, DFF, m0, tni * 128, DFF, [&](int tm, int q, int g, int, int) {
      f32x4 o;
#pragma unroll
      for (int j = 0; j < 4; ++j) { const float gte = acc[tm][2 * q][4 * g + j], up = acc[tm][2 * q + 1][4 * g + j]; o[j] = gte * sigmoidf_(gte) * up; }
      return o;
    });
  }
}
template <int TM, int TN, int NST>
DI void p7_tile(const Params& p, unsigned char* lds, int m0, int n0) {
  const bf16_t* H = (const bf16_t*)(p.ws + O_H);
  const bf16_t* ACT = (const bf16_t*)(p.ws + O_ACT);
  bf16_t* Z2 = (bf16_t*)(p.ws + O_Z2);
  f32x16 acc[TM][TN];
  gemm_mainloop<TM, TN, true, NST>(ACT, DFF, (const bf16_t*)(p.ws + O_WDN), DFF, DFF, m0, n0, 1024, acc, lds);
  epilogue_bf16<TM, TN, 64 * TN>(acc, lds, Z2, DM, m0, n0, DM, [&](int tm, int tn, int g, int rowl, int coll) {
    const u32x2 hv = *(const u32x2*)(H + (size_t)(m0 + rowl) * DM + n0 + coll);
    const f32x4 hf = {__uint_as_float(hv[0] << 16), __uint_as_float(hv[0] & 0xffff0000u), __uint_as_float(hv[1] << 16), __uint_as_float(hv[1] & 0xffff0000u)};
    return hf * DN_ALPHA + acc4(acc[tm][tn], g);
  });
}
DI void phase7(const Params& p, unsigned char* lds) {
  if (gridDim.x == 256) {
    TileIter ti; ti.init(NP / 256, 4);
    int tmi, tni;
    while (ti.next(tmi, tni)) p7_tile<2, 4, 2>(p, lds, tmi * 256, tni * 256);
    int m0, n0;
    if (small_tile_of_block(m0, n0)) p7_tile<1, 2, 3>(p, lds, m0, n0);
  } else {
    TileIter ti; ti.init(NT / 256, 8);
    int tmi, tni;
    while (ti.next(tmi, tni)) p7_tile<2, 2, 3>(p, lds, tmi * 256, tni * 128);
  }
}

DI void run_phase(const Params& p, unsigned char* lds, int ph) {
  switch (ph) {
    case 0: phase0(p, lds); break;
    case 1: phase1(p, lds); break;
    case 2: phase2(p, lds); break;
    case 3: phase3(p, lds); break;
    case 4: phase4a(p); break;
    case 5: phase4(p, lds); break;
    case 6: phase5(p, lds); break;
    case 7: ln_rows<true>((const bf16_t*)(p.ws + O_Z), p.in[26], p.in[27], (bf16_t*)(p.ws + O_H), nullptr); break;
    case 8: phase6(p, lds); break;
    case 9: phase7(p, lds); break;
    case 10: ln_rows<false>((const bf16_t*)(p.ws + O_Z2), p.in[30], p.in[31], nullptr, p.out + F_Y); break;
  }
}
constexpr int NPHASES = 11;

DI unsigned ctl_ld(unsigned* p) { return __hip_atomic_load(p, __ATOMIC_RELAXED, __HIP_MEMORY_SCOPE_AGENT); }
DI unsigned ctl_add(unsigned* p, unsigned v) { return __hip_atomic_fetch_add(p, v, __ATOMIC_RELAXED, __HIP_MEMORY_SCOPE_AGENT); }
DI void xbar(unsigned* ctl, unsigned x, unsigned nloc, unsigned nx, unsigned k) {
  asm volatile("s_waitcnt vmcnt(0)" ::: "memory");
  __syncthreads();
  if (threadIdx.x == 0) {
    const unsigned old = ctl_add(&ctl[(24 + x) * 64], 1u);
    if (old + 1u == k * nloc) {
      __builtin_amdgcn_fence(__ATOMIC_RELEASE, "agent");
      asm volatile("s_waitcnt vmcnt(0)" ::: "memory");
      ctl_add(&ctl[40 * 64], 1u);
    }
    while (ctl_ld(&ctl[40 * 64]) < k * nx) __builtin_amdgcn_s_sleep(1);
    __builtin_amdgcn_fence(__ATOMIC_ACQUIRE, "agent");
    asm volatile("s_waitcnt vmcnt(0)" ::: "memory");
  }
  __syncthreads();
}

__global__ void __launch_bounds__(NTHREADS) mega_kernel(Params p) {
  extern __shared__ __attribute__((aligned(16))) unsigned char lds[];
  volatile unsigned* s_bar = (volatile unsigned*)(lds + LDS_CTRL + 16);
  cg::grid_group grid = cg::this_grid();
  unsigned* ctl = (unsigned*)(p.ws + O_CTR);
  const unsigned x = (unsigned)__builtin_amdgcn_s_getreg((3 << 11) | 20) & 0xFu;
  if (threadIdx.x == 0) ctl_add(&ctl[(8 + x) * 64], 1u);
  run_phase(p, lds, 0); grid.sync();
  if (threadIdx.x == 0) {
    unsigned nx = 0;
    for (int i = 0; i < 16; ++i) nx += ctl_ld(&ctl[(8 + i) * 64]) != 0u ? 1u : 0u;
    s_bar[0] = ctl_ld(&ctl[(8 + x) * 64]); s_bar[1] = nx;
  }
  __syncthreads();
  const unsigned nloc = __builtin_amdgcn_readfirstlane(s_bar[0]), nx = __builtin_amdgcn_readfirstlane(s_bar[1]);
  run_phase(p, lds, 1); xbar(ctl, x, nloc, nx, 1);
  run_phase(p, lds, 2); xbar(ctl, x, nloc, nx, 2);
  run_phase(p, lds, 3); xbar(ctl, x, nloc, nx, 3);
  run_phase(p, lds, 4); xbar(ctl, x, nloc, nx, 4);
  run_phase(p, lds, 5); xbar(ctl, x, nloc, nx, 5);
  run_phase(p, lds, 6); xbar(ctl, x, nloc, nx, 6);
  run_phase(p, lds, 7); xbar(ctl, x, nloc, nx, 7);
  run_phase(p, lds, 8); xbar(ctl, x, nloc, nx, 8);
  run_phase(p, lds, 9); xbar(ctl, x, nloc, nx, 9);
  run_phase(p, lds, 10);
}
template <int PH> __global__ void __launch_bounds__(NTHREADS) phase_kernel(Params p) {
  extern __shared__ __attribute__((aligned(16))) unsigned char lds[];
  run_phase(p, lds, PH);
}
template <int PH> static void launch_phase(const Params& p, int grid, hipStream_t stream) {
  (void)hipFuncSetAttribute((const void*)phase_kernel<PH>, hipFuncAttributeMaxDynamicSharedMemorySize, LDS_BYTES);
  hipLaunchKernelGGL(phase_kernel<PH>, dim3(grid), dim3(NTHREADS), LDS_BYTES, stream, p);
}

extern "C" void kernel_launch(void* const* d_in, const int* in_sizes, int n_in, void* d_out, int out_size, void* d_ws, size_t ws_size, hipStream_t stream) {
  static int grid_blocks = 0;
  if (grid_blocks == 0) {
    if (n_in != 32 || ws_size < WS_END) { fprintf(stderr, "kernel_launch: unexpected n_in %d or ws_size %zu (< %zu)\n", n_in, ws_size, (size_t)WS_END); grid_blocks = -1; return; }
    int dev = 0, cus = 0, per_cu = 0;
    (void)hipGetDevice(&dev);
    (void)hipDeviceGetAttribute(&cus, hipDeviceAttributeMultiprocessorCount, dev);
#if MULTI_LAUNCH
    per_cu = 1;
#else
    (void)hipFuncSetAttribute((const void*)mega_kernel, hipFuncAttributeMaxDynamicSharedMemorySize, LDS_BYTES);
    (void)hipOccupancyMaxActiveBlocksPerMultiprocessor(&per_cu, (const void*)mega_kernel, NTHREADS, LDS_BYTES);
#endif
    if (per_cu < 1) { fprintf(stderr, "kernel_launch: occupancy query gave %d\n", per_cu); grid_blocks = -1; return; }
    grid_blocks = cus;
  }
  if (grid_blocks < 0) return;
  Params p{};
  for (int i = 0; i < 32; ++i) p.in[i] = (const float*)d_in[i];
  p.out = (float*)d_out;
  p.ws = (unsigned char*)d_ws;
#if MULTI_LAUNCH
  launch_phase<0>(p, grid_blocks, stream); launch_phase<1>(p, grid_blocks, stream); launch_phase<2>(p, grid_blocks, stream); launch_phase<3>(p, grid_blocks, stream);
  launch_phase<4>(p, grid_blocks, stream); launch_phase<5>(p, grid_blocks, stream); launch_phase<6>(p, grid_blocks, stream); launch_phase<7>(p, grid_blocks, stream);
  launch_phase<8>(p, grid_blocks, stream); launch_phase<9>(p, grid_blocks, stream); launch_phase<10>(p, grid_blocks, stream);
#else
  (void)hipMemsetAsync((unsigned char*)d_ws + O_CTR, 0, 16384, stream);
  void* args[] = {&p};
  hipError_t e = hipLaunchCooperativeKernel((void*)mega_kernel, dim3(grid_blocks), dim3(NTHREADS), args, LDS_BYTES, stream);
  if (e != hipSuccess) fprintf(stderr, "cooperative launch failed: %s (grid %d)\n", hipGetErrorString(e), grid_blocks);
#endif
}
```
